# Optimizing an MI355X kernel written in HIP

```python
import math
import jax, jax.numpy as jnp
from jax import lax
import numpy as np

D_MODEL = 1024
BATCH = 2
SEQ = 8192
DEPTH = 2
DEC_BATCH = 128
DEC_SEQ = 4
PAST_LEN = 8192
PAGE_SIZE = 128

N_EVEN = (DEPTH + 1) // 2
N_ODD = DEPTH // 2
N_MOD = 9
EPS = 1e-6
NEG = -1e30
GLA_HEADS = 4
GLA_DK = D_MODEL // 16
GLA_DV = D_MODEL // 8
GLA_GATE_RANK = 16
GLA_TAU = 16.0
GLA_CHUNK = 64
POOL_WINDOWS = (2, 4, 8, 16)
POOL_GROUP = D_MODEL // 8
POOL_WIDTH = len(POOL_WINDOWS) * POOL_GROUP
POOL_HIST = max(POOL_WINDOWS) - 1
MLA_HEADS = 8
MLA_Q_RANK = 3 * D_MODEL // 8
MLA_KV_RANK = D_MODEL // 4
MLA_NOPE = D_MODEL // 16
MLA_ROPE = D_MODEL // 32
MLA_V = D_MODEL // 16
MLA_SCALE = (MLA_NOPE + MLA_ROPE) ** -0.5
ROPE_BASE = 10000.0
Q_BLOCK = 128
CONV_WIDTH = 31
CONV_CH = D_MODEL // 2
CONV_HIST = CONV_WIDTH - 1
D_FF = 2816
EV_IN_SIZES = (GLA_HEADS * GLA_DK, GLA_HEADS * GLA_DK, GLA_HEADS * GLA_DV, GLA_HEADS * GLA_DV, GLA_GATE_RANK, POOL_WIDTH)
EV_IN = sum(EV_IN_SIZES)
EV_OUT = GLA_HEADS * GLA_DV + POOL_WIDTH
OD_IN_SIZES = (MLA_Q_RANK, MLA_KV_RANK, MLA_ROPE, 2 * CONV_CH)
OD_IN = sum(OD_IN_SIZES)
OD_OUT = MLA_HEADS * MLA_V + CONV_CH

kernel_name = 'hybrid_gla_pool_mla_conv_decoder_step'


def split_cols(z, sizes):
    idx = np.cumsum(sizes)[:-1].tolist()
    return jnp.split(z, idx, axis=-1)


def rmsnorm(x, g):
    xf = x.astype(jnp.float32)
    y = xf * lax.rsqrt(jnp.mean(xf * xf, axis=-1, keepdims=True) + EPS)
    return (y * g.astype(jnp.float32)).astype(x.dtype)


def layernorm(x, g, b):
    xf = x.astype(jnp.float32)
    mu = jnp.mean(xf, axis=-1, keepdims=True)
    var = jnp.mean(jnp.square(xf - mu), axis=-1, keepdims=True)
    y = (xf - mu) * lax.rsqrt(var + EPS)
    return (y * g.astype(jnp.float32) + b.astype(jnp.float32)).astype(x.dtype)


def rope(x, pos):
    half = x.shape[-1] // 2
    freqs = ROPE_BASE ** (-jnp.arange(half, dtype=jnp.float32) / half)
    ang = pos.astype(jnp.float32)[:, None] * freqs[None, :]
    shape = (pos.shape[0],) + (1,) * (x.ndim - 3) + (half,)
    cos = jnp.cos(ang).reshape(shape)
    sin = jnp.sin(ang).reshape(shape)
    xf = x.astype(jnp.float32)
    x1, x2 = xf[..., :half], xf[..., half:]
    return jnp.concatenate([x1 * cos - x2 * sin, x2 * cos + x1 * sin], axis=-1).astype(x.dtype)


def modulate(x, g, shift, scale):
    return rmsnorm(x, g) * (1.0 + scale[:, None, :]) + shift[:, None, :]


def swiglu(h, w1, w3, w2):
    return (jax.nn.silu(h @ w1) * (h @ w3)) @ w2


def gla_recurrence(q, k, v, log_a, s0):
    B, T, H, _ = q.shape
    DV = v.shape[-1]
    C = GLA_CHUNK if T % GLA_CHUNK == 0 else T
    n = T // C

    def chunks(t):
        return t.astype(jnp.float32).reshape(B, n, C, H, t.shape[-1]).transpose(1, 0, 3, 2, 4)

    causal = jnp.tril(jnp.ones((C, C), dtype=bool))

    def step(S, inp):
        qc, kc, vc, ac = inp
        b = jnp.cumsum(ac, axis=2)
        b_last = b[:, :, -1:, :]
        qi = qc * jnp.exp(b)
        ki = kc * jnp.exp(-b)
        att = jnp.where(causal, jnp.einsum('bhtk,bhsk->bhts', qi, ki), 0.0)
        o = jnp.einsum('bhtk,bhkv->bhtv', qi, S) + jnp.einsum('bhts,bhsv->bhtv', att, vc)
        S = jnp.exp(b_last)[:, :, 0, :, None] * S + jnp.einsum('bhsk,bhsv->bhkv', kc * jnp.exp(b_last - b), vc)
        return S, o

    S, o = lax.scan(step, s0.astype(jnp.float32), (chunks(q), chunks(k), chunks(v), chunks(log_a)))
    o = o.transpose(1, 0, 3, 2, 4).reshape(B, T, H, DV)
    return o.astype(v.dtype), S.astype(s0.dtype)


def pool_mix(u, hist, p0, pool_w, pool_scale):
    B, T, _ = u.shape
    L = POOL_HIST
    full = jnp.concatenate([hist, u], axis=1)
    cs = jnp.cumsum(full.astype(jnp.float32), axis=1)
    cs = jnp.concatenate([jnp.zeros((B, 1, POOL_WIDTH), jnp.float32), cs], axis=1)
    t = jnp.arange(T)
    means = []
    for g, w in enumerate(POOL_WINDOWS):
        sl = slice(g * POOL_GROUP, (g + 1) * POOL_GROUP)
        win = cs[:, L + 1:, sl] - cs[:, L + 1 - w:L + 1 - w + T, sl]
        cnt = jnp.minimum(p0 + t + 1, w).astype(jnp.float32)
        means.append(win / cnt[None, :, None])
    pooled = jnp.concatenate(means, axis=-1).astype(u.dtype) - u
    mixed = jnp.einsum('btgc,gcd->btgd', pooled.reshape(B, T, len(POOL_WINDOWS), POOL_GROUP), pool_w)
    return mixed.reshape(B, T, POOL_WIDTH) * pool_scale, full[:, -L:]


def even_mixer(h, s0, hist, p0, w_in, gate_w2, gate_b, out_norm, pool_w, pool_scale, w_out):
    B, T, _ = h.shape
    q, k, v, r, g_low, u = split_cols(h @ w_in, EV_IN_SIZES)
    log_a = jax.nn.log_sigmoid((g_low @ gate_w2 + gate_b).astype(jnp.float32)) / GLA_TAU
    hd = lambda t, d: t.reshape(B, T, GLA_HEADS, d)
    o, S = gla_recurrence(hd(q, GLA_DK) * (GLA_DK ** -0.5), hd(k, GLA_DK), hd(v, GLA_DV), hd(log_a, GLA_DK), s0)
    o = rmsnorm(o, out_norm.reshape(GLA_HEADS, GLA_DV)).reshape(B, T, GLA_HEADS * GLA_DV) * jax.nn.silu(r)
    pooled, hist_new = pool_mix(u, hist, p0, pool_w, pool_scale)
    y = jnp.concatenate([o, pooled], axis=-1) @ w_out
    return y, S, hist_new


def mla_scores(q_lat, q_rope, ckv, kr):
    s = jnp.einsum('bqhr,bkr->bhqk', q_lat, ckv, preferred_element_type=jnp.float32)
    s = s + jnp.einsum('bqhd,bkd->bhqk', q_rope, kr, preferred_element_type=jnp.float32)
    return s * MLA_SCALE


def mla_prompt(q_lat, q_rope, ckv, kr):
    B, T, H, R = q_lat.shape
    blk = Q_BLOCK if T % Q_BLOCK == 0 else T
    nb = T // blk
    kpos = jnp.arange(T)

    def one(args):
        ql, qr, qpos = args
        s = mla_scores(ql, qr, ckv, kr)
        s = jnp.where(kpos[None, :] <= qpos[:, None], s, NEG)
        p = jax.nn.softmax(s, axis=-1).astype(ckv.dtype)
        return jnp.einsum('bhqk,bkr->bqhr', p, ckv)

    to_blocks = lambda t: t.reshape((B, nb, blk) + t.shape[2:]).swapaxes(0, 1)
    out = lax.map(one, (to_blocks(q_lat), to_blocks(q_rope), kpos.reshape(nb, blk)))
    return out.swapaxes(0, 1).reshape(B, T, H, R)


def mla_sample(q_lat, q_rope, ckv, kr, past_ckv, past_kr):
    T = q_lat.shape[1]
    P = past_ckv.shape[1]
    s_past = mla_scores(q_lat, q_rope, past_ckv, past_kr)
    s_new = mla_scores(q_lat, q_rope, ckv, kr)
    s_new = jnp.where(jnp.tril(jnp.ones((T, T), dtype=bool)), s_new, NEG)
    p = jax.nn.softmax(jnp.concatenate([s_past, s_new], axis=-1), axis=-1).astype(ckv.dtype)
    return (jnp.einsum('bhqk,bkr->bqhr', p[..., :P], past_ckv)
            + jnp.einsum('bhqk,bkr->bqhr', p[..., P:], ckv))


def odd_mixer(h, conv_hist, p0, past, w_in, q_norm, w_uq, kv_norm, w_uk, w_uv,
              conv_w, conv_b, conv_norm_g, conv_norm_b, w_out):
    B, T, _ = h.shape
    cq, ckv_raw, kr_raw, glu = split_cols(h @ w_in, OD_IN_SIZES)
    pos = p0 + jnp.arange(T)
    q = (rmsnorm(cq, q_norm) @ w_uq).reshape(B, T, MLA_HEADS, MLA_NOPE + MLA_ROPE)
    q_nope, q_rope = q[..., :MLA_NOPE], rope(q[..., MLA_NOPE:], pos)
    q_lat = jnp.einsum('bthd,rhd->bthr', q_nope, w_uk)
    ckv = rmsnorm(ckv_raw, kv_norm)
    kr = rope(kr_raw, pos)
    if past is None:
        lat = mla_prompt(q_lat, q_rope, ckv, kr)
    else:
        lat = mla_sample(q_lat, q_rope, ckv, kr, past[0], past[1])
    attn = jnp.einsum('bthr,rhv->bthv', lat, w_uv).reshape(B, T, MLA_HEADS * MLA_V)
    a, gt = jnp.split(glu, 2, axis=-1)
    u = a * jax.nn.sigmoid(gt)
    full = jnp.concatenate([conv_hist, u], axis=1)
    cv = lax.conv_general_dilated(full, conv_w[:, None, :], window_strides=(1,), padding='VALID',
                                  dimension_numbers=('NWC', 'WIO', 'NWC'), feature_group_count=CONV_CH)
    cv = jax.nn.silu(layernorm(cv + conv_b, conv_norm_g, conv_norm_b))
    y = jnp.concatenate([attn, cv], axis=-1) @ w_out
    return y, ckv, kr, full[:, -CONV_HIST:]


def forward(x, c, p0, gla_init, pool_init, conv_init, mla_past, p):
    B = x.shape[0]
    new_gla, new_pool, new_ckv, new_kr, new_conv = [], [], [], [], []
    for layer in range(DEPTH):
        mod = (jax.nn.silu(c) @ p['ada_w'][layer] + p['ada_b'][layer]).reshape(B, N_MOD, D_MODEL)
        h = modulate(x, p['norm_g'][layer, 0], mod[:, 0], mod[:, 1])
        x = x + 0.5 * mod[:, 2][:, None, :] * swiglu(h, p['ffn_w1'][layer, 0], p['ffn_w3'][layer, 0], p['ffn_w2'][layer, 0])
        h = modulate(x, p['norm_g'][layer, 1], mod[:, 3], mod[:, 4])
        i = layer // 2
        if layer % 2 == 0:
            y, S, hist = even_mixer(h, gla_init[i], pool_init[i], p0, p['ev_w_in'][i], p['ev_gate_w2'][i], p['ev_gate_b'][i],
                                    p['ev_out_norm'][i], p['ev_pool_w'][i], p['ev_pool_scale'][i], p['ev_w_out'][i])
            new_gla.append(S)
            new_pool.append(hist)
        else:
            past = None if mla_past is None else mla_past[i]
            y, ckv, kr, chist = odd_mixer(h, conv_init[i], p0, past, p['od_w_in'][i], p['od_q_norm'][i], p['od_w_uq'][i],
                                          p['od_kv_norm'][i], p['od_w_uk'][i], p['od_w_uv'][i], p['od_conv_w'][i],
                                          p['od_conv_b'][i], p['od_conv_norm_g'][i], p['od_conv_norm_b'][i], p['od_w_out'][i])
            new_ckv.append(ckv)
            new_kr.append(kr)
            new_conv.append(chist)
        x = x + mod[:, 5][:, None, :] * y
        h = modulate(x, p['norm_g'][layer, 2], mod[:, 6], mod[:, 7])
        x = x + 0.5 * mod[:, 8][:, None, :] * swiglu(h, p['ffn_w1'][layer, 1], p['ffn_w3'][layer, 1], p['ffn_w2'][layer, 1])
    y = rmsnorm(x, p['final_norm'])
    return (y, jnp.stack(new_gla), jnp.stack(new_pool), jnp.stack(new_ckv), jnp.stack(new_kr), jnp.stack(new_conv))


def setup_inputs(seed: int = 0) -> dict:
    key = jax.random.key(seed)
    ks = iter(jax.random.split(key, 64))
    nrm = lambda shape, s: jax.random.normal(next(ks), shape, jnp.float32) * s
    D = D_MODEL
    n_pages = PAST_LEN // PAGE_SIZE
    n_used = DEC_BATCH * n_pages
    n_pool = (5 * n_used + 3) // 4
    x_prompt = nrm((BATCH, SEQ, D), 1.0)
    x_sample = nrm((DEC_BATCH, DEC_SEQ, D), 1.0)
    state_gla = nrm((N_EVEN, DEC_BATCH, GLA_HEADS, GLA_DK, GLA_DV), 0.5)
    state_pool = nrm((N_EVEN, DEC_BATCH, POOL_HIST, POOL_WIDTH), 1.0)
    cache_ckv = nrm((N_ODD, n_pool, PAGE_SIZE, MLA_KV_RANK), 1.0)
    cache_krope = nrm((N_ODD, n_pool, PAGE_SIZE, MLA_ROPE), 1.0)
    state_conv = nrm((N_ODD, DEC_BATCH, CONV_HIST, CONV_CH), 0.5)
    page_table = jax.random.permutation(next(ks), n_pool)[:n_used].astype(jnp.int32).reshape(DEC_BATCH, n_pages)
    c_prompt = nrm((BATCH, D), 1.0)
    c_sample = nrm((DEC_BATCH, D), 1.0)
    return {
        'x_prompt': x_prompt, 'x_sample': x_sample,
        'state_gla': state_gla, 'state_pool': state_pool,
        'cache_ckv': cache_ckv, 'cache_krope': cache_krope, 'state_conv': state_conv,
        'page_table': page_table, 'c_prompt': c_prompt, 'c_sample': c_sample,
        'ada_w': nrm((DEPTH, D, N_MOD * D), D ** -0.5),
        'ada_b': nrm((DEPTH, N_MOD * D), 0.02),
        'norm_g': 1.0 + nrm((DEPTH, 3, D), 0.02),
        'ffn_w1': nrm((DEPTH, 2, D, D_FF), D ** -0.5),
        'ffn_w3': nrm((DEPTH, 2, D, D_FF), D ** -0.5),
        'ffn_w2': nrm((DEPTH, 2, D_FF, D), D_FF ** -0.5),
        'ev_w_in': nrm((N_EVEN, D, EV_IN), D ** -0.5),
        'ev_gate_w2': nrm((N_EVEN, GLA_GATE_RANK, GLA_HEADS * GLA_DK), GLA_GATE_RANK ** -0.5),
        'ev_gate_b': nrm((N_EVEN, GLA_HEADS * GLA_DK), 0.02),
        'ev_out_norm': 1.0 + nrm((N_EVEN, GLA_HEADS * GLA_DV), 0.02),
        'ev_pool_w': nrm((N_EVEN, len(POOL_WINDOWS), POOL_GROUP, POOL_GROUP), POOL_GROUP ** -0.5),
        'ev_pool_scale': 1.0 + nrm((N_EVEN, POOL_WIDTH), 0.1),
        'ev_w_out': nrm((N_EVEN, EV_OUT, D), EV_OUT ** -0.5),
        'od_w_in': nrm((N_ODD, D, OD_IN), D ** -0.5),
        'od_q_norm': 1.0 + nrm((N_ODD, MLA_Q_RANK), 0.02),
        'od_w_uq': nrm((N_ODD, MLA_Q_RANK, MLA_HEADS * (MLA_NOPE + MLA_ROPE)), MLA_Q_RANK ** -0.5),
        'od_kv_norm': 1.0 + nrm((N_ODD, MLA_KV_RANK), 0.02),
        'od_w_uk': nrm((N_ODD, MLA_KV_RANK, MLA_HEADS, MLA_NOPE), MLA_KV_RANK ** -0.5),
        'od_w_uv': nrm((N_ODD, MLA_KV_RANK, MLA_HEADS, MLA_V), MLA_KV_RANK ** -0.5),
        'od_conv_w': nrm((N_ODD, CONV_WIDTH, CONV_CH), CONV_WIDTH ** -0.5),
        'od_conv_b': nrm((N_ODD, CONV_CH), 0.02),
        'od_conv_norm_g': 1.0 + nrm((N_ODD, CONV_CH), 0.02),
        'od_conv_norm_b': nrm((N_ODD, CONV_CH), 0.02),
        'od_w_out': nrm((N_ODD, OD_OUT, D), OD_OUT ** -0.5),
        'final_norm': 1.0 + nrm((D,), 0.02),
    }


def reference(x_prompt, x_sample, state_gla, state_pool, cache_ckv, cache_krope, state_conv, page_table,
              c_prompt, c_sample, ada_w, ada_b, norm_g, ffn_w1, ffn_w3, ffn_w2,
              ev_w_in, ev_gate_w2, ev_gate_b, ev_out_norm, ev_pool_w, ev_pool_scale, ev_w_out,
              od_w_in, od_q_norm, od_w_uq, od_kv_norm, od_w_uk, od_w_uv, od_conv_w, od_conv_b,
              od_conv_norm_g, od_conv_norm_b, od_w_out, final_norm):
    p = dict(ada_w=ada_w, ada_b=ada_b, norm_g=norm_g, ffn_w1=ffn_w1, ffn_w3=ffn_w3, ffn_w2=ffn_w2,
             ev_w_in=ev_w_in, ev_gate_w2=ev_gate_w2, ev_gate_b=ev_gate_b, ev_out_norm=ev_out_norm,
             ev_pool_w=ev_pool_w, ev_pool_scale=ev_pool_scale, ev_w_out=ev_w_out,
             od_w_in=od_w_in, od_q_norm=od_q_norm, od_w_uq=od_w_uq, od_kv_norm=od_kv_norm,
             od_w_uk=od_w_uk, od_w_uv=od_w_uv, od_conv_w=od_conv_w, od_conv_b=od_conv_b,
             od_conv_norm_g=od_conv_norm_g, od_conv_norm_b=od_conv_norm_b, od_w_out=od_w_out,
             final_norm=final_norm)
    B = x_prompt.shape[0]
    DB = x_sample.shape[0]
    dt = x_prompt.dtype
    gla0 = jnp.zeros((N_EVEN, B, GLA_HEADS, GLA_DK, GLA_DV), state_gla.dtype)
    pool0 = jnp.zeros((N_EVEN, B, POOL_HIST, POOL_WIDTH), dt)
    conv0 = jnp.zeros((N_ODD, B, CONV_HIST, CONV_CH), dt)
    y_prompt, gla_p, pool_p, ckv_p, kr_p, conv_p = forward(x_prompt, c_prompt, 0, gla0, pool0, conv0, None, p)
    past_len = page_table.shape[1] * cache_ckv.shape[2]
    mla_past = [(cache_ckv[i, page_table].reshape(DB, past_len, MLA_KV_RANK),
                 cache_krope[i, page_table].reshape(DB, past_len, MLA_ROPE)) for i in range(N_ODD)]
    y_sample, gla_s, pool_s, ckv_s, kr_s, conv_s = forward(x_sample, c_sample, past_len, state_gla, state_pool,
                                                           state_conv, mla_past, p)
    return (y_prompt, y_sample, gla_p, gla_s, pool_p, pool_s, ckv_p, ckv_s, kr_p, kr_s, conv_p, conv_s)
```

```cpp
#include <hip/hip_runtime.h>
#include <cstdio>
#include <cstdint>
#define GAS __attribute__((address_space(1)))
#define LAS __attribute__((address_space(3)))
constexpr int DM = 1024, MP = 16384, MS = 512, MT = MP + MS, TP = 8192, NBAT = 130, FF = 2816;
constexpr int MODLD = 18432;
constexpr int ZE = 2304, ZO = 1792;
constexpr float QSCALE = 0.10206207261596577f * 1.4426950408889634f;
__device__ __forceinline__ int bidx(int row) { return row < MP ? (row >> 13) : 2 + ((row - MP) >> 2); }
__device__ __forceinline__ int posof(int row) { return row < MP ? (row & (TP - 1)) : TP + ((row - MP) & 3); }
__device__ __forceinline__ float bf2f(unsigned short b) { return __uint_as_float(((unsigned)b) << 16); }
__device__ __forceinline__ unsigned f2bf(float f) { unsigned u = __builtin_bit_cast(unsigned, f); return (u + 0x7fffu + ((u >> 16) & 1u)) >> 16; }
__device__ __forceinline__ unsigned pk2(float lo, float hi) { return f2bf(lo) | (f2bf(hi) << 16); }
__device__ __forceinline__ float sigmoidf_(float x) { return 1.0f / (1.0f + __expf(-x)); }
__device__ __forceinline__ float siluf_(float x) { return x / (1.0f + __expf(-x)); }
namespace pg8 {
#define PG8_LAS __attribute__((address_space(3)))
typedef unsigned short bf16_t;
typedef short bf16x8 __attribute__((ext_vector_type(8)));
typedef float f32x4 __attribute__((ext_vector_type(4)));
typedef unsigned u32x4 __attribute__((ext_vector_type(4)));
constexpr int BM = 256, BK = 64, HALF = 128, HTB = HALF * BK * 2  , STAGE_BYTES = 8 * HTB, NXCD = 8, WGM = 8;

__host__ __device__ __forceinline__ int lds_byte(int r, int c) { const int st = (r >> 4) * 2 + (c >> 5), rr = r & 15, cc = c & 31, ob = rr * 64 + cc * 2; return st * 1024 + (ob ^ (((ob >> 9) & 1) << 5)); }
__host__ __device__ __forceinline__ void stage_rc(int b, int& R, int& C) { const int st = b / 1024, sb = b % 1024, swz = sb ^ (((sb >> 9) & 1) << 5); R = (st >> 1) * 16 + swz / 64; C = (st & 1) * 32 + (swz % 64) / 2; }
__host__ __device__ __forceinline__ int perm32(int rho) { const int n = rho >> 4, i = rho & 15; return 8 * (i >> 2) + 4 * n + (i & 3); }

struct Unit { int pm, pn; };
struct Gemm { const bf16_t* A; const bf16_t* Bt; int M, N, K; };

struct StaticOrder {
    int nM, nN, nwg, G, c;
    __host__ __device__ void init(int M, int N, int G_, int c_) { nM = M / BM; nN = N / BM; nwg = nM * nN; G = G_; c = c_; }
    __host__ __device__ bool next(int i, Unit& u) const {
        const long L = (long)i * G + c; if (L >= nwg) return false;
        int wgid = (int)L; { const int q = nwg / NXCD, r = nwg % NXCD, xcd = wgid % NXCD, off = wgid / NXCD; wgid = (xcd < r ? xcd * (q + 1) : r * (q + 1) + (xcd - r) * q) + off; }
        const int nig = WGM * nN, gid = wgid / nig, fm = gid * WGM, gsz = (nM - fm) < WGM ? (nM - fm) : WGM;
        u.pm = fm + ((wgid % nig) % gsz); u.pn = (wgid % nig) / gsz; return true;
    }
    __device__ __forceinline__ void a_ready(const Unit&) const {}
    __device__ __forceinline__ void done(const Unit&) const {}
};

__device__ __forceinline__ unsigned cvt_pk_bf16(float lo, float hi) { unsigned r; asm volatile("v_cvt_pk_bf16_f32 %0, %1, %2" : "=v"(r) : "v"(lo), "v"(hi)); return r; }

struct EpiPlain {
    static constexpr bool PERM = true, AFTER_DRAIN = false;
    bf16_t* O; int ldc;
    __device__ __forceinline__ void operator()(const f32x4 (&acc)[2][2][4][2], const Unit& u, int wr, int wc, int fr, int fq) const {
        const int row0 = u.pm * BM + wr * 64 + fr, col0 = u.pn * BM + wc * 32 + 8 * fq;
#pragma unroll
        for (int ai = 0; ai < 2; ++ai)
#pragma unroll
            for (int m = 0; m < 4; ++m) { bf16_t* rowp = O + (size_t)(row0 + ai * HALF + m * 16) * ldc + col0;
#pragma unroll
                for (int bj = 0; bj < 2; ++bj) { const f32x4 v0 = acc[ai][bj][m][0], v1 = acc[ai][bj][m][1];
                    u32x4 w; w.x = cvt_pk_bf16(v0[0], v0[1]); w.y = cvt_pk_bf16(v0[2], v0[3]); w.z = cvt_pk_bf16(v1[0], v1[1]); w.w = cvt_pk_bf16(v1[2], v1[3]);
                    *(u32x4*)(rowp + bj * HALF) = w; } }
    }
};
struct EpiSwiglu {
    static constexpr bool PERM = true, AFTER_DRAIN = false;
    bf16_t* O; int ldc;
    __device__ __forceinline__ void operator()(const f32x4 (&acc)[2][2][4][2], const Unit& u, int wr, int wc, int fr, int fq) const {
        const int row0 = u.pm * BM + wr * 64 + fr, col0 = u.pn * HALF + wc * 32 + 8 * fq;
#pragma unroll
        for (int ai = 0; ai < 2; ++ai)
#pragma unroll
            for (int m = 0; m < 4; ++m) { bf16_t* rowp = O + (size_t)(row0 + ai * HALF + m * 16) * ldc + col0;
                float o[8];
#pragma unroll
                for (int n = 0; n < 2; ++n)
#pragma unroll
                    for (int e = 0; e < 4; ++e) { const float g = acc[ai][0][m][n][e], uu = acc[ai][1][m][n][e]; o[n * 4 + e] = siluf_(g) * uu; }
                u32x4 w; w.x = cvt_pk_bf16(o[0], o[1]); w.y = cvt_pk_bf16(o[2], o[3]); w.z = cvt_pk_bf16(o[4], o[5]); w.w = cvt_pk_bf16(o[6], o[7]);
                *(u32x4*)rowp = w; }
    }
};
struct EpiRes {
    static constexpr bool PERM = false, AFTER_DRAIN = false;
    const float* bp; const float* bs; float* out; const float* gate; float coef;
    __device__ __forceinline__ void operator()(const f32x4 (&acc)[2][2][4][2], const Unit& u, int wr, int wc, int fr, int fq) const {
#pragma unroll
        for (int ai = 0; ai < 2; ++ai)
#pragma unroll
            for (int m = 0; m < 4; ++m) { const int row = u.pm * BM + ai * HALF + wr * 64 + m * 16 + fr; const int b = bidx(row);
                const float* base = (row < MP ? bp : bs) + (size_t)row * DM; const float* gr = gate + (size_t)b * MODLD; float* orow = out + (size_t)row * DM;
#pragma unroll
                for (int bj = 0; bj < 2; ++bj)
#pragma unroll
                    for (int n = 0; n < 2; ++n) { const int col = u.pn * BM + bj * HALF + wc * 32 + n * 16 + 4 * fq;
                        const f32x4 xin = *(const f32x4*)(base + col), g = *(const f32x4*)(gr + col);
                        *(f32x4*)(orow + col) = xin + (g * coef) * acc[ai][bj][m][n]; } }
    }
};
struct EpiMod {
    static constexpr bool PERM = false, AFTER_DRAIN = false;
    float* out; const float* bias;
    __device__ __forceinline__ void operator()(const f32x4 (&acc)[2][2][4][2], const Unit& u, int wr, int wc, int fr, int fq) const {
#pragma unroll
        for (int ai = 0; ai < 2; ++ai)
#pragma unroll
            for (int m = 0; m < 4; ++m) { const int row = u.pm * BM + ai * HALF + wr * 64 + m * 16 + fr; float* orow = out + (size_t)row * MODLD;
#pragma unroll
                for (int bj = 0; bj < 2; ++bj)
#pragma unroll
                    for (int n = 0; n < 2; ++n) { const int col = u.pn * BM + bj * HALF + wc * 32 + n * 16 + 4 * fq;
                        *(f32x4*)(orow + col) = acc[ai][bj][m][n] + *(const f32x4*)(bias + col); } }
    }
};
struct EpiQ {
    static constexpr bool PERM = false, AFTER_DRAIN = false;
    bf16_t* O; const float* rt;
    __device__ __forceinline__ void operator()(const f32x4 (&acc)[2][2][4][2], const Unit& u, int wr, int wc, int fr, int fq) const {
        typedef unsigned u32x2 __attribute__((ext_vector_type(2)));
#pragma unroll
        for (int ai = 0; ai < 2; ++ai)
#pragma unroll
            for (int m = 0; m < 4; ++m) { const int row = u.pm * BM + ai * HALF + wr * 64 + m * 16 + fr; const int pos = posof(row);
                const float* rtp = rt + (size_t)pos * 32 + 8 * fq;
#pragma unroll
                for (int bj = 0; bj < 2; ++bj) { const int gc0 = u.pn * BM + bj * HALF + wc * 32; const bool isrope = (gc0 % 96) == 64;
                    f32x4 v0 = acc[ai][bj][m][0] * QSCALE, v1 = acc[ai][bj][m][1] * QSCALE;
                    if (isrope) { const f32x4 cs0 = *(const f32x4*)(rtp), cs1 = *(const f32x4*)(rtp + 4);
                        const float c[4] = {cs0[0], cs0[2], cs1[0], cs1[2]}, s[4] = {cs0[1], cs0[3], cs1[1], cs1[3]};
                        f32x4 a, b;
#pragma unroll
                        for (int e = 0; e < 4; ++e) { a[e] = v0[e] * c[e] - v1[e] * s[e]; b[e] = v1[e] * c[e] + v0[e] * s[e]; }
                        v0 = a; v1 = b; }
                    bf16_t* p = O + (size_t)row * 768 + gc0 + 4 * fq;
                    u32x2 w0; w0.x = cvt_pk_bf16(v0[0], v0[1]); w0.y = cvt_pk_bf16(v0[2], v0[3]); *(u32x2*)p = w0;
                    u32x2 w1; w1.x = cvt_pk_bf16(v1[0], v1[1]); w1.y = cvt_pk_bf16(v1[2], v1[3]); *(u32x2*)(p + 16) = w1; }
                asm volatile("" ::: "memory"); }
    }
};

template <class Epi, class Sched, bool ALIGN_EPI = false, bool SP2 = false>
__device__ __forceinline__ void gemm_phase(PG8_LAS unsigned char* lds, const Gemm g, const Sched& S, const Epi& E) {
    int tid = threadIdx.x; asm volatile("" : "+v"(tid));
    const int wid = __builtin_amdgcn_readfirstlane(tid >> 6), lane = tid & 63, wr = wid >> 2, wc = wid & 3, fr = lane & 15, fq = lane >> 4;
    const int K = g.K, nt = K / BK;
    unsigned voffA[2], voffB[2];
#pragma unroll
    for (int i = 0; i < 2; ++i) { int R, C; stage_rc(tid * 16 + i * 8192, R, C); const int Rb = Epi::PERM ? ((R & ~31) + perm32(R & 31)) : R;
        voffA[i] = (unsigned)(R * K + C) * 2u; voffB[i] = (unsigned)(Rb * K + C) * 2u; }
    const size_t kstep = (size_t)(BK * 2);
    const size_t hstep = (size_t)HALF * K * 2;
    const size_t tstep = 2 * hstep;
    const unsigned ldsw = (unsigned)wid * 1024u;
    const int aoff = lds_byte(wr * 64 + fr, fq * 8), boff = lds_byte(wc * 32 + fr, fq * 8);
#define PG8_SA(b, h) (((b) * 2 + (h)) * HTB)
#define PG8_SB(b, h) ((4 + (b) * 2 + (h)) * HTB)
#define PG8_STAGE(bufoff, gbase, voff) do { _Pragma("unroll") for (int _i = 0; _i < 2; ++_i) \
        __builtin_amdgcn_global_load_lds((const unsigned*)((const char*)(gbase) + (voff)[_i]), (PG8_LAS unsigned*)(lds + (bufoff) + ldsw + _i * 8192), 16, 0, 0); } while (0)
#define PG8_LDA(dst, b, h) do { _Pragma("unroll") for (int m = 0; m < 4; ++m) _Pragma("unroll") for (int k = 0; k < 2; ++k) dst[m][k] = *(const PG8_LAS bf16x8*)(lds + PG8_SA(b, h) + aoff + m * 2048 + k * 1024); } while (0)
#define PG8_LDB(dst, b, h) do { _Pragma("unroll") for (int n = 0; n < 2; ++n) _Pragma("unroll") for (int k = 0; k < 2; ++k) dst[n][k] = *(const PG8_LAS bf16x8*)(lds + PG8_SB(b, h) + boff + n * 2048 + k * 1024); } while (0)
#define PG8_MMA(ai, bj, At, Bt) do { __builtin_amdgcn_s_setprio(1); _Pragma("unroll") for (int m = 0; m < 4; ++m) _Pragma("unroll") for (int n = 0; n < 2; ++n) _Pragma("unroll") for (int k = 0; k < 2; ++k) \
        acc[ai][bj][m][n] = __builtin_amdgcn_mfma_f32_16x16x32_bf16(Bt[n][k], At[m][k], acc[ai][bj][m][n], 0, 0, 0); __builtin_amdgcn_s_setprio(0); } while (0)
#define PG8_WAIT_V(n) asm volatile("s_waitcnt vmcnt(" #n ")" ::: "memory")
#define PG8_WAIT_L(n) asm volatile("s_waitcnt lgkmcnt(" #n ")" ::: "memory")
#define PG8_BAR __builtin_amdgcn_s_barrier()
#define PG8_SCHED __builtin_amdgcn_sched_barrier(0)
    Unit cur, nxt; int ui = 0;
    if (!S.next(0, cur)) return;
    f32x4 acc[2][2][4][2];
#pragma unroll
    for (int a = 0; a < 2; ++a)
#pragma unroll
        for (int b = 0; b < 2; ++b)
#pragma unroll
            for (int m = 0; m < 4; ++m)
#pragma unroll
                for (int n = 0; n < 2; ++n) acc[a][b][m][n] = (f32x4){0.f, 0.f, 0.f, 0.f};
    bf16x8 At[4][2], B0[2][2], B1[2][2];
    const char* cA = (const char*)g.A + (size_t)cur.pm * tstep; const char* cB = (const char*)g.Bt + (size_t)cur.pn * tstep;
    S.a_ready(cur);
    if constexpr (SP2) {
        PG8_STAGE(PG8_SB(0, 0), cB, voffB); PG8_STAGE(PG8_SB(0, 1), cB + hstep, voffB); PG8_STAGE(PG8_SA(0, 0), cA, voffA); PG8_STAGE(PG8_SA(0, 1), cA + hstep, voffA);
        if (wr == 1) PG8_BAR;
        PG8_WAIT_V(2); PG8_BAR;
        PG8_STAGE(PG8_SB(1, 0), cB + kstep, voffB); PG8_STAGE(PG8_SA(1, 0), cA + kstep, voffA); PG8_STAGE(PG8_SB(1, 1), cB + hstep + kstep, voffB);
        PG8_WAIT_V(6); PG8_BAR;
    } else {
        PG8_STAGE(PG8_SB(0, 0), cB, voffB); PG8_STAGE(PG8_SA(0, 0), cA, voffA); PG8_STAGE(PG8_SB(0, 1), cB + hstep, voffB); PG8_STAGE(PG8_SA(0, 1), cA + hstep, voffA);
        if (wr == 1) PG8_BAR;
        PG8_WAIT_V(4); PG8_BAR;
        PG8_STAGE(PG8_SB(1, 0), cB + kstep, voffB); PG8_STAGE(PG8_SA(1, 0), cA + kstep, voffA); PG8_STAGE(PG8_SB(1, 1), cB + hstep + kstep, voffB);
        PG8_WAIT_V(6); PG8_BAR;
    }
    for (;;) {
        const bool has_next = S.next(ui + 1, nxt);
        const char* nA = has_next ? (const char*)g.A + (size_t)nxt.pm * tstep : cA; const char* nB = has_next ? (const char*)g.Bt + (size_t)nxt.pn * tstep : cB;
        for (int t = 0; t < nt; t += 2) {
            const bool last = (t == nt - 2);
            const char* a1 = cA + (size_t)(t + 1) * kstep;
            const char* a2 = last ? nA : cA + (size_t)(t + 2) * kstep; const char* b2 = last ? nB : cB + (size_t)(t + 2) * kstep;
            const char* a3 = a2 + kstep; const char* b3 = b2 + kstep;
            if (last && has_next) S.a_ready(nxt);
            if constexpr (SP2) {
            PG8_LDB(B0, 0, 0); PG8_LDB(B1, 0, 1); PG8_SCHED; PG8_LDA(At, 0, 0); PG8_STAGE(PG8_SA(1, 1), a1 + hstep, voffA);
            PG8_WAIT_V(8); PG8_WAIT_L(0); PG8_BAR; PG8_MMA(0, 0, At, B0); PG8_MMA(0, 1, At, B1); PG8_BAR; PG8_SCHED;
            PG8_LDA(At, 0, 1); PG8_STAGE(PG8_SB(0, 0), b2, voffB); PG8_STAGE(PG8_SB(0, 1), b2 + hstep, voffB); PG8_STAGE(PG8_SA(0, 0), a2, voffA);
            PG8_WAIT_V(8); PG8_WAIT_L(0); PG8_BAR; PG8_MMA(1, 0, At, B0); PG8_MMA(1, 1, At, B1); PG8_BAR; PG8_SCHED;
            PG8_LDB(B0, 1, 0); PG8_LDB(B1, 1, 1); PG8_SCHED; PG8_LDA(At, 1, 0); PG8_STAGE(PG8_SA(0, 1), a2 + hstep, voffA);
            PG8_WAIT_V(8); PG8_WAIT_L(0); PG8_BAR; PG8_MMA(0, 0, At, B0); PG8_MMA(0, 1, At, B1); PG8_BAR; PG8_SCHED;
            PG8_LDA(At, 1, 1); PG8_STAGE(PG8_SB(1, 0), b3, voffB); PG8_STAGE(PG8_SB(1, 1), b3 + hstep, voffB); PG8_STAGE(PG8_SA(1, 0), a3, voffA);
            PG8_WAIT_V(8); PG8_WAIT_L(0); PG8_BAR; PG8_MMA(1, 0, At, B0); PG8_MMA(1, 1, At, B1); PG8_BAR; PG8_SCHED;
            } else {
            PG8_LDB(B0, 0, 0); PG8_SCHED; PG8_LDA(At, 0, 0); PG8_STAGE(PG8_SA(1, 1), a1 + hstep, voffA);
            PG8_WAIT_L(8); PG8_BAR; PG8_WAIT_L(0); PG8_MMA(0, 0, At, B0); PG8_BAR; PG8_SCHED;
            PG8_LDB(B1, 0, 1); PG8_STAGE(PG8_SB(0, 0), b2, voffB);
            PG8_BAR; PG8_WAIT_L(0); PG8_MMA(0, 1, At, B1); PG8_BAR;
            PG8_LDA(At, 0, 1); PG8_STAGE(PG8_SA(0, 0), a2, voffA);
            PG8_BAR; PG8_WAIT_L(0); PG8_MMA(1, 0, At, B0); PG8_BAR; PG8_SCHED;
            PG8_STAGE(PG8_SB(0, 1), b2 + hstep, voffB);
            PG8_WAIT_V(6); PG8_BAR; PG8_MMA(1, 1, At, B1); PG8_BAR;
            PG8_LDB(B0, 1, 0); PG8_SCHED; PG8_LDA(At, 1, 0); PG8_STAGE(PG8_SA(0, 1), a2 + hstep, voffA);
            PG8_WAIT_L(8); PG8_BAR; PG8_WAIT_L(0); PG8_MMA(0, 0, At, B0); PG8_BAR; PG8_SCHED;
            PG8_LDB(B1, 1, 1); PG8_STAGE(PG8_SB(1, 0), b3, voffB);
            PG8_BAR; PG8_WAIT_L(0); PG8_MMA(0, 1, At, B1); PG8_BAR;
            PG8_LDA(At, 1, 1); PG8_STAGE(PG8_SA(1, 0), a3, voffA);
            PG8_BAR; PG8_WAIT_L(0); PG8_MMA(1, 0, At, B0); PG8_BAR; PG8_SCHED;
            PG8_STAGE(PG8_SB(1, 1), b3 + hstep, voffB);
            PG8_WAIT_V(6); PG8_BAR; PG8_MMA(1, 1, At, B1); PG8_BAR;
            }
        }
        if constexpr (ALIGN_EPI) { if (wr == 0) PG8_BAR; }
        if constexpr (!Epi::AFTER_DRAIN) { E(acc, cur, wr, wc, fr, fq); S.done(cur); }
        if (!has_next) break;
#pragma unroll
        for (int a = 0; a < 2; ++a)
#pragma unroll
            for (int b = 0; b < 2; ++b)
#pragma unroll
                for (int m = 0; m < 4; ++m)
#pragma unroll
                    for (int n = 0; n < 2; ++n) acc[a][b][m][n] = (f32x4){0.f, 0.f, 0.f, 0.f};
        cur = nxt; cA = nA; cB = nB; ++ui;
        if constexpr (ALIGN_EPI) { if (wr == 1) PG8_BAR; }
    }
    PG8_WAIT_V(0);
    if constexpr (!ALIGN_EPI) { if (wr == 0) PG8_BAR; }
    PG8_BAR;
    if constexpr (Epi::AFTER_DRAIN) { E.fused(acc, cur, wr, wc, fr, fq, lds, wid, lane); S.done(cur); }
#undef PG8_SA
#undef PG8_SB
#undef PG8_STAGE
#undef PG8_LDA
#undef PG8_LDB
#undef PG8_MMA
#undef PG8_WAIT_V
#undef PG8_WAIT_L
#undef PG8_BAR
#undef PG8_SCHED
}
}
constexpr size_t MiB = 1u << 20;
constexpr size_t WS_CTL = 0, CTL_ZERO_BYTES = 1 * MiB;
constexpr size_t WS_W13T = 2 * MiB, W13T_STRIDE = 11 * MiB;
constexpr size_t WS_W2T = 46 * MiB, W2T_STRIDE = 5767168;
constexpr size_t WS_EVIN = 68 * MiB, WS_EVOUT = 73 * MiB, WS_ODIN = 75 * MiB, WS_ODOUT = 79 * MiB, WS_WUQ = 81 * MiB, WS_WKV = 82 * MiB;
constexpr size_t WS_ADAT = 83 * MiB, WS_SC = 119 * MiB, WS_RT = 120 * MiB, WS_MOD = 122 * MiB;
constexpr size_t WS_X = 140 * MiB, WS_H = 206 * MiB, WS_ACT = 239 * MiB, WS_Z = 330 * MiB, WS_OP = 405 * MiB;
constexpr size_t WS_US = 438 * MiB, WS_DS = 470 * MiB, WS_CQN = 471 * MiB, WS_CKVB = 484 * MiB, WS_KRB = 493 * MiB, WS_Q = 495 * MiB, WS_KV = 520 * MiB;
constexpr size_t WS_PART = 552 * MiB, WS_QD = 586 * MiB, WS_END = 592 * MiB;
constexpr int NSPLIT = 8, PART_F = 32 * 256 + 64;
constexpr size_t O_Y = 0, O_GLAP = 17301504, O_GLAS = O_GLAP + 65536, O_POOLP = O_GLAS + 4194304, O_POOLS = O_POOLP + 15360, O_CKV = O_POOLS + 983040,
                 O_KR = O_CKV + 4325376, O_CONVP = O_KR + 540672, O_CONVS = O_CONVP + 30720, O_END = O_CONVS + 1966080;
constexpr int CW_TMO = 0, CW_CODE = 1, CW_BAR = 4096;
constexpr int RING_BYTES = 131072, LDSCTL_OFF = RING_BYTES, MISC_OFF = LDSCTL_OFF + 320, LDS_BYTES = 147456;
constexpr int NWAVES = 8;

typedef unsigned short bf16;
typedef unsigned v4u __attribute__((ext_vector_type(4)));
typedef unsigned v2u __attribute__((ext_vector_type(2)));
typedef float f32x4 __attribute__((ext_vector_type(4)));
typedef float f32x2 __attribute__((ext_vector_type(2)));
typedef float f32x16 __attribute__((ext_vector_type(16)));
typedef short bf16x8 __attribute__((ext_vector_type(8)));
typedef short s16x4 __attribute__((ext_vector_type(4)));
typedef GAS unsigned gu32;
#define RLX_AGENT __ATOMIC_RELAXED, __HIP_MEMORY_SCOPE_AGENT
#define LDS_WAIT() asm volatile("s_waitcnt lgkmcnt(0)" ::: "memory")
#define VM_WAIT() asm volatile("s_waitcnt vmcnt(0)" ::: "memory")

#define XB_TMO      128
#define XB_XCNT(j)  (256  + 64 * (j))
#define XB_XSUB(j)  (1280 + 64 * (j))
#define XB_XGEN(j)  (2304 + 64 * (j))
#define XB_TOP      3328
#define XB_TOPGEN   3392
#define XCD_BAR_WORDS 3456
#define XB_SPIN_CAP (1u << 18)

__device__ __forceinline__ unsigned xb_ld(unsigned* p)              { return __hip_atomic_load(p, __ATOMIC_RELAXED, __HIP_MEMORY_SCOPE_AGENT); }
__device__ __forceinline__ unsigned xb_add(unsigned* p, unsigned v) { return __hip_atomic_fetch_add(p, v, __ATOMIC_RELAXED, __HIP_MEMORY_SCOPE_AGENT); }
__device__ __forceinline__ unsigned xb_xcc_id() { return (unsigned)__builtin_amdgcn_s_getreg((3 << 11) | 20) & 0xFu; }
#define XB_SPIN(cond, bar) do { unsigned _sp = 0; while (cond) { __builtin_amdgcn_s_sleep(1); \
    if ((++_sp & 255u) == 0u) { if (xb_ld(&(bar)[XB_TMO])) break; if (_sp > XB_SPIN_CAP) { atomicAdd(&(bar)[XB_TMO], 1u); break; } } } } while (0)

struct XcdBarrier {
    unsigned* bar; unsigned x;
    volatile LAS unsigned* st;
};

__device__ __forceinline__ XcdBarrier xcd_barrier_post(unsigned* bar, volatile LAS unsigned* st) {
    XcdBarrier b; b.bar = bar; b.x = xb_xcc_id(); b.st = st;
    if (threadIdx.x == 0) (void)xb_add(&bar[XB_XCNT(b.x)], 1u);
    return b;
}
__device__ __forceinline__ void xcd_barrier_complete(unsigned* bar, unsigned x, unsigned& nloc, unsigned& nx) {
    const unsigned G = gridDim.x * gridDim.y * gridDim.z;
    unsigned sum, cnt, mine, sp = 0u;
    for (;;) {
        sum = 0u; cnt = 0u; mine = 0u;
#pragma unroll
        for (unsigned j = 0; j < 16; ++j) { const unsigned c = xb_ld(&bar[XB_XCNT(j)]); sum += c; cnt += (c > 0u) ? 1u : 0u; mine = (j == x) ? c : mine; }
        if (sum == G) break;
        __builtin_amdgcn_s_sleep(1);
        if ((++sp & 255u) == 0u) { if (xb_ld(&bar[XB_TMO])) break; if (sp > XB_SPIN_CAP) { atomicAdd(&bar[XB_TMO], 1u); break; } }
    }
    nloc = mine > 0u ? mine : 1u; nx = cnt > 0u ? cnt : 1u;
}

__device__ __forceinline__ void xcd_barrier(const XcdBarrier& b) {
    asm volatile("s_waitcnt vmcnt(0)" ::: "memory");
    __syncthreads();
    if (threadIdx.x == 0) {
        unsigned* bar = b.bar;
        __builtin_amdgcn_s_waitcnt(0);
        unsigned nloc = b.st[0], nx = b.st[1];
        if (nloc == 0u) { xcd_barrier_complete(bar, b.x, nloc, nx); b.st[0] = nloc; b.st[1] = nx; }
        const unsigned old = xb_add(&bar[XB_XSUB(b.x)], 1u);
        const unsigned gen = old / nloc;
        if (old + 1u == (gen + 1u) * nloc) {
            __builtin_amdgcn_fence(__ATOMIC_RELEASE, "agent");
            asm volatile("s_waitcnt vmcnt(0)" ::: "memory");
            const unsigned og = xb_add(&bar[XB_TOP], 1u);
            const unsigned tg = og / nx;
            if (og + 1u == (tg + 1u) * nx) xb_add(&bar[XB_TOPGEN], 1u);
            else XB_SPIN(xb_ld(&bar[XB_TOPGEN]) == tg, bar);
            __builtin_amdgcn_fence(__ATOMIC_ACQUIRE, "agent");
            xb_add(&bar[XB_XGEN(b.x)], 1u);
            asm volatile("s_waitcnt vmcnt(0)" ::: "memory");
        } else {
            XB_SPIN(xb_ld(&bar[XB_XGEN(b.x)]) == gen, bar);
            __builtin_amdgcn_fence(__ATOMIC_ACQUIRE, "agent");
            asm volatile("s_waitcnt vmcnt(0)" ::: "memory");
        }
    }
    __syncthreads();
}
struct Args { const void* in[35]; float* out; unsigned char* ws; int ph_lo, ph_hi, use_bar, k_q, k_kv, pad; };
struct Frame {
    LAS unsigned char* lds;
    volatile LAS unsigned* MISC;
    gu32* ctl;
    int tid, lane, wave, G, bx;
    unsigned char* ws; float* out;
};
__device__ __forceinline__ float wave_sum(float v) {
#pragma unroll
    for (int o = 1; o < 64; o <<= 1) v += __shfl_xor(v, o);
    return v;
}
__device__ __forceinline__ float half_sum(float v) {
#pragma unroll
    for (int o = 1; o < 32; o <<= 1) v += __shfl_xor(v, o);
    return v;
}
#define WS_PTR(T, off) ((T*)(F.ws + (off)))

enum { RM_ID = 0, RM_W1 = 1, RM_W3 = 2, RM_EVIN = 3 };
__device__ __forceinline__ int map_row(int mode, int n) {
    if (mode == RM_W1) return 256 * (n >> 7) + (n & 127);
    if (mode == RM_W3) return 256 * (n >> 7) + 128 + (n & 127);
    if (mode == RM_EVIN) return n < 1536 ? n : (n < 1552 ? 2048 + (n - 1536) : 1536 + (n - 1552));
    return n;
}
__device__ __forceinline__ void p0_transpose_item(const float* W, int N, bf16* WT, int ldk, int mode, LAS float* scr, int item, int lane) {
    const int nblk = (N + 31) / 32, kb = item / nblk, nb = item % nblk, k0 = 64 * kb, n0 = 32 * nb;
    const bool okc = (n0 + (lane & 31)) < N;
#pragma unroll 8
    for (int i = 0; i < 32; ++i) { const int kk = 2 * i + (lane >> 5); scr[kk * 33 + (lane & 31)] = okc ? W[(size_t)(k0 + kk) * N + n0 + (lane & 31)] : 0.f; }
    LDS_WAIT(); asm volatile("" ::: "memory");
    const int c = lane & 7;
#pragma unroll
    for (int j = 0; j < 4; ++j) { const int n = (lane >> 3) + 8 * j; const LAS float* s = scr + (8 * c) * 33 + n;
        v4u o; o.x = pk2(s[0 * 33], s[1 * 33]); o.y = pk2(s[2 * 33], s[3 * 33]); o.z = pk2(s[4 * 33], s[5 * 33]); o.w = pk2(s[6 * 33], s[7 * 33]);
        if (n0 + n < N) *(GAS v4u*)(WT + (size_t)map_row(mode, n0 + n) * ldk + k0 + 8 * c) = o; }
    LDS_WAIT(); asm volatile("" ::: "memory");
}
__device__ __forceinline__ void p0_prologue(Frame& F, const Args& A) {
    LAS float* scr = (LAS float*)(F.lds + F.wave * 16384);
    const int gw = F.bx * NWAVES + F.wave, NGW = F.G * NWAVES;
    const float* ffn_w1 = (const float*)A.in[13]; const float* ffn_w3 = (const float*)A.in[14]; const float* ffn_w2 = (const float*)A.in[15];
    const float* ev_w_in = (const float*)A.in[16]; const float* ev_w_out = (const float*)A.in[22]; const float* od_w_in = (const float*)A.in[23]; const float* od_w_out = (const float*)A.in[33];
    const float* w_uq = (const float*)A.in[25]; const float* w_uk = (const float*)A.in[27]; const float* w_uv = (const float*)A.in[28]; const float* ada_w = (const float*)A.in[10];
    constexpr int I_W1 = 16 * 88, I_W2 = 44 * 32, I_FFN = 2 * I_W1 + I_W2;
    constexpr int I_EVIN = 16 * 65, I_EVOUT = 8 * 32, I_ODIN = 16 * 53, I_ODOUT = 16 * 32, I_UQ = 6 * 24, I_UK = 4 * 16, I_ADA = 16 * 288;
    constexpr int NITEMS = 4 * I_FFN + I_EVIN + I_EVOUT + I_ODIN + I_ODOUT + I_UQ + 2 * I_UK + 2 * I_ADA;
    for (int it = gw; it < NITEMS; it += NGW) {
        int r = it;
        if (r < 4 * I_FFN) { const int i = r / I_FFN; r -= i * I_FFN;
            bf16* w13 = WS_PTR(bf16, WS_W13T + (size_t)i * W13T_STRIDE); bf16* w2 = WS_PTR(bf16, WS_W2T + (size_t)i * W2T_STRIDE);
            if (r < I_W1) { p0_transpose_item(ffn_w1 + (size_t)i * DM * FF, FF, w13, DM, RM_W1, scr, r, F.lane); continue; } r -= I_W1;
            if (r < I_W1) { p0_transpose_item(ffn_w3 + (size_t)i * DM * FF, FF, w13, DM, RM_W3, scr, r, F.lane); continue; } r -= I_W1;
            p0_transpose_item(ffn_w2 + (size_t)i * FF * DM, DM, w2, FF, RM_ID, scr, r, F.lane); continue; }
        r -= 4 * I_FFN;
        if (r < I_EVIN) { p0_transpose_item(ev_w_in, 2064, WS_PTR(bf16, WS_EVIN), DM, RM_EVIN, scr, r, F.lane); continue; } r -= I_EVIN;
        if (r < I_EVOUT) { p0_transpose_item(ev_w_out, DM, WS_PTR(bf16, WS_EVOUT), DM, RM_ID, scr, r, F.lane); continue; } r -= I_EVOUT;
        if (r < I_ODIN) { p0_transpose_item(od_w_in, 1696, WS_PTR(bf16, WS_ODIN), DM, RM_ID, scr, r, F.lane); continue; } r -= I_ODIN;
        if (r < I_ODOUT) { p0_transpose_item(od_w_out, DM, WS_PTR(bf16, WS_ODOUT), DM, RM_ID, scr, r, F.lane); continue; } r -= I_ODOUT;
        if (r < I_UQ) { p0_transpose_item(w_uq, 768, WS_PTR(bf16, WS_WUQ), 384, RM_ID, scr, r, F.lane); continue; } r -= I_UQ;
        if (r < I_UK) { p0_transpose_item(w_uk, 512, WS_PTR(bf16, WS_WKV), 256, RM_ID, scr, r, F.lane); continue; } r -= I_UK;
        if (r < I_UK) { p0_transpose_item(w_uv, 512, WS_PTR(bf16, WS_WKV) + 512 * 256, 256, RM_ID, scr, r, F.lane); continue; } r -= I_UK;
        { const int l = r / I_ADA; r -= l * I_ADA; p0_transpose_item(ada_w + (size_t)l * DM * 9216, 9216, WS_PTR(bf16, WS_ADAT) + (size_t)l * 9216 * DM, DM, RM_ID, scr, r, F.lane); }
    }
    { constexpr int NZ = (240 + 96) * (DM / 8);
      for (int i = F.bx * 512 + F.tid; i < NZ; i += F.G * 512) { const int rr = i / (DM / 8), c8 = i % (DM / 8);
          bf16* dst = rr < 240 ? WS_PTR(bf16, WS_EVIN) + (size_t)(2064 + rr) * DM : WS_PTR(bf16, WS_ODIN) + (size_t)(1696 + rr - 240) * DM;
          *(GAS v4u*)(dst + c8 * 8) = (v4u){0u, 0u, 0u, 0u}; } }
    { const float* pool_w = (const float*)A.in[20]; const float* pool_scale = (const float*)A.in[21]; bf16* evo = WS_PTR(bf16, WS_EVOUT);
      for (int it = gw; it < 512; it += NGW) { const int g = it >> 7, c = it & 127;
          f32x4 acc[4] = {{0.f, 0.f, 0.f, 0.f}, {0.f, 0.f, 0.f, 0.f}, {0.f, 0.f, 0.f, 0.f}, {0.f, 0.f, 0.f, 0.f}};
          for (int d = 0; d < 128; ++d) { const float a = pool_w[(size_t)(g * 128 + c) * 128 + d] * pool_scale[g * 128 + d];
              const float* wr = ev_w_out + (size_t)(512 + g * 128 + d) * DM + 4 * F.lane;
#pragma unroll
              for (int j = 0; j < 4; ++j) acc[j] += a * *(const f32x4*)(wr + 256 * j); }
#pragma unroll
          for (int j = 0; j < 4; ++j)
#pragma unroll
              for (int e = 0; e < 4; ++e) evo[(size_t)(256 * j + 4 * F.lane + e) * DM + 512 + g * 128 + c] = (bf16)f2bf(acc[j][e]); } }
    { const float* cp = (const float*)A.in[8]; const float* cs = (const float*)A.in[9]; bf16* sc = WS_PTR(bf16, WS_SC);
      for (int r = gw; r < 256; r += NGW) { const float* src = r < 2 ? cp + (size_t)r * DM : cs + (size_t)(r - 2) * DM;
#pragma unroll
          for (int j = 0; j < 4; ++j) { f32x4 v = {0.f, 0.f, 0.f, 0.f}; if (r < NBAT) v = *(const f32x4*)(src + 4 * F.lane + 256 * j);
              v2u o; o.x = r < NBAT ? pk2(siluf_(v[0]), siluf_(v[1])) : 0u; o.y = r < NBAT ? pk2(siluf_(v[2]), siluf_(v[3])) : 0u;
              *(GAS v2u*)(sc + (size_t)r * DM + 4 * F.lane + 256 * j) = o; } } }
    { float* rt = WS_PTR(float, WS_RT);
      for (int i = F.bx * 512 + F.tid; i < 8196 * 16; i += F.G * 512) { const int pos = i >> 4, k = i & 15;
          const float freq = powf(10000.0f, -(float)k / 16.0f); const float ang = (float)pos * freq; float s, c; sincosf(ang, &s, &c);
          *(f32x2*)(rt + 2 * (size_t)i) = (f32x2){c, s}; } }
}

__device__ __forceinline__ void nm_phase(Frame& F, const float* bp, const float* bs, const float* g, const float* modsh, bf16* H) {
    const int gw = F.bx * NWAVES + F.wave, NGW = F.G * NWAVES;
    f32x4 gv[4];
#pragma unroll
    for (int j = 0; j < 4; ++j) gv[j] = *(const f32x4*)(g + 4 * F.lane + 256 * j);
    for (int row = gw; row < MT; row += NGW) {
        const float* xr = (row < MP ? bp : bs) + (size_t)row * DM + 4 * F.lane;
        f32x4 v[4]; float ss = 0.f;
#pragma unroll
        for (int j = 0; j < 4; ++j) { v[j] = *(const f32x4*)(xr + 256 * j); ss += (v[j][0] * v[j][0] + v[j][1] * v[j][1]) + (v[j][2] * v[j][2] + v[j][3] * v[j][3]); }
        const float rstd = 1.0f / sqrtf(wave_sum(ss) * (1.0f / DM) + 1e-6f);
        const float* mrow = modsh + (size_t)bidx(row) * MODLD + 4 * F.lane;
#pragma unroll
        for (int j = 0; j < 4; ++j) { const f32x4 sh = *(const f32x4*)(mrow + 256 * j), sc = *(const f32x4*)(mrow + DM + 256 * j);
            const f32x4 h = (v[j] * rstd) * gv[j] * (sc + 1.0f) + sh;
            v2u o; o.x = pk2(h[0], h[1]); o.y = pk2(h[2], h[3]);
            *(GAS v2u*)(H + (size_t)row * DM + 4 * F.lane + 256 * j) = o; }
    }
}
__device__ __forceinline__ void final_phase(Frame& F, const float* X, const float* g, float* out) {
    const int gw = F.bx * NWAVES + F.wave, NGW = F.G * NWAVES;
    f32x4 gv[4];
#pragma unroll
    for (int j = 0; j < 4; ++j) gv[j] = *(const f32x4*)(g + 4 * F.lane + 256 * j);
    for (int row = gw; row < MT; row += NGW) {
        const float* xr = X + (size_t)row * DM + 4 * F.lane;
        f32x4 v[4]; float ss = 0.f;
#pragma unroll
        for (int j = 0; j < 4; ++j) { v[j] = *(const f32x4*)(xr + 256 * j); ss += (v[j][0] * v[j][0] + v[j][1] * v[j][1]) + (v[j][2] * v[j][2] + v[j][3] * v[j][3]); }
        const float rstd = 1.0f / sqrtf(wave_sum(ss) * (1.0f / DM) + 1e-6f);
#pragma unroll
        for (int j = 0; j < 4; ++j) *(f32x4*)(out + (size_t)row * DM + 4 * F.lane + 256 * j) = (v[j] * rstd) * gv[j];
    }
}
__device__ __forceinline__ float logsig16(float x) { return (fminf(x, 0.f) - log1pf(__expf(-fabsf(x)))) * (1.0f / 16.0f); }
__device__ __forceinline__ void gla_cumdecay(Frame& F, const bf16* Z, int row0, int h, const float* gate_w2, const float* gate_b, LAS float* bcs, LAS float* gl, LAS float* seg) {
    const int tid = F.tid;
    { const int t = tid >> 3, j2 = (tid & 7) * 2; const unsigned w = *(const unsigned*)(Z + (size_t)(row0 + t) * ZE + 2048 + j2);
      gl[t * 16 + j2] = bf2f((unsigned short)(w & 0xffffu)); gl[t * 16 + j2 + 1] = bf2f((unsigned short)(w >> 16)); }
    __syncthreads();
    { const int t = tid >> 3, dk8 = (tid & 7) * 8; float x[8];
      { const f32x4 b0 = *(const f32x4*)(gate_b + h * 64 + dk8), b1 = *(const f32x4*)(gate_b + h * 64 + dk8 + 4);
#pragma unroll
        for (int e = 0; e < 4; ++e) { x[e] = b0[e]; x[4 + e] = b1[e]; } }
#pragma unroll
      for (int j = 0; j < 16; ++j) { const float gv = gl[t * 16 + j]; const f32x4 w0 = *(const f32x4*)(gate_w2 + j * 256 + h * 64 + dk8), w1 = *(const f32x4*)(gate_w2 + j * 256 + h * 64 + dk8 + 4);
#pragma unroll
          for (int e = 0; e < 4; ++e) { x[e] += gv * w0[e]; x[4 + e] += gv * w1[e]; } }
#pragma unroll
      for (int e = 0; e < 8; ++e) bcs[t * 64 + dk8 + e] = logsig16(x[e]); }
    __syncthreads();
    { const int dk = tid & 63, sg = tid >> 6; float run = 0.f;
#pragma unroll
      for (int i = 0; i < 8; ++i) { run += bcs[(sg * 8 + i) * 64 + dk]; bcs[(sg * 8 + i) * 64 + dk] = run; }
      seg[sg * 64 + dk] = run; }
    __syncthreads();
    { const int dk = tid & 63, sg = tid >> 6; float pre = 0.f;
      for (int s = 0; s < sg; ++s) pre += seg[s * 64 + dk];
#pragma unroll
      for (int i = 0; i < 8; ++i) bcs[(sg * 8 + i) * 64 + dk] += pre; }
    __syncthreads();
}
__device__ __forceinline__ void gla_g1_unit(Frame& F, const Args& A, int unit) {
    const bf16* Z = WS_PTR(bf16, WS_Z); float* US = WS_PTR(float, WS_US); float* DS = WS_PTR(float, WS_DS);
    const int bh = unit >> 7, n = unit & 127, b = bh >> 2, h = bh & 3, row0 = b * TP + n * 64, tid = F.tid;
    LAS float* bcs = (LAS float*)F.lds; LAS float* kk = bcs + 4096; LAS float* vv = kk + 4096; LAS float* gl = vv + 8192; LAS float* seg = gl + 1024;
    gla_cumdecay(F, Z, row0, h, (const float*)A.in[17], (const float*)A.in[18], bcs, gl, seg);
    { const int s = tid >> 3, dk8 = (tid & 7) * 8; const v4u kw = *(const v4u*)(Z + (size_t)(row0 + s) * ZE + 256 + h * 64 + dk8);
#pragma unroll
      for (int e = 0; e < 4; ++e) { const unsigned w = kw[e]; const int d0 = dk8 + 2 * e;
          kk[s * 64 + d0] = bf2f((unsigned short)(w & 0xffffu)) * __expf(bcs[63 * 64 + d0] - bcs[s * 64 + d0]);
          kk[s * 64 + d0 + 1] = bf2f((unsigned short)(w >> 16)) * __expf(bcs[63 * 64 + d0 + 1] - bcs[s * 64 + d0 + 1]); }
      const int dv16 = (tid & 7) * 16;
#pragma unroll
      for (int q = 0; q < 2; ++q) { const v4u vw = *(const v4u*)(Z + (size_t)(row0 + s) * ZE + 512 + h * 128 + dv16 + 8 * q);
#pragma unroll
          for (int e = 0; e < 4; ++e) { vv[s * 128 + dv16 + 8 * q + 2 * e] = bf2f((unsigned short)(vw[e] & 0xffffu)); vv[s * 128 + dv16 + 8 * q + 2 * e + 1] = bf2f((unsigned short)(vw[e] >> 16)); } }
      if (tid < 64) DS[(size_t)unit * 64 + tid] = __expf(bcs[63 * 64 + tid]); }
    __syncthreads();
    { const int dkq = tid >> 5, dvq = tid & 31; f32x4 acc[4] = {{0.f, 0.f, 0.f, 0.f}, {0.f, 0.f, 0.f, 0.f}, {0.f, 0.f, 0.f, 0.f}, {0.f, 0.f, 0.f, 0.f}};
#pragma unroll 4
      for (int s = 0; s < 64; ++s) { const f32x4 a = *(const LAS f32x4*)(kk + s * 64 + 4 * dkq), bv = *(const LAS f32x4*)(vv + s * 128 + 4 * dvq);
#pragma unroll
          for (int i = 0; i < 4; ++i) acc[i] += a[i] * bv; }
#pragma unroll
      for (int i = 0; i < 4; ++i) *(f32x4*)(US + ((size_t)unit * 64 + 4 * dkq + i) * 128 + 4 * dvq) = acc[i]; }
    __syncthreads();
}
__device__ __forceinline__ void gla_g2_phase(Frame& F) {
    float* US = WS_PTR(float, WS_US); const float* DS = WS_PTR(float, WS_DS); float* outp = F.out + O_GLAP;
    for (int gid = F.bx * 512 + F.tid; gid < 8 * 8192; gid += F.G * 512) {
        const int bh = gid >> 13, e = gid & 8191, dk = e >> 7;
        float* up = US + (size_t)bh * 128 * 8192 + e; const float* dp = DS + (size_t)bh * 128 * 64 + dk; float S = 0.f;
        for (int n0 = 0; n0 < 128; n0 += 8) { float uu[8], dd[8];
#pragma unroll
            for (int i = 0; i < 8; ++i) { uu[i] = up[(size_t)(n0 + i) * 8192]; dd[i] = dp[(n0 + i) * 64]; }
#pragma unroll
            for (int i = 0; i < 8; ++i) { up[(size_t)(n0 + i) * 8192] = S; S = dd[i] * S + uu[i]; } }
        outp[gid] = S;
    }
}
__device__ __forceinline__ void gla_g3_unit(Frame& F, const Args& A, int unit) {
    const bf16* Z = WS_PTR(bf16, WS_Z); const float* US = WS_PTR(float, WS_US); bf16* OP = WS_PTR(bf16, WS_OP);
    const int bh = unit >> 7, n = unit & 127, b = bh >> 2, h = bh & 3, row0 = b * TP + n * 64, tid = F.tid;
    LAS float* bcs = (LAS float*)F.lds; LAS float* attT = bcs;
    LAS float* qiT = bcs + 4096; LAS float* kiT = qiT + 4096; LAS float* vv = kiT + 4096; LAS float* Sst = vv + 8192; LAS float* gl = Sst + 8192; LAS float* seg = gl + 1024;
    gla_cumdecay(F, Z, row0, h, (const float*)A.in[17], (const float*)A.in[18], bcs, gl, seg);
    { const int t = tid >> 3, dk8 = (tid & 7) * 8;
      const v4u qw = *(const v4u*)(Z + (size_t)(row0 + t) * ZE + h * 64 + dk8), kw = *(const v4u*)(Z + (size_t)(row0 + t) * ZE + 256 + h * 64 + dk8);
#pragma unroll
      for (int e = 0; e < 4; ++e) { const int d0 = dk8 + 2 * e; const float b0 = bcs[t * 64 + d0], b1 = bcs[t * 64 + d0 + 1];
          qiT[d0 * 64 + t] = 0.125f * bf2f((unsigned short)(qw[e] & 0xffffu)) * __expf(b0); qiT[(d0 + 1) * 64 + t] = 0.125f * bf2f((unsigned short)(qw[e] >> 16)) * __expf(b1);
          kiT[d0 * 64 + t] = bf2f((unsigned short)(kw[e] & 0xffffu)) * __expf(-b0); kiT[(d0 + 1) * 64 + t] = bf2f((unsigned short)(kw[e] >> 16)) * __expf(-b1); }
      const int dv16 = (tid & 7) * 16;
#pragma unroll
      for (int q = 0; q < 2; ++q) { const v4u vw = *(const v4u*)(Z + (size_t)(row0 + t) * ZE + 512 + h * 128 + dv16 + 8 * q);
#pragma unroll
          for (int e = 0; e < 4; ++e) { vv[t * 128 + dv16 + 8 * q + 2 * e] = bf2f((unsigned short)(vw[e] & 0xffffu)); vv[t * 128 + dv16 + 8 * q + 2 * e + 1] = bf2f((unsigned short)(vw[e] >> 16)); } }
#pragma unroll
      for (int j = 0; j < 4; ++j) *(LAS f32x4*)(Sst + 4 * (tid + 512 * j)) = *(const f32x4*)(US + (size_t)unit * 8192 + 4 * (tid + 512 * j)); }
    __syncthreads();
    { const int t4 = tid >> 5, s2 = tid & 31; f32x4 a0 = {0.f, 0.f, 0.f, 0.f}, a1 = {0.f, 0.f, 0.f, 0.f};
#pragma unroll 4
      for (int dk = 0; dk < 64; ++dk) { const f32x4 qv = *(const LAS f32x4*)(qiT + dk * 64 + 4 * t4); const f32x2 kv = *(const LAS f32x2*)(kiT + dk * 64 + 2 * s2);
          a0 += qv * kv[0]; a1 += qv * kv[1]; }
#pragma unroll
      for (int i = 0; i < 4; ++i) { if (2 * s2 > 4 * t4 + i) a0[i] = 0.f; if (2 * s2 + 1 > 4 * t4 + i) a1[i] = 0.f; }
      *(LAS f32x4*)(attT + (2 * s2) * 64 + 4 * t4) = a0; *(LAS f32x4*)(attT + (2 * s2 + 1) * 64 + 4 * t4) = a1; }
    __syncthreads();
    { const int t4 = tid >> 5, dvq = tid & 31; f32x4 o[4] = {{0.f, 0.f, 0.f, 0.f}, {0.f, 0.f, 0.f, 0.f}, {0.f, 0.f, 0.f, 0.f}, {0.f, 0.f, 0.f, 0.f}};
#pragma unroll 4
      for (int dk = 0; dk < 64; ++dk) { const f32x4 qv = *(const LAS f32x4*)(qiT + dk * 64 + 4 * t4), sv = *(const LAS f32x4*)(Sst + dk * 128 + 4 * dvq);
#pragma unroll
          for (int i = 0; i < 4; ++i) o[i] += qv[i] * sv; }
      const int smax = 4 * t4 + 3;
      for (int s = 0; s <= smax; ++s) { const f32x4 av = *(const LAS f32x4*)(attT + s * 64 + 4 * t4), v4 = *(const LAS f32x4*)(vv + s * 128 + 4 * dvq);
#pragma unroll
          for (int i = 0; i < 4; ++i) o[i] += av[i] * v4; }
      const f32x4 gn = *(const f32x4*)((const float*)A.in[19] + h * 128 + 4 * dvq);
#pragma unroll
      for (int i = 0; i < 4; ++i) { const float ss = half_sum((o[i][0] * o[i][0] + o[i][1] * o[i][1]) + (o[i][2] * o[i][2] + o[i][3] * o[i][3]));
          const float rstd = 1.0f / sqrtf(ss * (1.0f / 128.0f) + 1e-6f); const int row = row0 + 4 * t4 + i;
          const v2u rw = *(const v2u*)(Z + (size_t)row * ZE + 1024 + h * 128 + 4 * dvq);
          const float r0 = bf2f((unsigned short)(rw.x & 0xffffu)), r1 = bf2f((unsigned short)(rw.x >> 16)), r2 = bf2f((unsigned short)(rw.y & 0xffffu)), r3 = bf2f((unsigned short)(rw.y >> 16));
          v2u ow; ow.x = pk2(o[i][0] * rstd * gn[0] * siluf_(r0), o[i][1] * rstd * gn[1] * siluf_(r1)); ow.y = pk2(o[i][2] * rstd * gn[2] * siluf_(r2), o[i][3] * rstd * gn[3] * siluf_(r3));
          *(GAS v2u*)(OP + (size_t)row * DM + h * 128 + 4 * dvq) = ow; } }
    __syncthreads();
}
__device__ __forceinline__ void gla_sample_unit(Frame& F, const Args& A, int unit) {
    const bf16* Z = WS_PTR(bf16, WS_Z); bf16* OP = WS_PTR(bf16, WS_OP);
    const float* gate_w2 = (const float*)A.in[17]; const float* gate_b = (const float*)A.in[18]; const float* S0g = (const float*)A.in[2] + (size_t)unit * 8192; float* Sout = F.out + O_GLAS + (size_t)unit * 8192;
    const int b = unit >> 2, h = unit & 3, row0 = MP + 4 * b, tid = F.tid;
    LAS float* S0 = (LAS float*)F.lds; LAS float* bc = S0 + 8192; LAS float* qi = bc + 256; LAS float* ki = qi + 256; LAS float* kk = ki + 256; LAS float* vv = kk + 256; LAS float* att = vv + 512; LAS float* gl = att + 16; LAS float* red = gl + 64;
#pragma unroll
    for (int j = 0; j < 4; ++j) *(LAS f32x4*)(S0 + 4 * (tid + 512 * j)) = *(const f32x4*)(S0g + 4 * (tid + 512 * j));
    if (tid < 64) gl[tid] = bf2f(Z[(size_t)(row0 + (tid >> 4)) * ZE + 2048 + (tid & 15)]);
    vv[tid] = bf2f(Z[(size_t)(row0 + (tid >> 7)) * ZE + 512 + h * 128 + (tid & 127)]);
    __syncthreads();
    if (tid < 256) { const int t = tid >> 6, dk = tid & 63; float x = gate_b[h * 64 + dk];
#pragma unroll
        for (int j = 0; j < 16; ++j) x += gl[t * 16 + j] * gate_w2[j * 256 + h * 64 + dk];
        bc[t * 64 + dk] = logsig16(x); }
    __syncthreads();
    if (tid < 64) { float run = 0.f;
#pragma unroll
        for (int t = 0; t < 4; ++t) { run += bc[t * 64 + tid]; bc[t * 64 + tid] = run; } }
    __syncthreads();
    if (tid < 256) { const int t = tid >> 6, dk = tid & 63; const float bb = bc[t * 64 + dk], bl = bc[3 * 64 + dk];
        const float qv = bf2f(Z[(size_t)(row0 + t) * ZE + h * 64 + dk]), kv = bf2f(Z[(size_t)(row0 + t) * ZE + 256 + h * 64 + dk]);
        qi[t * 64 + dk] = 0.125f * qv * __expf(bb); ki[t * 64 + dk] = kv * __expf(-bb); kk[t * 64 + dk] = kv * __expf(bl - bb); }
    __syncthreads();
    if (tid < 16) { const int t = tid >> 2, s = tid & 3; float a = 0.f;
        for (int dk = 0; dk < 64; ++dk) a += qi[t * 64 + dk] * ki[s * 64 + dk];
        att[tid] = (s <= t) ? a : 0.f; }
    __syncthreads();
    { const int t = tid >> 7, dv = tid & 127; float o = 0.f;
#pragma unroll 8
      for (int dk = 0; dk < 64; ++dk) o += qi[t * 64 + dk] * S0[dk * 128 + dv];
#pragma unroll
      for (int s = 0; s < 4; ++s) o += att[t * 4 + s] * vv[s * 128 + dv];
      const float ss = wave_sum(o * o); if (F.lane == 0) red[F.wave] = ss;
      __syncthreads();
      const float tot = red[2 * t] + red[2 * t + 1]; const float rstd = 1.0f / sqrtf(tot * (1.0f / 128.0f) + 1e-6f);
      const float gn = ((const float*)A.in[19])[h * 128 + dv]; const float rr = bf2f(Z[(size_t)(row0 + t) * ZE + 1024 + h * 128 + dv]);
      OP[(size_t)(row0 + t) * DM + h * 128 + dv] = (bf16)f2bf(o * rstd * gn * siluf_(rr)); }
#pragma unroll
    for (int j = 0; j < 4; ++j) { const int e = 4 * (tid + 512 * j), dk = e >> 7, dv = e & 127; const float dec = __expf(bc[3 * 64 + dk]);
        f32x4 sn = *(const LAS f32x4*)(S0 + e) * dec;
#pragma unroll
        for (int s = 0; s < 4; ++s) sn += kk[s * 64 + dk] * *(const LAS f32x4*)(vv + s * 128 + dv);
        *(f32x4*)(Sout + e) = sn; }
    __syncthreads();
}
__device__ __forceinline__ void pool_prompt_unit(Frame& F, int unit) {
    const bf16* Z = WS_PTR(bf16, WS_Z); bf16* OP = WS_PTR(bf16, WS_OP); float* hp = F.out + O_POOLP;
    const int b = unit >> 7, t0 = (unit & 127) * 64, c = F.tid, w = 2 << (c >> 7); const size_t rb = (size_t)b * TP;
    float s = 0.f;
    for (int j = t0 - w; j < t0; ++j) if (j >= 0) s += bf2f(Z[(rb + j) * ZE + 1536 + c]);
    for (int t = t0; t < t0 + 64; ++t) { const float ut = bf2f(Z[(rb + t) * ZE + 1536 + c]); s += ut; if (t - w >= 0) s -= bf2f(Z[(rb + t - w) * ZE + 1536 + c]);
        const float cnt = (float)((t + 1 < w) ? t + 1 : w);
        OP[(rb + t) * DM + 512 + c] = (bf16)f2bf(s / cnt - ut);
        if (t >= TP - 15) hp[((size_t)b * 15 + (t - (TP - 15))) * 512 + c] = ut; }
}
__device__ __forceinline__ void pool_sample_unit(Frame& F, const Args& A, int b) {
    const bf16* Z = WS_PTR(bf16, WS_Z); bf16* OP = WS_PTR(bf16, WS_OP); float* hs = F.out + O_POOLS + (size_t)b * 15 * 512; const float* hin = (const float*)A.in[3] + (size_t)b * 15 * 512;
    const int c = F.tid, w = 2 << (c >> 7); float full[19];
#pragma unroll
    for (int i = 0; i < 15; ++i) full[i] = hin[i * 512 + c];
#pragma unroll
    for (int t = 0; t < 4; ++t) full[15 + t] = bf2f(Z[(size_t)(MP + 4 * b + t) * ZE + 1536 + c]);
#pragma unroll
    for (int t = 0; t < 4; ++t) { float s = 0.f;
#pragma unroll
        for (int j = 0; j < 16; ++j) if (j < w) s += full[15 + t - j];
        OP[(size_t)(MP + 4 * b + t) * DM + 512 + c] = (bf16)f2bf(s / (float)w - full[15 + t]); }
#pragma unroll
    for (int i = 0; i < 15; ++i) hs[i * 512 + c] = full[4 + i];
}
__device__ __forceinline__ void even_mid_phase(Frame& F, const Args& A) {
    constexpr int N1 = 1024, N2 = 512, N3 = 256, N4 = 128;
    for (int u = F.bx; u < N1 + N2 + N3 + N4; u += F.G) {
        if (u < N1) gla_g1_unit(F, A, u);
        else if (u < N1 + N2) gla_sample_unit(F, A, u - N1);
        else if (u < N1 + N2 + N3) pool_prompt_unit(F, u - N1 - N2);
        else pool_sample_unit(F, A, u - N1 - N2 - N3);
    }
}
__device__ __forceinline__ void odd_rows(Frame& F, const Args& A) {
    const bf16* Z = WS_PTR(bf16, WS_Z); bf16* CQN = WS_PTR(bf16, WS_CQN); bf16* CKVB = WS_PTR(bf16, WS_CKVB); bf16* KRB = WS_PTR(bf16, WS_KRB); const float* rt = WS_PTR(float, WS_RT);
    const float* q_norm = (const float*)A.in[24]; const float* kv_norm = (const float*)A.in[26];
    const int gw = F.bx * NWAVES + F.wave, NGW = F.G * NWAVES, lane = F.lane;
    for (int row = gw; row < MT; row += NGW) {
        const bf16* zr = Z + (size_t)row * ZO;
        { float v[6]; float ss = 0.f;
#pragma unroll
          for (int j = 0; j < 3; ++j) { const unsigned w = *(const unsigned*)(zr + 2 * lane + 128 * j); v[2 * j] = bf2f((unsigned short)(w & 0xffffu)); v[2 * j + 1] = bf2f((unsigned short)(w >> 16)); ss += v[2 * j] * v[2 * j] + v[2 * j + 1] * v[2 * j + 1]; }
          const float rstd = 1.0f / sqrtf(wave_sum(ss) * (1.0f / 384.0f) + 1e-6f);
#pragma unroll
          for (int j = 0; j < 3; ++j) { const int c = 2 * lane + 128 * j; *(GAS unsigned*)(CQN + (size_t)row * 384 + c) = pk2(v[2 * j] * rstd * q_norm[c], v[2 * j + 1] * rstd * q_norm[c + 1]); } }
        { const v2u w = *(const v2u*)(zr + 384 + 4 * lane); f32x4 v = {bf2f((unsigned short)(w.x & 0xffffu)), bf2f((unsigned short)(w.x >> 16)), bf2f((unsigned short)(w.y & 0xffffu)), bf2f((unsigned short)(w.y >> 16))};
          const float ss = wave_sum((v[0] * v[0] + v[1] * v[1]) + (v[2] * v[2] + v[3] * v[3])); const float rstd = 1.0f / sqrtf(ss * (1.0f / 256.0f) + 1e-6f);
          const f32x4 o = (v * rstd) * *(const f32x4*)(kv_norm + 4 * lane);
          *(f32x4*)(F.out + O_CKV + (size_t)row * 256 + 4 * lane) = o;
          v2u ob; ob.x = pk2(o[0], o[1]); ob.y = pk2(o[2], o[3]); *(GAS v2u*)(CKVB + (size_t)row * 256 + 4 * lane) = ob; }
        if (lane < 16) { const float x1 = bf2f(zr[640 + lane]), x2 = bf2f(zr[640 + 16 + lane]); const f32x2 cs = *(const f32x2*)(rt + (size_t)posof(row) * 32 + 2 * lane);
          const float o1 = x1 * cs[0] - x2 * cs[1], o2 = x2 * cs[0] + x1 * cs[1];
          F.out[O_KR + (size_t)row * 32 + lane] = o1; F.out[O_KR + (size_t)row * 32 + 16 + lane] = o2;
          KRB[(size_t)row * 32 + lane] = (bf16)f2bf(o1); KRB[(size_t)row * 32 + 16 + lane] = (bf16)f2bf(o2); }
    }
}
template <bool SAMPLE> __device__ __forceinline__ void conv_unit(Frame& F, const Args& A, int unit) {
    constexpr int NTOK = SAMPLE ? 4 : 32, NR = NTOK + 30;
    const bf16* Z = WS_PTR(bf16, WS_Z); bf16* OP = WS_PTR(bf16, WS_OP);
    const float* conv_w = (const float*)A.in[29]; const float* conv_b = (const float*)A.in[30]; const float* ng = (const float*)A.in[31]; const float* nb = (const float*)A.in[32];
    const int c = F.tid; LAS float* ut = (LAS float*)F.lds;
    LAS float* stat = ut + 62 * 512;
    const int b = SAMPLE ? unit : (unit >> 8), t0 = SAMPLE ? 0 : (unit & 255) * 32; const size_t rb = SAMPLE ? (size_t)(MP + 4 * b) : (size_t)b * TP;
    for (int rr = 0; rr < NR; ++rr) { const int t = t0 - 30 + rr; float u = 0.f;
        if (t >= 0) { const bf16* zr = Z + (rb + t) * ZO; u = bf2f(zr[672 + c]) * sigmoidf_(bf2f(zr[1184 + c])); }
        else if (SAMPLE) u = ((const float*)A.in[6])[((size_t)b * 30 + rr) * 512 + c];
        ut[rr * 512 + c] = u; }
    float w[31];
#pragma unroll
    for (int j = 0; j < 31; ++j) w[j] = conv_w[j * 512 + c];
    const float bias = conv_b[c];
    if (SAMPLE) { float* cs = F.out + O_CONVS + (size_t)b * 30 * 512;
        for (int i = 0; i < 30; ++i) cs[i * 512 + c] = ut[(4 + i) * 512 + c]; }
    else if (t0 == TP - 32) { float* cp = F.out + O_CONVP + (size_t)b * 30 * 512;
        for (int i = 0; i < 30; ++i) cp[i * 512 + c] = ut[(32 + i) * 512 + c]; }
#pragma unroll 4
    for (int tt = 0; tt < NTOK; ++tt) { float a = bias;
#pragma unroll
        for (int j = 0; j < 31; ++j) a += w[j] * ut[(tt + j) * 512 + c];
        ut[tt * 512 + c] = a; }
    __syncthreads();
    for (int tt = F.wave; tt < NTOK; tt += NWAVES) { float s1 = 0.f, s2 = 0.f;
#pragma unroll
        for (int j = 0; j < 8; ++j) { const float x = ut[tt * 512 + F.lane + 64 * j]; s1 += x; s2 += x * x; }
        s1 = wave_sum(s1); s2 = wave_sum(s2); const float mean = s1 * (1.0f / 512.0f); const float var = fmaxf(s2 * (1.0f / 512.0f) - mean * mean, 0.f);
        if (F.lane == 0) { stat[2 * tt] = mean; stat[2 * tt + 1] = 1.0f / sqrtf(var + 1e-6f); } }
    __syncthreads();
    const float gg = ng[c], bb = nb[c];
#pragma unroll 4
    for (int tt = 0; tt < NTOK; ++tt) { const float y = (ut[tt * 512 + c] - stat[2 * tt]) * stat[2 * tt + 1] * gg + bb;
        OP[(rb + t0 + tt) * DM + 512 + c] = (bf16)f2bf(siluf_(y)); }
    __syncthreads();
}
__device__ __forceinline__ void odd_thin_phase(Frame& F, const Args& A) {
    odd_rows(F, A);
    for (int u = F.bx; u < 512 + 128; u += F.G) { if (u < 512) conv_unit<false>(F, A, u); else conv_unit<true>(F, A, u - 512); }
}
typedef short v4i16_t __attribute__((ext_vector_type(4)));
__device__ __forceinline__ s16x4 vtr(const LAS unsigned char* p) { return __builtin_bit_cast(s16x4, __builtin_amdgcn_ds_read_tr16_b64_v4i16((LAS v4i16_t*)p)); }
__device__ __forceinline__ int crow(int r, int hi) { return (r & 3) + 8 * (r >> 2) + 4 * hi; }
__device__ __forceinline__ bf16x8 pack8(const f32x16& p, int s8) {
    v4u w; w.x = pg8::cvt_pk_bf16(p[s8 + 0], p[s8 + 1]); w.y = pg8::cvt_pk_bf16(p[s8 + 2], p[s8 + 3]); w.z = pg8::cvt_pk_bf16(p[s8 + 4], p[s8 + 5]); w.w = pg8::cvt_pk_bf16(p[s8 + 6], p[s8 + 7]);
    return __builtin_bit_cast(bf16x8, w);
}
constexpr int PA_KROW = 208, PA_VROW = 144, PA_VOFF = 64 * PA_KROW, PA_BUF = PA_VOFF + 64 * PA_VROW;
__device__ __forceinline__ void pattn_unit(Frame& F, int b, int h, int qb) {
    const bf16* Q = WS_PTR(bf16, WS_Q); const bf16* KV = WS_PTR(bf16, WS_KV); const bf16* KRB = WS_PTR(bf16, WS_KRB); bf16* OP = WS_PTR(bf16, WS_OP);
    const int tid = F.tid, lane = F.lane, wid = F.wave, r32 = lane & 31, hi = lane >> 5;
    const size_t rb = (size_t)b * TP; const int q0w = 256 * qb + 32 * wid, NT = 4 * (qb + 1);
    LAS unsigned char* L = F.lds;
    const int skey = tid >> 3, sc = tid & 7, rkey = tid >> 2, rc = tid & 3;
    const bf16* gk = KV + (rb + skey) * 1024 + h * 64 + 8 * sc; const bf16* gv = gk + 512; const bf16* gr = KRB + (rb + rkey) * 32 + 8 * rc;
    const int lk = skey * PA_KROW + (sc << 4), lv = PA_VOFF + skey * PA_VROW + (sc << 4), lr = rkey * PA_KROW + ((8 + rc) << 4);
    v4u sk, sv, sr = {0u, 0u, 0u, 0u};
#define PA_LOAD(kt) do { sk = *(const v4u*)(gk + (size_t)(kt) * 64 * 1024); sv = *(const v4u*)(gv + (size_t)(kt) * 64 * 1024); if (tid < 256) sr = *(const v4u*)(gr + (size_t)(kt) * 64 * 32); } while (0)
#define PA_STORE(bufo) do { *(LAS v4u*)(L + (bufo) + lk) = sk; *(LAS v4u*)(L + (bufo) + lv) = sv; if (tid < 256) *(LAS v4u*)(L + (bufo) + lr) = sr; } while (0)
    PA_LOAD(0);
    bf16x8 qf[6];
    { const bf16* qp = Q + (rb + q0w + r32) * 768 + h * 96 + 8 * hi;
#pragma unroll
      for (int kk = 0; kk < 6; ++kk) qf[kk] = *(const bf16x8*)(qp + 16 * kk); }
    f32x16 o0 = {}, o1 = {}; float mrun = -1e30f, lrun = 0.f;
    PA_STORE(0);
    __syncthreads();
    const int aoffk = r32 * PA_KROW + (hi << 4);
    const int g = lane >> 4, i16 = lane & 15, hg = g >> 1;
    const int voff = PA_VOFF + (4 * hg + (i16 >> 2)) * PA_VROW + ((16 * (g & 1) + 4 * (i16 & 3)) << 1);
    for (int kt = 0; kt < NT; ++kt) {
        const int bufo = (kt & 1) * PA_BUF;
        if (kt + 1 < NT) PA_LOAD(kt + 1);
        if (64 * kt <= q0w + 31) {
            f32x16 p0 = {}, p1 = {};
#pragma unroll
            for (int kk = 0; kk < 6; ++kk) {
                const bf16x8 a0 = *(const LAS bf16x8*)(L + bufo + aoffk + 32 * kk), a1 = *(const LAS bf16x8*)(L + bufo + aoffk + 32 * PA_KROW + 32 * kk);
                p0 = __builtin_amdgcn_mfma_f32_32x32x16_bf16(a0, qf[kk], p0, 0, 0, 0); p1 = __builtin_amdgcn_mfma_f32_32x32x16_bf16(a1, qf[kk], p1, 0, 0, 0); }
            if (64 * kt + 63 > q0w) { const int qq = q0w + r32;
#pragma unroll
                for (int r = 0; r < 16; ++r) { const int key = 64 * kt + crow(r, hi); if (key > qq) p0[r] = -INFINITY; if (key + 32 > qq) p1[r] = -INFINITY; } }
            float mt = fmaxf(p0[0], p1[0]);
#pragma unroll
            for (int r = 1; r < 16; ++r) mt = fmaxf(mt, fmaxf(p0[r], p1[r]));
            mt = fmaxf(mt, __shfl_xor(mt, 32));
            const float mnew = fmaxf(mrun, mt), alpha = __builtin_amdgcn_exp2f(mrun - mnew); mrun = mnew;
            float rs = 0.f;
#pragma unroll
            for (int r = 0; r < 16; ++r) { p0[r] = __builtin_amdgcn_exp2f(p0[r] - mnew); p1[r] = __builtin_amdgcn_exp2f(p1[r] - mnew); rs += p0[r] + p1[r]; }
            rs += __shfl_xor(rs, 32); lrun = lrun * alpha + rs;
#pragma unroll
            for (int r = 0; r < 16; ++r) { o0[r] *= alpha; o1[r] *= alpha; }
#pragma unroll
            for (int hf = 0; hf < 2; ++hf)
#pragma unroll
                for (int s = 0; s < 2; ++s) { const bf16x8 pb = pack8(hf ? p1 : p0, 8 * s);
#pragma unroll
                    for (int dt = 0; dt < 2; ++dt) { const int a0 = bufo + voff + (32 * hf + 16 * s) * PA_VROW + 64 * dt, a1 = a0 + 8 * PA_VROW;
                        const s16x4 lo = vtr(L + a0), hh = vtr(L + a1);
                        const bf16x8 va = {lo[0], lo[1], lo[2], lo[3], hh[0], hh[1], hh[2], hh[3]};
                        if (dt == 0) o0 = __builtin_amdgcn_mfma_f32_32x32x16_bf16(va, pb, o0, 0, 0, 0); else o1 = __builtin_amdgcn_mfma_f32_32x32x16_bf16(va, pb, o1, 0, 0, 0); } }
        }
        if (kt + 1 < NT) PA_STORE(((kt + 1) & 1) * PA_BUF);
        __syncthreads();
    }
#undef PA_LOAD
#undef PA_STORE
    const float rl = 1.0f / lrun;
    bf16* op = OP + (rb + q0w + r32) * DM + h * 64;
#pragma unroll
    for (int dt = 0; dt < 2; ++dt)
#pragma unroll
        for (int rq = 0; rq < 4; ++rq) { const f32x16& o = dt ? o1 : o0; v2u w; w.x = pk2(o[4 * rq] * rl, o[4 * rq + 1] * rl); w.y = pk2(o[4 * rq + 2] * rl, o[4 * rq + 3] * rl);
            *(GAS v2u*)(op + 32 * dt + 8 * rq + 4 * hi) = w; }
}

constexpr int DT_ROW = 592, DT_TILE = 64 * DT_ROW, DT_QOFF = 2 * DT_TILE, DT_QN = DT_QOFF + 32 * DT_ROW, DT_ML = 133120;
__device__ __forceinline__ void dattn_unit(Frame& F, const Args& A, int unit) {
    const bf16* Q = WS_PTR(bf16, WS_Q); float* PART = WS_PTR(float, WS_PART) + (size_t)unit * PART_F; float* QD = WS_PTR(float, WS_QD);
    const float* cckv = (const float*)A.in[4]; const float* ckr = (const float*)A.in[5]; const int* ptab = (const int*)A.in[7]; const float* w_uk = (const float*)A.in[27];
    const int tid = F.tid, lane = F.lane, wid = F.wave, r32 = lane & 31, hi = lane >> 5, b = unit >> 3, sp = unit & 7;
    LAS unsigned char* L = F.lds; LAS float* qn = (LAS float*)(L + DT_QN); LAS float* ml = (LAS float*)(L + DT_ML);
    f32x4 st[9];
    const int wofs = (tid >> 6) * DT_ROW + (tid & 63) * 8, wofr = (tid >> 3) * DT_ROW + 512 + (tid & 7) * 8;
#define DT_LOAD(tl) do { const int pid = ptab[b * 64 + sp * 8 + ((tl) >> 1)]; const f32x4* pc = (const f32x4*)(cckv + ((size_t)pid * 128 + ((tl) & 1) * 64) * 256); const f32x4* pr = (const f32x4*)(ckr + ((size_t)pid * 128 + ((tl) & 1) * 64) * 32); \
        _Pragma("unroll") for (int i = 0; i < 8; ++i) st[i] = __builtin_nontemporal_load(pc + tid + 512 * i); \
        st[8] = __builtin_nontemporal_load(pr + tid); } while (0)
#define DT_STORE(bufo) do { _Pragma("unroll") for (int i = 0; i < 8; ++i) { v2u w_; w_.x = pg8::cvt_pk_bf16(st[i][0], st[i][1]); w_.y = pg8::cvt_pk_bf16(st[i][2], st[i][3]); *(LAS v2u*)(L + (bufo) + wofs + i * 8 * DT_ROW) = w_; } \
        { v2u w_; w_.x = pg8::cvt_pk_bf16(st[8][0], st[8][1]); w_.y = pg8::cvt_pk_bf16(st[8][2], st[8][3]); *(LAS v2u*)(L + (bufo) + wofr) = w_; } } while (0)
    DT_LOAD(0);
    { const int t = tid >> 7, c6 = (tid & 127) * 6;
      const bf16* qp = Q + (size_t)(MP + 4 * b + t) * 768 + c6;
#pragma unroll
      for (int e = 0; e < 6; ++e) { const int c = c6 + e, hh = c / 96, d = c % 96; const bf16 v = qp[e];
          if (d < 64) qn[(t * 8 + hh) * 64 + d] = bf2f(v);
          else { const int q = t * 8 + hh, col = 256 + (d - 64); *(LAS bf16*)(L + DT_QOFF + q * DT_ROW + col * 2) = v;
                 if (sp == 0) QD[((size_t)b * 32 + q) * 288 + col] = bf2f(v); } } }
    __syncthreads();
    { const int hh = tid >> 6, rr = tid & 63;
#pragma unroll 1
      for (int j = 0; j < 4; ++j) { const int r = rr + 64 * j; const f32x4* wp = (const f32x4*)(w_uk + ((size_t)r * 8 + hh) * 64); float a0 = 0.f, a1 = 0.f, a2 = 0.f, a3 = 0.f;
#pragma unroll 4
          for (int d4 = 0; d4 < 16; ++d4) { const f32x4 w = wp[d4];
              const f32x4 x0 = *(const LAS f32x4*)(qn + (0 * 8 + hh) * 64 + 4 * d4), x1 = *(const LAS f32x4*)(qn + (1 * 8 + hh) * 64 + 4 * d4), x2 = *(const LAS f32x4*)(qn + (2 * 8 + hh) * 64 + 4 * d4), x3 = *(const LAS f32x4*)(qn + (3 * 8 + hh) * 64 + 4 * d4);
              a0 += (w[0] * x0[0] + w[1] * x0[1]) + (w[2] * x0[2] + w[3] * x0[3]); a1 += (w[0] * x1[0] + w[1] * x1[1]) + (w[2] * x1[2] + w[3] * x1[3]);
              a2 += (w[0] * x2[0] + w[1] * x2[1]) + (w[2] * x2[2] + w[3] * x2[3]); a3 += (w[0] * x3[0] + w[1] * x3[1]) + (w[2] * x3[2] + w[3] * x3[3]); }
          const float av[4] = {a0, a1, a2, a3};
#pragma unroll
          for (int t = 0; t < 4; ++t) { const int q = t * 8 + hh; *(LAS bf16*)(L + DT_QOFF + q * DT_ROW + r * 2) = (bf16)f2bf(av[t]);
              if (sp == 0) QD[((size_t)b * 32 + q) * 288 + r] = av[t]; } } }
    DT_STORE(0);
    __syncthreads();
    const int kh = wid & 1, dq = wid >> 1, g = lane >> 4, i16 = lane & 15, hg = g >> 1;
    f32x16 o0 = {}, o1 = {}; float mrun = -1e30f, lrun = 0.f;
    const int arow = (32 * kh + r32) * DT_ROW + (hi << 4), qrow = DT_QOFF + r32 * DT_ROW + (hi << 4);
    const int voff = (32 * kh + 4 * hg + (i16 >> 2)) * DT_ROW + ((64 * dq + 16 * (g & 1) + 4 * (i16 & 3)) << 1);
    for (int tl = 0; tl < 16; ++tl) {
        const int bufo = (tl & 1) * DT_TILE;
        if (tl + 1 < 16) DT_LOAD(tl + 1);
        f32x16 p = {};
#pragma unroll
        for (int kk = 0; kk < 18; ++kk) { const bf16x8 a = *(const LAS bf16x8*)(L + bufo + arow + 32 * kk), qv = *(const LAS bf16x8*)(L + qrow + 32 * kk);
            p = __builtin_amdgcn_mfma_f32_32x32x16_bf16(a, qv, p, 0, 0, 0); }
        float mt = p[0];
#pragma unroll
        for (int r = 1; r < 16; ++r) mt = fmaxf(mt, p[r]);
        mt = fmaxf(mt, __shfl_xor(mt, 32));
        const float mnew = fmaxf(mrun, mt), alpha = __builtin_amdgcn_exp2f(mrun - mnew); mrun = mnew;
        float rs = 0.f;
#pragma unroll
        for (int r = 0; r < 16; ++r) { p[r] = __builtin_amdgcn_exp2f(p[r] - mnew); rs += p[r]; }
        rs += __shfl_xor(rs, 32); lrun = lrun * alpha + rs;
#pragma unroll
        for (int r = 0; r < 16; ++r) { o0[r] *= alpha; o1[r] *= alpha; }
#pragma unroll
        for (int s = 0; s < 2; ++s) { const bf16x8 pb = pack8(p, 8 * s);
#pragma unroll
            for (int dt = 0; dt < 2; ++dt) { const int a0 = bufo + voff + 16 * s * DT_ROW + 64 * dt, a1 = a0 + 8 * DT_ROW;
                const s16x4 lo = vtr(L + a0), hh = vtr(L + a1);
                const bf16x8 va = {lo[0], lo[1], lo[2], lo[3], hh[0], hh[1], hh[2], hh[3]};
                if (dt == 0) o0 = __builtin_amdgcn_mfma_f32_32x32x16_bf16(va, pb, o0, 0, 0, 0); else o1 = __builtin_amdgcn_mfma_f32_32x32x16_bf16(va, pb, o1, 0, 0, 0); } }
        if (tl + 1 < 16) DT_STORE(((tl + 1) & 1) * DT_TILE);
        __syncthreads();
    }
#undef DT_LOAD
#undef DT_STORE
    { LAS float* ow = (LAS float*)L + (size_t)wid * 2048;
#pragma unroll
      for (int dt = 0; dt < 2; ++dt)
#pragma unroll
          for (int r = 0; r < 16; ++r) ow[(32 * dt + crow(r, hi)) * 32 + r32] = dt ? o1[r] : o0[r];
      if (hi == 0) { ml[wid * 64 + r32] = mrun; ml[wid * 64 + 32 + r32] = lrun; } }
    __syncthreads();
    { const int q = tid & 31, dvg = tid >> 5, dqq = dvg >> 2;
      const float m0 = ml[(2 * dqq) * 64 + q], m1 = ml[(2 * dqq + 1) * 64 + q], ms = fmaxf(m0, m1);
      const float w0 = __builtin_amdgcn_exp2f(m0 - ms), w1 = __builtin_amdgcn_exp2f(m1 - ms);
      const float ls = w0 * ml[(2 * dqq) * 64 + 32 + q] + w1 * ml[(2 * dqq + 1) * 64 + 32 + q];
#pragma unroll
      for (int j = 0; j < 16; ++j) { const int dv = dvg * 16 + j, dvl = dv & 63;
          PART[dv * 32 + q] = w0 * ((LAS float*)L)[(size_t)(2 * dqq) * 2048 + dvl * 32 + q] + w1 * ((LAS float*)L)[(size_t)(2 * dqq + 1) * 2048 + dvl * 32 + q]; }
      if (dvg == 0) { PART[8192 + q] = ms; PART[8192 + 32 + q] = ls; } }
    __syncthreads();
}
__device__ __forceinline__ void dcombine_unit(Frame& F, const Args& A, int b) {
    const float* PART = WS_PTR(float, WS_PART) + (size_t)b * NSPLIT * PART_F; const float* QD = WS_PTR(float, WS_QD) + (size_t)b * 32 * 288; bf16* OP = WS_PTR(bf16, WS_OP);
    const float* ckv = F.out + O_CKV + (size_t)(MP + 4 * b) * 256; const float* kr = F.out + O_KR + (size_t)(MP + 4 * b) * 32; const float* w_uv = (const float*)A.in[28];
    const int tid = F.tid; LAS float* lat = (LAS float*)F.lds; LAS float* sn = lat + 8192; LAS float* ck = sn + 128;
    for (int i = tid; i < 1024; i += 512) ck[i] = ckv[i];
    if (tid < 128) { const int q = tid >> 2, s = tid & 3; const float* qd = QD + q * 288; const float* cr = ckv + s * 256; const float* krr = kr + s * 32; float a = 0.f;
        for (int r = 0; r < 256; ++r) a += qd[r] * cr[r];
        for (int i = 0; i < 32; ++i) a += qd[256 + i] * krr[i];
        sn[tid] = (s <= (q >> 3)) ? a : -INFINITY; }
    __syncthreads();
    { const int q = tid & 31, dvg = tid >> 5; float mk[NSPLIT], ms = -1e30f;
#pragma unroll
      for (int s = 0; s < NSPLIT; ++s) { mk[s] = PART[(size_t)s * PART_F + 8192 + q]; ms = fmaxf(ms, mk[s]); }
      float pn[4];
#pragma unroll
      for (int s = 0; s < 4; ++s) { pn[s] = sn[q * 4 + s]; ms = fmaxf(ms, pn[s]); }
      float wg[NSPLIT], ls = 0.f;
#pragma unroll
      for (int s = 0; s < NSPLIT; ++s) { wg[s] = __builtin_amdgcn_exp2f(mk[s] - ms); ls += wg[s] * PART[(size_t)s * PART_F + 8192 + 32 + q]; }
#pragma unroll
      for (int s = 0; s < 4; ++s) { pn[s] = __builtin_amdgcn_exp2f(pn[s] - ms); ls += pn[s]; }
      const float rl = 1.0f / ls;
#pragma unroll 4
      for (int j = 0; j < 16; ++j) { const int dv = dvg * 16 + j; float acc = 0.f;
#pragma unroll
          for (int s = 0; s < NSPLIT; ++s) acc += wg[s] * PART[(size_t)s * PART_F + dv * 32 + q];
#pragma unroll
          for (int s = 0; s < 4; ++s) acc += pn[s] * ck[s * 256 + dv];
          lat[q * 256 + dv] = acc * rl; } }
    __syncthreads();
    { const int hh = tid >> 6, v = tid & 63; float a[4] = {0.f, 0.f, 0.f, 0.f};
#pragma unroll 4
      for (int r = 0; r < 256; ++r) { const float w = w_uv[((size_t)r * 8 + hh) * 64 + v];
#pragma unroll
          for (int t = 0; t < 4; ++t) a[t] += w * lat[(t * 8 + hh) * 256 + r]; }
#pragma unroll
      for (int t = 0; t < 4; ++t) OP[(size_t)(MP + 4 * b + t) * DM + hh * 64 + v] = (bf16)f2bf(a[t]); }
    __syncthreads();
}
__device__ __forceinline__ void attn_phase(Frame& F, const Args& A) {
    for (int pr = F.bx; pr < 256; pr += F.G) { const int bh = pr >> 4, s = pr & 15; pattn_unit(F, bh >> 3, bh & 7, 31 - s); pattn_unit(F, bh >> 3, bh & 7, s); }
    for (int du = F.bx; du < 128 * NSPLIT; du += F.G) dattn_unit(F, A, du);
}
constexpr int N_PHASE_IDS = 43;
#ifndef PHMASK
#define PHMASK 0xFFFFFFFFu
#endif
#define EN(n) (((PHMASK) >> (n)) & 1u)
#ifndef MK_ONE_LAUNCH
#define MK_ONE_LAUNCH 0
#endif
__global__ void __launch_bounds__(NWAVES * 64, 2) mk_fwd(Args args) {
    extern __shared__ __attribute__((aligned(16))) unsigned char lds[];
    Frame F;
    F.lds = (LAS unsigned char*)lds; F.MISC = (volatile LAS unsigned*)(F.lds + MISC_OFF);
    F.tid = threadIdx.x; F.lane = F.tid & 63; F.wave = __builtin_amdgcn_readfirstlane(F.tid >> 6); F.G = gridDim.x; F.bx = blockIdx.x;
    F.ws = args.ws; F.out = args.out; F.ctl = (gu32*)(args.ws + WS_CTL);
    for (int u = F.tid; u < (LDS_BYTES - LDSCTL_OFF) / 4; u += NWAVES * 64) ((LAS unsigned*)(F.lds + LDSCTL_OFF))[u] = 0u;
    __syncthreads();
    XcdBarrier bar; bar.bar = (unsigned*)(F.ctl + CW_BAR); bar.x = 0; bar.st = nullptr;
    if (args.use_bar) bar = xcd_barrier_post((unsigned*)(F.ctl + CW_BAR), F.MISC + 8);
    const int lo = args.ph_lo, hi = args.ph_hi;
#define RUN(k) (lo <= (k) && (k) < hi)
#define FRESH() do { int t_ = threadIdx.x; asm volatile("" : "+v"(t_)); F.tid = t_; F.lane = t_ & 63; F.wave = __builtin_amdgcn_readfirstlane(t_ >> 6); } while (0)
#define SEAM(k) do { if (args.use_bar && (k) + 1 < hi) xcd_barrier(bar); } while (0)
    LAS unsigned char* ring = F.lds;
    const float* xin_p = (const float*)args.in[0]; const float* xin_s = (const float*)args.in[1] - (size_t)MP * DM;
    float* X = WS_PTR(float, WS_X); bf16* H = WS_PTR(bf16, WS_H); bf16* ACT = WS_PTR(bf16, WS_ACT); bf16* Z = WS_PTR(bf16, WS_Z); bf16* OP = WS_PTR(bf16, WS_OP); float* MOD = WS_PTR(float, WS_MOD);
    const float* norm_g = (const float*)args.in[12];

    if (EN(0) && RUN(0)) { FRESH(); p0_prologue(F, args); SEAM(0); }
    if (EN(1) && RUN(1)) { pg8::Gemm g{WS_PTR(bf16, WS_SC), WS_PTR(bf16, WS_ADAT), 256, MODLD, DM}; pg8::StaticOrder S; S.init(256, MODLD, F.G, F.bx);
        pg8::EpiMod E{MOD, (const float*)args.in[11]};
        pg8::gemm_phase<pg8::EpiMod, pg8::StaticOrder, true, true>(ring, g, S, E); SEAM(1); }
    for (int i = 0; i < 4; ++i) {
        const int pb = 2 + 10 * i, l = i >> 1, f = i & 1;
        const float* src_p = (i == 0) ? xin_p : X; const float* src_s = (i == 0) ? xin_s : X;
        const float* modl = MOD + l * 9216;
        if (EN(2) && RUN(pb + 0)) { FRESH(); nm_phase(F, src_p, src_s, norm_g + (l * 3 + (f ? 2 : 0)) * DM, modl + (f ? 6 : 0) * DM, H); SEAM(pb + 0); }
        if (EN(3) && RUN(pb + 1)) { pg8::Gemm g{H, WS_PTR(bf16, WS_W13T + (size_t)i * W13T_STRIDE), MT, 2 * FF, DM}; pg8::StaticOrder S; S.init(MT, 2 * FF, F.G, F.bx);
            pg8::EpiSwiglu E{ACT, FF};
            pg8::gemm_phase<pg8::EpiSwiglu, pg8::StaticOrder, true, true>(ring, g, S, E); SEAM(pb + 1); }
        if (EN(4) && RUN(pb + 2)) { pg8::Gemm g{ACT, WS_PTR(bf16, WS_W2T + (size_t)i * W2T_STRIDE), MT, DM, FF}; pg8::StaticOrder S; S.init(MT, DM, F.G, F.bx);
            pg8::EpiRes E{src_p, src_s, X, modl + (f ? 8 : 2) * DM, 0.5f};
            pg8::gemm_phase<pg8::EpiRes, pg8::StaticOrder, true, true>(ring, g, S, E); SEAM(pb + 2); }
        if (f == 0) {
            if (EN(5) && RUN(pb + 3)) { FRESH(); nm_phase(F, X, X, norm_g + (l * 3 + 1) * DM, modl + 3 * DM, H); SEAM(pb + 3); }
            if (EN(6) && RUN(pb + 4)) { const int NZ = l ? ZO : ZE; pg8::Gemm g{H, WS_PTR(bf16, l ? WS_ODIN : WS_EVIN), MT, NZ, DM}; pg8::StaticOrder S; S.init(MT, NZ, F.G, F.bx);
                pg8::EpiPlain E{Z, NZ};
                pg8::gemm_phase<pg8::EpiPlain, pg8::StaticOrder, true, true>(ring, g, S, E); SEAM(pb + 4); }
            if (RUN(pb + 5)) { FRESH(); if (l == 0) { if (EN(7)) even_mid_phase(F, args); } else { if (EN(8)) odd_thin_phase(F, args); } SEAM(pb + 5); }
            if (RUN(pb + 6)) { FRESH();
                if (l == 0) { if (EN(9)) gla_g2_phase(F); }
                else { if (EN(10)) { pg8::Gemm g{WS_PTR(bf16, WS_CQN), WS_PTR(bf16, WS_WUQ), MT, 768, args.k_q}; pg8::StaticOrder S; S.init(MT, 768, F.G, F.bx);
                         pg8::EpiQ E{WS_PTR(bf16, WS_Q), WS_PTR(float, WS_RT)};
                         pg8::gemm_phase<pg8::EpiQ, pg8::StaticOrder, true, true>(ring, g, S, E); }
                       __syncthreads();
                       if (EN(16)) { pg8::Gemm g{WS_PTR(bf16, WS_CKVB), WS_PTR(bf16, WS_WKV), MP, 1024, args.k_kv}; pg8::StaticOrder S; S.init(MP, 1024, F.G, F.bx);
                         pg8::EpiPlain E{WS_PTR(bf16, WS_KV), 1024};
                         pg8::gemm_phase<pg8::EpiPlain, pg8::StaticOrder, true, true>(ring, g, S, E); } }
                SEAM(pb + 6); }
            if (RUN(pb + 7)) { FRESH(); if (l == 0) { if (EN(11)) for (int u = F.bx; u < 1024; u += F.G) gla_g3_unit(F, args, u); } else { if (EN(12)) attn_phase(F, args); } SEAM(pb + 7); }
            if (RUN(pb + 8)) { FRESH(); if (l == 1) { if (EN(13)) for (int b = F.bx; b < 128; b += F.G) dcombine_unit(F, args, b); SEAM(pb + 8); } }
            if (EN(14) && RUN(pb + 9)) { pg8::Gemm g{OP, WS_PTR(bf16, l ? WS_ODOUT : WS_EVOUT), MT, DM, DM}; pg8::StaticOrder S; S.init(MT, DM, F.G, F.bx);
                pg8::EpiRes E{X, X, X, modl + 5 * DM, 1.0f};
                pg8::gemm_phase<pg8::EpiRes, pg8::StaticOrder, true, true>(ring, g, S, E); SEAM(pb + 9); }
        }
    }
    if (EN(15) && RUN(42)) { FRESH(); final_phase(F, X, (const float*)args.in[34], F.out + O_Y); }
#undef RUN
#undef SEAM
}

extern "C" void kernel_launch(void* const* d_in, const int* in_sizes, int n_in, void* d_out, int out_size, void* d_ws, size_t ws_size, hipStream_t stream) {
    static int grid = 0;
    if (grid == 0) {
        if (n_in != 35 || (size_t)out_size != O_END || ws_size < WS_END) { fprintf(stderr, "kernel_launch: unexpected shapes: n_in %d out %d ws %zu\n", n_in, out_size, ws_size); grid = -1; return; }
        int dev = 0, cus = 0, per_cu = 0;
        if (hipGetDevice(&dev) != hipSuccess || hipDeviceGetAttribute(&cus, hipDeviceAttributeMultiprocessorCount, dev) != hipSuccess) { grid = -1; return; }
        if (hipFuncSetAttribute((const void*)mk_fwd, hipFuncAttributeMaxDynamicSharedMemorySize, LDS_BYTES) != hipSuccess) { fprintf(stderr, "kernel_launch: hipFuncSetAttribute failed\n"); grid = -1; return; }
        if (hipOccupancyMaxActiveBlocksPerMultiprocessor(&per_cu, (const void*)mk_fwd, NWAVES * 64, LDS_BYTES) != hipSuccess || per_cu < 1) fprintf(stderr, "kernel_launch: occupancy query says %d\n", per_cu);
        (void)hipGetLastError();
        grid = cus;
    }
    if (grid < 0) return;
    if (hipMemsetAsync((char*)d_ws + WS_CTL, 0, CTL_ZERO_BYTES, stream) != hipSuccess) return;
    Args a{};
    for (int i = 0; i < 35; ++i) a.in[i] = d_in[i];
    a.out = (float*)d_out; a.ws = (unsigned char*)d_ws; a.k_q = 384; a.k_kv = 256; a.pad = 0;
#if MK_ONE_LAUNCH
    a.ph_lo = 0; a.ph_hi = N_PHASE_IDS; a.use_bar = 1;
    hipLaunchKernelGGL(mk_fwd, dim3(grid), dim3(NWAVES * 64), LDS_BYTES, stream, a);
#else
    for (int id = 0; id < N_PHASE_IDS; ++id) {
        if (id >= 2 && id < 42) { const int i = (id - 2) / 10, k = (id - 2) % 10; if (k >= 3 && (i & 1)) continue; if (k == 8 && i == 0) continue; }
        a.ph_lo = id; a.ph_hi = id + 1; a.use_bar = 0;
        hipLaunchKernelGGL(mk_fwd, dim3(grid), dim3(NWAVES * 64), LDS_BYTES, stream, a);
    }
#endif
}
```

```cpp
#include <hip/hip_runtime.h>
#include <cstdio>
#include <cstdint>
#define GAS __attribute__((address_space(1)))
#define LAS __attribute__((address_space(3)))
constexpr int DM = 1024, MP = 16384, MS = 512, MT = MP + MS, TP = 8192, NBAT = 130, FF = 2816;
constexpr int MODLD = 18432;
constexpr int ZE = 2304, ZO = 1792;
constexpr float QSCALE = 0.10206207261596577f * 1.4426950408889634f;
__device__ __forceinline__ int bidx(int row) { return row < MP ? (row >> 13) : 2 + ((row - MP) >> 2); }
__device__ __forceinline__ int posof(int row) { return row < MP ? (row & (TP - 1)) : TP + ((row - MP) & 3); }
__device__ __forceinline__ float bf2f(unsigned short b) { return __uint_as_float(((unsigned)b) << 16); }
__device__ __forceinline__ unsigned f2bf(float f) { unsigned u = __builtin_bit_cast(unsigned, f); return (u + 0x7fffu + ((u >> 16) & 1u)) >> 16; }
__device__ __forceinline__ unsigned pk2(float lo, float hi) { return f2bf(lo) | (f2bf(hi) << 16); }
__device__ __forceinline__ float sigmoidf_(float x) { return 1.0f / (1.0f + __expf(-x)); }
__device__ __forceinline__ float siluf_(float x) { return x / (1.0f + __expf(-x)); }
namespace pg8 {
#define PG8_LAS __attribute__((address_space(3)))
typedef unsigned short bf16_t;
typedef short bf16x8 __attribute__((ext_vector_type(8)));
typedef float f32x4 __attribute__((ext_vector_type(4)));
typedef unsigned u32x4 __attribute__((ext_vector_type(4)));
constexpr int BM = 256, BK = 64, HALF = 128, HTB = HALF * BK * 2  , STAGE_BYTES = 8 * HTB, NXCD = 8, WGM = 8;

__host__ __device__ __forceinline__ int lds_byte(int r, int c) { const int st = (r >> 4) * 2 + (c >> 5), rr = r & 15, cc = c & 31, ob = rr * 64 + cc * 2; return st * 1024 + (ob ^ (((ob >> 9) & 1) << 5)); }
__host__ __device__ __forceinline__ void stage_rc(int b, int& R, int& C) { const int st = b / 1024, sb = b % 1024, swz = sb ^ (((sb >> 9) & 1) << 5); R = (st >> 1) * 16 + swz / 64; C = (st & 1) * 32 + (swz % 64) / 2; }
__host__ __device__ __forceinline__ int perm32(int rho) { const int n = rho >> 4, i = rho & 15; return 8 * (i >> 2) + 4 * n + (i & 3); }

struct Unit { int pm, pn; };
struct Gemm { const bf16_t* A; const bf16_t* Bt; int M, N, K; };

struct StaticOrder {
    int nM, nN, nwg, G, c;
    __host__ __device__ void init(int M, int N, int G_, int c_) { nM = M / BM; nN = N / BM; nwg = nM * nN; G = G_; c = c_; }
    __host__ __device__ bool next(int i, Unit& u) const {
        const long L = (long)i * G + c; if (L >= nwg) return false;
        int wgid = (int)L; { const int q = nwg / NXCD, r = nwg % NXCD, xcd = wgid % NXCD, off = wgid / NXCD; wgid = (xcd < r ? xcd * (q + 1) : r * (q + 1) + (xcd - r) * q) + off; }
        const int nig = WGM * nN, gid = wgid / nig, fm = gid * WGM, gsz = (nM - fm) < WGM ? (nM - fm) : WGM;
        u.pm = fm + ((wgid % nig) % gsz); u.pn = (wgid % nig) / gsz; return true;
    }
    __device__ __forceinline__ void a_ready(const Unit&) const {}
    __device__ __forceinline__ void done(const Unit&) const {}
};

__device__ __forceinline__ unsigned cvt_pk_bf16(float lo, float hi) { unsigned r; asm volatile("v_cvt_pk_bf16_f32 %0, %1, %2" : "=v"(r) : "v"(lo), "v"(hi)); return r; }

struct EpiPlain {
    static constexpr bool PERM = true, AFTER_DRAIN = false;
    bf16_t* O; int ldc;
    __device__ __forceinline__ void operator()(const f32x4 (&acc)[2][2][4][2], const Unit& u, int wr, int wc, int fr, int fq) const {
        const int row0 = u.pm * BM + wr * 64 + fr, col0 = u.pn * BM + wc * 32 + 8 * fq;
#pragma unroll
        for (int ai = 0; ai < 2; ++ai)
#pragma unroll
            for (int m = 0; m < 4; ++m) { bf16_t* rowp = O + (size_t)(row0 + ai * HALF + m * 16) * ldc + col0;
#pragma unroll
                for (int bj = 0; bj < 2; ++bj) { const f32x4 v0 = acc[ai][bj][m][0], v1 = acc[ai][bj][m][1];
                    u32x4 w; w.x = cvt_pk_bf16(v0[0], v0[1]); w.y = cvt_pk_bf16(v0[2], v0[3]); w.z = cvt_pk_bf16(v1[0], v1[1]); w.w = cvt_pk_bf16(v1[2], v1[3]);
                    *(u32x4*)(rowp + bj * HALF) = w; } }
    }
};
struct EpiSwiglu {
    static constexpr bool PERM = true, AFTER_DRAIN = false;
    bf16_t* O; int ldc;
    __device__ __forceinline__ void operator()(const f32x4 (&acc)[2][2][4][2], const Unit& u, int wr, int wc, int fr, int fq) const {
        const int row0 = u.pm * BM + wr * 64 + fr, col0 = u.pn * HALF + wc * 32 + 8 * fq;
#pragma unroll
        for (int ai = 0; ai < 2; ++ai)
#pragma unroll
            for (int m = 0; m < 4; ++m) { bf16_t* rowp = O + (size_t)(row0 + ai * HALF + m * 16) * ldc + col0;
                float o[8];
#pragma unroll
                for (int n = 0; n < 2; ++n)
#pragma unroll
                    for (int e = 0; e < 4; ++e) { const float g = acc[ai][0][m][n][e], uu = acc[ai][1][m][n][e]; o[n * 4 + e] = siluf_(g) * uu; }
                u32x4 w; w.x = cvt_pk_bf16(o[0], o[1]); w.y = cvt_pk_bf16(o[2], o[3]); w.z = cvt_pk_bf16(o[4], o[5]); w.w = cvt_pk_bf16(o[6], o[7]);
                *(u32x4*)rowp = w; }
    }
};
struct EpiRes {
    static constexpr bool PERM = false, AFTER_DRAIN = false;
    const float* bp; const float* bs; float* out; const float* gate; float coef;
    __device__ __forceinline__ void operator()(const f32x4 (&acc)[2][2][4][2], const Unit& u, int wr, int wc, int fr, int fq) const {
#pragma unroll
        for (int ai = 0; ai < 2; ++ai)
#pragma unroll
            for (int m = 0; m < 4; ++m) { const int row = u.pm * BM + ai * HALF + wr * 64 + m * 16 + fr; const int b = bidx(row);
                const float* base = (row < MP ? bp : bs) + (size_t)row * DM; const float* gr = gate + (size_t)b * MODLD; float* orow = out + (size_t)row * DM;
#pragma unroll
                for (int bj = 0; bj < 2; ++bj)
#pragma unroll
                    for (int n = 0; n < 2; ++n) { const int col = u.pn * BM + bj * HALF + wc * 32 + n * 16 + 4 * fq;
                        const f32x4 xin = *(const f32x4*)(base + col), g = *(const f32x4*)(gr + col);
                        *(f32x4*)(orow + col) = xin + (g * coef) * acc[ai][bj][m][n]; } }
    }
};
struct EpiMod {
    static constexpr bool PERM = false, AFTER_DRAIN = false;
    float* out; const float* bias;
    __device__ __forceinline__ void operator()(const f32x4 (&acc)[2][2][4][2], const Unit& u, int wr, int wc, int fr, int fq) const {
#pragma unroll
        for (int ai = 0; ai < 2; ++ai)
#pragma unroll
            for (int m = 0; m < 4; ++m) { const int row = u.pm * BM + ai * HALF + wr * 64 + m * 16 + fr; float* orow = out + (size_t)row * MODLD;
#pragma unroll
                for (int bj = 0; bj < 2; ++bj)
#pragma unroll
                    for (int n = 0; n < 2; ++n) { const int col = u.pn * BM + bj * HALF + wc * 32 + n * 16 + 4 * fq;
                        *(f32x4*)(orow + col) = acc[ai][bj][m][n] + *(const f32x4*)(bias + col); } }
    }
};
struct EpiQ {
    static constexpr bool PERM = false, AFTER_DRAIN = false;
    bf16_t* O; const float* rt;
    __device__ __forceinline__ void operator()(const f32x4 (&acc)[2][2][4][2], const Unit& u, int wr, int wc, int fr, int fq) const {
        typedef unsigned u32x2 __attribute__((ext_vector_type(2)));
#pragma unroll
        for (int ai = 0; ai < 2; ++ai)
#pragma unroll
            for (int m = 0; m < 4; ++m) { const int row = u.pm * BM + ai * HALF + wr * 64 + m * 16 + fr; const int pos = posof(row);
                const float* rtp = rt + (size_t)pos * 32 + 8 * fq;
#pragma unroll
                for (int bj = 0; bj < 2; ++bj) { const int gc0 = u.pn * BM + bj * HALF + wc * 32; const bool isrope = (gc0 % 96) == 64;
                    f32x4 v0 = acc[ai][bj][m][0] * QSCALE, v1 = acc[ai][bj][m][1] * QSCALE;
                    if (isrope) { const f32x4 cs0 = *(const f32x4*)(rtp), cs1 = *(const f32x4*)(rtp + 4);
                        const float c[4] = {cs0[0], cs0[2], cs1[0], cs1[2]}, s[4] = {cs0[1], cs0[3], cs1[1], cs1[3]};
                        f32x4 a, b;
#pragma unroll
                        for (int e = 0; e < 4; ++e) { a[e] = v0[e] * c[e] - v1[e] * s[e]; b[e] = v1[e] * c[e] + v0[e] * s[e]; }
                        v0 = a; v1 = b; }
                    bf16_t* p = O + (size_t)row * 768 + gc0 + 4 * fq;
                    u32x2 w0; w0.x = cvt_pk_bf16(v0[0], v0[1]); w0.y = cvt_pk_bf16(v0[2], v0[3]); *(u32x2*)p = w0;
                    u32x2 w1; w1.x = cvt_pk_bf16(v1[0], v1[1]); w1.y = cvt_pk_bf16(v1[2], v1[3]); *(u32x2*)(p + 16) = w1; }
                asm volatile("" ::: "memory"); }
    }
};

template <class Epi, class Sched, bool ALIGN_EPI = false, bool SP2 = false>
__device__ __forceinline__ void gemm_phase(PG8_LAS unsigned char* lds, const Gemm g, const Sched& S, const Epi& E) {
    int tid = threadIdx.x; asm volatile("" : "+v"(tid));
    const int wid = __builtin_amdgcn_readfirstlane(tid >> 6), lane = tid & 63, wr = wid >> 2, wc = wid & 3, fr = lane & 15, fq = lane >> 4;
    const int K = g.K, nt = K / BK;
    unsigned voffA[2], voffB[2];
#pragma unroll
    for (int i = 0; i < 2; ++i) { int R, C; stage_rc(tid * 16 + i * 8192, R, C); const int Rb = Epi::PERM ? ((R & ~31) + perm32(R & 31)) : R;
        voffA[i] = (unsigned)(R * K + C) * 2u; voffB[i] = (unsigned)(Rb * K + C) * 2u; }
    const size_t kstep = (size_t)(BK * 2);
    const size_t hstep = (size_t)HALF * K * 2;
    const size_t tstep = 2 * hstep;
    const unsigned ldsw = (unsigned)wid * 1024u;
    const int aoff = lds_byte(wr * 64 + fr, fq * 8), boff = lds_byte(wc * 32 + fr, fq * 8);
#define PG8_SA(b, h) (((b) * 2 + (h)) * HTB)
#define PG8_SB(b, h) ((4 + (b) * 2 + (h)) * HTB)
#define PG8_STAGE(bufoff, gbase, voff) do { _Pragma("unroll") for (int _i = 0; _i < 2; ++_i) \
        __builtin_amdgcn_global_load_lds((const unsigned*)((const char*)(gbase) + (voff)[_i]), (PG8_LAS unsigned*)(lds + (bufoff) + ldsw + _i * 8192), 16, 0, 0); } while (0)
#define PG8_LDA(dst, b, h) do { _Pragma("unroll") for (int m = 0; m < 4; ++m) _Pragma("unroll") for (int k = 0; k < 2; ++k) dst[m][k] = *(const PG8_LAS bf16x8*)(lds + PG8_SA(b, h) + aoff + m * 2048 + k * 1024); } while (0)
#define PG8_LDB(dst, b, h) do { _Pragma("unroll") for (int n = 0; n < 2; ++n) _Pragma("unroll") for (int k = 0; k < 2; ++k) dst[n][k] = *(const PG8_LAS bf16x8*)(lds + PG8_SB(b, h) + boff + n * 2048 + k * 1024); } while (0)
#define PG8_MMA(ai, bj, At, Bt) do { __builtin_amdgcn_s_setprio(1); _Pragma("unroll") for (int m = 0; m < 4; ++m) _Pragma("unroll") for (int n = 0; n < 2; ++n) _Pragma("unroll") for (int k = 0; k < 2; ++k) \
        acc[ai][bj][m][n] = __builtin_amdgcn_mfma_f32_16x16x32_bf16(Bt[n][k], At[m][k], acc[ai][bj][m][n], 0, 0, 0); __builtin_amdgcn_s_setprio(0); } while (0)
#define PG8_WAIT_V(n) asm volatile("s_waitcnt vmcnt(" #n ")" ::: "memory")
#define PG8_WAIT_L(n) asm volatile("s_waitcnt lgkmcnt(" #n ")" ::: "memory")
#define PG8_BAR __builtin_amdgcn_s_barrier()
#define PG8_SCHED __builtin_amdgcn_sched_barrier(0)
    Unit cur, nxt; int ui = 0;
    if (!S.next(0, cur)) return;
    f32x4 acc[2][2][4][2];
#pragma unroll
    for (int a = 0; a < 2; ++a)
#pragma unroll
        for (int b = 0; b < 2; ++b)
#pragma unroll
            for (int m = 0; m < 4; ++m)
#pragma unroll
                for (int n = 0; n < 2; ++n) acc[a][b][m][n] = (f32x4){0.f, 0.f, 0.f, 0.f};
    bf16x8 At[4][2], B0[2][2], B1[2][2];
    const char* cA = (const char*)g.A + (size_t)cur.pm * tstep; const char* cB = (const char*)g.Bt + (size_t)cur.pn * tstep;
    S.a_ready(cur);
    if constexpr (SP2) {
        PG8_STAGE(PG8_SB(0, 0), cB, voffB); PG8_STAGE(PG8_SB(0, 1), cB + hstep, voffB); PG8_STAGE(PG8_SA(0, 0), cA, voffA); PG8_STAGE(PG8_SA(0, 1), cA + hstep, voffA);
        if (wr == 1) PG8_BAR;
        PG8_WAIT_V(2); PG8_BAR;
        PG8_STAGE(PG8_SB(1, 0), cB + kstep, voffB); PG8_STAGE(PG8_SA(1, 0), cA + kstep, voffA); PG8_STAGE(PG8_SB(1, 1), cB + hstep + kstep, voffB);
        PG8_WAIT_V(6); PG8_BAR;
    } else {
        PG8_STAGE(PG8_SB(0, 0), cB, voffB); PG8_STAGE(PG8_SA(0, 0), cA, voffA); PG8_STAGE(PG8_SB(0, 1), cB + hstep, voffB); PG8_STAGE(PG8_SA(0, 1), cA + hstep, voffA);
        if (wr == 1) PG8_BAR;
        PG8_WAIT_V(4); PG8_BAR;
        PG8_STAGE(PG8_SB(1, 0), cB + kstep, voffB); PG8_STAGE(PG8_SA(1, 0), cA + kstep, voffA); PG8_STAGE(PG8_SB(1, 1), cB + hstep + kstep, voffB);
        PG8_WAIT_V(6); PG8_BAR;
    }
    for (;;) {
        const bool has_next = S.next(ui + 1, nxt);
        const char* nA = has_next ? (const char*)g.A + (size_t)nxt.pm * tstep : cA; const char* nB = has_next ? (const char*)g.Bt + (size_t)nxt.pn * tstep : cB;
        for (int t = 0; t < nt; t += 2) {
            const bool last = (t == nt - 2);
            const char* a1 = cA + (size_t)(t + 1) * kstep;
            const char* a2 = last ? nA : cA + (size_t)(t + 2) * kstep; const char* b2 = last ? nB : cB + (size_t)(t + 2) * kstep;
            const char* a3 = a2 + kstep; const char* b3 = b2 + kstep;
            if (last && has_next) S.a_ready(nxt);
            if constexpr (SP2) {
            PG8_LDB(B0, 0, 0); PG8_LDB(B1, 0, 1); PG8_SCHED; PG8_LDA(At, 0, 0); PG8_STAGE(PG8_SA(1, 1), a1 + hstep, voffA);
            PG8_WAIT_V(8); PG8_WAIT_L(0); PG8_BAR; PG8_MMA(0, 0, At, B0); PG8_MMA(0, 1, At, B1); PG8_BAR; PG8_SCHED;
            PG8_LDA(At, 0, 1); PG8_STAGE(PG8_SB(0, 0), b2, voffB); PG8_STAGE(PG8_SB(0, 1), b2 + hstep, voffB); PG8_STAGE(PG8_SA(0, 0), a2, voffA);
            PG8_WAIT_V(8); PG8_WAIT_L(0); PG8_BAR; PG8_MMA(1, 0, At, B0); PG8_MMA(1, 1, At, B1); PG8_BAR; PG8_SCHED;
            PG8_LDB(B0, 1, 0); PG8_LDB(B1, 1, 1); PG8_SCHED; PG8_LDA(At, 1, 0); PG8_STAGE(PG8_SA(0, 1), a2 + hstep, voffA);
            PG8_WAIT_V(8); PG8_WAIT_L(0); PG8_BAR; PG8_MMA(0, 0, At, B0); PG8_MMA(0, 1, At, B1); PG8_BAR; PG8_SCHED;
            PG8_LDA(At, 1, 1); PG8_STAGE(PG8_SB(1, 0), b3, voffB); PG8_STAGE(PG8_SB(1, 1), b3 + hstep, voffB); PG8_STAGE(PG8_SA(1, 0), a3, voffA);
            PG8_WAIT_V(8); PG8_WAIT_L(0); PG8_BAR; PG8_MMA(1, 0, At, B0); PG8_MMA(1, 1, At, B1); PG8_BAR; PG8_SCHED;
            } else {
            PG8_LDB(B0, 0, 0); PG8_SCHED; PG8_LDA(At, 0, 0); PG8_STAGE(PG8_SA(1, 1), a1 + hstep, voffA);
            PG8_WAIT_L(8); PG8_BAR; PG8_WAIT_L(0); PG8_MMA(0, 0, At, B0); PG8_BAR; PG8_SCHED;
            PG8_LDB(B1, 0, 1); PG8_STAGE(PG8_SB(0, 0), b2, voffB);
            PG8_BAR; PG8_WAIT_L(0); PG8_MMA(0, 1, At, B1); PG8_BAR;
            PG8_LDA(At, 0, 1); PG8_STAGE(PG8_SA(0, 0), a2, voffA);
            PG8_BAR; PG8_WAIT_L(0); PG8_MMA(1, 0, At, B0); PG8_BAR; PG8_SCHED;
            PG8_STAGE(PG8_SB(0, 1), b2 + hstep, voffB);
            PG8_WAIT_V(6); PG8_BAR; PG8_MMA(1, 1, At, B1); PG8_BAR;
            PG8_LDB(B0, 1, 0); PG8_SCHED; PG8_LDA(At, 1, 0); PG8_STAGE(PG8_SA(0, 1), a2 + hstep, voffA);
            PG8_WAIT_L(8); PG8_BAR; PG8_WAIT_L(0); PG8_MMA(0, 0, At, B0); PG8_BAR; PG8_SCHED;
            PG8_LDB(B1, 1, 1); PG8_STAGE(PG8_SB(1, 0), b3, voffB);
            PG8_BAR; PG8_WAIT_L(0); PG8_MMA(0, 1, At, B1); PG8_BAR;
            PG8_LDA(At, 1, 1); PG8_STAGE(PG8_SA(1, 0), a3, voffA);
            PG8_BAR; PG8_WAIT_L(0); PG8_MMA(1, 0, At, B0); PG8_BAR; PG8_SCHED;
            PG8_STAGE(PG8_SB(1, 1), b3 + hstep, voffB);
            PG8_WAIT_V(6); PG8_BAR; PG8_MMA(1, 1, At, B1); PG8_BAR;
            }
        }
        if constexpr (ALIGN_EPI) { if (wr == 0) PG8_BAR; }
        if constexpr (!Epi::AFTER_DRAIN) { E(acc, cur, wr, wc, fr, fq); S.done(cur); }
        if (!has_next) break;
#pragma unroll
        for (int a = 0; a < 2; ++a)
#pragma unroll
            for (int b = 0; b < 2; ++b)
#pragma unroll
                for (int m = 0; m < 4; ++m)
#pragma unroll
                    for (int n = 0; n < 2; ++n) acc[a][b][m][n] = (f32x4){0.f, 0.f, 0.f, 0.f};
        cur = nxt; cA = nA; cB = nB; ++ui;
        if constexpr (ALIGN_EPI) { if (wr == 1) PG8_BAR; }
    }
    PG8_WAIT_V(0);
    if constexpr (!ALIGN_EPI) { if (wr == 0) PG8_BAR; }
    PG8_BAR;
    if constexpr (Epi::AFTER_DRAIN) { E.fused(acc, cur, wr, wc, fr, fq, lds, wid, lane); S.done(cur); }
#undef PG8_SA
#undef PG8_SB
#undef PG8_STAGE
#undef PG8_LDA
#undef PG8_LDB
#undef PG8_MMA
#undef PG8_WAIT_V
#undef PG8_WAIT_L
#undef PG8_BAR
#undef PG8_SCHED
}
}
constexpr size_t MiB = 1u << 20;
constexpr size_t WS_CTL = 0, CTL_ZERO_BYTES = 1 * MiB;
constexpr size_t WS_W13T = 2 * MiB, W13T_STRIDE = 11 * MiB;
constexpr size_t WS_W2T = 46 * MiB, W2T_STRIDE = 5767168;
constexpr size_t WS_EVIN = 68 * MiB, WS_EVOUT = 73 * MiB, WS_ODIN = 75 * MiB, WS_ODOUT = 79 * MiB, WS_WUQ = 81 * MiB, WS_WKV = 82 * MiB;
constexpr size_t WS_ADAT = 83 * MiB, WS_SC = 119 * MiB, WS_RT = 120 * MiB, WS_MOD = 122 * MiB;
constexpr size_t WS_X = 140 * MiB, WS_H = 206 * MiB, WS_ACT = 239 * MiB, WS_Z = 330 * MiB, WS_OP = 405 * MiB;
constexpr size_t WS_US = 438 * MiB, WS_DS = 470 * MiB, WS_CQN = 471 * MiB, WS_CKVB = 484 * MiB, WS_KRB = 493 * MiB, WS_Q = 495 * MiB, WS_KV = 520 * MiB;
constexpr size_t WS_PART = 552 * MiB, WS_QD = 586 * MiB, WS_END = 592 * MiB;
constexpr int NSPLIT = 8, PART_F = 32 * 256 + 64;
constexpr size_t O_Y = 0, O_GLAP = 17301504, O_GLAS = O_GLAP + 65536, O_POOLP = O_GLAS + 4194304, O_POOLS = O_POOLP + 15360, O_CKV = O_POOLS + 983040,
                 O_KR = O_CKV + 4325376, O_CONVP = O_KR + 540672, O_CONVS = O_CONVP + 30720, O_END = O_CONVS + 1966080;
constexpr int CW_TMO = 0, CW_CODE = 1, CW_BAR = 4096;
constexpr int RING_BYTES = 131072, LDSCTL_OFF = RING_BYTES, MISC_OFF = LDSCTL_OFF + 320, LDS_BYTES = 147456;
constexpr int NWAVES = 8;

typedef unsigned short bf16;
typedef unsigned v4u __attribute__((ext_vector_type(4)));
typedef unsigned v2u __attribute__((ext_vector_type(2)));
typedef float f32x4 __attribute__((ext_vector_type(4)));
typedef float f32x2 __attribute__((ext_vector_type(2)));
typedef float f32x16 __attribute__((ext_vector_type(16)));
typedef short bf16x8 __attribute__((ext_vector_type(8)));
typedef short s16x4 __attribute__((ext_vector_type(4)));
typedef GAS unsigned gu32;
#define RLX_AGENT __ATOMIC_RELAXED, __HIP_MEMORY_SCOPE_AGENT
#define LDS_WAIT() asm volatile("s_waitcnt lgkmcnt(0)" ::: "memory")
#define VM_WAIT() asm volatile("s_waitcnt vmcnt(0)" ::: "memory")

#define XB_TMO      128
#define XB_XCNT(j)  (256  + 64 * (j))
#define XB_XSUB(j)  (1280 + 64 * (j))
#define XB_XGEN(j)  (2304 + 64 * (j))
#define XB_TOP      3328
#define XB_TOPGEN   3392
#define XCD_BAR_WORDS 3456
#define XB_SPIN_CAP (1u << 18)

__device__ __forceinline__ unsigned xb_ld(unsigned* p)              { return __hip_atomic_load(p, __ATOMIC_RELAXED, __HIP_MEMORY_SCOPE_AGENT); }
__device__ __forceinline__ unsigned xb_add(unsigned* p, unsigned v) { return __hip_atomic_fetch_add(p, v, __ATOMIC_RELAXED, __HIP_MEMORY_SCOPE_AGENT); }
__device__ __forceinline__ unsigned xb_xcc_id() { return (unsigned)__builtin_amdgcn_s_getreg((3 << 11) | 20) & 0xFu; }
#define XB_SPIN(cond, bar) do { unsigned _sp = 0; while (cond) { __builtin_amdgcn_s_sleep(1); \
    if ((++_sp & 255u) == 0u) { if (xb_ld(&(bar)[XB_TMO])) break; if (_sp > XB_SPIN_CAP) { atomicAdd(&(bar)[XB_TMO], 1u); break; } } } } while (0)

struct XcdBarrier {
    unsigned* bar; unsigned x;
    volatile LAS unsigned* st;
};

__device__ __forceinline__ XcdBarrier xcd_barrier_post(unsigned* bar, volatile LAS unsigned* st) {
    XcdBarrier b; b.bar = bar; b.x = xb_xcc_id(); b.st = st;
    if (threadIdx.x == 0) (void)xb_add(&bar[XB_XCNT(b.x)], 1u);
    return b;
}
__device__ __forceinline__ void xcd_barrier_complete(unsigned* bar, unsigned x, unsigned& nloc, unsigned& nx) {
    const unsigned G = gridDim.x * gridDim.y * gridDim.z;
    unsigned sum, cnt, mine, sp = 0u;
    for (;;) {
        sum = 0u; cnt = 0u; mine = 0u;
#pragma unroll
        for (unsigned j = 0; j < 16; ++j) { const unsigned c = xb_ld(&bar[XB_XCNT(j)]); sum += c; cnt += (c > 0u) ? 1u : 0u; mine = (j == x) ? c : mine; }
        if (sum == G) break;
        __builtin_amdgcn_s_sleep(1);
        if ((++sp & 255u) == 0u) { if (xb_ld(&bar[XB_TMO])) break; if (sp > XB_SPIN_CAP) { atomicAdd(&bar[XB_TMO], 1u); break; } }
    }
    nloc = mine > 0u ? mine : 1u; nx = cnt > 0u ? cnt : 1u;
}

__device__ __forceinline__ void xcd_barrier(const XcdBarrier& b) {
    asm volatile("s_waitcnt vmcnt(0)" ::: "memory");
    __syncthreads();
    if (threadIdx.x == 0) {
        unsigned* bar = b.bar;
        __builtin_amdgcn_s_waitcnt(0);
        unsigned nloc = b.st[0], nx = b.st[1];
        if (nloc == 0u) { xcd_barrier_complete(bar, b.x, nloc, nx); b.st[0] = nloc; b.st[1] = nx; }
        const unsigned old = xb_add(&bar[XB_XSUB(b.x)], 1u);
        const unsigned gen = old / nloc;
        if (old + 1u == (gen + 1u) * nloc) {
            __builtin_amdgcn_fence(__ATOMIC_RELEASE, "agent");
            asm volatile("s_waitcnt vmcnt(0)" ::: "memory");
            const unsigned og = xb_add(&bar[XB_TOP], 1u);
            const unsigned tg = og / nx;
            if (og + 1u == (tg + 1u) * nx) xb_add(&bar[XB_TOPGEN], 1u);
            else XB_SPIN(xb_ld(&bar[XB_TOPGEN]) == tg, bar);
            __builtin_amdgcn_fence(__ATOMIC_ACQUIRE, "agent");
            xb_add(&bar[XB_XGEN(b.x)], 1u);
            asm volatile("s_waitcnt vmcnt(0)" ::: "memory");
        } else {
            XB_SPIN(xb_ld(&bar[XB_XGEN(b.x)]) == gen, bar);
            __builtin_amdgcn_fence(__ATOMIC_ACQUIRE, "agent");
            asm volatile("s_waitcnt vmcnt(0)" ::: "memory");
        }
    }
    __syncthreads();
}
struct Args { const void* in[35]; float* out; unsigned char* ws; int ph_lo, ph_hi, use_bar, k_q, k_kv, pad; };
struct Frame {
    LAS unsigned char* lds;
    volatile LAS unsigned* MISC;
    gu32* ctl;
    int tid, lane, wave, G, bx;
    unsigned char* ws; float* out;
};
__device__ __forceinline__ float wave_sum(float v) {
#pragma unroll
    for (int o = 1; o < 64; o <<= 1) v += __shfl_xor(v, o);
    return v;
}
__device__ __forceinline__ float half_sum(float v) {
#pragma unroll
    for (int o = 1; o < 32; o <<= 1) v += __shfl_xor(v, o);
    return v;
}
#define WS_PTR(T, off) ((T*)(F.ws + (off)))

enum { RM_ID = 0, RM_W1 = 1, RM_W3 = 2, RM_EVIN = 3 };
__device__ __forceinline__ int map_row(int mode, int n) {
    if (mode == RM_W1) return 256 * (n >> 7) + (n & 127);
    if (mode == RM_W3) return 256 * (n >> 7) + 128 + (n & 127);
    if (mode == RM_EVIN) return n < 1536 ? n : (n < 1552 ? 2048 + (n - 1536) : 1536 + (n - 1552));
    return n;
}
__device__ __forceinline__ void p0_transpose_item(const float* W, int N, bf16* WT, int ldk, int mode, LAS float* scr, int item, int lane) {
    const int nblk = (N + 31) / 32, kb = item / nblk, nb = item % nblk, k0 = 64 * kb, n0 = 32 * nb;
    const bool okc = (n0 + (lane & 31)) < N;
#pragma unroll 8
    for (int i = 0; i < 32; ++i) { const int kk = 2 * i + (lane >> 5); scr[kk * 33 + (lane & 31)] = okc ? W[(size_t)(k0 + kk) * N + n0 + (lane & 31)] : 0.f; }
    LDS_WAIT(); asm volatile("" ::: "memory");
    const int c = lane & 7;
#pragma unroll
    for (int j = 0; j < 4; ++j) { const int n = (lane >> 3) + 8 * j; const LAS float* s = scr + (8 * c) * 33 + n;
        v4u o; o.x = pk2(s[0 * 33], s[1 * 33]); o.y = pk2(s[2 * 33], s[3 * 33]); o.z = pk2(s[4 * 33], s[5 * 33]); o.w = pk2(s[6 * 33], s[7 * 33]);
        if (n0 + n < N) *(GAS v4u*)(WT + (size_t)map_row(mode, n0 + n) * ldk + k0 + 8 * c) = o; }
    LDS_WAIT(); asm volatile("" ::: "memory");
}
__device__ __forceinline__ void p0_prologue(Frame& F, const Args& A) {
    LAS float* scr = (LAS float*)(F.lds + F.wave * 16384);
    const int gw = F.bx * NWAVES + F.wave, NGW = F.G * NWAVES;
    const float* ffn_w1 = (const float*)A.in[13]; const float* ffn_w3 = (const float*)A.in[14]; const float* ffn_w2 = (const float*)A.in[15];
    const float* ev_w_in = (const float*)A.in[16]; const float* ev_w_out = (const float*)A.in[22]; const float* od_w_in = (const float*)A.in[23]; const float* od_w_out = (const float*)A.in[33];
    const float* w_uq = (const float*)A.in[25]; const float* w_uk = (const float*)A.in[27]; const float* w_uv = (const float*)A.in[28]; const float* ada_w = (const float*)A.in[10];
    constexpr int I_W1 = 16 * 88, I_W2 = 44 * 32, I_FFN = 2 * I_W1 + I_W2;
    constexpr int I_EVIN = 16 * 65, I_EVOUT = 8 * 32, I_ODIN = 16 * 53, I_ODOUT = 16 * 32, I_UQ = 6 * 24, I_UK = 4 * 16, I_ADA = 16 * 288;
    constexpr int NITEMS = 4 * I_FFN + I_EVIN + I_EVOUT + I_ODIN + I_ODOUT + I_UQ + 2 * I_UK + 2 * I_ADA;
    for (int it = gw; it < NITEMS; it += NGW) {
        int r = it;
        if (r < 4 * I_FFN) { const int i = r / I_FFN; r -= i * I_FFN;
            bf16* w13 = WS_PTR(bf16, WS_W13T + (size_t)i * W13T_STRIDE); bf16* w2 = WS_PTR(bf16, WS_W2T + (size_t)i * W2T_STRIDE);
            if (r < I_W1) { p0_transpose_item(ffn_w1 + (size_t)i * DM * FF, FF, w13, DM, RM_W1, scr, r, F.lane); continue; } r -= I_W1;
            if (r < I_W1) { p0_transpose_item(ffn_w3 + (size_t)i * DM * FF, FF, w13, DM, RM_W3, scr, r, F.lane); continue; } r -= I_W1;
            p0_transpose_item(ffn_w2 + (size_t)i * FF * DM, DM, w2, FF, RM_ID, scr, r, F.lane); continue; }
        r -= 4 * I_FFN;
        if (r < I_EVIN) { p0_transpose_item(ev_w_in, 2064, WS_PTR(bf16, WS_EVIN), DM, RM_EVIN, scr, r, F.lane); continue; } r -= I_EVIN;
        if (r < I_EVOUT) { p0_transpose_item(ev_w_out, DM, WS_PTR(bf16, WS_EVOUT), DM, RM_ID, scr, r, F.lane); continue; } r -= I_EVOUT;
        if (r < I_ODIN) { p0_transpose_item(od_w_in, 1696, WS_PTR(bf16, WS_ODIN), DM, RM_ID, scr, r, F.lane); continue; } r -= I_ODIN;
        if (r < I_ODOUT) { p0_transpose_item(od_w_out, DM, WS_PTR(bf16, WS_ODOUT), DM, RM_ID, scr, r, F.lane); continue; } r -= I_ODOUT;
        if (r < I_UQ) { p0_transpose_item(w_uq, 768, WS_PTR(bf16, WS_WUQ), 384, RM_ID, scr, r, F.lane); continue; } r -= I_UQ;
        if (r < I_UK) { p0_transpose_item(w_uk, 512, WS_PTR(bf16, WS_WKV), 256, RM_ID, scr, r, F.lane); continue; } r -= I_UK;
        if (r < I_UK) { p0_transpose_item(w_uv, 512, WS_PTR(bf16, WS_WKV) + 512 * 256, 256, RM_ID, scr, r, F.lane); continue; } r -= I_UK;
        { const int l = r / I_ADA; r -= l * I_ADA; p0_transpose_item(ada_w + (size_t)l * DM * 9216, 9216, WS_PTR(bf16, WS_ADAT) + (size_t)l * 9216 * DM, DM, RM_ID, scr, r, F.lane); }
    }
    { constexpr int NZ = (240 + 96) * (DM / 8);
      for (int i = F.bx * 512 + F.tid; i < NZ; i += F.G * 512) { const int rr = i / (DM / 8), c8 = i % (DM / 8);
          bf16* dst = rr < 240 ? WS_PTR(bf16, WS_EVIN) + (size_t)(2064 + rr) * DM : WS_PTR(bf16, WS_ODIN) + (size_t)(1696 + rr - 240) * DM;
          *(GAS v4u*)(dst + c8 * 8) = (v4u){0u, 0u, 0u, 0u}; } }
    { const float* pool_w = (const float*)A.in[20]; const float* pool_scale = (const float*)A.in[21]; bf16* evo = WS_PTR(bf16, WS_EVOUT);
      for (int it = gw; it < 512; it += NGW) { const int g = it >> 7, c = it & 127;
          f32x4 acc[4] = {{0.f, 0.f, 0.f, 0.f}, {0.f, 0.f, 0.f, 0.f}, {0.f, 0.f, 0.f, 0.f}, {0.f, 0.f, 0.f, 0.f}};
          for (int d = 0; d < 128; ++d) { const float a = pool_w[(size_t)(g * 128 + c) * 128 + d] * pool_scale[g * 128 + d];
              const float* wr = ev_w_out + (size_t)(512 + g * 128 + d) * DM + 4 * F.lane;
#pragma unroll
              for (int j = 0; j < 4; ++j) acc[j] += a * *(const f32x4*)(wr + 256 * j); }
#pragma unroll
          for (int j = 0; j < 4; ++j)
#pragma unroll
              for (int e = 0; e < 4; ++e) evo[(size_t)(256 * j + 4 * F.lane + e) * DM + 512 + g * 128 + c] = (bf16)f2bf(acc[j][e]); } }
    { const float* cp = (const float*)A.in[8]; const float* cs = (const float*)A.in[9]; bf16* sc = WS_PTR(bf16, WS_SC);
      for (int r = gw; r < 256; r += NGW) { const float* src = r < 2 ? cp + (size_t)r * DM : cs + (size_t)(r - 2) * DM;
#pragma unroll
          for (int j = 0; j < 4; ++j) { f32x4 v = {0.f, 0.f, 0.f, 0.f}; if (r < NBAT) v = *(const f32x4*)(src + 4 * F.lane + 256 * j);
              v2u o; o.x = r < NBAT ? pk2(siluf_(v[0]), siluf_(v[1])) : 0u; o.y = r < NBAT ? pk2(siluf_(v[2]), siluf_(v[3])) : 0u;
              *(GAS v2u*)(sc + (size_t)r * DM + 4 * F.lane + 256 * j) = o; } } }
    { float* rt = WS_PTR(float, WS_RT);
      for (int i = F.bx * 512 + F.tid; i < 8196 * 16; i += F.G * 512) { const int pos = i >> 4, k = i & 15;
          const float freq = powf(10000.0f, -(float)k / 16.0f); const float ang = (float)pos * freq; float s, c; sincosf(ang, &s, &c);
          *(f32x2*)(rt + 2 * (size_t)i) = (f32x2){c, s}; } }
}

__device__ __forceinline__ void nm_phase(Frame& F, const float* bp, const float* bs, const float* g, const float* modsh, bf16* H) {
    const int gw = F.bx * NWAVES + F.wave, NGW = F.G * NWAVES;
    f32x4 gv[4];
#pragma unroll
    for (int j = 0; j < 4; ++j) gv[j] = *(const f32x4*)(g + 4 * F.lane + 256 * j);
    for (int row = gw; row < MT; row += NGW) {
        const float* xr = (row < MP ? bp : bs) + (size_t)row * DM + 4 * F.lane;
        f32x4 v[4]; float ss = 0.f;
#pragma unroll
        for (int j = 0; j < 4; ++j) { v[j] = *(const f32x4*)(xr + 256 * j); ss += (v[j][0] * v[j][0] + v[j][1] * v[j][1]) + (v[j][2] * v[j][2] + v[j][3] * v[j][3]); }
        const float rstd = 1.0f / sqrtf(wave_sum(ss) * (1.0f / DM) + 1e-6f);
        const float* mrow = modsh + (size_t)bidx(row) * MODLD + 4 * F.lane;
#pragma unroll
        for (int j = 0; j < 4; ++j) { const f32x4 sh = *(const f32x4*)(mrow + 256 * j), sc = *(const f32x4*)(mrow + DM + 256 * j);
            const f32x4 h = (v[j] * rstd) * gv[j] * (sc + 1.0f) + sh;
            v2u o; o.x = pk2(h[0], h[1]); o.y = pk2(h[2], h[3]);
            *(GAS v2u*)(H + (size_t)row * DM + 4 * F.lane + 256 * j) = o; }
    }
}
__device__ __forceinline__ void final_phase(Frame& F, const float* X, const float* g, float* out) {
    const int gw = F.bx * NWAVES + F.wave, NGW = F.G * NWAVES;
    f32x4 gv[4];
#pragma unroll
    for (int j = 0; j < 4; ++j) gv[j] = *(const f32x4*)(g + 4 * F.lane + 256 * j);
    for (int row = gw; row < MT; row += NGW) {
        const float* xr = X + (size_t)row * DM + 4 * F.lane;
        f32x4 v[4]; float ss = 0.f;
#pragma unroll
        for (int j = 0; j < 4; ++j) { v[j] = *(const f32x4*)(xr + 256 * j); ss += (v[j][0] * v[j][0] + v[j][1] * v[j][1]) + (v[j][2] * v[j][2] + v[j][3] * v[j][3]); }
        const float rstd = 1.0f / sqrtf(wave_sum(ss) * (1.0f / DM) + 1e-6f);
#pragma unroll
        for (int j = 0; j < 4; ++j) *(f32x4*)(out + (size_t)row * DM + 4 * F.lane + 256 * j) = (v[j] * rstd) * gv[j];
    }
}
__device__ __forceinline__ float logsig16(float x) { return (fminf(x, 0.f) - log1pf(__expf(-fabsf(x)))) * (1.0f / 16.0f); }
__device__ __forceinline__ void gla_cumdecay(Frame& F, const bf16* Z, int row0, int h, const float* gate_w2, const float* gate_b, LAS float* bcs, LAS float* gl, LAS float* seg) {
    const int tid = F.tid;
    { const int t = tid >> 3, j2 = (tid & 7) * 2; const unsigned w = *(const unsigned*)(Z + (size_t)(row0 + t) * ZE + 2048 + j2);
      gl[t * 16 + j2] = bf2f((unsigned short)(w & 0xffffu)); gl[t * 16 + j2 + 1] = bf2f((unsigned short)(w >> 16)); }
    __syncthreads();
    { const int t = tid >> 3, dk8 = (tid & 7) * 8; float x[8];
      { const f32x4 b0 = *(const f32x4*)(gate_b + h * 64 + dk8), b1 = *(const f32x4*)(gate_b + h * 64 + dk8 + 4);
#pragma unroll
        for (int e = 0; e < 4; ++e) { x[e] = b0[e]; x[4 + e] = b1[e]; } }
#pragma unroll
      for (int j = 0; j < 16; ++j) { const float gv = gl[t * 16 + j]; const f32x4 w0 = *(const f32x4*)(gate_w2 + j * 256 + h * 64 + dk8), w1 = *(const f32x4*)(gate_w2 + j * 256 + h * 64 + dk8 + 4);
#pragma unroll
          for (int e = 0; e < 4; ++e) { x[e] += gv * w0[e]; x[4 + e] += gv * w1[e]; } }
#pragma unroll
      for (int e = 0; e < 8; ++e) bcs[t * 64 + dk8 + e] = logsig16(x[e]); }
    __syncthreads();
    { const int dk = tid & 63, sg = tid >> 6; float run = 0.f;
#pragma unroll
      for (int i = 0; i < 8; ++i) { run += bcs[(sg * 8 + i) * 64 + dk]; bcs[(sg * 8 + i) * 64 + dk] = run; }
      seg[sg * 64 + dk] = run; }
    __syncthreads();
    { const int dk = tid & 63, sg = tid >> 6; float pre = 0.f;
      for (int s = 0; s < sg; ++s) pre += seg[s * 64 + dk];
#pragma unroll
      for (int i = 0; i < 8; ++i) bcs[(sg * 8 + i) * 64 + dk] += pre; }
    __syncthreads();
}
__device__ __forceinline__ void gla_g1_unit(Frame& F, const Args& A, int unit) {
    const bf16* Z = WS_PTR(bf16, WS_Z); float* US = WS_PTR(float, WS_US); float* DS = WS_PTR(float, WS_DS);
    const int bh = unit >> 7, n = unit & 127, b = bh >> 2, h = bh & 3, row0 = b * TP + n * 64, tid = F.tid;
    LAS float* bcs = (LAS float*)F.lds; LAS float* kk = bcs + 4096; LAS float* vv = kk + 4096; LAS float* gl = vv + 8192; LAS float* seg = gl + 1024;
    gla_cumdecay(F, Z, row0, h, (const float*)A.in[17], (const float*)A.in[18], bcs, gl, seg);
    { const int s = tid >> 3, dk8 = (tid & 7) * 8; const v4u kw = *(const v4u*)(Z + (size_t)(row0 + s) * ZE + 256 + h * 64 + dk8);
#pragma unroll
      for (int e = 0; e < 4; ++e) { const unsigned w = kw[e]; const int d0 = dk8 + 2 * e;
          kk[s * 64 + d0] = bf2f((unsigned short)(w & 0xffffu)) * __expf(bcs[63 * 64 + d0] - bcs[s * 64 + d0]);
          kk[s * 64 + d0 + 1] = bf2f((unsigned short)(w >> 16)) * __expf(bcs[63 * 64 + d0 + 1] - bcs[s * 64 + d0 + 1]); }
      const int dv16 = (tid & 7) * 16;
#pragma unroll
      for (int q = 0; q < 2; ++q) { const v4u vw = *(const v4u*)(Z + (size_t)(row0 + s) * ZE + 512 + h * 128 + dv16 + 8 * q);
#pragma unroll
          for (int e = 0; e < 4; ++e) { vv[s * 128 + dv16 + 8 * q + 2 * e] = bf2f((unsigned short)(vw[e] & 0xffffu)); vv[s * 128 + dv16 + 8 * q + 2 * e + 1] = bf2f((unsigned short)(vw[e] >> 16)); } }
      if (tid < 64) DS[(size_t)unit * 64 + tid] = __expf(bcs[63 * 64 + tid]); }
    __syncthreads();
    { const int dkq = tid >> 5, dvq = tid & 31; f32x4 acc[4] = {{0.f, 0.f, 0.f, 0.f}, {0.f, 0.f, 0.f, 0.f}, {0.f, 0.f, 0.f, 0.f}, {0.f, 0.f, 0.f, 0.f}};
#pragma unroll 4
      for (int s = 0; s < 64; ++s) { const f32x4 a = *(const LAS f32x4*)(kk + s * 64 + 4 * dkq), bv = *(const LAS f32x4*)(vv + s * 128 + 4 * dvq);
#pragma unroll
          for (int i = 0; i < 4; ++i) acc[i] += a[i] * bv; }
#pragma unroll
      for (int i = 0; i < 4; ++i) *(f32x4*)(US + ((size_t)unit * 64 + 4 * dkq + i) * 128 + 4 * dvq) = acc[i]; }
    __syncthreads();
}
__device__ __forceinline__ void gla_g2_phase(Frame& F) {
    float* US = WS_PTR(float, WS_US); const float* DS = WS_PTR(float, WS_DS); float* outp = F.out + O_GLAP;
    for (int gid = F.bx * 512 + F.tid; gid < 8 * 8192; gid += F.G * 512) {
        const int bh = gid >> 13, e = gid & 8191, dk = e >> 7;
        float* up = US + (size_t)bh * 128 * 8192 + e; const float* dp = DS + (size_t)bh * 128 * 64 + dk; float S = 0.f;
        for (int n0 = 0; n0 < 128; n0 += 8) { float uu[8], dd[8];
#pragma unroll
            for (int i = 0; i < 8; ++i) { uu[i] = up[(size_t)(n0 + i) * 8192]; dd[i] = dp[(n0 + i) * 64]; }
#pragma unroll
            for (int i = 0; i < 8; ++i) { up[(size_t)(n0 + i) * 8192] = S; S = dd[i] * S + uu[i]; } }
        outp[gid] = S;
    }
}
__device__ __forceinline__ void gla_g3_unit(Frame& F, const Args& A, int unit) {
    const bf16* Z = WS_PTR(bf16, WS_Z); const float* US = WS_PTR(float, WS_US); bf16* OP = WS_PTR(bf16, WS_OP);
    const int bh = unit >> 7, n = unit & 127, b = bh >> 2, h = bh & 3, row0 = b * TP + n * 64, tid = F.tid;
    LAS float* bcs = (LAS float*)F.lds; LAS float* attT = bcs;
    LAS float* qiT = bcs + 4096; LAS float* kiT = qiT + 4096; LAS float* vv = kiT + 4096; LAS float* Sst = vv + 8192; LAS float* gl = Sst + 8192; LAS float* seg = gl + 1024;
    gla_cumdecay(F, Z, row0, h, (const float*)A.in[17], (const float*)A.in[18], bcs, gl, seg);
    { const int t = tid >> 3, dk8 = (tid & 7) * 8;
      const v4u qw = *(const v4u*)(Z + (size_t)(row0 + t) * ZE + h * 64 + dk8), kw = *(const v4u*)(Z + (size_t)(row0 + t) * ZE + 256 + h * 64 + dk8);
#pragma unroll
      for (int e = 0; e < 4; ++e) { const int d0 = dk8 + 2 * e; const float b0 = bcs[t * 64 + d0], b1 = bcs[t * 64 + d0 + 1];
          qiT[d0 * 64 + t] = 0.125f * bf2f((unsigned short)(qw[e] & 0xffffu)) * __expf(b0); qiT[(d0 + 1) * 64 + t] = 0.125f * bf2f((unsigned short)(qw[e] >> 16)) * __expf(b1);
          kiT[d0 * 64 + t] = bf2f((unsigned short)(kw[e] & 0xffffu)) * __expf(-b0); kiT[(d0 + 1) * 64 + t] = bf2f((unsigned short)(kw[e] >> 16)) * __expf(-b1); }
      const int dv16 = (tid & 7) * 16;
#pragma unroll
      for (int q = 0; q < 2; ++q) { const v4u vw = *(const v4u*)(Z + (size_t)(row0 + t) * ZE + 512 + h * 128 + dv16 + 8 * q);
#pragma unroll
          for (int e = 0; e < 4; ++e) { vv[t * 128 + dv16 + 8 * q + 2 * e] = bf2f((unsigned short)(vw[e] & 0xffffu)); vv[t * 128 + dv16 + 8 * q + 2 * e + 1] = bf2f((unsigned short)(vw[e] >> 16)); } }
#pragma unroll
      for (int j = 0; j < 4; ++j) *(LAS f32x4*)(Sst + 4 * (tid + 512 * j)) = *(const f32x4*)(US + (size_t)unit * 8192 + 4 * (tid + 512 * j)); }
    __syncthreads();
    { const int t4 = tid >> 5, s2 = tid & 31; f32x4 a0 = {0.f, 0.f, 0.f, 0.f}, a1 = {0.f, 0.f, 0.f, 0.f};
#pragma unroll 4
      for (int dk = 0; dk < 64; ++dk) { const f32x4 qv = *(const LAS f32x4*)(qiT + dk * 64 + 4 * t4); const f32x2 kv = *(const LAS f32x2*)(kiT + dk * 64 + 2 * s2);
          a0 += qv * kv[0]; a1 += qv * kv[1]; }
#pragma unroll
      for (int i = 0; i < 4; ++i) { if (2 * s2 > 4 * t4 + i) a0[i] = 0.f; if (2 * s2 + 1 > 4 * t4 + i) a1[i] = 0.f; }
      *(LAS f32x4*)(attT + (2 * s2) * 64 + 4 * t4) = a0; *(LAS f32x4*)(attT + (2 * s2 + 1) * 64 + 4 * t4) = a1; }
    __syncthreads();
    { const int t4 = tid >> 5, dvq = tid & 31; f32x4 o[4] = {{0.f, 0.f, 0.f, 0.f}, {0.f, 0.f, 0.f, 0.f}, {0.f, 0.f, 0.f, 0.f}, {0.f, 0.f, 0.f, 0.f}};
#pragma unroll 4
      for (int dk = 0; dk < 64; ++dk) { const f32x4 qv = *(const LAS f32x4*)(qiT + dk * 64 + 4 * t4), sv = *(const LAS f32x4*)(Sst + dk * 128 + 4 * dvq);
#pragma unroll
          for (int i = 0; i < 4; ++i) o[i] += qv[i] * sv; }
      const int smax = 4 * t4 + 3;
      for (int s = 0; s <= smax; ++s) { const f32x4 av = *(const LAS f32x4*)(attT + s * 64 + 4 * t4), v4 = *(const LAS f32x4*)(vv + s * 128 + 4 * dvq);
#pragma unroll
          for (int i = 0; i < 4; ++i) o[i] += av[i] * v4; }
      const f32x4 gn = *(const f32x4*)((const float*)A.in[19] + h * 128 + 4 * dvq);
#pragma unroll
      for (int i = 0; i < 4; ++i) { const float ss = half_sum((o[i][0] * o[i][0] + o[i][1] * o[i][1]) + (o[i][2] * o[i][2] + o[i][3] * o[i][3]));
          const float rstd = 1.0f / sqrtf(ss * (1.0f / 128.0f) + 1e-6f); const int row = row0 + 4 * t4 + i;
          const v2u rw = *(const v2u*)(Z + (size_t)row * ZE + 1024 + h * 128 + 4 * dvq);
          const float r0 = bf2f((unsigned short)(rw.x & 0xffffu)), r1 = bf2f((unsigned short)(rw.x >> 16)), r2 = bf2f((unsigned short)(rw.y & 0xffffu)), r3 = bf2f((unsigned short)(rw.y >> 16));
          v2u ow; ow.x = pk2(o[i][0] * rstd * gn[0] * siluf_(r0), o[i][1] * rstd * gn[1] * siluf_(r1)); ow.y = pk2(o[i][2] * rstd * gn[2] * siluf_(r2), o[i][3] * rstd * gn[3] * siluf_(r3));
          *(GAS v2u*)(OP + (size_t)row * DM + h * 128 + 4 * dvq) = ow; } }
    __syncthreads();
}
__device__ __forceinline__ void gla_sample_unit(Frame& F, const Args& A, int unit) {
    const bf16* Z = WS_PTR(bf16, WS_Z); bf16* OP = WS_PTR(bf16, WS_OP);
    const float* gate_w2 = (const float*)A.in[17]; const float* gate_b = (const float*)A.in[18]; const float* S0g = (const float*)A.in[2] + (size_t)unit * 8192; float* Sout = F.out + O_GLAS + (size_t)unit * 8192;
    const int b = unit >> 2, h = unit & 3, row0 = MP + 4 * b, tid = F.tid;
    LAS float* S0 = (LAS float*)F.lds; LAS float* bc = S0 + 8192; LAS float* qi = bc + 256; LAS float* ki = qi + 256; LAS float* kk = ki + 256; LAS float* vv = kk + 256; LAS float* att = vv + 512; LAS float* gl = att + 16; LAS float* red = gl + 64;
#pragma unroll
    for (int j = 0; j < 4; ++j) *(LAS f32x4*)(S0 + 4 * (tid + 512 * j)) = *(const f32x4*)(S0g + 4 * (tid + 512 * j));
    if (tid < 64) gl[tid] = bf2f(Z[(size_t)(row0 + (tid >> 4)) * ZE + 2048 + (tid & 15)]);
    vv[tid] = bf2f(Z[(size_t)(row0 + (tid >> 7)) * ZE + 512 + h * 128 + (tid & 127)]);
    __syncthreads();
    if (tid < 256) { const int t = tid >> 6, dk = tid & 63; float x = gate_b[h * 64 + dk];
#pragma unroll
        for (int j = 0; j < 16; ++j) x += gl[t * 16 + j] * gate_w2[j * 256 + h * 64 + dk];
        bc[t * 64 + dk] = logsig16(x); }
    __syncthreads();
    if (tid < 64) { float run = 0.f;
#pragma unroll
        for (int t = 0; t < 4; ++t) { run += bc[t * 64 + tid]; bc[t * 64 + tid] = run; } }
    __syncthreads();
    if (tid < 256) { const int t = tid >> 6, dk = tid & 63; const float bb = bc[t * 64 + dk], bl = bc[3 * 64 + dk];
        const float qv = bf2f(Z[(size_t)(row0 + t) * ZE + h * 64 + dk]), kv = bf2f(Z[(size_t)(row0 + t) * ZE + 256 + h * 64 + dk]);
        qi[t * 64 + dk] = 0.125f * qv * __expf(bb); ki[t * 64 + dk] = kv * __expf(-bb); kk[t * 64 + dk] = kv * __expf(bl - bb); }
    __syncthreads();
    if (tid < 16) { const int t = tid >> 2, s = tid & 3; float a = 0.f;
        for (int dk = 0; dk < 64; ++dk) a += qi[t * 64 + dk] * ki[s * 64 + dk];
        att[tid] = (s <= t) ? a : 0.f; }
    __syncthreads();
    { const int t = tid >> 7, dv = tid & 127; float o = 0.f;
#pragma unroll 8
      for (int dk = 0; dk < 64; ++dk) o += qi[t * 64 + dk] * S0[dk * 128 + dv];
#pragma unroll
      for (int s = 0; s < 4; ++s) o += att[t * 4 + s] * vv[s * 128 + dv];
      const float ss = wave_sum(o * o); if (F.lane == 0) red[F.wave] = ss;
      __syncthreads();
      const float tot = red[2 * t] + red[2 * t + 1]; const float rstd = 1.0f / sqrtf(tot * (1.0f / 128.0f) + 1e-6f);
      const float gn = ((const float*)A.in[19])[h * 128 + dv]; const float rr = bf2f(Z[(size_t)(row0 + t) * ZE + 1024 + h * 128 + dv]);
      OP[(size_t)(row0 + t) * DM + h * 128 + dv] = (bf16)f2bf(o * rstd * gn * siluf_(rr)); }
#pragma unroll
    for (int j = 0; j < 4; ++j) { const int e = 4 * (tid + 512 * j), dk = e >> 7, dv = e & 127; const float dec = __expf(bc[3 * 64 + dk]);
        f32x4 sn = *(const LAS f32x4*)(S0 + e) * dec;
#pragma unroll
        for (int s = 0; s < 4; ++s) sn += kk[s * 64 + dk] * *(const LAS f32x4*)(vv + s * 128 + dv);
        *(f32x4*)(Sout + e) = sn; }
    __syncthreads();
}
__device__ __forceinline__ void pool_prompt_unit(Frame& F, int unit) {
    const bf16* Z = WS_PTR(bf16, WS_Z); bf16* OP = WS_PTR(bf16, WS_OP); float* hp = F.out + O_POOLP;
    const int b = unit >> 7, t0 = (unit & 127) * 64, c = F.tid, w = 2 << (c >> 7); const size_t rb = (size_t)b * TP;
    float s = 0.f;
    for (int j = t0 - w; j < t0; ++j) if (j >= 0) s += bf2f(Z[(rb + j) * ZE + 1536 + c]);
    for (int t = t0; t < t0 + 64; ++t) { const float ut = bf2f(Z[(rb + t) * ZE + 1536 + c]); s += ut; if (t - w >= 0) s -= bf2f(Z[(rb + t - w) * ZE + 1536 + c]);
        const float cnt = (float)((t + 1 < w) ? t + 1 : w);
        OP[(rb + t) * DM + 512 + c] = (bf16)f2bf(s / cnt - ut);
        if (t >= TP - 15) hp[((size_t)b * 15 + (t - (TP - 15))) * 512 + c] = ut; }
}
__device__ __forceinline__ void pool_sample_unit(Frame& F, const Args& A, int b) {
    const bf16* Z = WS_PTR(bf16, WS_Z); bf16* OP = WS_PTR(bf16, WS_OP); float* hs = F.out + O_POOLS + (size_t)b * 15 * 512; const float* hin = (const float*)A.in[3] + (size_t)b * 15 * 512;
    const int c = F.tid, w = 2 << (c >> 7); float full[19];
#pragma unroll
    for (int i = 0; i < 15; ++i) full[i] = hin[i * 512 + c];
#pragma unroll
    for (int t = 0; t < 4; ++t) full[15 + t] = bf2f(Z[(size_t)(MP + 4 * b + t) * ZE + 1536 + c]);
#pragma unroll
    for (int t = 0; t < 4; ++t) { float s = 0.f;
#pragma unroll
        for (int j = 0; j < 16; ++j) if (j < w) s += full[15 + t - j];
        OP[(size_t)(MP + 4 * b + t) * DM + 512 + c] = (bf16)f2bf(s / (float)w - full[15 + t]); }
#pragma unroll
    for (int i = 0; i < 15; ++i) hs[i * 512 + c] = full[4 + i];
}
__device__ __forceinline__ void even_mid_phase(Frame& F, const Args& A) {
    constexpr int N1 = 1024, N2 = 512, N3 = 256, N4 = 128;
    for (int u = F.bx; u < N1 + N2 + N3 + N4; u += F.G) {
        if (u < N1) gla_g1_unit(F, A, u);
        else if (u < N1 + N2) gla_sample_unit(F, A, u - N1);
        else if (u < N1 + N2 + N3) pool_prompt_unit(F, u - N1 - N2);
        else pool_sample_unit(F, A, u - N1 - N2 - N3);
    }
}
__device__ __forceinline__ void odd_rows(Frame& F, const Args& A) {
    const bf16* Z = WS_PTR(bf16, WS_Z); bf16* CQN = WS_PTR(bf16, WS_CQN); bf16* CKVB = WS_PTR(bf16, WS_CKVB); bf16* KRB = WS_PTR(bf16, WS_KRB); const float* rt = WS_PTR(float, WS_RT);
    const float* q_norm = (const float*)A.in[24]; const float* kv_norm = (const float*)A.in[26];
    const int gw = F.bx * NWAVES + F.wave, NGW = F.G * NWAVES, lane = F.lane;
    for (int row = gw; row < MT; row += NGW) {
        const bf16* zr = Z + (size_t)row * ZO;
        { float v[6]; float ss = 0.f;
#pragma unroll
          for (int j = 0; j < 3; ++j) { const unsigned w = *(const unsigned*)(zr + 2 * lane + 128 * j); v[2 * j] = bf2f((unsigned short)(w & 0xffffu)); v[2 * j + 1] = bf2f((unsigned short)(w >> 16)); ss += v[2 * j] * v[2 * j] + v[2 * j + 1] * v[2 * j + 1]; }
          const float rstd = 1.0f / sqrtf(wave_sum(ss) * (1.0f / 384.0f) + 1e-6f);
#pragma unroll
          for (int j = 0; j < 3; ++j) { const int c = 2 * lane + 128 * j; *(GAS unsigned*)(CQN + (size_t)row * 384 + c) = pk2(v[2 * j] * rstd * q_norm[c], v[2 * j + 1] * rstd * q_norm[c + 1]); } }
        { const v2u w = *(const v2u*)(zr + 384 + 4 * lane); f32x4 v = {bf2f((unsigned short)(w.x & 0xffffu)), bf2f((unsigned short)(w.x >> 16)), bf2f((unsigned short)(w.y & 0xffffu)), bf2f((unsigned short)(w.y >> 16))};
          const float ss = wave_sum((v[0] * v[0] + v[1] * v[1]) + (v[2] * v[2] + v[3] * v[3])); const float rstd = 1.0f / sqrtf(ss * (1.0f / 256.0f) + 1e-6f);
          const f32x4 o = (v * rstd) * *(const f32x4*)(kv_norm + 4 * lane);
          *(f32x4*)(F.out + O_CKV + (size_t)row * 256 + 4 * lane) = o;
          v2u ob; ob.x = pk2(o[0], o[1]); ob.y = pk2(o[2], o[3]); *(GAS v2u*)(CKVB + (size_t)row * 256 + 4 * lane) = ob; }
        if (lane < 16) { const float x1 = bf2f(zr[640 + lane]), x2 = bf2f(zr[640 + 16 + lane]); const f32x2 cs = *(const f32x2*)(rt + (size_t)posof(row) * 32 + 2 * lane);
          const float o1 = x1 * cs[0] - x2 * cs[1], o2 = x2 * cs[0] + x1 * cs[1];
          F.out[O_KR + (size_t)row * 32 + lane] = o1; F.out[O_KR + (size_t)row * 32 + 16 + lane] = o2;
          KRB[(size_t)row * 32 + lane] = (bf16)f2bf(o1); KRB[(size_t)row * 32 + 16 + lane] = (bf16)f2bf(o2); }
    }
}
template <bool SAMPLE> __device__ __forceinline__ void conv_unit(Frame& F, const Args& A, int unit) {
    constexpr int NTOK = SAMPLE ? 4 : 32, NR = NTOK + 30;
    const bf16* Z = WS_PTR(bf16, WS_Z); bf16* OP = WS_PTR(bf16, WS_OP);
    const float* conv_w = (const float*)A.in[29]; const float* conv_b = (const float*)A.in[30]; const float* ng = (const float*)A.in[31]; const float* nb = (const float*)A.in[32];
    const int c = F.tid; LAS float* ut = (LAS float*)F.lds;
    LAS float* stat = ut + 62 * 512;
    const int b = SAMPLE ? unit : (unit >> 8), t0 = SAMPLE ? 0 : (unit & 255) * 32; const size_t rb = SAMPLE ? (size_t)(MP + 4 * b) : (size_t)b * TP;
    for (int rr = 0; rr < NR; ++rr) { const int t = t0 - 30 + rr; float u = 0.f;
        if (t >= 0) { const bf16* zr = Z + (rb + t) * ZO; u = bf2f(zr[672 + c]) * sigmoidf_(bf2f(zr[1184 + c])); }
        else if (SAMPLE) u = ((const float*)A.in[6])[((size_t)b * 30 + rr) * 512 + c];
        ut[rr * 512 + c] = u; }
    float w[31];
#pragma unroll
    for (int j = 0; j < 31; ++j) w[j] = conv_w[j * 512 + c];
    const float bias = conv_b[c];
    if (SAMPLE) { float* cs = F.out + O_CONVS + (size_t)b * 30 * 512;
        for (int i = 0; i < 30; ++i) cs[i * 512 + c] = ut[(4 + i) * 512 + c]; }
    else if (t0 == TP - 32) { float* cp = F.out + O_CONVP + (size_t)b * 30 * 512;
        for (int i = 0; i < 30; ++i) cp[i * 512 + c] = ut[(32 + i) * 512 + c]; }
#pragma unroll 4
    for (int tt = 0; tt < NTOK; ++tt) { float a = bias;
#pragma unroll
        for (int j = 0; j < 31; ++j) a += w[j] * ut[(tt + j) * 512 + c];
        ut[tt * 512 + c] = a; }
    __syncthreads();
    for (int tt = F.wave; tt < NTOK; tt += NWAVES) { float s1 = 0.f, s2 = 0.f;
#pragma unroll
        for (int j = 0; j < 8; ++j) { const float x = ut[tt * 512 + F.lane + 64 * j]; s1 += x; s2 += x * x; }
        s1 = wave_sum(s1); s2 = wave_sum(s2); const float mean = s1 * (1.0f / 512.0f); const float var = fmaxf(s2 * (1.0f / 512.0f) - mean * mean, 0.f);
        if (F.lane == 0) { stat[2 * tt] = mean; stat[2 * tt + 1] = 1.0f / sqrtf(var + 1e-6f); } }
    __syncthreads();
    const float gg = ng[c], bb = nb[c];
#pragma unroll 4
    for (int tt = 0; tt < NTOK; ++tt) { const float y = (ut[tt * 512 + c] - stat[2 * tt]) * stat[2 * tt + 1] * gg + bb;
        OP[(rb + t0 + tt) * DM + 512 + c] = (bf16)f2bf(siluf_(y)); }
    __syncthreads();
}
__device__ __forceinline__ void odd_thin_phase(Frame& F, const Args& A) {
    odd_rows(F, A);
    for (int u = F.bx; u < 512 + 128; u += F.G) { if (u < 512) conv_unit<false>(F, A, u); else conv_unit<true>(F, A, u - 512); }
}
typedef short v4i16_t __attribute__((ext_vector_type(4)));
__device__ __forceinline__ s16x4 vtr(const LAS unsigned char* p) { return __builtin_bit_cast(s16x4, __builtin_amdgcn_ds_read_tr16_b64_v4i16((LAS v4i16_t*)p)); }
__device__ __forceinline__ int crow(int r, int hi) { return (r & 3) + 8 * (r >> 2) + 4 * hi; }
__device__ __forceinline__ bf16x8 pack8(const f32x16& p, int s8) {
    v4u w; w.x = pg8::cvt_pk_bf16(p[s8 + 0], p[s8 + 1]); w.y = pg8::cvt_pk_bf16(p[s8 + 2], p[s8 + 3]); w.z = pg8::cvt_pk_bf16(p[s8 + 4], p[s8 + 5]); w.w = pg8::cvt_pk_bf16(p[s8 + 6], p[s8 + 7]);
    return __builtin_bit_cast(bf16x8, w);
}
constexpr int PA_KROW = 208, PA_VROW = 144, PA_VOFF = 64 * PA_KROW, PA_BUF = PA_VOFF + 64 * PA_VROW;
__device__ __forceinline__ void pattn_unit(Frame& F, int b, int h, int qb) {
    const bf16* Q = WS_PTR(bf16, WS_Q); const bf16* KV = WS_PTR(bf16, WS_KV); const bf16* KRB = WS_PTR(bf16, WS_KRB); bf16* OP = WS_PTR(bf16, WS_OP);
    const int tid = F.tid, lane = F.lane, wid = F.wave, r32 = lane & 31, hi = lane >> 5;
    const size_t rb = (size_t)b * TP; const int q0w = 256 * qb + 32 * wid, NT = 4 * (qb + 1);
    LAS unsigned char* L = F.lds;
    const int skey = tid >> 3, sc = tid & 7, rkey = tid >> 2, rc = tid & 3;
    const bf16* gk = KV + (rb + skey) * 1024 + h * 64 + 8 * sc; const bf16* gv = gk + 512; const bf16* gr = KRB + (rb + rkey) * 32 + 8 * rc;
    const int lk = skey * PA_KROW + (sc << 4), lv = PA_VOFF + skey * PA_VROW + (sc << 4), lr = rkey * PA_KROW + ((8 + rc) << 4);
    v4u sk, sv, sr = {0u, 0u, 0u, 0u};
#define PA_LOAD(kt) do { sk = *(const v4u*)(gk + (size_t)(kt) * 64 * 1024); sv = *(const v4u*)(gv + (size_t)(kt) * 64 * 1024); if (tid < 256) sr = *(const v4u*)(gr + (size_t)(kt) * 64 * 32); } while (0)
#define PA_STORE(bufo) do { *(LAS v4u*)(L + (bufo) + lk) = sk; *(LAS v4u*)(L + (bufo) + lv) = sv; if (tid < 256) *(LAS v4u*)(L + (bufo) + lr) = sr; } while (0)
    PA_LOAD(0);
    bf16x8 qf[6];
    { const bf16* qp = Q + (rb + q0w + r32) * 768 + h * 96 + 8 * hi;
#pragma unroll
      for (int kk = 0; kk < 6; ++kk) qf[kk] = *(const bf16x8*)(qp + 16 * kk); }
    f32x16 o0 = {}, o1 = {}; float mrun = -1e30f, lrun = 0.f;
    PA_STORE(0);
    __syncthreads();
    const int aoffk = r32 * PA_KROW + (hi << 4);
    const int g = lane >> 4, i16 = lane & 15, hg = g >> 1;
    const int voff = PA_VOFF + (4 * hg + (i16 >> 2)) * PA_VROW + ((16 * (g & 1) + 4 * (i16 & 3)) << 1);
    for (int kt = 0; kt < NT; ++kt) {
        const int bufo = (kt & 1) * PA_BUF;
        if (kt + 1 < NT) PA_LOAD(kt + 1);
        if (64 * kt <= q0w + 31) {
            f32x16 p0 = {}, p1 = {};
#pragma unroll
            for (int kk = 0; kk < 6; ++kk) {
                const bf16x8 a0 = *(const LAS bf16x8*)(L + bufo + aoffk + 32 * kk), a1 = *(const LAS bf16x8*)(L + bufo + aoffk + 32 * PA_KROW + 32 * kk);
                p0 = __builtin_amdgcn_mfma_f32_32x32x16_bf16(a0, qf[kk], p0, 0, 0, 0); p1 = __builtin_amdgcn_mfma_f32_32x32x16_bf16(a1, qf[kk], p1, 0, 0, 0); }
            if (64 * kt + 63 > q0w) { const int qq = q0w + r32;
#pragma unroll
                for (int r = 0; r < 16; ++r) { const int key = 64 * kt + crow(r, hi); if (key > qq) p0[r] = -INFINITY; if (key + 32 > qq) p1[r] = -INFINITY; } }
            float mt = fmaxf(p0[0], p1[0]);
#pragma unroll
            for (int r = 1; r < 16; ++r) mt = fmaxf(mt, fmaxf(p0[r], p1[r]));
            mt = fmaxf(mt, __shfl_xor(mt, 32));
            const float mnew = fmaxf(mrun, mt), alpha = __builtin_amdgcn_exp2f(mrun - mnew); mrun = mnew;
            float rs = 0.f;
#pragma unroll
            for (int r = 0; r < 16; ++r) { p0[r] = __builtin_amdgcn_exp2f(p0[r] - mnew); p1[r] = __builtin_amdgcn_exp2f(p1[r] - mnew); rs += p0[r] + p1[r]; }
            rs += __shfl_xor(rs, 32); lrun = lrun * alpha + rs;
#pragma unroll
            for (int r = 0; r < 16; ++r) { o0[r] *= alpha; o1[r] *= alpha; }
#pragma unroll
            for (int hf = 0; hf < 2; ++hf)
#pragma unroll
                for (int s = 0; s < 2; ++s) { const bf16x8 pb = pack8(hf ? p1 : p0, 8 * s);
#pragma unroll
                    for (int dt = 0; dt < 2; ++dt) { const int a0 = bufo + voff + (32 * hf + 16 * s) * PA_VROW + 64 * dt, a1 = a0 + 8 * PA_VROW;
                        const s16x4 lo = vtr(L + a0), hh = vtr(L + a1);
                        const bf16x8 va = {lo[0], lo[1], lo[2], lo[3], hh[0], hh[1], hh[2], hh[3]};
                        if (dt == 0) o0 = __builtin_amdgcn_mfma_f32_32x32x16_bf16(va, pb, o0, 0, 0, 0); else o1 = __builtin_amdgcn_mfma_f32_32x32x16_bf16(va, pb, o1, 0, 0, 0); } }
        }
        if (kt + 1 < NT) PA_STORE(((kt + 1) & 1) * PA_BUF);
        __syncthreads();
    }
#undef PA_LOAD
#undef PA_STORE
    const float rl = 1.0f / lrun;
    bf16* op = OP + (rb + q0w + r32) * DM + h * 64;
#pragma unroll
    for (int dt = 0; dt < 2; ++dt)
#pragma unroll
        for (int rq = 0; rq < 4; ++rq) { const f32x16& o = dt ? o1 : o0; v2u w; w.x = pk2(o[4 * rq] * rl, o[4 * rq + 1] * rl); w.y = pk2(o[4 * rq + 2] * rl, o[4 * rq + 3] * rl);
            *(GAS v2u*)(op + 32 * dt + 8 * rq + 4 * hi) = w; }
}

constexpr int DT_ROW = 592, DT_TILE = 64 * DT_ROW, DT_QOFF = 2 * DT_TILE, DT_QN = DT_QOFF + 32 * DT_ROW, DT_ML = 133120;
__device__ __forceinline__ void dattn_unit(Frame& F, const Args& A, int unit) {
    const bf16* Q = WS_PTR(bf16, WS_Q); float* PART = WS_PTR(float, WS_PART) + (size_t)unit * PART_F; float* QD = WS_PTR(float, WS_QD);
    const float* cckv = (const float*)A.in[4]; const float* ckr = (const float*)A.in[5]; const int* ptab = (const int*)A.in[7]; const float* w_uk = (const float*)A.in[27];
    const int tid = F.tid, lane = F.lane, wid = F.wave, r32 = lane & 31, hi = lane >> 5, b = unit >> 3, sp = unit & 7;
    LAS unsigned char* L = F.lds; LAS float* qn = (LAS float*)(L + DT_QN); LAS float* ml = (LAS float*)(L + DT_ML);
    f32x4 st[9];
    const int wofs = (tid >> 6) * DT_ROW + (tid & 63) * 8, wofr = (tid >> 3) * DT_ROW + 512 + (tid & 7) * 8;
#define DT_LOAD(tl) do { const int pid = ptab[b * 64 + sp * 8 + ((tl) >> 1)]; const f32x4* pc = (const f32x4*)(cckv + ((size_t)pid * 128 + ((tl) & 1) * 64) * 256); const f32x4* pr = (const f32x4*)(ckr + ((size_t)pid * 128 + ((tl) & 1) * 64) * 32); \
        _Pragma("unroll") for (int i = 0; i < 8; ++i) st[i] = __builtin_nontemporal_load(pc + tid + 512 * i); \
        st[8] = __builtin_nontemporal_load(pr + tid); } while (0)
#define DT_STORE(bufo) do { _Pragma("unroll") for (int i = 0; i < 8; ++i) { v2u w_; w_.x = pg8::cvt_pk_bf16(st[i][0], st[i][1]); w_.y = pg8::cvt_pk_bf16(st[i][2], st[i][3]); *(LAS v2u*)(L + (bufo) + wofs + i * 8 * DT_ROW) = w_; } \
        { v2u w_; w_.x = pg8::cvt_pk_bf16(st[8][0], st[8][1]); w_.y = pg8::cvt_pk_bf16(st[8][2], st[8][3]); *(LAS v2u*)(L + (bufo) + wofr) = w_; } } while (0)
    DT_LOAD(0);
    { const int t = tid >> 7, c6 = (tid & 127) * 6;
      const bf16* qp = Q + (size_t)(MP + 4 * b + t) * 768 + c6;
#pragma unroll
      for (int e = 0; e < 6; ++e) { const int c = c6 + e, hh = c / 96, d = c % 96; const bf16 v = qp[e];
          if (d < 64) qn[(t * 8 + hh) * 64 + d] = bf2f(v);
          else { const int q = t * 8 + hh, col = 256 + (d - 64); *(LAS bf16*)(L + DT_QOFF + q * DT_ROW + col * 2) = v;
                 if (sp == 0) QD[((size_t)b * 32 + q) * 288 + col] = bf2f(v); } } }
    __syncthreads();
    { const int hh = tid >> 6, rr = tid & 63;
#pragma unroll 1
      for (int j = 0; j < 4; ++j) { const int r = rr + 64 * j; const f32x4* wp = (const f32x4*)(w_uk + ((size_t)r * 8 + hh) * 64); float a0 = 0.f, a1 = 0.f, a2 = 0.f, a3 = 0.f;
#pragma unroll 4
          for (int d4 = 0; d4 < 16; ++d4) { const f32x4 w = wp[d4];
              const f32x4 x0 = *(const LAS f32x4*)(qn + (0 * 8 + hh) * 64 + 4 * d4), x1 = *(const LAS f32x4*)(qn + (1 * 8 + hh) * 64 + 4 * d4), x2 = *(const LAS f32x4*)(qn + (2 * 8 + hh) * 64 + 4 * d4), x3 = *(const LAS f32x4*)(qn + (3 * 8 + hh) * 64 + 4 * d4);
              a0 += (w[0] * x0[0] + w[1] * x0[1]) + (w[2] * x0[2] + w[3] * x0[3]); a1 += (w[0] * x1[0] + w[1] * x1[1]) + (w[2] * x1[2] + w[3] * x1[3]);
              a2 += (w[0] * x2[0] + w[1] * x2[1]) + (w[2] * x2[2] + w[3] * x2[3]); a3 += (w[0] * x3[0] + w[1] * x3[1]) + (w[2] * x3[2] + w[3] * x3[3]); }
          const float av[4] = {a0, a1, a2, a3};
#pragma unroll
          for (int t = 0; t < 4; ++t) { const int q = t * 8 + hh; *(LAS bf16*)(L + DT_QOFF + q * DT_ROW + r * 2) = (bf16)f2bf(av[t]);
              if (sp == 0) QD[((size_t)b * 32 + q) * 288 + r] = av[t]; } } }
    DT_STORE(0);
    __syncthreads();
    const int kh = wid & 1, dq = wid >> 1, g = lane >> 4, i16 = lane & 15, hg = g >> 1;
    f32x16 o0 = {}, o1 = {}; float mrun = -1e30f, lrun = 0.f;
    const int arow = (32 * kh + r32) * DT_ROW + (hi << 4), qrow = DT_QOFF + r32 * DT_ROW + (hi << 4);
    const int voff = (32 * kh + 4 * hg + (i16 >> 2)) * DT_ROW + ((64 * dq + 16 * (g & 1) + 4 * (i16 & 3)) << 1);
    for (int tl = 0; tl < 16; ++tl) {
        const int bufo = (tl & 1) * DT_TILE;
        if (tl + 1 < 16) DT_LOAD(tl + 1);
        f32x16 p = {};
#pragma unroll
        for (int kk = 0; kk < 18; ++kk) { const bf16x8 a = *(const LAS bf16x8*)(L + bufo + arow + 32 * kk), qv = *(const LAS bf16x8*)(L + qrow + 32 * kk);
            p = __builtin_amdgcn_mfma_f32_32x32x16_bf16(a, qv, p, 0, 0, 0); }
        float mt = p[0];
#pragma unroll
        for (int r = 1; r < 16; ++r) mt = fmaxf(mt, p[r]);
        mt = fmaxf(mt, __shfl_xor(mt, 32));
        const float mnew = fmaxf(mrun, mt), alpha = __builtin_amdgcn_exp2f(mrun - mnew); mrun = mnew;
        float rs = 0.f;
#pragma unroll
        for (int r = 0; r < 16; ++r) { p[r] = __builtin_amdgcn_exp2f(p[r] - mnew); rs += p[r]; }
        rs += __shfl_xor(rs, 32); lrun = lrun * alpha + rs;
#pragma unroll
        for (int r = 0; r < 16; ++r) { o0[r] *= alpha; o1[r] *= alpha; }
#pragma unroll
        for (int s = 0; s < 2; ++s) { const bf16x8 pb = pack8(p, 8 * s);
#pragma unroll
            for (int dt = 0; dt < 2; ++dt) { const int a0 = bufo + voff + 16 * s * DT_ROW + 64 * dt, a1 = a0 + 8 * DT_ROW;
                const s16x4 lo = vtr(L + a0), hh = vtr(L + a1);
                const bf16x8 va = {lo[0], lo[1], lo[2], lo[3], hh[0], hh[1], hh[2], hh[3]};
                if (dt == 0) o0 = __builtin_amdgcn_mfma_f32_32x32x16_bf16(va, pb, o0, 0, 0, 0); else o1 = __builtin_amdgcn_mfma_f32_32x32x16_bf16(va, pb, o1, 0, 0, 0); } }
        if (tl + 1 < 16) DT_STORE(((tl + 1) & 1) * DT_TILE);
        __syncthreads();
    }
#undef DT_LOAD
#undef DT_STORE
    { LAS float* ow = (LAS float*)L + (size_t)wid * 2048;
#pragma unroll
      for (int dt = 0; dt < 2; ++dt)
#pragma unroll
          for (int r = 0; r < 16; ++r) ow[(32 * dt + crow(r, hi)) * 32 + r32] = dt ? o1[r] : o0[r];
      if (hi == 0) { ml[wid * 64 + r32] = mrun; ml[wid * 64 + 32 + r32] = lrun; } }
    __syncthreads();
    { const int q = tid & 31, dvg = tid >> 5, dqq = dvg >> 2;
      const float m0 = ml[(2 * dqq) * 64 + q], m1 = ml[(2 * dqq + 1) * 64 + q], ms = fmaxf(m0, m1);
      const float w0 = __builtin_amdgcn_exp2f(m0 - ms), w1 = __builtin_amdgcn_exp2f(m1 - ms);
      const float ls = w0 * ml[(2 * dqq) * 64 + 32 + q] + w1 * ml[(2 * dqq + 1) * 64 + 32 + q];
#pragma unroll
      for (int j = 0; j < 16; ++j) { const int dv = dvg * 16 + j, dvl = dv & 63;
          PART[dv * 32 + q] = w0 * ((LAS float*)L)[(size_t)(2 * dqq) * 2048 + dvl * 32 + q] + w1 * ((LAS float*)L)[(size_t)(2 * dqq + 1) * 2048 + dvl * 32 + q]; }
      if (dvg == 0) { PART[8192 + q] = ms; PART[8192 + 32 + q] = ls; } }
    __syncthreads();
}
__device__ __forceinline__ void dcombine_unit(Frame& F, const Args& A, int b) {
    const float* PART = WS_PTR(float, WS_PART) + (size_t)b * NSPLIT * PART_F; const float* QD = WS_PTR(float, WS_QD) + (size_t)b * 32 * 288; bf16* OP = WS_PTR(bf16, WS_OP);
    const float* ckv = F.out + O_CKV + (size_t)(MP + 4 * b) * 256; const float* kr = F.out + O_KR + (size_t)(MP + 4 * b) * 32; const float* w_uv = (const float*)A.in[28];
    const int tid = F.tid; LAS float* lat = (LAS float*)F.lds; LAS float* sn = lat + 8192; LAS float* ck = sn + 128;
    for (int i = tid; i < 1024; i += 512) ck[i] = ckv[i];
    if (tid < 128) { const int q = tid >> 2, s = tid & 3; const float* qd = QD + q * 288; const float* cr = ckv + s * 256; const float* krr = kr + s * 32; float a = 0.f;
        for (int r = 0; r < 256; ++r) a += qd[r] * cr[r];
        for (int i = 0; i < 32; ++i) a += qd[256 + i] * krr[i];
        sn[tid] = (s <= (q >> 3)) ? a : -INFINITY; }
    __syncthreads();
    { const int q = tid & 31, dvg = tid >> 5; float mk[NSPLIT], ms = -1e30f;
#pragma unroll
      for (int s = 0; s < NSPLIT; ++s) { mk[s] = PART[(size_t)s * PART_F + 8192 + q]; ms = fmaxf(ms, mk[s]); }
      float pn[4];
#pragma unroll
      for (int s = 0; s < 4; ++s) { pn[s] = sn[q * 4 + s]; ms = fmaxf(ms, pn[s]); }
      float wg[NSPLIT], ls = 0.f;
#pragma unroll
      for (int s = 0; s < NSPLIT; ++s) { wg[s] = __builtin_amdgcn_exp2f(mk[s] - ms); ls += wg[s] * PART[(size_t)s * PART_F + 8192 + 32 + q]; }
#pragma unroll
      for (int s = 0; s < 4; ++s) { pn[s] = __builtin_amdgcn_exp2f(pn[s] - ms); ls += pn[s]; }
      const float rl = 1.0f / ls;
#pragma unroll 4
      for (int j = 0; j < 16; ++j) { const int dv = dvg * 16 + j; float acc = 0.f;
#pragma unroll
          for (int s = 0; s < NSPLIT; ++s) acc += wg[s] * PART[(size_t)s * PART_F + dv * 32 + q];
#pragma unroll
          for (int s = 0; s < 4; ++s) acc += pn[s] * ck[s * 256 + dv];
          lat[q * 256 + dv] = acc * rl; } }
    __syncthreads();
    { const int hh = tid >> 6, v = tid & 63; float a[4] = {0.f, 0.f, 0.f, 0.f};
#pragma unroll 4
      for (int r = 0; r < 256; ++r) { const float w = w_uv[((size_t)r * 8 + hh) * 64 + v];
#pragma unroll
          for (int t = 0; t < 4; ++t) a[t] += w * lat[(t * 8 + hh) * 256 + r]; }
#pragma unroll
      for (int t = 0; t < 4; ++t) OP[(size_t)(MP + 4 * b + t) * DM + hh * 64 + v] = (bf16)f2bf(a[t]); }
    __syncthreads();
}
__device__ __forceinline__ void attn_phase(Frame& F, const Args& A) {
    for (int pr = F.bx; pr < 256; pr += F.G) { const int bh = pr >> 4, s = pr & 15; pattn_unit(F, bh >> 3, bh & 7, 31 - s); pattn_unit(F, bh >> 3, bh & 7, s); }
    for (int du = F.bx; du < 128 * NSPLIT; du += F.G) dattn_unit(F, A, du);
}
constexpr int N_PHASE_IDS = 43;
#ifndef PHMASK
#define PHMASK 0xFFFFFFFFu
#endif
#define EN(n) (((PHMASK) >> (n)) & 1u)
#ifndef MK_ONE_LAUNCH
#define MK_ONE_LAUNCH 1
#endif
__global__ void __launch_bounds__(NWAVES * 64, 2) mk_fwd(Args args) {
    extern __shared__ __attribute__((aligned(16))) unsigned char lds[];
    Frame F;
    F.lds = (LAS unsigned char*)lds; F.MISC = (volatile LAS unsigned*)(F.lds + MISC_OFF);
    F.tid = threadIdx.x; F.lane = F.tid & 63; F.wave = __builtin_amdgcn_readfirstlane(F.tid >> 6); F.G = gridDim.x; F.bx = blockIdx.x;
    F.ws = args.ws; F.out = args.out; F.ctl = (gu32*)(args.ws + WS_CTL);
    for (int u = F.tid; u < (LDS_BYTES - LDSCTL_OFF) / 4; u += NWAVES * 64) ((LAS unsigned*)(F.lds + LDSCTL_OFF))[u] = 0u;
    __syncthreads();
    XcdBarrier bar; bar.bar = (unsigned*)(F.ctl + CW_BAR); bar.x = 0; bar.st = nullptr;
    if (args.use_bar) bar = xcd_barrier_post((unsigned*)(F.ctl + CW_BAR), F.MISC + 8);
    const int lo = args.ph_lo, hi = args.ph_hi;
#define RUN(k) (lo <= (k) && (k) < hi)
#define FRESH() do { int t_ = threadIdx.x; asm volatile("" : "+v"(t_)); F.tid = t_; F.lane = t_ & 63; F.wave = __builtin_amdgcn_readfirstlane(t_ >> 6); } while (0)
#define SEAM(k) do { if (args.use_bar && (k) + 1 < hi) xcd_barrier(bar); } while (0)
    LAS unsigned char* ring = F.lds;
    const float* xin_p = (const float*)args.in[0]; const float* xin_s = (const float*)args.in[1] - (size_t)MP * DM;
    float* X = WS_PTR(float, WS_X); bf16* H = WS_PTR(bf16, WS_H); bf16* ACT = WS_PTR(bf16, WS_ACT); bf16* Z = WS_PTR(bf16, WS_Z); bf16* OP = WS_PTR(bf16, WS_OP); float* MOD = WS_PTR(float, WS_MOD);
    const float* norm_g = (const float*)args.in[12];

    if (EN(0) && RUN(0)) { FRESH(); p0_prologue(F, args); SEAM(0); }
    if (EN(1) && RUN(1)) { pg8::Gemm g{WS_PTR(bf16, WS_SC), WS_PTR(bf16, WS_ADAT), 256, MODLD, DM}; pg8::StaticOrder S; S.init(256, MODLD, F.G, F.bx);
        pg8::EpiMod E{MOD, (const float*)args.in[11]};
        pg8::gemm_phase<pg8::EpiMod, pg8::StaticOrder, true, true>(ring, g, S, E); SEAM(1); }
    for (int i = 0; i < 4; ++i) {
        const int pb = 2 + 10 * i, l = i >> 1, f = i & 1;
        const float* src_p = (i == 0) ? xin_p : X; const float* src_s = (i == 0) ? xin_s : X;
        const float* modl = MOD + l * 9216;
        if (EN(2) && RUN(pb + 0)) { FRESH(); nm_phase(F, src_p, src_s, norm_g + (l * 3 + (f ? 2 : 0)) * DM, modl + (f ? 6 : 0) * DM, H); SEAM(pb + 0); }
        if (EN(3) && RUN(pb + 1)) { pg8::Gemm g{H, WS_PTR(bf16, WS_W13T + (size_t)i * W13T_STRIDE), MT, 2 * FF, DM}; pg8::StaticOrder S; S.init(MT, 2 * FF, F.G, F.bx);
            pg8::EpiSwiglu E{ACT, FF};
            pg8::gemm_phase<pg8::EpiSwiglu, pg8::StaticOrder, true, true>(ring, g, S, E); SEAM(pb + 1); }
        if (EN(4) && RUN(pb + 2)) { pg8::Gemm g{ACT, WS_PTR(bf16, WS_W2T + (size_t)i * W2T_STRIDE), MT, DM, FF}; pg8::StaticOrder S; S.init(MT, DM, F.G, F.bx);
            pg8::EpiRes E{src_p, src_s, X, modl + (f ? 8 : 2) * DM, 0.5f};
            pg8::gemm_phase<pg8::EpiRes, pg8::StaticOrder, true, true>(ring, g, S, E); SEAM(pb + 2); }
        if (f == 0) {
            if (EN(5) && RUN(pb + 3)) { FRESH(); nm_phase(F, X, X, norm_g + (l * 3 + 1) * DM, modl + 3 * DM, H); SEAM(pb + 3); }
            if (EN(6) && RUN(pb + 4)) { const int NZ = l ? ZO : ZE; pg8::Gemm g{H, WS_PTR(bf16, l ? WS_ODIN : WS_EVIN), MT, NZ, DM}; pg8::StaticOrder S; S.init(MT, NZ, F.G, F.bx);
                pg8::EpiPlain E{Z, NZ};
                pg8::gemm_phase<pg8::EpiPlain, pg8::StaticOrder, true, true>(ring, g, S, E); SEAM(pb + 4); }
            if (RUN(pb + 5)) { FRESH(); if (l == 0) { if (EN(7)) even_mid_phase(F, args); } else { if (EN(8)) odd_thin_phase(F, args); } SEAM(pb + 5); }
            if (RUN(pb + 6)) { FRESH();
                if (l == 0) { if (EN(9)) gla_g2_phase(F); }
                else { if (EN(10)) { pg8::Gemm g{WS_PTR(bf16, WS_CQN), WS_PTR(bf16, WS_WUQ), MT, 768, args.k_q}; pg8::StaticOrder S; S.init(MT, 768, F.G, F.bx);
                         pg8::EpiQ E{WS_PTR(bf16, WS_Q), WS_PTR(float, WS_RT)};
                         pg8::gemm_phase<pg8::EpiQ, pg8::StaticOrder, true, true>(ring, g, S, E); }
                       __syncthreads();
                       if (EN(16)) { pg8::Gemm g{WS_PTR(bf16, WS_CKVB), WS_PTR(bf16, WS_WKV), MP, 1024, args.k_kv}; pg8::StaticOrder S; S.init(MP, 1024, F.G, F.bx);
                         pg8::EpiPlain E{WS_PTR(bf16, WS_KV), 1024};
                         pg8::gemm_phase<pg8::EpiPlain, pg8::StaticOrder, true, true>(ring, g, S, E); } }
                SEAM(pb + 6); }
            if (RUN(pb + 7)) { FRESH(); if (l == 0) { if (EN(11)) for (int u = F.bx; u < 1024; u += F.G) gla_g3_unit(F, args, u); } else { if (EN(12)) attn_phase(F, args); } SEAM(pb + 7); }
            if (RUN(pb + 8)) { FRESH(); if (l == 1) { if (EN(13)) for (int b = F.bx; b < 128; b += F.G) dcombine_unit(F, args, b); SEAM(pb + 8); } }
            if (EN(14) && RUN(pb + 9)) { pg8::Gemm g{OP, WS_PTR(bf16, l ? WS_ODOUT : WS_EVOUT), MT, DM, DM}; pg8::StaticOrder S; S.init(MT, DM, F.G, F.bx);
                pg8::EpiRes E{X, X, X, modl + 5 * DM, 1.0f};
                pg8::gemm_phase<pg8::EpiRes, pg8::StaticOrder, true, true>(ring, g, S, E); SEAM(pb + 9); }
        }
    }
    if (EN(15) && RUN(42)) { FRESH(); final_phase(F, X, (const float*)args.in[34], F.out + O_Y); }
#undef RUN
#undef SEAM
}

extern "C" void kernel_launch(void* const* d_in, const int* in_sizes, int n_in, void* d_out, int out_size, void* d_ws, size_t ws_size, hipStream_t stream) {
    static int grid = 0;
    if (grid == 0) {
        if (n_in != 35 || (size_t)out_size != O_END || ws_size < WS_END) { fprintf(stderr, "kernel_launch: unexpected shapes: n_in %d out %d ws %zu\n", n_in, out_size, ws_size); grid = -1; return; }
        int dev = 0, cus = 0, per_cu = 0;
        if (hipGetDevice(&dev) != hipSuccess || hipDeviceGetAttribute(&cus, hipDeviceAttributeMultiprocessorCount, dev) != hipSuccess) { grid = -1; return; }
        if (hipFuncSetAttribute((const void*)mk_fwd, hipFuncAttributeMaxDynamicSharedMemorySize, LDS_BYTES) != hipSuccess) { fprintf(stderr, "kernel_launch: hipFuncSetAttribute failed\n"); grid = -1; return; }
        if (hipOccupancyMaxActiveBlocksPerMultiprocessor(&per_cu, (const void*)mk_fwd, NWAVES * 64, LDS_BYTES) != hipSuccess || per_cu < 1) fprintf(stderr, "kernel_launch: occupancy query says %d\n", per_cu);
        (void)hipGetLastError();
        grid = cus;
    }
    if (grid < 0) return;
    if (hipMemsetAsync((char*)d_ws + WS_CTL, 0, CTL_ZERO_BYTES, stream) != hipSuccess) return;
    Args a{};
    for (int i = 0; i < 35; ++i) a.in[i] = d_in[i];
    a.out = (float*)d_out; a.ws = (unsigned char*)d_ws; a.k_q = 384; a.k_kv = 256; a.pad = 0;
#if MK_ONE_LAUNCH
    a.ph_lo = 0; a.ph_hi = N_PHASE_IDS; a.use_bar = 1;
    hipLaunchKernelGGL(mk_fwd, dim3(grid), dim3(NWAVES * 64), LDS_BYTES, stream, a);
#else
    for (int id = 0; id < N_PHASE_IDS; ++id) {
        if (id >= 2 && id < 42) { const int i = (id - 2) / 10, k = (id - 2) % 10; if (k >= 3 && (i & 1)) continue; if (k == 8 && i == 0) continue; }
        a.ph_lo = id; a.ph_hi = id + 1; a.use_bar = 0;
        hipLaunchKernelGGL(mk_fwd, dim3(grid), dim3(NWAVES * 64), LDS_BYTES, stream, a);
    }
#endif
}
```

```cpp
#include <hip/hip_runtime.h>
#include <cstdio>
#include <cstdint>
#define GAS __attribute__((address_space(1)))
#define LAS __attribute__((address_space(3)))
constexpr int DM = 1024, MP = 16384, MS = 512, MT = MP + MS, TP = 8192, NBAT = 130, FF = 2816;
constexpr int MODLD = 18432;
constexpr int ZE = 2304, ZO = 1792;
constexpr float QSCALE = 0.10206207261596577f * 1.4426950408889634f;
__device__ __forceinline__ int bidx(int row) { return row < MP ? (row >> 13) : 2 + ((row - MP) >> 2); }
__device__ __forceinline__ int posof(int row) { return row < MP ? (row & (TP - 1)) : TP + ((row - MP) & 3); }
__device__ __forceinline__ float bf2f(unsigned short b) { return __uint_as_float(((unsigned)b) << 16); }
__device__ __forceinline__ unsigned f2bf(float f) { unsigned u = __builtin_bit_cast(unsigned, f); return (u + 0x7fffu + ((u >> 16) & 1u)) >> 16; }
__device__ __forceinline__ unsigned pk2(float lo, float hi) { return f2bf(lo) | (f2bf(hi) << 16); }
__device__ __forceinline__ float sigmoidf_(float x) { return 1.0f / (1.0f + __expf(-x)); }
__device__ __forceinline__ float siluf_(float x) { return x / (1.0f + __expf(-x)); }
namespace pg8 {
#define PG8_LAS __attribute__((address_space(3)))
typedef unsigned short bf16_t;
typedef short bf16x8 __attribute__((ext_vector_type(8)));
typedef float f32x4 __attribute__((ext_vector_type(4)));
typedef unsigned u32x4 __attribute__((ext_vector_type(4)));
constexpr int BM = 256, BK = 64, HALF = 128, HTB = HALF * BK * 2  , STAGE_BYTES = 8 * HTB, NXCD = 8, WGM = 8;

__host__ __device__ __forceinline__ int lds_byte(int r, int c) { const int st = (r >> 4) * 2 + (c >> 5), rr = r & 15, cc = c & 31, ob = rr * 64 + cc * 2; return st * 1024 + (ob ^ (((ob >> 9) & 1) << 5)); }
__host__ __device__ __forceinline__ void stage_rc(int b, int& R, int& C) { const int st = b / 1024, sb = b % 1024, swz = sb ^ (((sb >> 9) & 1) << 5); R = (st >> 1) * 16 + swz / 64; C = (st & 1) * 32 + (swz % 64) / 2; }
__host__ __device__ __forceinline__ int perm32(int rho) { const int n = rho >> 4, i = rho & 15; return 8 * (i >> 2) + 4 * n + (i & 3); }

struct Unit { int pm, pn, koff; };
struct Gemm { const bf16_t* A; const bf16_t* Bt; int M, N, K, lda, ldb; };

struct StaticOrder {
    int nM, nN, nwg, G, c;
    __host__ __device__ void init(int M, int N, int G_, int c_) { nM = M / BM; nN = N / BM; nwg = nM * nN; G = G_; c = c_; }
    __host__ __device__ bool next(int i, Unit& u) const {
        const long L = (long)i * G + c; if (L >= nwg) return false;
        int wgid = (int)L; { const int q = nwg / NXCD, r = nwg % NXCD, xcd = wgid % NXCD, off = wgid / NXCD; wgid = (xcd < r ? xcd * (q + 1) : r * (q + 1) + (xcd - r) * q) + off; }
        const int nig = WGM * nN, gid = wgid / nig, fm = gid * WGM, gsz = (nM - fm) < WGM ? (nM - fm) : WGM;
        u.pm = fm + ((wgid % nig) % gsz); u.pn = (wgid % nig) / gsz; u.koff = 0; return true;
    }
    __device__ __forceinline__ void a_ready(const Unit&) const {}
    __device__ __forceinline__ void done(const Unit&) const {}
};
struct SplitKOrder {
    int pm0, nP, nN, nch, kc, G, c;
    __device__ bool next(int i, Unit& u) const { const int j = i * G + c; if (j >= nP * nN * nch) return false; const int ch = j % nch, t = j / nch; u.pn = t % nN; u.pm = pm0 + t / nN; u.koff = ch * kc; return true; }
    __device__ __forceinline__ void a_ready(const Unit&) const {}
    __device__ __forceinline__ void done(const Unit&) const {}
};

__device__ __forceinline__ unsigned cvt_pk_bf16(float lo, float hi) { unsigned r; asm volatile("v_cvt_pk_bf16_f32 %0, %1, %2" : "=v"(r) : "v"(lo), "v"(hi)); return r; }

struct EpiPlain {
    static constexpr bool PERM = true, AFTER_DRAIN = false;
    bf16_t* O; int ldc;
    __device__ __forceinline__ void operator()(const f32x4 (&acc)[2][2][4][2], const Unit& u, int wr, int wc, int fr, int fq) const {
        const int row0 = u.pm * BM + wr * 64 + fr, col0 = u.pn * BM + wc * 32 + 8 * fq;
#pragma unroll
        for (int ai = 0; ai < 2; ++ai)
#pragma unroll
            for (int m = 0; m < 4; ++m) { bf16_t* rowp = O + (size_t)(row0 + ai * HALF + m * 16) * ldc + col0;
#pragma unroll
                for (int bj = 0; bj < 2; ++bj) { const f32x4 v0 = acc[ai][bj][m][0], v1 = acc[ai][bj][m][1];
                    u32x4 w; w.x = cvt_pk_bf16(v0[0], v0[1]); w.y = cvt_pk_bf16(v0[2], v0[3]); w.z = cvt_pk_bf16(v1[0], v1[1]); w.w = cvt_pk_bf16(v1[2], v1[3]);
                    *(u32x4*)(rowp + bj * HALF) = w; } }
    }
};
struct EpiSwiglu {
    static constexpr bool PERM = true, AFTER_DRAIN = false;
    bf16_t* O; int ldc;
    __device__ __forceinline__ void operator()(const f32x4 (&acc)[2][2][4][2], const Unit& u, int wr, int wc, int fr, int fq) const {
        const int row0 = u.pm * BM + wr * 64 + fr, col0 = u.pn * HALF + wc * 32 + 8 * fq;
#pragma unroll
        for (int ai = 0; ai < 2; ++ai)
#pragma unroll
            for (int m = 0; m < 4; ++m) { bf16_t* rowp = O + (size_t)(row0 + ai * HALF + m * 16) * ldc + col0;
                float o[8];
#pragma unroll
                for (int n = 0; n < 2; ++n)
#pragma unroll
                    for (int e = 0; e < 4; ++e) { const float g = acc[ai][0][m][n][e], uu = acc[ai][1][m][n][e]; o[n * 4 + e] = siluf_(g) * uu; }
                u32x4 w; w.x = cvt_pk_bf16(o[0], o[1]); w.y = cvt_pk_bf16(o[2], o[3]); w.z = cvt_pk_bf16(o[4], o[5]); w.w = cvt_pk_bf16(o[6], o[7]);
                *(u32x4*)rowp = w; }
    }
};
struct EpiRes {
    static constexpr bool PERM = false, AFTER_DRAIN = false;
    const float* bp; const float* bs; float* out; const float* gate; float coef;
    __device__ __forceinline__ void operator()(const f32x4 (&acc)[2][2][4][2], const Unit& u, int wr, int wc, int fr, int fq) const {
#pragma unroll
        for (int ai = 0; ai < 2; ++ai)
#pragma unroll
            for (int m = 0; m < 4; ++m) { const int row = u.pm * BM + ai * HALF + wr * 64 + m * 16 + fr; const int b = bidx(row);
                const float* base = (row < MP ? bp : bs) + (size_t)row * DM; const float* gr = gate + (size_t)b * MODLD; float* orow = out + (size_t)row * DM;
#pragma unroll
                for (int bj = 0; bj < 2; ++bj)
#pragma unroll
                    for (int n = 0; n < 2; ++n) { const int col = u.pn * BM + bj * HALF + wc * 32 + n * 16 + 4 * fq;
                        const f32x4 xin = *(const f32x4*)(base + col), g = *(const f32x4*)(gr + col);
                        *(f32x4*)(orow + col) = xin + (g * coef) * acc[ai][bj][m][n]; } }
    }
};
struct EpiPartial {
    static constexpr bool PERM = false, AFTER_DRAIN = false;
    float* slab;
    __device__ __forceinline__ void operator()(const f32x4 (&acc)[2][2][4][2], const Unit& u, int wr, int wc, int fr, int fq) const {
        float* sb = slab + (size_t)(u.koff >> 8) * (MS * DM);
#pragma unroll
        for (int ai = 0; ai < 2; ++ai)
#pragma unroll
            for (int m = 0; m < 4; ++m) { const int row = u.pm * BM + ai * HALF + wr * 64 + m * 16 + fr - MP; float* orow = sb + (size_t)row * DM;
#pragma unroll
                for (int bj = 0; bj < 2; ++bj)
#pragma unroll
                    for (int n = 0; n < 2; ++n) { const int col = u.pn * BM + bj * HALF + wc * 32 + n * 16 + 4 * fq; *(f32x4*)(orow + col) = acc[ai][bj][m][n]; } }
    }
};
struct EpiMod {
    static constexpr bool PERM = false, AFTER_DRAIN = false;
    float* out; const float* bias;
    __device__ __forceinline__ void operator()(const f32x4 (&acc)[2][2][4][2], const Unit& u, int wr, int wc, int fr, int fq) const {
#pragma unroll
        for (int ai = 0; ai < 2; ++ai)
#pragma unroll
            for (int m = 0; m < 4; ++m) { const int row = u.pm * BM + ai * HALF + wr * 64 + m * 16 + fr; float* orow = out + (size_t)row * MODLD;
#pragma unroll
                for (int bj = 0; bj < 2; ++bj)
#pragma unroll
                    for (int n = 0; n < 2; ++n) { const int col = u.pn * BM + bj * HALF + wc * 32 + n * 16 + 4 * fq;
                        *(f32x4*)(orow + col) = acc[ai][bj][m][n] + *(const f32x4*)(bias + col); } }
    }
};
struct EpiQ {
    static constexpr bool PERM = false, AFTER_DRAIN = false;
    bf16_t* O; const float* rt;
    __device__ __forceinline__ void operator()(const f32x4 (&acc)[2][2][4][2], const Unit& u, int wr, int wc, int fr, int fq) const {
        typedef unsigned u32x2 __attribute__((ext_vector_type(2)));
#pragma unroll
        for (int ai = 0; ai < 2; ++ai)
#pragma unroll
            for (int m = 0; m < 4; ++m) { const int row = u.pm * BM + ai * HALF + wr * 64 + m * 16 + fr; const int pos = posof(row);
                const float* rtp = rt + (size_t)pos * 32 + 8 * fq;
#pragma unroll
                for (int bj = 0; bj < 2; ++bj) { const int gc0 = u.pn * BM + bj * HALF + wc * 32; const bool isrope = (gc0 % 96) == 64;
                    f32x4 v0 = acc[ai][bj][m][0] * QSCALE, v1 = acc[ai][bj][m][1] * QSCALE;
                    if (isrope) { const f32x4 cs0 = *(const f32x4*)(rtp), cs1 = *(const f32x4*)(rtp + 4);
                        const float c[4] = {cs0[0], cs0[2], cs1[0], cs1[2]}, s[4] = {cs0[1], cs0[3], cs1[1], cs1[3]};
                        f32x4 a, b;
#pragma unroll
                        for (int e = 0; e < 4; ++e) { a[e] = v0[e] * c[e] - v1[e] * s[e]; b[e] = v1[e] * c[e] + v0[e] * s[e]; }
                        v0 = a; v1 = b; }
                    bf16_t* p = O + (size_t)row * 768 + gc0 + 4 * fq;
                    u32x2 w0; w0.x = cvt_pk_bf16(v0[0], v0[1]); w0.y = cvt_pk_bf16(v0[2], v0[3]); *(u32x2*)p = w0;
                    u32x2 w1; w1.x = cvt_pk_bf16(v1[0], v1[1]); w1.y = cvt_pk_bf16(v1[2], v1[3]); *(u32x2*)(p + 16) = w1; }
                asm volatile("" ::: "memory"); }
    }
};

template <class Epi, class Sched, bool ALIGN_EPI = false, bool SP2 = false>
__device__ __forceinline__ void gemm_phase(PG8_LAS unsigned char* lds, const Gemm g, const Sched& S, const Epi& E) {
    int tid = threadIdx.x; asm volatile("" : "+v"(tid));
    const int wid = __builtin_amdgcn_readfirstlane(tid >> 6), lane = tid & 63, wr = wid >> 2, wc = wid & 3, fr = lane & 15, fq = lane >> 4;
    const int K = g.K, nt = K / BK;
    unsigned voffA[2], voffB[2];
#pragma unroll
    for (int i = 0; i < 2; ++i) { int R, C; stage_rc(tid * 16 + i * 8192, R, C); const int Rb = Epi::PERM ? ((R & ~31) + perm32(R & 31)) : R;
        voffA[i] = (unsigned)(R * g.lda + C) * 2u; voffB[i] = (unsigned)(Rb * g.ldb + C) * 2u; }
    const size_t kstep = (size_t)(BK * 2);
    const int lda = g.lda, ldb = g.ldb;
    const size_t hstepA = (size_t)HALF * lda * 2, hstepB = (size_t)HALF * ldb * 2;
    const size_t tstepA = 2 * hstepA, tstepB = 2 * hstepB;
    const unsigned ldsw = (unsigned)wid * 1024u;
    const int aoff = lds_byte(wr * 64 + fr, fq * 8), boff = lds_byte(wc * 32 + fr, fq * 8);
#define PG8_SA(b, h) (((b) * 2 + (h)) * HTB)
#define PG8_SB(b, h) ((4 + (b) * 2 + (h)) * HTB)
#define PG8_STAGE(bufoff, gbase, voff) do { _Pragma("unroll") for (int _i = 0; _i < 2; ++_i) \
        __builtin_amdgcn_global_load_lds((const unsigned*)((const char*)(gbase) + (voff)[_i]), (PG8_LAS unsigned*)(lds + (bufoff) + ldsw + _i * 8192), 16, 0, 0); } while (0)
#define PG8_LDA(dst, b, h) do { _Pragma("unroll") for (int m = 0; m < 4; ++m) _Pragma("unroll") for (int k = 0; k < 2; ++k) dst[m][k] = *(const PG8_LAS bf16x8*)(lds + PG8_SA(b, h) + aoff + m * 2048 + k * 1024); } while (0)
#define PG8_LDB(dst, b, h) do { _Pragma("unroll") for (int n = 0; n < 2; ++n) _Pragma("unroll") for (int k = 0; k < 2; ++k) dst[n][k] = *(const PG8_LAS bf16x8*)(lds + PG8_SB(b, h) + boff + n * 2048 + k * 1024); } while (0)
#define PG8_MMA(ai, bj, At, Bt) do { __builtin_amdgcn_s_setprio(1); _Pragma("unroll") for (int m = 0; m < 4; ++m) _Pragma("unroll") for (int n = 0; n < 2; ++n) _Pragma("unroll") for (int k = 0; k < 2; ++k) \
        acc[ai][bj][m][n] = __builtin_amdgcn_mfma_f32_16x16x32_bf16(Bt[n][k], At[m][k], acc[ai][bj][m][n], 0, 0, 0); __builtin_amdgcn_s_setprio(0); } while (0)
#define PG8_WAIT_V(n) asm volatile("s_waitcnt vmcnt(" #n ")" ::: "memory")
#define PG8_WAIT_L(n) asm volatile("s_waitcnt lgkmcnt(" #n ")" ::: "memory")
#define PG8_BAR __builtin_amdgcn_s_barrier()
#define PG8_SCHED __builtin_amdgcn_sched_barrier(0)
    Unit cur, nxt; int ui = 0;
    if (!S.next(0, cur)) return;
    f32x4 acc[2][2][4][2];
#pragma unroll
    for (int a = 0; a < 2; ++a)
#pragma unroll
        for (int b = 0; b < 2; ++b)
#pragma unroll
            for (int m = 0; m < 4; ++m)
#pragma unroll
                for (int n = 0; n < 2; ++n) acc[a][b][m][n] = (f32x4){0.f, 0.f, 0.f, 0.f};
    bf16x8 At[4][2], B0[2][2], B1[2][2];
    const char* cA = (const char*)g.A + (size_t)cur.pm * tstepA + (size_t)cur.koff * 2; const char* cB = (const char*)g.Bt + (size_t)cur.pn * tstepB + (size_t)cur.koff * 2;
    S.a_ready(cur);
    if constexpr (SP2) {
        PG8_STAGE(PG8_SB(0, 0), cB, voffB); PG8_STAGE(PG8_SB(0, 1), cB + hstepB, voffB); PG8_STAGE(PG8_SA(0, 0), cA, voffA); PG8_STAGE(PG8_SA(0, 1), cA + hstepA, voffA);
        if (wr == 1) PG8_BAR;
        PG8_WAIT_V(2); PG8_BAR;
        PG8_STAGE(PG8_SB(1, 0), cB + kstep, voffB); PG8_STAGE(PG8_SA(1, 0), cA + kstep, voffA); PG8_STAGE(PG8_SB(1, 1), cB + hstepB + kstep, voffB);
        PG8_WAIT_V(6); PG8_BAR;
    } else {
        PG8_STAGE(PG8_SB(0, 0), cB, voffB); PG8_STAGE(PG8_SA(0, 0), cA, voffA); PG8_STAGE(PG8_SB(0, 1), cB + hstepB, voffB); PG8_STAGE(PG8_SA(0, 1), cA + hstepA, voffA);
        if (wr == 1) PG8_BAR;
        PG8_WAIT_V(4); PG8_BAR;
        PG8_STAGE(PG8_SB(1, 0), cB + kstep, voffB); PG8_STAGE(PG8_SA(1, 0), cA + kstep, voffA); PG8_STAGE(PG8_SB(1, 1), cB + hstepB + kstep, voffB);
        PG8_WAIT_V(6); PG8_BAR;
    }
    for (;;) {
        const bool has_next = S.next(ui + 1, nxt);
        const char* nA = has_next ? (const char*)g.A + (size_t)nxt.pm * tstepA + (size_t)nxt.koff * 2 : cA; const char* nB = has_next ? (const char*)g.Bt + (size_t)nxt.pn * tstepB + (size_t)nxt.koff * 2 : cB;
        for (int t = 0; t < nt; t += 2) {
            const bool last = (t == nt - 2);
            const char* a1 = cA + (size_t)(t + 1) * kstep;
            const char* a2 = last ? nA : cA + (size_t)(t + 2) * kstep; const char* b2 = last ? nB : cB + (size_t)(t + 2) * kstep;
            const char* a3 = a2 + kstep; const char* b3 = b2 + kstep;
            if (last && has_next) S.a_ready(nxt);
            if constexpr (SP2) {
            PG8_LDB(B0, 0, 0); PG8_LDB(B1, 0, 1); PG8_SCHED; PG8_LDA(At, 0, 0); PG8_STAGE(PG8_SA(1, 1), a1 + hstepA, voffA);
            PG8_WAIT_V(8); PG8_WAIT_L(0); PG8_BAR; PG8_MMA(0, 0, At, B0); PG8_MMA(0, 1, At, B1); PG8_BAR; PG8_SCHED;
            PG8_LDA(At, 0, 1); PG8_STAGE(PG8_SB(0, 0), b2, voffB); PG8_STAGE(PG8_SB(0, 1), b2 + hstepB, voffB); PG8_STAGE(PG8_SA(0, 0), a2, voffA);
            PG8_WAIT_V(8); PG8_WAIT_L(0); PG8_BAR; PG8_MMA(1, 0, At, B0); PG8_MMA(1, 1, At, B1); PG8_BAR; PG8_SCHED;
            PG8_LDB(B0, 1, 0); PG8_LDB(B1, 1, 1); PG8_SCHED; PG8_LDA(At, 1, 0); PG8_STAGE(PG8_SA(0, 1), a2 + hstepA, voffA);
            PG8_WAIT_V(8); PG8_WAIT_L(0); PG8_BAR; PG8_MMA(0, 0, At, B0); PG8_MMA(0, 1, At, B1); PG8_BAR; PG8_SCHED;
            PG8_LDA(At, 1, 1); PG8_STAGE(PG8_SB(1, 0), b3, voffB); PG8_STAGE(PG8_SB(1, 1), b3 + hstepB, voffB); PG8_STAGE(PG8_SA(1, 0), a3, voffA);
            PG8_WAIT_V(8); PG8_WAIT_L(0); PG8_BAR; PG8_MMA(1, 0, At, B0); PG8_MMA(1, 1, At, B1); PG8_BAR; PG8_SCHED;
            } else {
            PG8_LDB(B0, 0, 0); PG8_SCHED; PG8_LDA(At, 0, 0); PG8_STAGE(PG8_SA(1, 1), a1 + hstepA, voffA);
            PG8_WAIT_L(8); PG8_BAR; PG8_WAIT_L(0); PG8_MMA(0, 0, At, B0); PG8_BAR; PG8_SCHED;
            PG8_LDB(B1, 0, 1); PG8_STAGE(PG8_SB(0, 0), b2, voffB);
            PG8_BAR; PG8_WAIT_L(0); PG8_MMA(0, 1, At, B1); PG8_BAR;
            PG8_LDA(At, 0, 1); PG8_STAGE(PG8_SA(0, 0), a2, voffA);
            PG8_BAR; PG8_WAIT_L(0); PG8_MMA(1, 0, At, B0); PG8_BAR; PG8_SCHED;
            PG8_STAGE(PG8_SB(0, 1), b2 + hstepB, voffB);
            PG8_WAIT_V(6); PG8_BAR; PG8_MMA(1, 1, At, B1); PG8_BAR;
            PG8_LDB(B0, 1, 0); PG8_SCHED; PG8_LDA(At, 1, 0); PG8_STAGE(PG8_SA(0, 1), a2 + hstepA, voffA);
            PG8_WAIT_L(8); PG8_BAR; PG8_WAIT_L(0); PG8_MMA(0, 0, At, B0); PG8_BAR; PG8_SCHED;
            PG8_LDB(B1, 1, 1); PG8_STAGE(PG8_SB(1, 0), b3, voffB);
            PG8_BAR; PG8_WAIT_L(0); PG8_MMA(0, 1, At, B1); PG8_BAR;
            PG8_LDA(At, 1, 1); PG8_STAGE(PG8_SA(1, 0), a3, voffA);
            PG8_BAR; PG8_WAIT_L(0); PG8_MMA(1, 0, At, B0); PG8_BAR; PG8_SCHED;
            PG8_STAGE(PG8_SB(1, 1), b3 + hstepB, voffB);
            PG8_WAIT_V(6); PG8_BAR; PG8_MMA(1, 1, At, B1); PG8_BAR;
            }
        }
        if constexpr (ALIGN_EPI) { if (wr == 0) PG8_BAR; }
        if constexpr (!Epi::AFTER_DRAIN) { E(acc, cur, wr, wc, fr, fq); S.done(cur); }
        if (!has_next) break;
#pragma unroll
        for (int a = 0; a < 2; ++a)
#pragma unroll
            for (int b = 0; b < 2; ++b)
#pragma unroll
                for (int m = 0; m < 4; ++m)
#pragma unroll
                    for (int n = 0; n < 2; ++n) acc[a][b][m][n] = (f32x4){0.f, 0.f, 0.f, 0.f};
        cur = nxt; cA = nA; cB = nB; ++ui;
        if constexpr (ALIGN_EPI) { if (wr == 1) PG8_BAR; }
    }
    PG8_WAIT_V(0);
    if constexpr (!ALIGN_EPI) { if (wr == 0) PG8_BAR; }
    PG8_BAR;
    if constexpr (Epi::AFTER_DRAIN) { E.fused(acc, cur, wr, wc, fr, fq, lds, wid, lane); S.done(cur); }
#undef PG8_SA
#undef PG8_SB
#undef PG8_STAGE
#undef PG8_LDA
#undef PG8_LDB
#undef PG8_MMA
#undef PG8_WAIT_V
#undef PG8_WAIT_L
#undef PG8_BAR
#undef PG8_SCHED
}
}
constexpr size_t MiB = 1u << 20;
constexpr size_t WS_CTL = 0, CTL_ZERO_BYTES = 1 * MiB;
constexpr size_t WS_W13T = 2 * MiB, W13T_STRIDE = 11 * MiB;
constexpr size_t WS_W2T = 46 * MiB, W2T_STRIDE = 5767168;
constexpr size_t WS_EVIN = 68 * MiB, WS_EVOUT = 73 * MiB, WS_ODIN = 75 * MiB, WS_ODOUT = 79 * MiB, WS_WUQ = 81 * MiB, WS_WKV = 82 * MiB;
constexpr size_t WS_ADAT = 83 * MiB, WS_SC = 119 * MiB, WS_RT = 120 * MiB, WS_MOD = 122 * MiB;
constexpr size_t WS_X = 140 * MiB, WS_H = 206 * MiB, WS_ACT = 239 * MiB, WS_Z = 330 * MiB, WS_OP = 405 * MiB;
constexpr size_t WS_US = 438 * MiB, WS_DS = 470 * MiB, WS_CQN = 471 * MiB, WS_CKVB = 484 * MiB, WS_KRB = 493 * MiB, WS_Q = 495 * MiB, WS_KV = 520 * MiB;
constexpr size_t WS_PART = 552 * MiB, WS_QD = 586 * MiB, WS_SLAB = 592 * MiB, WS_DUMMY = 616 * MiB, WS_END = 682 * MiB;
constexpr int NSPLIT = 8, PART_F = 32 * 256 + 64;
constexpr size_t O_Y = 0, O_GLAP = 17301504, O_GLAS = O_GLAP + 65536, O_POOLP = O_GLAS + 4194304, O_POOLS = O_POOLP + 15360, O_CKV = O_POOLS + 983040,
                 O_KR = O_CKV + 4325376, O_CONVP = O_KR + 540672, O_CONVS = O_CONVP + 30720, O_END = O_CONVS + 1966080;
constexpr int CW_TMO = 0, CW_CODE = 1, CW_BAR = 4096;
constexpr int RING_BYTES = 131072, LDSCTL_OFF = RING_BYTES, MISC_OFF = LDSCTL_OFF + 320, LDS_BYTES = 147456;
constexpr int NWAVES = 8;

typedef unsigned short bf16;
typedef unsigned v4u __attribute__((ext_vector_type(4)));
typedef unsigned v2u __attribute__((ext_vector_type(2)));
typedef float f32x4 __attribute__((ext_vector_type(4)));
typedef float f32x2 __attribute__((ext_vector_type(2)));
typedef float f32x16 __attribute__((ext_vector_type(16)));
typedef short bf16x8 __attribute__((ext_vector_type(8)));
typedef short s16x4 __attribute__((ext_vector_type(4)));
typedef GAS unsigned gu32;
#define RLX_AGENT __ATOMIC_RELAXED, __HIP_MEMORY_SCOPE_AGENT
#define LDS_WAIT() asm volatile("s_waitcnt lgkmcnt(0)" ::: "memory")
#define VM_WAIT() asm volatile("s_waitcnt vmcnt(0)" ::: "memory")

#define XB_TMO      128
#define XB_XCNT(j)  (256  + 64 * (j))
#define XB_XSUB(j)  (1280 + 64 * (j))
#define XB_XGEN(j)  (2304 + 64 * (j))
#define XB_TOP      3328
#define XB_TOPGEN   3392
#define XCD_BAR_WORDS 3456
#define XB_SPIN_CAP (1u << 18)

__device__ __forceinline__ unsigned xb_ld(unsigned* p)              { return __hip_atomic_load(p, __ATOMIC_RELAXED, __HIP_MEMORY_SCOPE_AGENT); }
__device__ __forceinline__ unsigned xb_add(unsigned* p, unsigned v) { return __hip_atomic_fetch_add(p, v, __ATOMIC_RELAXED, __HIP_MEMORY_SCOPE_AGENT); }
__device__ __forceinline__ unsigned xb_xcc_id() { return (unsigned)__builtin_amdgcn_s_getreg((3 << 11) | 20) & 0xFu; }
#define XB_SPIN(cond, bar) do { unsigned _sp = 0; while (cond) { __builtin_amdgcn_s_sleep(1); \
    if ((++_sp & 255u) == 0u) { if (xb_ld(&(bar)[XB_TMO])) break; if (_sp > XB_SPIN_CAP) { atomicAdd(&(bar)[XB_TMO], 1u); break; } } } } while (0)

struct XcdBarrier {
    unsigned* bar; unsigned x;
    volatile LAS unsigned* st;
};

__device__ __forceinline__ XcdBarrier xcd_barrier_post(unsigned* bar, volatile LAS unsigned* st) {
    XcdBarrier b; b.bar = bar; b.x = xb_xcc_id(); b.st = st;
    if (threadIdx.x == 0) (void)xb_add(&bar[XB_XCNT(b.x)], 1u);
    return b;
}
__device__ __forceinline__ void xcd_barrier_complete(unsigned* bar, unsigned x, unsigned& nloc, unsigned& nx) {
    const unsigned G = gridDim.x * gridDim.y * gridDim.z;
    unsigned sum, cnt, mine, sp = 0u;
    for (;;) {
        sum = 0u; cnt = 0u; mine = 0u;
#pragma unroll
        for (unsigned j = 0; j < 16; ++j) { const unsigned c = xb_ld(&bar[XB_XCNT(j)]); sum += c; cnt += (c > 0u) ? 1u : 0u; mine = (j == x) ? c : mine; }
        if (sum == G) break;
        __builtin_amdgcn_s_sleep(1);
        if ((++sp & 255u) == 0u) { if (xb_ld(&bar[XB_TMO])) break; if (sp > XB_SPIN_CAP) { atomicAdd(&bar[XB_TMO], 1u); break; } }
    }
    nloc = mine > 0u ? mine : 1u; nx = cnt > 0u ? cnt : 1u;
}

__device__ __forceinline__ void xcd_barrier(const XcdBarrier& b) {
    asm volatile("s_waitcnt vmcnt(0)" ::: "memory");
    __syncthreads();
    if (threadIdx.x == 0) {
        unsigned* bar = b.bar;
        __builtin_amdgcn_s_waitcnt(0);
        unsigned nloc = b.st[0], nx = b.st[1];
        if (nloc == 0u) { xcd_barrier_complete(bar, b.x, nloc, nx); b.st[0] = nloc; b.st[1] = nx; }
        const unsigned old = xb_add(&bar[XB_XSUB(b.x)], 1u);
        const unsigned gen = old / nloc;
        if (old + 1u == (gen + 1u) * nloc) {
            __builtin_amdgcn_fence(__ATOMIC_RELEASE, "agent");
            asm volatile("s_waitcnt vmcnt(0)" ::: "memory");
            const unsigned og = xb_add(&bar[XB_TOP], 1u);
            const unsigned tg = og / nx;
            if (og + 1u == (tg + 1u) * nx) xb_add(&bar[XB_TOPGEN], 1u);
            else XB_SPIN(xb_ld(&bar[XB_TOPGEN]) == tg, bar);
            __builtin_amdgcn_fence(__ATOMIC_ACQUIRE, "agent");
            xb_add(&bar[XB_XGEN(b.x)], 1u);
            asm volatile("s_waitcnt vmcnt(0)" ::: "memory");
        } else {
            XB_SPIN(xb_ld(&bar[XB_XGEN(b.x)]) == gen, bar);
            __builtin_amdgcn_fence(__ATOMIC_ACQUIRE, "agent");
            asm volatile("s_waitcnt vmcnt(0)" ::: "memory");
        }
    }
    __syncthreads();
}
struct Args { const void* in[35]; float* out; unsigned char* ws; int ph_lo, ph_hi, use_bar, k_q, k_kv, pad; };
struct Frame {
    LAS unsigned char* lds;
    volatile LAS unsigned* MISC;
    gu32* ctl;
    int tid, lane, wave, G, bx;
    unsigned char* ws; float* out;
};
__device__ __forceinline__ float wave_sum(float v) {
#pragma unroll
    for (int o = 1; o < 64; o <<= 1) v += __shfl_xor(v, o);
    return v;
}
__device__ __forceinline__ float half_sum(float v) {
#pragma unroll
    for (int o = 1; o < 32; o <<= 1) v += __shfl_xor(v, o);
    return v;
}
#define WS_PTR(T, off) ((T*)(F.ws + (off)))

enum { RM_ID = 0, RM_W1 = 1, RM_W3 = 2, RM_EVIN = 3 };
__device__ __forceinline__ int map_row(int mode, int n) {
    if (mode == RM_W1) return 256 * (n >> 7) + (n & 127);
    if (mode == RM_W3) return 256 * (n >> 7) + 128 + (n & 127);
    if (mode == RM_EVIN) return n < 1536 ? n : (n < 1552 ? 2048 + (n - 1536) : 1536 + (n - 1552));
    return n;
}
__device__ __forceinline__ void p0_transpose_item(const float* W, int N, bf16* WT, int ldk, int mode, LAS float* scr, int item, int lane) {
    const int nblk = (N + 31) / 32, kb = item / nblk, nb = item % nblk, k0 = 64 * kb, n0 = 32 * nb;
    const bool okc = (n0 + (lane & 31)) < N;
    float tv[32];
#pragma unroll
    for (int i = 0; i < 32; ++i) { const int kk = 2 * i + (lane >> 5); tv[i] = okc ? __builtin_nontemporal_load(W + (size_t)(k0 + kk) * N + n0 + (lane & 31)) : 0.f; }
#pragma unroll
    for (int i = 0; i < 32; ++i) { const int kk = 2 * i + (lane >> 5); scr[kk * 33 + (lane & 31)] = tv[i]; }
    LDS_WAIT(); asm volatile("" ::: "memory");
    const int c = lane & 7;
#pragma unroll
    for (int j = 0; j < 4; ++j) { const int n = (lane >> 3) + 8 * j; const LAS float* s = scr + (8 * c) * 33 + n;
        v4u o; o.x = pk2(s[0 * 33], s[1 * 33]); o.y = pk2(s[2 * 33], s[3 * 33]); o.z = pk2(s[4 * 33], s[5 * 33]); o.w = pk2(s[6 * 33], s[7 * 33]);
        if (n0 + n < N) *(GAS v4u*)(WT + (size_t)map_row(mode, n0 + n) * ldk + k0 + 8 * c) = o; }
    LDS_WAIT(); asm volatile("" ::: "memory");
}
__device__ __forceinline__ void p0_prologue(Frame& F, const Args& A) {
    LAS float* scr = (LAS float*)(F.lds + F.wave * 16384);
    const int gw = F.bx * NWAVES + F.wave, NGW = F.G * NWAVES;
    const float* ffn_w1 = (const float*)A.in[13]; const float* ffn_w3 = (const float*)A.in[14]; const float* ffn_w2 = (const float*)A.in[15];
    const float* ev_w_in = (const float*)A.in[16]; const float* ev_w_out = (const float*)A.in[22]; const float* od_w_in = (const float*)A.in[23]; const float* od_w_out = (const float*)A.in[33];
    const float* w_uq = (const float*)A.in[25]; const float* w_uk = (const float*)A.in[27]; const float* w_uv = (const float*)A.in[28]; const float* ada_w = (const float*)A.in[10];
    constexpr int I_W1 = 16 * 88, I_W2 = 44 * 32, I_FFN = 2 * I_W1 + I_W2;
    constexpr int I_EVIN = 16 * 65, I_EVOUT = 8 * 32, I_ODIN = 16 * 53, I_ODOUT = 16 * 32, I_UQ = 6 * 24, I_UK = 4 * 16, I_ADA = 16 * 288;
    constexpr int NITEMS = 4 * I_FFN + I_EVIN + I_EVOUT + I_ODIN + I_ODOUT + I_UQ + 2 * I_UK + 2 * I_ADA;
    for (int it = gw; it < NITEMS; it += NGW) {
        int r = it;
        if (r < 4 * I_FFN) { const int i = r / I_FFN; r -= i * I_FFN;
            bf16* w13 = WS_PTR(bf16, WS_W13T + (size_t)i * W13T_STRIDE); bf16* w2 = WS_PTR(bf16, WS_W2T + (size_t)i * W2T_STRIDE);
            if (r < I_W1) { p0_transpose_item(ffn_w1 + (size_t)i * DM * FF, FF, w13, DM, RM_W1, scr, r, F.lane); continue; } r -= I_W1;
            if (r < I_W1) { p0_transpose_item(ffn_w3 + (size_t)i * DM * FF, FF, w13, DM, RM_W3, scr, r, F.lane); continue; } r -= I_W1;
            p0_transpose_item(ffn_w2 + (size_t)i * FF * DM, DM, w2, FF, RM_ID, scr, r, F.lane); continue; }
        r -= 4 * I_FFN;
        if (r < I_EVIN) { p0_transpose_item(ev_w_in, 2064, WS_PTR(bf16, WS_EVIN), DM, RM_EVIN, scr, r, F.lane); continue; } r -= I_EVIN;
        if (r < I_EVOUT) { p0_transpose_item(ev_w_out, DM, WS_PTR(bf16, WS_EVOUT), DM, RM_ID, scr, r, F.lane); continue; } r -= I_EVOUT;
        if (r < I_ODIN) { p0_transpose_item(od_w_in, 1696, WS_PTR(bf16, WS_ODIN), DM, RM_ID, scr, r, F.lane); continue; } r -= I_ODIN;
        if (r < I_ODOUT) { p0_transpose_item(od_w_out, DM, WS_PTR(bf16, WS_ODOUT), DM, RM_ID, scr, r, F.lane); continue; } r -= I_ODOUT;
        if (r < I_UQ) { p0_transpose_item(w_uq, 768, WS_PTR(bf16, WS_WUQ), 384, RM_ID, scr, r, F.lane); continue; } r -= I_UQ;
        if (r < I_UK) { p0_transpose_item(w_uk, 512, WS_PTR(bf16, WS_WKV), 256, RM_ID, scr, r, F.lane); continue; } r -= I_UK;
        if (r < I_UK) { p0_transpose_item(w_uv, 512, WS_PTR(bf16, WS_WKV) + 512 * 256, 256, RM_ID, scr, r, F.lane); continue; } r -= I_UK;
        { const int l = r / I_ADA; r -= l * I_ADA; p0_transpose_item(ada_w + (size_t)l * DM * 9216, 9216, WS_PTR(bf16, WS_ADAT) + (size_t)l * 9216 * DM, DM, RM_ID, scr, r, F.lane); }
    }
    { constexpr int NZ = (240 + 96) * (DM / 8);
      for (int i = F.bx * 512 + F.tid; i < NZ; i += F.G * 512) { const int rr = i / (DM / 8), c8 = i % (DM / 8);
          bf16* dst = rr < 240 ? WS_PTR(bf16, WS_EVIN) + (size_t)(2064 + rr) * DM : WS_PTR(bf16, WS_ODIN) + (size_t)(1696 + rr - 240) * DM;
          *(GAS v4u*)(dst + c8 * 8) = (v4u){0u, 0u, 0u, 0u}; } }
    { const float* pool_w = (const float*)A.in[20]; const float* pool_scale = (const float*)A.in[21]; bf16* evo = WS_PTR(bf16, WS_EVOUT);
      for (int it = gw; it < 512; it += NGW) { const int g = it >> 7, c = it & 127;
          f32x4 acc[4] = {{0.f, 0.f, 0.f, 0.f}, {0.f, 0.f, 0.f, 0.f}, {0.f, 0.f, 0.f, 0.f}, {0.f, 0.f, 0.f, 0.f}};
          for (int d = 0; d < 128; ++d) { const float a = pool_w[(size_t)(g * 128 + c) * 128 + d] * pool_scale[g * 128 + d];
              const float* wr = ev_w_out + (size_t)(512 + g * 128 + d) * DM + 4 * F.lane;
#pragma unroll
              for (int j = 0; j < 4; ++j) acc[j] += a * *(const f32x4*)(wr + 256 * j); }
#pragma unroll
          for (int j = 0; j < 4; ++j)
#pragma unroll
              for (int e = 0; e < 4; ++e) evo[(size_t)(256 * j + 4 * F.lane + e) * DM + 512 + g * 128 + c] = (bf16)f2bf(acc[j][e]); } }
    { const float* cp = (const float*)A.in[8]; const float* cs = (const float*)A.in[9]; bf16* sc = WS_PTR(bf16, WS_SC);
      for (int r = gw; r < 256; r += NGW) { const float* src = r < 2 ? cp + (size_t)r * DM : cs + (size_t)(r - 2) * DM;
#pragma unroll
          for (int j = 0; j < 4; ++j) { f32x4 v = {0.f, 0.f, 0.f, 0.f}; if (r < NBAT) v = *(const f32x4*)(src + 4 * F.lane + 256 * j);
              v2u o; o.x = r < NBAT ? pk2(siluf_(v[0]), siluf_(v[1])) : 0u; o.y = r < NBAT ? pk2(siluf_(v[2]), siluf_(v[3])) : 0u;
              *(GAS v2u*)(sc + (size_t)r * DM + 4 * F.lane + 256 * j) = o; } } }
    { const f32x4* xs = (const f32x4*)A.in[1]; f32x4* xd = (f32x4*)(WS_PTR(float, WS_X) + (size_t)MP * DM);
      for (int i = F.bx * 512 + F.tid; i < MS * DM / 4; i += F.G * 512) xd[i] = xs[i]; }
    { float* rt = WS_PTR(float, WS_RT);
      for (int i = F.bx * 512 + F.tid; i < 8196 * 16; i += F.G * 512) { const int pos = i >> 4, k = i & 15;
          const float freq = exp2f(-(float)k * 0.8304820237218406f);    const float ang = (float)pos * freq; float s, c; sincosf(ang, &s, &c);
          *(f32x2*)(rt + 2 * (size_t)i) = (f32x2){c, s}; } }
}

__device__ __forceinline__ void nm_phase(Frame& F, const float* bp, const float* bs, const float* g, const float* modsh, bf16* H, float* X, const float* slab, int nch, const float* pgate, float pcoef) {
    const int gw = F.bx * NWAVES + F.wave, NGW = F.G * NWAVES;
    f32x4 gv[4];
#pragma unroll
    for (int j = 0; j < 4; ++j) gv[j] = *(const f32x4*)(g + 4 * F.lane + 256 * j);
    for (int row = gw; row < MT; row += NGW) {
        const float* xr = (row < MP ? bp : bs) + (size_t)row * DM + 4 * F.lane;
        f32x4 v[4]; float ss = 0.f;
#pragma unroll
        for (int j = 0; j < 4; ++j) v[j] = *(const f32x4*)(xr + 256 * j);
        if (row >= MP && nch > 0) { f32x4 a[4] = {{0.f, 0.f, 0.f, 0.f}, {0.f, 0.f, 0.f, 0.f}, {0.f, 0.f, 0.f, 0.f}, {0.f, 0.f, 0.f, 0.f}};
            for (int k = 0; k < nch; ++k) { const float* sp = slab + ((size_t)k * MS + (row - MP)) * DM + 4 * F.lane;
#pragma unroll
                for (int j = 0; j < 4; ++j) a[j] += *(const f32x4*)(sp + 256 * j); }
            const float* gp = pgate + (size_t)bidx(row) * MODLD + 4 * F.lane;
#pragma unroll
            for (int j = 0; j < 4; ++j) { v[j] += (*(const f32x4*)(gp + 256 * j) * pcoef) * a[j]; *(f32x4*)(X + (size_t)row * DM + 4 * F.lane + 256 * j) = v[j]; } }
#pragma unroll
        for (int j = 0; j < 4; ++j) ss += (v[j][0] * v[j][0] + v[j][1] * v[j][1]) + (v[j][2] * v[j][2] + v[j][3] * v[j][3]);
        const float rstd = 1.0f / sqrtf(wave_sum(ss) * (1.0f / DM) + 1e-6f);
        const float* mrow = modsh + (size_t)bidx(row) * MODLD + 4 * F.lane;
#pragma unroll
        for (int j = 0; j < 4; ++j) { const f32x4 sh = *(const f32x4*)(mrow + 256 * j), sc = *(const f32x4*)(mrow + DM + 256 * j);
            const f32x4 h = (v[j] * rstd) * gv[j] * (sc + 1.0f) + sh;
            v2u o; o.x = pk2(h[0], h[1]); o.y = pk2(h[2], h[3]);
            *(GAS v2u*)(H + (size_t)row * DM + 4 * F.lane + 256 * j) = o; }
    }
}
__device__ __forceinline__ void final_phase(Frame& F, const float* X, const float* g, float* out, const float* slab, int nch, const float* pgate, float pcoef) {
    const int gw = F.bx * NWAVES + F.wave, NGW = F.G * NWAVES;
    f32x4 gv[4];
#pragma unroll
    for (int j = 0; j < 4; ++j) gv[j] = *(const f32x4*)(g + 4 * F.lane + 256 * j);
    for (int row = gw; row < MT; row += NGW) {
        const float* xr = X + (size_t)row * DM + 4 * F.lane;
        f32x4 v[4]; float ss = 0.f;
#pragma unroll
        for (int j = 0; j < 4; ++j) v[j] = *(const f32x4*)(xr + 256 * j);
        if (row >= MP) { f32x4 a[4] = {{0.f, 0.f, 0.f, 0.f}, {0.f, 0.f, 0.f, 0.f}, {0.f, 0.f, 0.f, 0.f}, {0.f, 0.f, 0.f, 0.f}};
            for (int k = 0; k < nch; ++k) { const float* sp = slab + ((size_t)k * MS + (row - MP)) * DM + 4 * F.lane;
#pragma unroll
                for (int j = 0; j < 4; ++j) a[j] += *(const f32x4*)(sp + 256 * j); }
            const float* gp = pgate + (size_t)bidx(row) * MODLD + 4 * F.lane;
#pragma unroll
            for (int j = 0; j < 4; ++j) v[j] += (*(const f32x4*)(gp + 256 * j) * pcoef) * a[j]; }
#pragma unroll
        for (int j = 0; j < 4; ++j) ss += (v[j][0] * v[j][0] + v[j][1] * v[j][1]) + (v[j][2] * v[j][2] + v[j][3] * v[j][3]);
        const float rstd = 1.0f / sqrtf(wave_sum(ss) * (1.0f / DM) + 1e-6f);
#pragma unroll
        for (int j = 0; j < 4; ++j) *(f32x4*)(out + (size_t)row * DM + 4 * F.lane + 256 * j) = (v[j] * rstd) * gv[j];
    }
}
__device__ __forceinline__ float logsig16(float x) { return (fminf(x, 0.f) - __logf(1.0f + __expf(-fabsf(x)))) * (1.0f / 16.0f); }
__device__ __forceinline__ void gla_cumdecay(Frame& F, const bf16* Z, int row0, int h, const float* gate_w2, const float* gate_b, LAS float* bcs, LAS float* gl, LAS float* seg) {
    const int tid = F.tid;
    { const int t = tid >> 3, j2 = (tid & 7) * 2; const unsigned w = *(const unsigned*)(Z + (size_t)(row0 + t) * ZE + 2048 + j2);
      gl[t * 16 + j2] = bf2f((unsigned short)(w & 0xffffu)); gl[t * 16 + j2 + 1] = bf2f((unsigned short)(w >> 16)); }
    __syncthreads();
    { const int t = tid >> 3, dk8 = (tid & 7) * 8; float x[8];
      { const f32x4 b0 = *(const f32x4*)(gate_b + h * 64 + dk8), b1 = *(const f32x4*)(gate_b + h * 64 + dk8 + 4);
#pragma unroll
        for (int e = 0; e < 4; ++e) { x[e] = b0[e]; x[4 + e] = b1[e]; } }
#pragma unroll
      for (int j = 0; j < 16; ++j) { const float gv = gl[t * 16 + j]; const f32x4 w0 = *(const f32x4*)(gate_w2 + j * 256 + h * 64 + dk8), w1 = *(const f32x4*)(gate_w2 + j * 256 + h * 64 + dk8 + 4);
#pragma unroll
          for (int e = 0; e < 4; ++e) { x[e] += gv * w0[e]; x[4 + e] += gv * w1[e]; } }
#pragma unroll
      for (int e = 0; e < 8; ++e) bcs[t * 64 + dk8 + e] = logsig16(x[e]); }
    __syncthreads();
    { const int dk = tid & 63, sg = tid >> 6; float run = 0.f;
#pragma unroll
      for (int i = 0; i < 8; ++i) { run += bcs[(sg * 8 + i) * 64 + dk]; bcs[(sg * 8 + i) * 64 + dk] = run; }
      seg[sg * 64 + dk] = run; }
    __syncthreads();
    { const int dk = tid & 63, sg = tid >> 6; float pre = 0.f;
      for (int s = 0; s < sg; ++s) pre += seg[s * 64 + dk];
#pragma unroll
      for (int i = 0; i < 8; ++i) bcs[(sg * 8 + i) * 64 + dk] += pre; }
    __syncthreads();
}
__device__ __forceinline__ void gla_g1_unit(Frame& F, const Args& A, int unit) {
    const bf16* Z = WS_PTR(bf16, WS_Z); float* US = WS_PTR(float, WS_US); float* DS = WS_PTR(float, WS_DS);
    int tid = threadIdx.x; asm volatile("" : "+v"(tid)); F.tid = tid; F.lane = tid & 63; F.wave = __builtin_amdgcn_readfirstlane(tid >> 6);
    const int bh = unit >> 7, n = unit & 127, b = bh >> 2, h = bh & 3, row0 = b * TP + n * 64;
    LAS float* bcs = (LAS float*)F.lds; LAS float* kk = bcs + 4096; LAS float* vv = kk + 4096; LAS float* gl = vv + 8192; LAS float* seg = gl + 1024;
    gla_cumdecay(F, Z, row0, h, (const float*)A.in[17], (const float*)A.in[18], bcs, gl, seg);
    { const int s = tid >> 3, dk8 = (tid & 7) * 8; const v4u kw = *(const v4u*)(Z + (size_t)(row0 + s) * ZE + 256 + h * 64 + dk8);
#pragma unroll
      for (int e = 0; e < 4; ++e) { const unsigned w = kw[e]; const int d0 = dk8 + 2 * e;
          kk[s * 64 + d0] = bf2f((unsigned short)(w & 0xffffu)) * __expf(bcs[63 * 64 + d0] - bcs[s * 64 + d0]);
          kk[s * 64 + d0 + 1] = bf2f((unsigned short)(w >> 16)) * __expf(bcs[63 * 64 + d0 + 1] - bcs[s * 64 + d0 + 1]); }
      const int dv16 = (tid & 7) * 16;
#pragma unroll
      for (int q = 0; q < 2; ++q) { const v4u vw = *(const v4u*)(Z + (size_t)(row0 + s) * ZE + 512 + h * 128 + dv16 + 8 * q);
#pragma unroll
          for (int e = 0; e < 4; ++e) { vv[s * 128 + dv16 + 8 * q + 2 * e] = bf2f((unsigned short)(vw[e] & 0xffffu)); vv[s * 128 + dv16 + 8 * q + 2 * e + 1] = bf2f((unsigned short)(vw[e] >> 16)); } }
      if (tid < 64) DS[(size_t)unit * 64 + tid] = __expf(bcs[63 * 64 + tid]); }
    __syncthreads();
    { const int dkq = tid >> 5, dvq = tid & 31; f32x4 acc[4] = {{0.f, 0.f, 0.f, 0.f}, {0.f, 0.f, 0.f, 0.f}, {0.f, 0.f, 0.f, 0.f}, {0.f, 0.f, 0.f, 0.f}};
#pragma unroll 4
      for (int s = 0; s < 64; ++s) { const f32x4 a = *(const LAS f32x4*)(kk + s * 64 + 4 * dkq), bv = *(const LAS f32x4*)(vv + s * 128 + 4 * dvq);
#pragma unroll
          for (int i = 0; i < 4; ++i) acc[i] += a[i] * bv; }
#pragma unroll
      for (int i = 0; i < 4; ++i) *(f32x4*)(US + ((size_t)unit * 64 + 4 * dkq + i) * 128 + 4 * dvq) = acc[i]; }
    __syncthreads();
}
__device__ __forceinline__ void gla_g2_phase(Frame& F) {
    float* US = WS_PTR(float, WS_US); const float* DS = WS_PTR(float, WS_DS); float* outp = F.out + O_GLAP;
    for (int gid = F.bx * 512 + F.tid; gid < 8 * 8192; gid += F.G * 512) {
        const int bh = gid >> 13, e = gid & 8191, dk = e >> 7;
        float* up = US + (size_t)bh * 128 * 8192 + e; const float* dp = DS + (size_t)bh * 128 * 64 + dk; float S = 0.f;
        for (int n0 = 0; n0 < 128; n0 += 8) { float uu[8], dd[8];
#pragma unroll
            for (int i = 0; i < 8; ++i) { uu[i] = up[(size_t)(n0 + i) * 8192]; dd[i] = dp[(n0 + i) * 64]; }
#pragma unroll
            for (int i = 0; i < 8; ++i) { up[(size_t)(n0 + i) * 8192] = S; S = dd[i] * S + uu[i]; } }
        outp[gid] = S;
    }
}
__device__ __forceinline__ void gla_g3_unit(Frame& F, const Args& A, int unit) {
    const bf16* Z = WS_PTR(bf16, WS_Z); const float* US = WS_PTR(float, WS_US); bf16* OP = WS_PTR(bf16, WS_OP);
    int tid = threadIdx.x; asm volatile("" : "+v"(tid)); F.tid = tid; F.lane = tid & 63; F.wave = __builtin_amdgcn_readfirstlane(tid >> 6);
    const int bh = unit >> 7, n = unit & 127, b = bh >> 2, h = bh & 3, row0 = b * TP + n * 64;
    LAS float* bcs = (LAS float*)F.lds; LAS float* attT = bcs;
    LAS float* qiT = bcs + 4096; LAS float* kiT = qiT + 4096; LAS float* vv = kiT + 4096; LAS float* Sst = vv + 8192; LAS float* gl = Sst + 8192; LAS float* seg = gl + 1024;
    gla_cumdecay(F, Z, row0, h, (const float*)A.in[17], (const float*)A.in[18], bcs, gl, seg);
    { const int t = tid >> 3, dk8 = (tid & 7) * 8;
      const v4u qw = *(const v4u*)(Z + (size_t)(row0 + t) * ZE + h * 64 + dk8), kw = *(const v4u*)(Z + (size_t)(row0 + t) * ZE + 256 + h * 64 + dk8);
#pragma unroll
      for (int e = 0; e < 4; ++e) { const int d0 = dk8 + 2 * e; const float b0 = bcs[t * 64 + d0], b1 = bcs[t * 64 + d0 + 1];
          qiT[d0 * 64 + t] = 0.125f * bf2f((unsigned short)(qw[e] & 0xffffu)) * __expf(b0); qiT[(d0 + 1) * 64 + t] = 0.125f * bf2f((unsigned short)(qw[e] >> 16)) * __expf(b1);
          kiT[d0 * 64 + t] = bf2f((unsigned short)(kw[e] & 0xffffu)) * __expf(-b0); kiT[(d0 + 1) * 64 + t] = bf2f((unsigned short)(kw[e] >> 16)) * __expf(-b1); }
      const int dv16 = (tid & 7) * 16;
#pragma unroll
      for (int q = 0; q < 2; ++q) { const v4u vw = *(const v4u*)(Z + (size_t)(row0 + t) * ZE + 512 + h * 128 + dv16 + 8 * q);
#pragma unroll
          for (int e = 0; e < 4; ++e) { vv[t * 128 + dv16 + 8 * q + 2 * e] = bf2f((unsigned short)(vw[e] & 0xffffu)); vv[t * 128 + dv16 + 8 * q + 2 * e + 1] = bf2f((unsigned short)(vw[e] >> 16)); } }
#pragma unroll
      for (int j = 0; j < 4; ++j) *(LAS f32x4*)(Sst + 4 * (tid + 512 * j)) = *(const f32x4*)(US + (size_t)unit * 8192 + 4 * (tid + 512 * j)); }
    __syncthreads();
    { const int t4 = tid >> 5, s2 = tid & 31; f32x4 a0 = {0.f, 0.f, 0.f, 0.f}, a1 = {0.f, 0.f, 0.f, 0.f};
#pragma unroll 4
      for (int dk = 0; dk < 64; ++dk) { const f32x4 qv = *(const LAS f32x4*)(qiT + dk * 64 + 4 * t4); const f32x2 kv = *(const LAS f32x2*)(kiT + dk * 64 + 2 * s2);
          a0 += qv * kv[0]; a1 += qv * kv[1]; }
#pragma unroll
      for (int i = 0; i < 4; ++i) { if (2 * s2 > 4 * t4 + i) a0[i] = 0.f; if (2 * s2 + 1 > 4 * t4 + i) a1[i] = 0.f; }
      *(LAS f32x4*)(attT + (2 * s2) * 64 + 4 * t4) = a0; *(LAS f32x4*)(attT + (2 * s2 + 1) * 64 + 4 * t4) = a1; }
    __syncthreads();
    { const int t4 = tid >> 5, dvq = tid & 31; f32x4 o[4] = {{0.f, 0.f, 0.f, 0.f}, {0.f, 0.f, 0.f, 0.f}, {0.f, 0.f, 0.f, 0.f}, {0.f, 0.f, 0.f, 0.f}};
#pragma unroll 4
      for (int dk = 0; dk < 64; ++dk) { const f32x4 qv = *(const LAS f32x4*)(qiT + dk * 64 + 4 * t4), sv = *(const LAS f32x4*)(Sst + dk * 128 + 4 * dvq);
#pragma unroll
          for (int i = 0; i < 4; ++i) o[i] += qv[i] * sv; }
      const int smax = 4 * t4 + 3;
      for (int s = 0; s <= smax; ++s) { const f32x4 av = *(const LAS f32x4*)(attT + s * 64 + 4 * t4), v4 = *(const LAS f32x4*)(vv + s * 128 + 4 * dvq);
#pragma unroll
          for (int i = 0; i < 4; ++i) o[i] += av[i] * v4; }
      const f32x4 gn = *(const f32x4*)((const float*)A.in[19] + h * 128 + 4 * dvq);
#pragma unroll
      for (int i = 0; i < 4; ++i) { const float ss = half_sum((o[i][0] * o[i][0] + o[i][1] * o[i][1]) + (o[i][2] * o[i][2] + o[i][3] * o[i][3]));
          const float rstd = 1.0f / sqrtf(ss * (1.0f / 128.0f) + 1e-6f); const int row = row0 + 4 * t4 + i;
          const v2u rw = *(const v2u*)(Z + (size_t)row * ZE + 1024 + h * 128 + 4 * dvq);
          const float r0 = bf2f((unsigned short)(rw.x & 0xffffu)), r1 = bf2f((unsigned short)(rw.x >> 16)), r2 = bf2f((unsigned short)(rw.y & 0xffffu)), r3 = bf2f((unsigned short)(rw.y >> 16));
          v2u ow; ow.x = pk2(o[i][0] * rstd * gn[0] * siluf_(r0), o[i][1] * rstd * gn[1] * siluf_(r1)); ow.y = pk2(o[i][2] * rstd * gn[2] * siluf_(r2), o[i][3] * rstd * gn[3] * siluf_(r3));
          *(GAS v2u*)(OP + (size_t)row * DM + h * 128 + 4 * dvq) = ow; } }
    __syncthreads();
}
__device__ __forceinline__ void gla_sample_unit(Frame& F, const Args& A, int unit) {
    const bf16* Z = WS_PTR(bf16, WS_Z); bf16* OP = WS_PTR(bf16, WS_OP);
    const float* gate_w2 = (const float*)A.in[17]; const float* gate_b = (const float*)A.in[18]; const float* S0g = (const float*)A.in[2] + (size_t)unit * 8192; float* Sout = F.out + O_GLAS + (size_t)unit * 8192;
    int tid = threadIdx.x; asm volatile("" : "+v"(tid)); F.tid = tid; F.lane = tid & 63; F.wave = __builtin_amdgcn_readfirstlane(tid >> 6);
    const int b = unit >> 2, h = unit & 3, row0 = MP + 4 * b;
    LAS float* S0 = (LAS float*)F.lds; LAS float* bc = S0 + 8192; LAS float* qi = bc + 256; LAS float* ki = qi + 256; LAS float* kk = ki + 256; LAS float* vv = kk + 256; LAS float* att = vv + 512; LAS float* gl = att + 16; LAS float* red = gl + 64;
#pragma unroll
    for (int j = 0; j < 4; ++j) *(LAS f32x4*)(S0 + 4 * (tid + 512 * j)) = *(const f32x4*)(S0g + 4 * (tid + 512 * j));
    if (tid < 64) gl[tid] = bf2f(Z[(size_t)(row0 + (tid >> 4)) * ZE + 2048 + (tid & 15)]);
    vv[tid] = bf2f(Z[(size_t)(row0 + (tid >> 7)) * ZE + 512 + h * 128 + (tid & 127)]);
    __syncthreads();
    if (tid < 256) { const int t = tid >> 6, dk = tid & 63; float x = gate_b[h * 64 + dk];
#pragma unroll
        for (int j = 0; j < 16; ++j) x += gl[t * 16 + j] * gate_w2[j * 256 + h * 64 + dk];
        bc[t * 64 + dk] = logsig16(x); }
    __syncthreads();
    if (tid < 64) { float run = 0.f;
#pragma unroll
        for (int t = 0; t < 4; ++t) { run += bc[t * 64 + tid]; bc[t * 64 + tid] = run; } }
    __syncthreads();
    if (tid < 256) { const int t = tid >> 6, dk = tid & 63; const float bb = bc[t * 64 + dk], bl = bc[3 * 64 + dk];
        const float qv = bf2f(Z[(size_t)(row0 + t) * ZE + h * 64 + dk]), kv = bf2f(Z[(size_t)(row0 + t) * ZE + 256 + h * 64 + dk]);
        qi[t * 64 + dk] = 0.125f * qv * __expf(bb); ki[t * 64 + dk] = kv * __expf(-bb); kk[t * 64 + dk] = kv * __expf(bl - bb); }
    __syncthreads();
    if (tid < 16) { const int t = tid >> 2, s = tid & 3; float a = 0.f;
        for (int dk = 0; dk < 64; ++dk) a += qi[t * 64 + dk] * ki[s * 64 + dk];
        att[tid] = (s <= t) ? a : 0.f; }
    __syncthreads();
    { const int t = tid >> 7, dv = tid & 127; float o = 0.f;
#pragma unroll 8
      for (int dk = 0; dk < 64; ++dk) o += qi[t * 64 + dk] * S0[dk * 128 + dv];
#pragma unroll
      for (int s = 0; s < 4; ++s) o += att[t * 4 + s] * vv[s * 128 + dv];
      const float ss = wave_sum(o * o); if (F.lane == 0) red[F.wave] = ss;
      __syncthreads();
      const float tot = red[2 * t] + red[2 * t + 1]; const float rstd = 1.0f / sqrtf(tot * (1.0f / 128.0f) + 1e-6f);
      const float gn = ((const float*)A.in[19])[h * 128 + dv]; const float rr = bf2f(Z[(size_t)(row0 + t) * ZE + 1024 + h * 128 + dv]);
      OP[(size_t)(row0 + t) * DM + h * 128 + dv] = (bf16)f2bf(o * rstd * gn * siluf_(rr)); }
#pragma unroll
    for (int j = 0; j < 4; ++j) { const int e = 4 * (tid + 512 * j), dk = e >> 7, dv = e & 127; const float dec = __expf(bc[3 * 64 + dk]);
        f32x4 sn = *(const LAS f32x4*)(S0 + e) * dec;
#pragma unroll
        for (int s = 0; s < 4; ++s) sn += kk[s * 64 + dk] * *(const LAS f32x4*)(vv + s * 128 + dv);
        *(f32x4*)(Sout + e) = sn; }
    __syncthreads();
}
__device__ __forceinline__ void pool_prompt_unit(Frame& F, int unit) {
    const bf16* Z = WS_PTR(bf16, WS_Z); bf16* OP = WS_PTR(bf16, WS_OP); float* hp = F.out + O_POOLP;
    int c = threadIdx.x; asm volatile("" : "+v"(c));
    const int b = unit >> 7, t0 = (unit & 127) * 64, w = 2 << (c >> 7); const size_t rb = (size_t)b * TP;
    float s = 0.f;
    { float pv[16];
#pragma unroll
      for (int j = 0; j < 16; ++j) { const int t = t0 - 1 - j; pv[j] = (j < w && t >= 0) ? bf2f(Z[(rb + t) * ZE + 1536 + c]) : 0.f; }
#pragma unroll
      for (int j = 0; j < 16; ++j) s += pv[j]; }
#pragma unroll 1
    for (int tb = t0; tb < t0 + 64; tb += 16) { float uv[16], ov[16];
#pragma unroll
        for (int j = 0; j < 16; ++j) { const int t = tb + j; uv[j] = bf2f(Z[(rb + t) * ZE + 1536 + c]); ov[j] = (t - w >= 0) ? bf2f(Z[(rb + t - w) * ZE + 1536 + c]) : 0.f; }
#pragma unroll
        for (int j = 0; j < 16; ++j) { const int t = tb + j; s += uv[j]; s -= ov[j];
            const float cnt = (float)((t + 1 < w) ? t + 1 : w);
            OP[(rb + t) * DM + 512 + c] = (bf16)f2bf(s / cnt - uv[j]);
            if (t >= TP - 15) hp[((size_t)b * 15 + (t - (TP - 15))) * 512 + c] = uv[j]; } }
}
__device__ __forceinline__ void pool_sample_unit(Frame& F, const Args& A, int b) {
    const bf16* Z = WS_PTR(bf16, WS_Z); bf16* OP = WS_PTR(bf16, WS_OP); float* hs = F.out + O_POOLS + (size_t)b * 15 * 512; const float* hin = (const float*)A.in[3] + (size_t)b * 15 * 512;
    int c = threadIdx.x; asm volatile("" : "+v"(c));
    const int w = 2 << (c >> 7); float full[19];
#pragma unroll
    for (int i = 0; i < 15; ++i) full[i] = hin[i * 512 + c];
#pragma unroll
    for (int t = 0; t < 4; ++t) full[15 + t] = bf2f(Z[(size_t)(MP + 4 * b + t) * ZE + 1536 + c]);
#pragma unroll
    for (int t = 0; t < 4; ++t) { float s = 0.f;
#pragma unroll
        for (int j = 0; j < 16; ++j) if (j < w) s += full[15 + t - j];
        OP[(size_t)(MP + 4 * b + t) * DM + 512 + c] = (bf16)f2bf(s / (float)w - full[15 + t]); }
#pragma unroll
    for (int i = 0; i < 15; ++i) hs[i * 512 + c] = full[4 + i];
}
__device__ __forceinline__ void even_mid_phase(Frame& F, const Args& A) {
    constexpr int N1 = 1024, N2 = 512, N3 = 256, N4 = 128;
    for (int u = F.bx; u < N1 + N2 + N3 + N4; u += F.G) {
        if (u < N1) gla_g1_unit(F, A, u);
        else if (u < N1 + N2) gla_sample_unit(F, A, u - N1);
        else if (u < N1 + N2 + N3) pool_prompt_unit(F, u - N1 - N2);
        else pool_sample_unit(F, A, u - N1 - N2 - N3);
    }
}
__device__ __forceinline__ void odd_rows(Frame& F, const Args& A) {
    const bf16* Z = WS_PTR(bf16, WS_Z); bf16* CQN = WS_PTR(bf16, WS_CQN); bf16* CKVB = WS_PTR(bf16, WS_CKVB); bf16* KRB = WS_PTR(bf16, WS_KRB); const float* rt = WS_PTR(float, WS_RT);
    const float* q_norm = (const float*)A.in[24]; const float* kv_norm = (const float*)A.in[26];
    const int gw = F.bx * NWAVES + F.wave, NGW = F.G * NWAVES, lane = F.lane;
    for (int row = gw; row < MT; row += NGW) {
        const bf16* zr = Z + (size_t)row * ZO;
        { float v[6]; float ss = 0.f;
#pragma unroll
          for (int j = 0; j < 3; ++j) { const unsigned w = *(const unsigned*)(zr + 2 * lane + 128 * j); v[2 * j] = bf2f((unsigned short)(w & 0xffffu)); v[2 * j + 1] = bf2f((unsigned short)(w >> 16)); ss += v[2 * j] * v[2 * j] + v[2 * j + 1] * v[2 * j + 1]; }
          const float rstd = 1.0f / sqrtf(wave_sum(ss) * (1.0f / 384.0f) + 1e-6f);
#pragma unroll
          for (int j = 0; j < 3; ++j) { const int c = 2 * lane + 128 * j; *(GAS unsigned*)(CQN + (size_t)row * 384 + c) = pk2(v[2 * j] * rstd * q_norm[c], v[2 * j + 1] * rstd * q_norm[c + 1]); } }
        { const v2u w = *(const v2u*)(zr + 384 + 4 * lane); f32x4 v = {bf2f((unsigned short)(w.x & 0xffffu)), bf2f((unsigned short)(w.x >> 16)), bf2f((unsigned short)(w.y & 0xffffu)), bf2f((unsigned short)(w.y >> 16))};
          const float ss = wave_sum((v[0] * v[0] + v[1] * v[1]) + (v[2] * v[2] + v[3] * v[3])); const float rstd = 1.0f / sqrtf(ss * (1.0f / 256.0f) + 1e-6f);
          const f32x4 o = (v * rstd) * *(const f32x4*)(kv_norm + 4 * lane);
          *(f32x4*)(F.out + O_CKV + (size_t)row * 256 + 4 * lane) = o;
          v2u ob; ob.x = pk2(o[0], o[1]); ob.y = pk2(o[2], o[3]); *(GAS v2u*)(CKVB + (size_t)row * 256 + 4 * lane) = ob; }
        if (lane < 16) { const float x1 = bf2f(zr[640 + lane]), x2 = bf2f(zr[640 + 16 + lane]); const f32x2 cs = *(const f32x2*)(rt + (size_t)posof(row) * 32 + 2 * lane);
          const float o1 = x1 * cs[0] - x2 * cs[1], o2 = x2 * cs[0] + x1 * cs[1];
          F.out[O_KR + (size_t)row * 32 + lane] = o1; F.out[O_KR + (size_t)row * 32 + 16 + lane] = o2;
          KRB[(size_t)row * 32 + lane] = (bf16)f2bf(o1); KRB[(size_t)row * 32 + 16 + lane] = (bf16)f2bf(o2); }
    }
}
template <bool SAMPLE> __device__ __forceinline__ void conv_unit(Frame& F, const Args& A, int unit) {
    constexpr int NTOK = SAMPLE ? 4 : 32, NR = NTOK + 30;
    const bf16* Z = WS_PTR(bf16, WS_Z); bf16* OP = WS_PTR(bf16, WS_OP);
    const float* conv_w = (const float*)A.in[29]; const float* conv_b = (const float*)A.in[30]; const float* ng = (const float*)A.in[31]; const float* nb = (const float*)A.in[32];
    const int c = F.tid; LAS float* ut = (LAS float*)F.lds;
    LAS float* stat = ut + 62 * 512;
    const int b = SAMPLE ? unit : (unit >> 8), t0 = SAMPLE ? 0 : (unit & 255) * 32; const size_t rb = SAMPLE ? (size_t)(MP + 4 * b) : (size_t)b * TP;
    constexpr int FB = SAMPLE ? 17 : 16;
#pragma unroll 1
    for (int r0 = 0; r0 < NR; r0 += FB) { bf16 av[FB], gv[FB]; float hv[FB];
#pragma unroll
        for (int q = 0; q < FB; ++q) { const int rr = r0 + q, t = t0 - 30 + rr; av[q] = 0; gv[q] = 0; hv[q] = 0.f;
            if (rr < NR) { if (t >= 0) { const bf16* zr = Z + (rb + t) * ZO; av[q] = zr[672 + c]; gv[q] = zr[1184 + c]; }
                           else if (SAMPLE) hv[q] = ((const float*)A.in[6])[((size_t)b * 30 + rr) * 512 + c]; } }
#pragma unroll
        for (int q = 0; q < FB; ++q) { const int rr = r0 + q, t = t0 - 30 + rr;
            if (rr < NR) ut[rr * 512 + c] = (t >= 0) ? bf2f(av[q]) * sigmoidf_(bf2f(gv[q])) : hv[q]; } }
    float w[31];
#pragma unroll
    for (int j = 0; j < 31; ++j) w[j] = conv_w[j * 512 + c];
    const float bias = conv_b[c];
    if (SAMPLE) { float* cs = F.out + O_CONVS + (size_t)b * 30 * 512;
        for (int i = 0; i < 30; ++i) cs[i * 512 + c] = ut[(4 + i) * 512 + c]; }
    else if (t0 == TP - 32) { float* cp = F.out + O_CONVP + (size_t)b * 30 * 512;
        for (int i = 0; i < 30; ++i) cp[i * 512 + c] = ut[(32 + i) * 512 + c]; }
#pragma unroll 4
    for (int tt = 0; tt < NTOK; ++tt) { float a = bias;
#pragma unroll
        for (int j = 0; j < 31; ++j) a += w[j] * ut[(tt + j) * 512 + c];
        ut[tt * 512 + c] = a; }
    __syncthreads();
    for (int tt = F.wave; tt < NTOK; tt += NWAVES) { float s1 = 0.f, s2 = 0.f;
#pragma unroll
        for (int j = 0; j < 8; ++j) { const float x = ut[tt * 512 + F.lane + 64 * j]; s1 += x; s2 += x * x; }
        s1 = wave_sum(s1); s2 = wave_sum(s2); const float mean = s1 * (1.0f / 512.0f); const float var = fmaxf(s2 * (1.0f / 512.0f) - mean * mean, 0.f);
        if (F.lane == 0) { stat[2 * tt] = mean; stat[2 * tt + 1] = 1.0f / sqrtf(var + 1e-6f); } }
    __syncthreads();
    const float gg = ng[c], bb = nb[c];
#pragma unroll 4
    for (int tt = 0; tt < NTOK; ++tt) { const float y = (ut[tt * 512 + c] - stat[2 * tt]) * stat[2 * tt + 1] * gg + bb;
        OP[(rb + t0 + tt) * DM + 512 + c] = (bf16)f2bf(siluf_(y)); }
    __syncthreads();
}
__device__ __forceinline__ void odd_thin_phase(Frame& F, const Args& A) {
    odd_rows(F, A);
    for (int u = F.bx; u < 512 + 128; u += F.G) { if (u < 512) conv_unit<false>(F, A, u); else conv_unit<true>(F, A, u - 512); }
}
typedef short v4i16_t __attribute__((ext_vector_type(4)));
__device__ __forceinline__ s16x4 vtr(const LAS unsigned char* p) { return __builtin_bit_cast(s16x4, __builtin_amdgcn_ds_read_tr16_b64_v4i16((LAS v4i16_t*)p)); }
__device__ __forceinline__ int crow(int r, int hi) { return (r & 3) + 8 * (r >> 2) + 4 * hi; }
__device__ __forceinline__ bf16x8 pack8(const f32x16& p, int s8) {
    v4u w; w.x = pg8::cvt_pk_bf16(p[s8 + 0], p[s8 + 1]); w.y = pg8::cvt_pk_bf16(p[s8 + 2], p[s8 + 3]); w.z = pg8::cvt_pk_bf16(p[s8 + 4], p[s8 + 5]); w.w = pg8::cvt_pk_bf16(p[s8 + 6], p[s8 + 7]);
    return __builtin_bit_cast(bf16x8, w);
}
constexpr int PA_KROW = 208, PA_VROW = 144, PA_VOFF = 64 * PA_KROW, PA_BUF = PA_VOFF + 64 * PA_VROW;
__device__ __forceinline__ void pattn_unit(Frame& F, int b, int h, int qb) {
    const bf16* Q = WS_PTR(bf16, WS_Q); const bf16* KV = WS_PTR(bf16, WS_KV); const bf16* KRB = WS_PTR(bf16, WS_KRB); bf16* OP = WS_PTR(bf16, WS_OP);
    int tid = threadIdx.x; asm volatile("" : "+v"(tid));
    const int lane = tid & 63, wid = __builtin_amdgcn_readfirstlane(tid >> 6), r32 = lane & 31, hi = lane >> 5;
    const size_t rb = (size_t)b * TP; const int q0w = 256 * qb + 32 * wid, NT = 4 * (qb + 1);
    LAS unsigned char* L = F.lds;
    const int skey = tid >> 3, sc = tid & 7, rkey = tid >> 2, rc = tid & 3;
    const bf16* gk = KV + (rb + skey) * 1024 + h * 64 + 8 * sc; const bf16* gv = gk + 512; const bf16* gr = KRB + (rb + rkey) * 32 + 8 * rc;
    const int lk = skey * PA_KROW + (sc << 4), lv = PA_VOFF + skey * PA_VROW + (sc << 4), lr = rkey * PA_KROW + ((8 + rc) << 4);
    v4u sk, sv, sr = {0u, 0u, 0u, 0u};
#define PA_LOAD(kt) do { sk = *(const v4u*)(gk + (size_t)(kt) * 64 * 1024); sv = *(const v4u*)(gv + (size_t)(kt) * 64 * 1024); if (tid < 256) sr = *(const v4u*)(gr + (size_t)(kt) * 64 * 32); } while (0)
#define PA_STORE(bufo) do { *(LAS v4u*)(L + (bufo) + lk) = sk; *(LAS v4u*)(L + (bufo) + lv) = sv; if (tid < 256) *(LAS v4u*)(L + (bufo) + lr) = sr; } while (0)
    PA_LOAD(0);
    bf16x8 qf[6];
    { const bf16* qp = Q + (rb + q0w + r32) * 768 + h * 96 + 8 * hi;
#pragma unroll
      for (int kk = 0; kk < 6; ++kk) qf[kk] = *(const bf16x8*)(qp + 16 * kk); }
    f32x16 o0 = {}, o1 = {}; float mrun = -1e30f, lrun = 0.f;
    PA_STORE(0);
    __syncthreads();
    const int aoffk = r32 * PA_KROW + (hi << 4);
    const int g = lane >> 4, i16 = lane & 15, hg = g >> 1;
    const int voff = PA_VOFF + (4 * hg + (i16 >> 2)) * PA_VROW + ((16 * (g & 1) + 4 * (i16 & 3)) << 1);
    for (int kt = 0; kt < NT; ++kt) {
        const int bufo = (kt & 1) * PA_BUF;
        if (kt + 1 < NT) PA_LOAD(kt + 1);
        if (64 * kt <= q0w + 31) {
            f32x16 p0 = {}, p1 = {};
#pragma unroll
            for (int kk = 0; kk < 6; ++kk) {
                const bf16x8 a0 = *(const LAS bf16x8*)(L + bufo + aoffk + 32 * kk), a1 = *(const LAS bf16x8*)(L + bufo + aoffk + 32 * PA_KROW + 32 * kk);
                p0 = __builtin_amdgcn_mfma_f32_32x32x16_bf16(a0, qf[kk], p0, 0, 0, 0); p1 = __builtin_amdgcn_mfma_f32_32x32x16_bf16(a1, qf[kk], p1, 0, 0, 0); }
            if (64 * kt + 63 > q0w) { const int qq = q0w + r32;
#pragma unroll
                for (int r = 0; r < 16; ++r) { const int key = 64 * kt + crow(r, hi); if (key > qq) p0[r] = -INFINITY; if (key + 32 > qq) p1[r] = -INFINITY; } }
            float mt = fmaxf(p0[0], p1[0]);
#pragma unroll
            for (int r = 1; r < 16; ++r) mt = fmaxf(mt, fmaxf(p0[r], p1[r]));
            mt = fmaxf(mt, __shfl_xor(mt, 32));
            const float mnew = fmaxf(mrun, mt), alpha = __builtin_amdgcn_exp2f(mrun - mnew); mrun = mnew;
            float rs = 0.f;
#pragma unroll
            for (int r = 0; r < 16; ++r) { p0[r] = __builtin_amdgcn_exp2f(p0[r] - mnew); p1[r] = __builtin_amdgcn_exp2f(p1[r] - mnew); rs += p0[r] + p1[r]; }
            rs += __shfl_xor(rs, 32); lrun = lrun * alpha + rs;
#pragma unroll
            for (int r = 0; r < 16; ++r) { o0[r] *= alpha; o1[r] *= alpha; }
#pragma unroll
            for (int hf = 0; hf < 2; ++hf)
#pragma unroll
                for (int s = 0; s < 2; ++s) { const bf16x8 pb = pack8(hf ? p1 : p0, 8 * s);
#pragma unroll
                    for (int dt = 0; dt < 2; ++dt) { const int a0 = bufo + voff + (32 * hf + 16 * s) * PA_VROW + 64 * dt, a1 = a0 + 8 * PA_VROW;
                        const s16x4 lo = vtr(L + a0), hh = vtr(L + a1);
                        const bf16x8 va = {lo[0], lo[1], lo[2], lo[3], hh[0], hh[1], hh[2], hh[3]};
                        if (dt == 0) o0 = __builtin_amdgcn_mfma_f32_32x32x16_bf16(va, pb, o0, 0, 0, 0); else o1 = __builtin_amdgcn_mfma_f32_32x32x16_bf16(va, pb, o1, 0, 0, 0); } }
        }
        if (kt + 1 < NT) PA_STORE(((kt + 1) & 1) * PA_BUF);
        __syncthreads();
    }
#undef PA_LOAD
#undef PA_STORE
    const float rl = 1.0f / lrun;
    bf16* op = OP + (rb + q0w + r32) * DM + h * 64;
#pragma unroll
    for (int dt = 0; dt < 2; ++dt)
#pragma unroll
        for (int rq = 0; rq < 4; ++rq) { const f32x16& o = dt ? o1 : o0; v2u w; w.x = pk2(o[4 * rq] * rl, o[4 * rq + 1] * rl); w.y = pk2(o[4 * rq + 2] * rl, o[4 * rq + 3] * rl);
            *(GAS v2u*)(op + 32 * dt + 8 * rq + 4 * hi) = w; }
}

constexpr int DT_ROW = 592, DT_TILE = 64 * DT_ROW, DT_QOFF = 2 * DT_TILE, DT_QN = DT_QOFF + 32 * DT_ROW, DT_ML = 133120;
__device__ __forceinline__ void dattn_unit(Frame& F, const Args& A, int unit) {
    const bf16* Q = WS_PTR(bf16, WS_Q); float* PART = WS_PTR(float, WS_PART) + (size_t)unit * PART_F; float* QD = WS_PTR(float, WS_QD);
    const float* cckv = (const float*)A.in[4]; const float* ckr = (const float*)A.in[5]; const int* ptab = (const int*)A.in[7]; const float* w_uk = (const float*)A.in[27];
    int tid = threadIdx.x; asm volatile("" : "+v"(tid));
    const int lane = tid & 63, wid = __builtin_amdgcn_readfirstlane(tid >> 6), r32 = lane & 31, hi = lane >> 5, b = unit >> 3, sp = unit & 7;
    LAS unsigned char* L = F.lds; LAS float* qn = (LAS float*)(L + DT_QN); LAS float* ml = (LAS float*)(L + DT_ML);
    f32x4 st0[9], st1[9];
    const int wofs = (tid >> 6) * DT_ROW + (tid & 63) * 8, wofr = (tid >> 3) * DT_ROW + 512 + (tid & 7) * 8;
#define DT_LOAD(tl, st) do { const int pid = ptab[b * 64 + sp * 8 + ((tl) >> 1)]; const f32x4* pc = (const f32x4*)(cckv + ((size_t)pid * 128 + ((tl) & 1) * 64) * 256); const f32x4* pr = (const f32x4*)(ckr + ((size_t)pid * 128 + ((tl) & 1) * 64) * 32); \
        _Pragma("unroll") for (int i = 0; i < 8; ++i) st[i] = __builtin_nontemporal_load(pc + tid + 512 * i); \
        st[8] = __builtin_nontemporal_load(pr + tid); } while (0)
#define DT_STORE(bufo, st) do { _Pragma("unroll") for (int i = 0; i < 8; ++i) { v2u w_; w_.x = pg8::cvt_pk_bf16(st[i][0], st[i][1]); w_.y = pg8::cvt_pk_bf16(st[i][2], st[i][3]); *(LAS v2u*)(L + (bufo) + wofs + i * 8 * DT_ROW) = w_; } \
        { v2u w_; w_.x = pg8::cvt_pk_bf16(st[8][0], st[8][1]); w_.y = pg8::cvt_pk_bf16(st[8][2], st[8][3]); *(LAS v2u*)(L + (bufo) + wofr) = w_; } } while (0)
    DT_LOAD(0, st0); DT_LOAD(1, st1);
    { const int t = tid >> 7, c6 = (tid & 127) * 6;
      const bf16* qp = Q + (size_t)(MP + 4 * b + t) * 768 + c6;
#pragma unroll
      for (int e = 0; e < 6; ++e) { const int c = c6 + e, hh = c / 96, d = c % 96; const bf16 v = qp[e];
          if (d < 64) qn[(t * 8 + hh) * 64 + d] = bf2f(v);
          else { const int q = t * 8 + hh, col = 256 + (d - 64); *(LAS bf16*)(L + DT_QOFF + q * DT_ROW + col * 2) = v;
                 if (sp == 0) QD[((size_t)b * 32 + q) * 288 + col] = bf2f(v); } } }
    __syncthreads();
    { const int hh = tid >> 6, rr = tid & 63;
#pragma unroll 1
      for (int j = 0; j < 4; ++j) { const int r = rr + 64 * j; const f32x4* wp = (const f32x4*)(w_uk + ((size_t)r * 8 + hh) * 64); float a0 = 0.f, a1 = 0.f, a2 = 0.f, a3 = 0.f;
#pragma unroll 4
          for (int d4 = 0; d4 < 16; ++d4) { const f32x4 w = wp[d4];
              const f32x4 x0 = *(const LAS f32x4*)(qn + (0 * 8 + hh) * 64 + 4 * d4), x1 = *(const LAS f32x4*)(qn + (1 * 8 + hh) * 64 + 4 * d4), x2 = *(const LAS f32x4*)(qn + (2 * 8 + hh) * 64 + 4 * d4), x3 = *(const LAS f32x4*)(qn + (3 * 8 + hh) * 64 + 4 * d4);
              a0 += (w[0] * x0[0] + w[1] * x0[1]) + (w[2] * x0[2] + w[3] * x0[3]); a1 += (w[0] * x1[0] + w[1] * x1[1]) + (w[2] * x1[2] + w[3] * x1[3]);
              a2 += (w[0] * x2[0] + w[1] * x2[1]) + (w[2] * x2[2] + w[3] * x2[3]); a3 += (w[0] * x3[0] + w[1] * x3[1]) + (w[2] * x3[2] + w[3] * x3[3]); }
          const float av[4] = {a0, a1, a2, a3};
#pragma unroll
          for (int t = 0; t < 4; ++t) { const int q = t * 8 + hh; *(LAS bf16*)(L + DT_QOFF + q * DT_ROW + r * 2) = (bf16)f2bf(av[t]);
              if (sp == 0) QD[((size_t)b * 32 + q) * 288 + r] = av[t]; } } }
    DT_STORE(0, st0);
    __syncthreads();
    DT_LOAD(2, st0);
    const int kh = wid & 1, dq = wid >> 1, g = lane >> 4, i16 = lane & 15, hg = g >> 1;
    f32x16 o0 = {}, o1 = {}; float mrun = -1e30f, lrun = 0.f;
    const int arow = (32 * kh + r32) * DT_ROW + (hi << 4), qrow = DT_QOFF + r32 * DT_ROW + (hi << 4);
    const int voff = (32 * kh + 4 * hg + (i16 >> 2)) * DT_ROW + ((64 * dq + 16 * (g & 1) + 4 * (i16 & 3)) << 1);
#define DT_ITER(tl, bufo, bufn, stn) do { \
        f32x16 p = {}; \
_Pragma("unroll 6") \
        for (int kk = 0; kk < 18; ++kk) { const bf16x8 a = *(const LAS bf16x8*)(L + bufo + arow + 32 * kk), qv = *(const LAS bf16x8*)(L + qrow + 32 * kk); \
            p = __builtin_amdgcn_mfma_f32_32x32x16_bf16(a, qv, p, 0, 0, 0); } \
        float mt = p[0]; \
_Pragma("unroll") \
        for (int r = 1; r < 16; ++r) mt = fmaxf(mt, p[r]); \
        mt = fmaxf(mt, __shfl_xor(mt, 32)); \
        const float mnew = fmaxf(mrun, mt), alpha = __builtin_amdgcn_exp2f(mrun - mnew); mrun = mnew; \
        float rs = 0.f; \
_Pragma("unroll") \
        for (int r = 0; r < 16; ++r) { p[r] = __builtin_amdgcn_exp2f(p[r] - mnew); rs += p[r]; } \
        rs += __shfl_xor(rs, 32); lrun = lrun * alpha + rs; \
_Pragma("unroll") \
        for (int r = 0; r < 16; ++r) { o0[r] *= alpha; o1[r] *= alpha; } \
_Pragma("unroll") \
        for (int s = 0; s < 2; ++s) { const bf16x8 pb = pack8(p, 8 * s); \
_Pragma("unroll") \
            for (int dt = 0; dt < 2; ++dt) { const int a0 = bufo + voff + 16 * s * DT_ROW + 64 * dt, a1 = a0 + 8 * DT_ROW; \
                const s16x4 lo = vtr(L + a0), hh = vtr(L + a1); \
                const bf16x8 va = {lo[0], lo[1], lo[2], lo[3], hh[0], hh[1], hh[2], hh[3]}; \
                if (dt == 0) o0 = __builtin_amdgcn_mfma_f32_32x32x16_bf16(va, pb, o0, 0, 0, 0); else o1 = __builtin_amdgcn_mfma_f32_32x32x16_bf16(va, pb, o1, 0, 0, 0); } } \
        if ((tl) + 1 < 16) DT_STORE(bufn, stn); \
        __syncthreads(); \
        if ((tl) + 3 < 16) DT_LOAD((tl) + 3, stn); } while (0)
    for (int tl = 0; tl < 16; tl += 2) { DT_ITER(tl, 0, DT_TILE, st1); DT_ITER(tl + 1, DT_TILE, 0, st0); }
#undef DT_ITER
#undef DT_LOAD
#undef DT_STORE
    { LAS float* ow = (LAS float*)L + (size_t)wid * 2048;
#pragma unroll
      for (int dt = 0; dt < 2; ++dt)
#pragma unroll
          for (int r = 0; r < 16; ++r) ow[(32 * dt + crow(r, hi)) * 32 + r32] = dt ? o1[r] : o0[r];
      if (hi == 0) { ml[wid * 64 + r32] = mrun; ml[wid * 64 + 32 + r32] = lrun; } }
    __syncthreads();
    { const int q = tid & 31, dvg = tid >> 5, dqq = dvg >> 2;
      const float m0 = ml[(2 * dqq) * 64 + q], m1 = ml[(2 * dqq + 1) * 64 + q], ms = fmaxf(m0, m1);
      const float w0 = __builtin_amdgcn_exp2f(m0 - ms), w1 = __builtin_amdgcn_exp2f(m1 - ms);
      const float ls = w0 * ml[(2 * dqq) * 64 + 32 + q] + w1 * ml[(2 * dqq + 1) * 64 + 32 + q];
#pragma unroll
      for (int j = 0; j < 16; ++j) { const int dv = dvg * 16 + j, dvl = dv & 63;
          PART[dv * 32 + q] = w0 * ((LAS float*)L)[(size_t)(2 * dqq) * 2048 + dvl * 32 + q] + w1 * ((LAS float*)L)[(size_t)(2 * dqq + 1) * 2048 + dvl * 32 + q]; }
      if (dvg == 0) { PART[8192 + q] = ms; PART[8192 + 32 + q] = ls; } }
    __syncthreads();
}
__device__ __forceinline__ void dcombine_unit(Frame& F, const Args& A, int b) {
    const float* PART = WS_PTR(float, WS_PART) + (size_t)b * NSPLIT * PART_F; const float* QD = WS_PTR(float, WS_QD) + (size_t)b * 32 * 288; bf16* OP = WS_PTR(bf16, WS_OP);
    const float* ckv = F.out + O_CKV + (size_t)(MP + 4 * b) * 256; const float* kr = F.out + O_KR + (size_t)(MP + 4 * b) * 32; const float* w_uv = (const float*)A.in[28];
    const int tid = F.tid; LAS float* lat = (LAS float*)F.lds; LAS float* sn = lat + 8192; LAS float* ck = sn + 128;
    for (int i = tid; i < 1024; i += 512) ck[i] = ckv[i];
    if (tid < 128) { const int q = tid >> 2, s = tid & 3; const float* qd = QD + q * 288; const float* cr = ckv + s * 256; const float* krr = kr + s * 32; float a = 0.f;
        for (int r = 0; r < 256; ++r) a += qd[r] * cr[r];
        for (int i = 0; i < 32; ++i) a += qd[256 + i] * krr[i];
        sn[tid] = (s <= (q >> 3)) ? a : -INFINITY; }
    __syncthreads();
    { const int q = tid & 31, dvg = tid >> 5; float mk[NSPLIT], ms = -1e30f;
#pragma unroll
      for (int s = 0; s < NSPLIT; ++s) { mk[s] = PART[(size_t)s * PART_F + 8192 + q]; ms = fmaxf(ms, mk[s]); }
      float pn[4];
#pragma unroll
      for (int s = 0; s < 4; ++s) { pn[s] = sn[q * 4 + s]; ms = fmaxf(ms, pn[s]); }
      float wg[NSPLIT], ls = 0.f;
#pragma unroll
      for (int s = 0; s < NSPLIT; ++s) { wg[s] = __builtin_amdgcn_exp2f(mk[s] - ms); ls += wg[s] * PART[(size_t)s * PART_F + 8192 + 32 + q]; }
#pragma unroll
      for (int s = 0; s < 4; ++s) { pn[s] = __builtin_amdgcn_exp2f(pn[s] - ms); ls += pn[s]; }
      const float rl = 1.0f / ls;
#pragma unroll 4
      for (int j = 0; j < 16; ++j) { const int dv = dvg * 16 + j; float acc = 0.f;
#pragma unroll
          for (int s = 0; s < NSPLIT; ++s) acc += wg[s] * PART[(size_t)s * PART_F + dv * 32 + q];
#pragma unroll
          for (int s = 0; s < 4; ++s) acc += pn[s] * ck[s * 256 + dv];
          lat[q * 256 + dv] = acc * rl; } }
    __syncthreads();
    { const int hh = tid >> 6, v = tid & 63; float a[4] = {0.f, 0.f, 0.f, 0.f};
#pragma unroll 4
      for (int r = 0; r < 256; ++r) { const float w = w_uv[((size_t)r * 8 + hh) * 64 + v];
#pragma unroll
          for (int t = 0; t < 4; ++t) a[t] += w * lat[(t * 8 + hh) * 256 + r]; }
#pragma unroll
      for (int t = 0; t < 4; ++t) OP[(size_t)(MP + 4 * b + t) * DM + hh * 64 + v] = (bf16)f2bf(a[t]); }
    __syncthreads();
}
__device__ __forceinline__ void attn_phase(Frame& F, const Args& A) {
    const bool dfirst = ((F.bx >> 3) & 1) != 0;
#pragma unroll 1
    for (int part = 0; part < 2; ++part) {
#ifndef ATT_NO_D
        if ((part == 0) == dfirst) { for (int du = F.bx; du < 128 * NSPLIT; du += F.G) dattn_unit(F, A, du); }
        else
#endif
#ifndef ATT_NO_P
        { for (int pr2 = 2 * F.bx; pr2 < 512; pr2 += 2 * F.G) {
#pragma unroll 1
                   for (int e = 0; e < 2; ++e) { const int pr = pr2 >> 1, bh = pr >> 4, s = pr & 15; pattn_unit(F, bh >> 3, bh & 7, e ? s : 31 - s); } } }
#else
        {}
#endif
    }
}
constexpr int N_PHASE_IDS = 43;
#ifndef PHMASK
#define PHMASK 0xFFFFFFFFu
#endif
#define EN(n) (((PHMASK) >> (n)) & 1u)
#ifndef PROBE_DUP
#define PROBE_DUP 0u
#endif
__device__ __forceinline__ int opaque_int(int v) { asm volatile("" : "+s"(v)); return v; }
#define NREP(n) ((((PROBE_DUP) >> (n)) & 1u) ? opaque_int(2) : 1)
#define REPSEAM(n) do { if (rep_ + 1 < NREP(n) && args.use_bar) xcd_barrier(bar); } while (0)
#ifndef MK_ONE_LAUNCH
#define MK_ONE_LAUNCH 1
#endif
__global__ void __launch_bounds__(NWAVES * 64, 2) mk_fwd(Args args) {
    extern __shared__ __attribute__((aligned(16))) unsigned char lds[];
    Frame F;
    F.lds = (LAS unsigned char*)lds; F.MISC = (volatile LAS unsigned*)(F.lds + MISC_OFF);
    F.tid = threadIdx.x; F.lane = F.tid & 63; F.wave = __builtin_amdgcn_readfirstlane(F.tid >> 6); F.G = gridDim.x; F.bx = blockIdx.x;
    F.ws = args.ws; F.out = args.out; F.ctl = (gu32*)(args.ws + WS_CTL);
    for (int u = F.tid; u < (LDS_BYTES - LDSCTL_OFF) / 4; u += NWAVES * 64) ((LAS unsigned*)(F.lds + LDSCTL_OFF))[u] = 0u;
    __syncthreads();
    XcdBarrier bar; bar.bar = (unsigned*)(F.ctl + CW_BAR); bar.x = 0; bar.st = nullptr;
    if (args.use_bar) bar = xcd_barrier_post((unsigned*)(F.ctl + CW_BAR), F.MISC + 8);
    const int lo = args.ph_lo, hi = args.ph_hi;
#define RUN(k) (lo <= (k) && (k) < hi)
#define FRESH() do { int t_ = threadIdx.x; asm volatile("" : "+v"(t_)); F.tid = t_; F.lane = t_ & 63; F.wave = __builtin_amdgcn_readfirstlane(t_ >> 6); } while (0)
#define SEAM(k) do { if (args.use_bar && (k) + 1 < hi) xcd_barrier(bar); } while (0)
    LAS unsigned char* ring = F.lds;
    const float* xin_p = (const float*)args.in[0]; const float* xin_s = (const float*)args.in[1] - (size_t)MP * DM;
    float* X = WS_PTR(float, WS_X); bf16* H = WS_PTR(bf16, WS_H); bf16* ACT = WS_PTR(bf16, WS_ACT); bf16* Z = WS_PTR(bf16, WS_Z); bf16* OP = WS_PTR(bf16, WS_OP); float* MOD = WS_PTR(float, WS_MOD);
    const float* norm_g = (const float*)args.in[12];

    if (EN(0) && RUN(0)) { for (int rep_ = 0; rep_ < NREP(0); ++rep_) { FRESH(); p0_prologue(F, args); REPSEAM(0); } SEAM(0); }
    if (EN(1) && RUN(1)) { pg8::Gemm g{WS_PTR(bf16, WS_SC), WS_PTR(bf16, WS_ADAT), 256, MODLD, DM, DM, DM}; pg8::StaticOrder S; S.init(256, MODLD, F.G, F.bx);
        pg8::EpiMod E{MOD, (const float*)args.in[11]};
        pg8::gemm_phase<pg8::EpiMod, pg8::StaticOrder, true, true>(ring, g, S, E); SEAM(1); }
    for (int i = 0; i < 4; ++i) {
        const int pb = 2 + 10 * i, l = i >> 1, f = i & 1;
        const float* src_p = (i == 0) ? xin_p : X; const float* src_s = (i == 0) ? xin_s : X;
        const float* modl = MOD + l * 9216;
        if (EN(2) && RUN(pb + 0)) { for (int rep_ = 0; rep_ < NREP(2); ++rep_) { FRESH(); nm_phase(F, src_p, src_s, norm_g + (l * 3 + (f ? 2 : 0)) * DM, modl + (f ? 6 : 0) * DM, H, X, WS_PTR(float, WS_SLAB), (i == 0 || rep_ > 0) ? 0 : (f ? 4 : 11), (f ? MOD + (l) * 9216 + 5 * DM : MOD + (l - 1) * 9216 + 8 * DM), f ? 1.0f : 0.5f); REPSEAM(2); } SEAM(pb + 0); }
        if (EN(3) && RUN(pb + 1)) { for (int rep_ = 0; rep_ < NREP(3); ++rep_) { pg8::Gemm g{H, WS_PTR(bf16, WS_W13T + (size_t)i * W13T_STRIDE), MT, 2 * FF, DM, DM, DM}; pg8::StaticOrder S; S.init(MT, 2 * FF, F.G, F.bx);
            pg8::EpiSwiglu E{ACT, FF};
            pg8::gemm_phase<pg8::EpiSwiglu, pg8::StaticOrder, true, true>(ring, g, S, E); REPSEAM(3); } SEAM(pb + 1); }
        if (EN(4) && RUN(pb + 2)) { for (int rep_ = 0; rep_ < NREP(4); ++rep_) {
            { pg8::Gemm g{ACT, WS_PTR(bf16, WS_W2T + (size_t)i * W2T_STRIDE), MP, DM, FF, FF, FF}; pg8::StaticOrder S; S.init(MP, DM, F.G, F.bx);
              pg8::EpiRes E{src_p, src_s, rep_ ? WS_PTR(float, WS_DUMMY) : X, modl + (f ? 8 : 2) * DM, 0.5f};
              pg8::gemm_phase<pg8::EpiRes, pg8::StaticOrder, true, true>(ring, g, S, E); }
            __syncthreads();
            { pg8::Gemm g{ACT, WS_PTR(bf16, WS_W2T + (size_t)i * W2T_STRIDE), MT, DM, args.k_kv, FF, FF}; pg8::SplitKOrder S{MP / 256, 2, 4, 11, 256, F.G, F.bx};
              pg8::EpiPartial E{WS_PTR(float, WS_SLAB)};
              pg8::gemm_phase<pg8::EpiPartial, pg8::SplitKOrder, true, true>(ring, g, S, E); }
            REPSEAM(4); } SEAM(pb + 2); }
        if (f == 0) {
            if (EN(5) && RUN(pb + 3)) { for (int rep_ = 0; rep_ < NREP(2); ++rep_) { FRESH(); nm_phase(F, X, X, norm_g + (l * 3 + 1) * DM, modl + 3 * DM, H, X, WS_PTR(float, WS_SLAB), rep_ ? 0 : 11, modl + 2 * DM, 0.5f); REPSEAM(2); } SEAM(pb + 3); }
            if (EN(6) && RUN(pb + 4)) { for (int rep_ = 0; rep_ < NREP(6); ++rep_) { const int NZ = l ? ZO : ZE; pg8::Gemm g{H, WS_PTR(bf16, l ? WS_ODIN : WS_EVIN), MT, NZ, DM, DM, DM}; pg8::StaticOrder S; S.init(MT, NZ, F.G, F.bx);
                pg8::EpiPlain E{Z, NZ};
                pg8::gemm_phase<pg8::EpiPlain, pg8::StaticOrder, true, true>(ring, g, S, E); REPSEAM(6); } SEAM(pb + 4); }
            if (RUN(pb + 5)) { if (l == 0) { if (EN(7)) for (int rep_ = 0; rep_ < NREP(7); ++rep_) { FRESH(); even_mid_phase(F, args); REPSEAM(7); } } else { if (EN(8)) for (int rep_ = 0; rep_ < NREP(8); ++rep_) { FRESH(); odd_thin_phase(F, args); REPSEAM(8); } } SEAM(pb + 5); }
            if (RUN(pb + 6)) { FRESH();
                if (l == 0) { if (EN(9)) gla_g2_phase(F); }
                else { if (EN(10)) { pg8::Gemm g{WS_PTR(bf16, WS_CQN), WS_PTR(bf16, WS_WUQ), MT, 768, args.k_q, args.k_q, args.k_q}; pg8::StaticOrder S; S.init(MT, 768, F.G, F.bx);
                         pg8::EpiQ E{WS_PTR(bf16, WS_Q), WS_PTR(float, WS_RT)};
                         pg8::gemm_phase<pg8::EpiQ, pg8::StaticOrder, true, true>(ring, g, S, E); }
                       __syncthreads();
                       if (EN(16)) { const int nkv = opaque_int(1024), mkv = opaque_int(MP); pg8::Gemm g{WS_PTR(bf16, WS_CKVB), WS_PTR(bf16, WS_WKV), mkv, nkv, args.k_kv, args.k_kv, args.k_kv}; pg8::StaticOrder S; S.init(mkv, nkv, F.G, F.bx);
                         pg8::EpiPlain E{WS_PTR(bf16, WS_KV), nkv};
                         pg8::gemm_phase<pg8::EpiPlain, pg8::StaticOrder, true, true>(ring, g, S, E); } }
                SEAM(pb + 6); }
            if (RUN(pb + 7)) { if (l == 0) { if (EN(11)) for (int rep_ = 0; rep_ < NREP(11); ++rep_) { FRESH(); for (int u = F.bx; u < 1024; u += F.G) gla_g3_unit(F, args, u); REPSEAM(11); } } else { if (EN(12)) for (int rep_ = 0; rep_ < NREP(12); ++rep_) { FRESH(); attn_phase(F, args); REPSEAM(12); } } SEAM(pb + 7); }
            if (RUN(pb + 8)) { FRESH(); if (l == 1) { if (EN(13)) for (int b = F.bx; b < 128; b += F.G) dcombine_unit(F, args, b); SEAM(pb + 8); } }
            if (EN(14) && RUN(pb + 9)) { for (int rep_ = 0; rep_ < NREP(14); ++rep_) {
                { pg8::Gemm g{OP, WS_PTR(bf16, l ? WS_ODOUT : WS_EVOUT), MP, DM, DM, DM, DM}; pg8::StaticOrder S; S.init(MP, DM, F.G, F.bx);
                  pg8::EpiRes E{X, X, rep_ ? WS_PTR(float, WS_DUMMY) : X, modl + 5 * DM, 1.0f};
                  pg8::gemm_phase<pg8::EpiRes, pg8::StaticOrder, true, true>(ring, g, S, E); }
                __syncthreads();
                { pg8::Gemm g{OP, WS_PTR(bf16, l ? WS_ODOUT : WS_EVOUT), MT, DM, args.k_kv, DM, DM}; pg8::SplitKOrder S{MP / 256, 2, 4, 4, 256, F.G, F.bx};
                  pg8::EpiPartial E{WS_PTR(float, WS_SLAB)};
                  pg8::gemm_phase<pg8::EpiPartial, pg8::SplitKOrder, true, true>(ring, g, S, E); }
                REPSEAM(14); } SEAM(pb + 9); }
        }
    }
    if (EN(15) && RUN(42)) { FRESH(); final_phase(F, X, (const float*)args.in[34], F.out + O_Y, WS_PTR(float, WS_SLAB), 11, MOD + 9216 + 8 * DM, 0.5f); }
#undef RUN
#undef SEAM
}

extern "C" void kernel_launch(void* const* d_in, const int* in_sizes, int n_in, void* d_out, int out_size, void* d_ws, size_t ws_size, hipStream_t stream) {
    static int grid = 0;
    if (grid == 0) {
        if (n_in != 35 || (size_t)out_size != O_END || ws_size < WS_END) { fprintf(stderr, "kernel_launch: unexpected shapes: n_in %d out %d ws %zu\n", n_in, out_size, ws_size); grid = -1; return; }
        int dev = 0, cus = 0, per_cu = 0;
        if (hipGetDevice(&dev) != hipSuccess || hipDeviceGetAttribute(&cus, hipDeviceAttributeMultiprocessorCount, dev) != hipSuccess) { grid = -1; return; }
        if (hipFuncSetAttribute((const void*)mk_fwd, hipFuncAttributeMaxDynamicSharedMemorySize, LDS_BYTES) != hipSuccess) { fprintf(stderr, "kernel_launch: hipFuncSetAttribute failed\n"); grid = -1; return; }
        if (hipOccupancyMaxActiveBlocksPerMultiprocessor(&per_cu, (const void*)mk_fwd, NWAVES * 64, LDS_BYTES) != hipSuccess || per_cu < 1) fprintf(stderr, "kernel_launch: occupancy query says %d\n", per_cu);
        (void)hipGetLastError();
        grid = cus;
    }
    if (grid < 0) return;
    if (hipMemsetAsync((char*)d_ws + WS_CTL, 0, CTL_ZERO_BYTES, stream) != hipSuccess) return;
    Args a{};
    for (int i = 0; i < 35; ++i) a.in[i] = d_in[i];
    a.out = (float*)d_out; a.ws = (unsigned char*)d_ws; a.k_q = 384; a.k_kv = 256; a.pad = 0;
#if MK_ONE_LAUNCH
    a.ph_lo = 0; a.ph_hi = N_PHASE_IDS; a.use_bar = 1;
    hipLaunchKernelGGL(mk_fwd, dim3(grid), dim3(NWAVES * 64), LDS_BYTES, stream, a);
#else
    for (int id = 0; id < N_PHASE_IDS; ++id) {
        if (id >= 2 && id < 42) { const int i = (id - 2) / 10, k = (id - 2) % 10; if (k >= 3 && (i & 1)) continue; if (k == 8 && i == 0) continue; }
        a.ph_lo = id; a.ph_hi = id + 1; a.use_bar = 0;
        hipLaunchKernelGGL(mk_fwd, dim3(grid), dim3(NWAVES * 64), LDS_BYTES, stream, a);
    }
#endif
}
```

```cpp
#include <hip/hip_runtime.h>
#include <cstdio>
#include <cstdint>
#define GAS __attribute__((address_space(1)))
#define LAS __attribute__((address_space(3)))
constexpr int DM = 1024, MP = 16384, MS = 512, MT = MP + MS, TP = 8192, NBAT = 130, FF = 2816;
constexpr int MODLD = 18432;
constexpr int ZE = 2304, ZO = 1792;
constexpr float QSCALE = 0.10206207261596577f * 1.4426950408889634f;
__device__ __forceinline__ int bidx(int row) { return row < MP ? (row >> 13) : 2 + ((row - MP) >> 2); }
__device__ __forceinline__ int posof(int row) { return row < MP ? (row & (TP - 1)) : TP + ((row - MP) & 3); }
__device__ __forceinline__ float bf2f(unsigned short b) { return __uint_as_float(((unsigned)b) << 16); }
__device__ __forceinline__ unsigned f2bf(float f) { unsigned u = __builtin_bit_cast(unsigned, f); return (u + 0x7fffu + ((u >> 16) & 1u)) >> 16; }
__device__ __forceinline__ unsigned pk2(float lo, float hi) { return f2bf(lo) | (f2bf(hi) << 16); }
__device__ __forceinline__ float sigmoidf_(float x) { return 1.0f / (1.0f + __expf(-x)); }
__device__ __forceinline__ float siluf_(float x) { return x / (1.0f + __expf(-x)); }
namespace pg8 {
#define PG8_LAS __attribute__((address_space(3)))
typedef unsigned short bf16_t;
typedef short bf16x8 __attribute__((ext_vector_type(8)));
typedef float f32x4 __attribute__((ext_vector_type(4)));
typedef unsigned u32x4 __attribute__((ext_vector_type(4)));
constexpr int BM = 256, BK = 64, HALF = 128, HTB = HALF * BK * 2  , STAGE_BYTES = 8 * HTB, NXCD = 8, WGM = 8;

__host__ __device__ __forceinline__ int lds_byte(int r, int c) { const int st = (r >> 4) * 2 + (c >> 5), rr = r & 15, cc = c & 31, ob = rr * 64 + cc * 2; return st * 1024 + (ob ^ (((ob >> 9) & 1) << 5)); }
__host__ __device__ __forceinline__ void stage_rc(int b, int& R, int& C) { const int st = b / 1024, sb = b % 1024, swz = sb ^ (((sb >> 9) & 1) << 5); R = (st >> 1) * 16 + swz / 64; C = (st & 1) * 32 + (swz % 64) / 2; }
__host__ __device__ __forceinline__ int perm32(int rho) { const int n = rho >> 4, i = rho & 15; return 8 * (i >> 2) + 4 * n + (i & 3); }

struct Unit { int pm, pn, koff; };
struct Gemm { const bf16_t* A; const bf16_t* Bt; int M, N, K, lda, ldb; };

struct StaticOrder {
    int nM, nN, nwg, G, c;
    __host__ __device__ void init(int M, int N, int G_, int c_) { nM = M / BM; nN = N / BM; nwg = nM * nN; G = G_; c = c_; }
    __host__ __device__ bool next(int i, Unit& u) const {
        const long L = (long)i * G + c; if (L >= nwg) return false;
        int wgid = (int)L; { const int q = nwg / NXCD, r = nwg % NXCD, xcd = wgid % NXCD, off = wgid / NXCD; wgid = (xcd < r ? xcd * (q + 1) : r * (q + 1) + (xcd - r) * q) + off; }
        const int nig = WGM * nN, gid = wgid / nig, fm = gid * WGM, gsz = (nM - fm) < WGM ? (nM - fm) : WGM;
        u.pm = fm + ((wgid % nig) % gsz); u.pn = (wgid % nig) / gsz; u.koff = 0; return true;
    }
    __device__ __forceinline__ void a_ready(const Unit&) const {}
    __device__ __forceinline__ void done(const Unit&) const {}
};
struct SplitKOrder {
    int pm0, nP, nN, nch, kc, G, c;
    __device__ bool next(int i, Unit& u) const { const int j = i * G + c; if (j >= nP * nN * nch) return false; const int ch = j % nch, t = j / nch; u.pn = t % nN; u.pm = pm0 + t / nN; u.koff = ch * kc; return true; }
    __device__ __forceinline__ void a_ready(const Unit&) const {}
    __device__ __forceinline__ void done(const Unit&) const {}
};

__device__ __forceinline__ unsigned cvt_pk_bf16(float lo, float hi) { unsigned r; asm volatile("v_cvt_pk_bf16_f32 %0, %1, %2" : "=v"(r) : "v"(lo), "v"(hi)); return r; }

struct EpiPlain {
    static constexpr bool PERM = true, AFTER_DRAIN = false;
    bf16_t* O; int ldc;
    __device__ __forceinline__ void operator()(const f32x4 (&acc)[2][2][4][2], const Unit& u, int wr, int wc, int fr, int fq) const {
        const int row0 = u.pm * BM + wr * 64 + fr, col0 = u.pn * BM + wc * 32 + 8 * fq;
#pragma unroll
        for (int ai = 0; ai < 2; ++ai)
#pragma unroll
            for (int m = 0; m < 4; ++m) { bf16_t* rowp = O + (size_t)(row0 + ai * HALF + m * 16) * ldc + col0;
#pragma unroll
                for (int bj = 0; bj < 2; ++bj) { const f32x4 v0 = acc[ai][bj][m][0], v1 = acc[ai][bj][m][1];
                    u32x4 w; w.x = cvt_pk_bf16(v0[0], v0[1]); w.y = cvt_pk_bf16(v0[2], v0[3]); w.z = cvt_pk_bf16(v1[0], v1[1]); w.w = cvt_pk_bf16(v1[2], v1[3]);
                    *(u32x4*)(rowp + bj * HALF) = w; } }
    }
};
struct EpiSwiglu {
    static constexpr bool PERM = true, AFTER_DRAIN = false;
    bf16_t* O; int ldc;
    __device__ __forceinline__ void operator()(const f32x4 (&acc)[2][2][4][2], const Unit& u, int wr, int wc, int fr, int fq) const {
        const int row0 = u.pm * BM + wr * 64 + fr, col0 = u.pn * HALF + wc * 32 + 8 * fq;
#pragma unroll
        for (int ai = 0; ai < 2; ++ai)
#pragma unroll
            for (int m = 0; m < 4; ++m) { bf16_t* rowp = O + (size_t)(row0 + ai * HALF + m * 16) * ldc + col0;
                float o[8];
#pragma unroll
                for (int n = 0; n < 2; ++n)
#pragma unroll
                    for (int e = 0; e < 4; ++e) { const float g = acc[ai][0][m][n][e], uu = acc[ai][1][m][n][e]; o[n * 4 + e] = siluf_(g) * uu; }
                u32x4 w; w.x = cvt_pk_bf16(o[0], o[1]); w.y = cvt_pk_bf16(o[2], o[3]); w.z = cvt_pk_bf16(o[4], o[5]); w.w = cvt_pk_bf16(o[6], o[7]);
                *(u32x4*)rowp = w; }
    }
};
struct EpiRes {
    static constexpr bool PERM = false, AFTER_DRAIN = false;
    const float* bp; const float* bs; float* out; const float* gate; float coef;
    __device__ __forceinline__ void operator()(const f32x4 (&acc)[2][2][4][2], const Unit& u, int wr, int wc, int fr, int fq) const {
#pragma unroll
        for (int ai = 0; ai < 2; ++ai)
#pragma unroll
            for (int m = 0; m < 4; ++m) { const int row = u.pm * BM + ai * HALF + wr * 64 + m * 16 + fr; const int b = bidx(row);
                const float* base = (row < MP ? bp : bs) + (size_t)row * DM; const float* gr = gate + (size_t)b * MODLD; float* orow = out + (size_t)row * DM;
#pragma unroll
                for (int bj = 0; bj < 2; ++bj)
#pragma unroll
                    for (int n = 0; n < 2; ++n) { const int col = u.pn * BM + bj * HALF + wc * 32 + n * 16 + 4 * fq;
                        const f32x4 xin = *(const f32x4*)(base + col), g = *(const f32x4*)(gr + col);
                        *(f32x4*)(orow + col) = xin + (g * coef) * acc[ai][bj][m][n]; } }
    }
};
struct EpiPartial {
    static constexpr bool PERM = false, AFTER_DRAIN = false;
    float* slab;
    __device__ __forceinline__ void operator()(const f32x4 (&acc)[2][2][4][2], const Unit& u, int wr, int wc, int fr, int fq) const {
        float* sb = slab + (size_t)(u.koff >> 8) * (MS * DM);
#pragma unroll
        for (int ai = 0; ai < 2; ++ai)
#pragma unroll
            for (int m = 0; m < 4; ++m) { const int row = u.pm * BM + ai * HALF + wr * 64 + m * 16 + fr - MP; float* orow = sb + (size_t)row * DM;
#pragma unroll
                for (int bj = 0; bj < 2; ++bj)
#pragma unroll
                    for (int n = 0; n < 2; ++n) { const int col = u.pn * BM + bj * HALF + wc * 32 + n * 16 + 4 * fq; *(f32x4*)(orow + col) = acc[ai][bj][m][n]; } }
    }
};
struct EpiMod {
    static constexpr bool PERM = false, AFTER_DRAIN = false;
    float* out; const float* bias;
    __device__ __forceinline__ void operator()(const f32x4 (&acc)[2][2][4][2], const Unit& u, int wr, int wc, int fr, int fq) const {
#pragma unroll
        for (int ai = 0; ai < 2; ++ai)
#pragma unroll
            for (int m = 0; m < 4; ++m) { const int row = u.pm * BM + ai * HALF + wr * 64 + m * 16 + fr; float* orow = out + (size_t)row * MODLD;
#pragma unroll
                for (int bj = 0; bj < 2; ++bj)
#pragma unroll
                    for (int n = 0; n < 2; ++n) { const int col = u.pn * BM + bj * HALF + wc * 32 + n * 16 + 4 * fq;
                        *(f32x4*)(orow + col) = acc[ai][bj][m][n] + *(const f32x4*)(bias + col); } }
    }
};
struct EpiQ {
    static constexpr bool PERM = false, AFTER_DRAIN = false;
    bf16_t* O; const float* rt;
    __device__ __forceinline__ void operator()(const f32x4 (&acc)[2][2][4][2], const Unit& u, int wr, int wc, int fr, int fq) const {
        typedef unsigned u32x2 __attribute__((ext_vector_type(2)));
#pragma unroll
        for (int ai = 0; ai < 2; ++ai)
#pragma unroll
            for (int m = 0; m < 4; ++m) { const int row = u.pm * BM + ai * HALF + wr * 64 + m * 16 + fr; const int pos = posof(row);
                const float* rtp = rt + (size_t)pos * 32 + 8 * fq;
#pragma unroll
                for (int bj = 0; bj < 2; ++bj) { const int gc0 = u.pn * BM + bj * HALF + wc * 32; const bool isrope = (gc0 % 96) == 64;
                    f32x4 v0 = acc[ai][bj][m][0] * QSCALE, v1 = acc[ai][bj][m][1] * QSCALE;
                    if (isrope) { const f32x4 cs0 = *(const f32x4*)(rtp), cs1 = *(const f32x4*)(rtp + 4);
                        const float c[4] = {cs0[0], cs0[2], cs1[0], cs1[2]}, s[4] = {cs0[1], cs0[3], cs1[1], cs1[3]};
                        f32x4 a, b;
#pragma unroll
                        for (int e = 0; e < 4; ++e) { a[e] = v0[e] * c[e] - v1[e] * s[e]; b[e] = v1[e] * c[e] + v0[e] * s[e]; }
                        v0 = a; v1 = b; }
                    bf16_t* p = O + (size_t)row * 768 + gc0 + 4 * fq;
                    u32x2 w0; w0.x = cvt_pk_bf16(v0[0], v0[1]); w0.y = cvt_pk_bf16(v0[2], v0[3]); *(u32x2*)p = w0;
                    u32x2 w1; w1.x = cvt_pk_bf16(v1[0], v1[1]); w1.y = cvt_pk_bf16(v1[2], v1[3]); *(u32x2*)(p + 16) = w1; }
                asm volatile("" ::: "memory"); }
    }
};

template <class Epi, class Sched, bool ALIGN_EPI = false, bool SP2 = false>
__device__ __forceinline__ void gemm_phase(PG8_LAS unsigned char* lds, const Gemm g, const Sched& S, const Epi& E) {
    int tid = threadIdx.x; asm volatile("" : "+v"(tid));
    const int wid = __builtin_amdgcn_readfirstlane(tid >> 6), lane = tid & 63, wr = wid >> 2, wc = wid & 3, fr = lane & 15, fq = lane >> 4;
    const int K = g.K, nt = K / BK;
    unsigned voffA[2], voffB[2];
#pragma unroll
    for (int i = 0; i < 2; ++i) { int R, C; stage_rc(tid * 16 + i * 8192, R, C); const int Rb = Epi::PERM ? ((R & ~31) + perm32(R & 31)) : R;
        voffA[i] = (unsigned)(R * g.lda + C) * 2u; voffB[i] = (unsigned)(Rb * g.ldb + C) * 2u; }
    const size_t kstep = (size_t)(BK * 2);
    const int lda = g.lda, ldb = g.ldb;
    const size_t hstepA = (size_t)HALF * lda * 2, hstepB = (size_t)HALF * ldb * 2;
    const size_t tstepA = 2 * hstepA, tstepB = 2 * hstepB;
    const unsigned ldsw = (unsigned)wid * 1024u;
    const int aoff = lds_byte(wr * 64 + fr, fq * 8), boff = lds_byte(wc * 32 + fr, fq * 8);
#define PG8_SA(b, h) (((b) * 2 + (h)) * HTB)
#define PG8_SB(b, h) ((4 + (b) * 2 + (h)) * HTB)
#define PG8_STAGE(bufoff, gbase, voff) do { _Pragma("unroll") for (int _i = 0; _i < 2; ++_i) \
        __builtin_amdgcn_global_load_lds((const unsigned*)((const char*)(gbase) + (voff)[_i]), (PG8_LAS unsigned*)(lds + (bufoff) + ldsw + _i * 8192), 16, 0, 0); } while (0)
#define PG8_LDA(dst, b, h) do { _Pragma("unroll") for (int m = 0; m < 4; ++m) _Pragma("unroll") for (int k = 0; k < 2; ++k) dst[m][k] = *(const PG8_LAS bf16x8*)(lds + PG8_SA(b, h) + aoff + m * 2048 + k * 1024); } while (0)
#define PG8_LDB(dst, b, h) do { _Pragma("unroll") for (int n = 0; n < 2; ++n) _Pragma("unroll") for (int k = 0; k < 2; ++k) dst[n][k] = *(const PG8_LAS bf16x8*)(lds + PG8_SB(b, h) + boff + n * 2048 + k * 1024); } while (0)
#define PG8_MMA(ai, bj, At, Bt) do { __builtin_amdgcn_s_setprio(1); _Pragma("unroll") for (int m = 0; m < 4; ++m) _Pragma("unroll") for (int n = 0; n < 2; ++n) _Pragma("unroll") for (int k = 0; k < 2; ++k) \
        acc[ai][bj][m][n] = __builtin_amdgcn_mfma_f32_16x16x32_bf16(Bt[n][k], At[m][k], acc[ai][bj][m][n], 0, 0, 0); __builtin_amdgcn_s_setprio(0); } while (0)
#define PG8_WAIT_V(n) asm volatile("s_waitcnt vmcnt(" #n ")" ::: "memory")
#define PG8_WAIT_L(n) asm volatile("s_waitcnt lgkmcnt(" #n ")" ::: "memory")
#define PG8_BAR __builtin_amdgcn_s_barrier()
#define PG8_SCHED __builtin_amdgcn_sched_barrier(0)
    Unit cur, nxt; int ui = 0;
    if (!S.next(0, cur)) return;
    f32x4 acc[2][2][4][2];
#pragma unroll
    for (int a = 0; a < 2; ++a)
#pragma unroll
        for (int b = 0; b < 2; ++b)
#pragma unroll
            for (int m = 0; m < 4; ++m)
#pragma unroll
                for (int n = 0; n < 2; ++n) acc[a][b][m][n] = (f32x4){0.f, 0.f, 0.f, 0.f};
    bf16x8 At[4][2], B0[2][2], B1[2][2];
    const char* cA = (const char*)g.A + (size_t)cur.pm * tstepA + (size_t)cur.koff * 2; const char* cB = (const char*)g.Bt + (size_t)cur.pn * tstepB + (size_t)cur.koff * 2;
    S.a_ready(cur);
    if constexpr (SP2) {
        PG8_STAGE(PG8_SB(0, 0), cB, voffB); PG8_STAGE(PG8_SB(0, 1), cB + hstepB, voffB); PG8_STAGE(PG8_SA(0, 0), cA, voffA); PG8_STAGE(PG8_SA(0, 1), cA + hstepA, voffA);
        if (wr == 1) PG8_BAR;
        PG8_WAIT_V(2); PG8_BAR;
        PG8_STAGE(PG8_SB(1, 0), cB + kstep, voffB); PG8_STAGE(PG8_SA(1, 0), cA + kstep, voffA); PG8_STAGE(PG8_SB(1, 1), cB + hstepB + kstep, voffB);
        PG8_WAIT_V(6); PG8_BAR;
    } else {
        PG8_STAGE(PG8_SB(0, 0), cB, voffB); PG8_STAGE(PG8_SA(0, 0), cA, voffA); PG8_STAGE(PG8_SB(0, 1), cB + hstepB, voffB); PG8_STAGE(PG8_SA(0, 1), cA + hstepA, voffA);
        if (wr == 1) PG8_BAR;
        PG8_WAIT_V(4); PG8_BAR;
        PG8_STAGE(PG8_SB(1, 0), cB + kstep, voffB); PG8_STAGE(PG8_SA(1, 0), cA + kstep, voffA); PG8_STAGE(PG8_SB(1, 1), cB + hstepB + kstep, voffB);
        PG8_WAIT_V(6); PG8_BAR;
    }
    for (;;) {
        const bool has_next = S.next(ui + 1, nxt);
        const char* nA = has_next ? (const char*)g.A + (size_t)nxt.pm * tstepA + (size_t)nxt.koff * 2 : cA; const char* nB = has_next ? (const char*)g.Bt + (size_t)nxt.pn * tstepB + (size_t)nxt.koff * 2 : cB;
        for (int t = 0; t < nt; t += 2) {
            const bool last = (t == nt - 2);
            const char* a1 = cA + (size_t)(t + 1) * kstep;
            const char* a2 = last ? nA : cA + (size_t)(t + 2) * kstep; const char* b2 = last ? nB : cB + (size_t)(t + 2) * kstep;
            const char* a3 = a2 + kstep; const char* b3 = b2 + kstep;
            if (last && has_next) S.a_ready(nxt);
            if constexpr (SP2) {
            PG8_LDB(B0, 0, 0); PG8_LDB(B1, 0, 1); PG8_SCHED; PG8_LDA(At, 0, 0); PG8_STAGE(PG8_SA(1, 1), a1 + hstepA, voffA);
            PG8_WAIT_V(8); PG8_WAIT_L(0); PG8_BAR; PG8_MMA(0, 0, At, B0); PG8_MMA(0, 1, At, B1); PG8_BAR; PG8_SCHED;
            PG8_LDA(At, 0, 1); PG8_STAGE(PG8_SB(0, 0), b2, voffB); PG8_STAGE(PG8_SB(0, 1), b2 + hstepB, voffB); PG8_STAGE(PG8_SA(0, 0), a2, voffA);
            PG8_WAIT_V(8); PG8_WAIT_L(0); PG8_BAR; PG8_MMA(1, 0, At, B0); PG8_MMA(1, 1, At, B1); PG8_BAR; PG8_SCHED;
            PG8_LDB(B0, 1, 0); PG8_LDB(B1, 1, 1); PG8_SCHED; PG8_LDA(At, 1, 0); PG8_STAGE(PG8_SA(0, 1), a2 + hstepA, voffA);
            PG8_WAIT_V(8); PG8_WAIT_L(0); PG8_BAR; PG8_MMA(0, 0, At, B0); PG8_MMA(0, 1, At, B1); PG8_BAR; PG8_SCHED;
            PG8_LDA(At, 1, 1); PG8_STAGE(PG8_SB(1, 0), b3, voffB); PG8_STAGE(PG8_SB(1, 1), b3 + hstepB, voffB); PG8_STAGE(PG8_SA(1, 0), a3, voffA);
            PG8_WAIT_V(8); PG8_WAIT_L(0); PG8_BAR; PG8_MMA(1, 0, At, B0); PG8_MMA(1, 1, At, B1); PG8_BAR; PG8_SCHED;
            } else {
            PG8_LDB(B0, 0, 0); PG8_SCHED; PG8_LDA(At, 0, 0); PG8_STAGE(PG8_SA(1, 1), a1 + hstepA, voffA);
            PG8_WAIT_L(8); PG8_BAR; PG8_WAIT_L(0); PG8_MMA(0, 0, At, B0); PG8_BAR; PG8_SCHED;
            PG8_LDB(B1, 0, 1); PG8_STAGE(PG8_SB(0, 0), b2, voffB);
            PG8_BAR; PG8_WAIT_L(0); PG8_MMA(0, 1, At, B1); PG8_BAR;
            PG8_LDA(At, 0, 1); PG8_STAGE(PG8_SA(0, 0), a2, voffA);
            PG8_BAR; PG8_WAIT_L(0); PG8_MMA(1, 0, At, B0); PG8_BAR; PG8_SCHED;
            PG8_STAGE(PG8_SB(0, 1), b2 + hstepB, voffB);
            PG8_WAIT_V(6); PG8_BAR; PG8_MMA(1, 1, At, B1); PG8_BAR;
            PG8_LDB(B0, 1, 0); PG8_SCHED; PG8_LDA(At, 1, 0); PG8_STAGE(PG8_SA(0, 1), a2 + hstepA, voffA);
            PG8_WAIT_L(8); PG8_BAR; PG8_WAIT_L(0); PG8_MMA(0, 0, At, B0); PG8_BAR; PG8_SCHED;
            PG8_LDB(B1, 1, 1); PG8_STAGE(PG8_SB(1, 0), b3, voffB);
            PG8_BAR; PG8_WAIT_L(0); PG8_MMA(0, 1, At, B1); PG8_BAR;
            PG8_LDA(At, 1, 1); PG8_STAGE(PG8_SA(1, 0), a3, voffA);
            PG8_BAR; PG8_WAIT_L(0); PG8_MMA(1, 0, At, B0); PG8_BAR; PG8_SCHED;
            PG8_STAGE(PG8_SB(1, 1), b3 + hstepB, voffB);
            PG8_WAIT_V(6); PG8_BAR; PG8_MMA(1, 1, At, B1); PG8_BAR;
            }
        }
        if constexpr (ALIGN_EPI) { if (wr == 0) PG8_BAR; }
        if constexpr (!Epi::AFTER_DRAIN) { E(acc, cur, wr, wc, fr, fq); S.done(cur); }
        if (!has_next) break;
#pragma unroll
        for (int a = 0; a < 2; ++a)
#pragma unroll
            for (int b = 0; b < 2; ++b)
#pragma unroll
                for (int m = 0; m < 4; ++m)
#pragma unroll
                    for (int n = 0; n < 2; ++n) acc[a][b][m][n] = (f32x4){0.f, 0.f, 0.f, 0.f};
        cur = nxt; cA = nA; cB = nB; ++ui;
        if constexpr (ALIGN_EPI) { if (wr == 1) PG8_BAR; }
    }
    PG8_WAIT_V(0);
    if constexpr (!ALIGN_EPI) { if (wr == 0) PG8_BAR; }
    PG8_BAR;
    if constexpr (Epi::AFTER_DRAIN) { E.fused(acc, cur, wr, wc, fr, fq, lds, wid, lane); S.done(cur); }
#undef PG8_SA
#undef PG8_SB
#undef PG8_STAGE
#undef PG8_LDA
#undef PG8_LDB
#undef PG8_MMA
#undef PG8_WAIT_V
#undef PG8_WAIT_L
#undef PG8_BAR
#undef PG8_SCHED
}
}
constexpr size_t MiB = 1u << 20;
constexpr size_t WS_CTL = 0, CTL_ZERO_BYTES = 1 * MiB;
constexpr size_t WS_W13T = 2 * MiB, W13T_STRIDE = 11 * MiB;
constexpr size_t WS_W2T = 46 * MiB, W2T_STRIDE = 5767168;
constexpr size_t WS_EVIN = 68 * MiB, WS_EVOUT = 73 * MiB, WS_ODIN = 75 * MiB, WS_ODOUT = 79 * MiB, WS_WUQ = 81 * MiB, WS_WKV = 82 * MiB;
constexpr size_t WS_ADAT = 83 * MiB, WS_SC = 119 * MiB, WS_RT = 120 * MiB, WS_MOD = 122 * MiB;
constexpr size_t WS_X = 140 * MiB, WS_H = 206 * MiB, WS_ACT = 239 * MiB, WS_Z = 330 * MiB, WS_OP = 405 * MiB;
constexpr size_t WS_US = 438 * MiB, WS_DS = 470 * MiB, WS_CQN = 471 * MiB, WS_CKVB = 484 * MiB, WS_KRB = 493 * MiB, WS_Q = 495 * MiB, WS_KV = 520 * MiB;
constexpr size_t WS_PART = 552 * MiB, WS_QD = 586 * MiB, WS_SLAB = 592 * MiB, WS_DUMMY = 616 * MiB, WS_END = 682 * MiB;
constexpr int NSPLIT = 8, PART_F = 32 * 256 + 64;
constexpr size_t O_Y = 0, O_GLAP = 17301504, O_GLAS = O_GLAP + 65536, O_POOLP = O_GLAS + 4194304, O_POOLS = O_POOLP + 15360, O_CKV = O_POOLS + 983040,
                 O_KR = O_CKV + 4325376, O_CONVP = O_KR + 540672, O_CONVS = O_CONVP + 30720, O_END = O_CONVS + 1966080;
constexpr int CW_TMO = 0, CW_CODE = 1, CW_BAR = 4096;
constexpr int RING_BYTES = 131072, LDSCTL_OFF = RING_BYTES, MISC_OFF = LDSCTL_OFF + 320, LDS_BYTES = 147456;
constexpr int NWAVES = 8;

typedef unsigned short bf16;
typedef unsigned v4u __attribute__((ext_vector_type(4)));
typedef unsigned v2u __attribute__((ext_vector_type(2)));
typedef float f32x4 __attribute__((ext_vector_type(4)));
typedef float f32x2 __attribute__((ext_vector_type(2)));
typedef float f32x16 __attribute__((ext_vector_type(16)));
typedef short bf16x8 __attribute__((ext_vector_type(8)));
typedef short s16x4 __attribute__((ext_vector_type(4)));
typedef GAS unsigned gu32;
#define RLX_AGENT __ATOMIC_RELAXED, __HIP_MEMORY_SCOPE_AGENT
#define LDS_WAIT() asm volatile("s_waitcnt lgkmcnt(0)" ::: "memory")
#define VM_WAIT() asm volatile("s_waitcnt vmcnt(0)" ::: "memory")


#ifndef PROBE_DUP
#define PROBE_DUP 0u
#endif
__device__ __forceinline__ int opaque_int(int v) { asm volatile("" : "+s"(v)); return v; }
#define NREP(n) ((((PROBE_DUP) >> (n)) & 1u) ? opaque_int(2) : 1)

#define XB_TMO      128
#define XB_XCNT(j)  (256  + 64 * (j))
#define XB_XSUB(j)  (1280 + 64 * (j))
#define XB_XGEN(j)  (2304 + 64 * (j))
#define XB_TOP      3328
#define XB_TOPGEN   3392
#define XCD_BAR_WORDS 3456
#define XB_SPIN_CAP (1u << 18)

__device__ __forceinline__ unsigned xb_ld(unsigned* p)              { return __hip_atomic_load(p, __ATOMIC_RELAXED, __HIP_MEMORY_SCOPE_AGENT); }
__device__ __forceinline__ unsigned xb_add(unsigned* p, unsigned v) { return __hip_atomic_fetch_add(p, v, __ATOMIC_RELAXED, __HIP_MEMORY_SCOPE_AGENT); }
__device__ __forceinline__ unsigned xb_xcc_id() { return (unsigned)__builtin_amdgcn_s_getreg((3 << 11) | 20) & 0xFu; }
#define XB_SPIN(cond, bar) do { unsigned _sp = 0; while (cond) { __builtin_amdgcn_s_sleep(1); \
    if ((++_sp & 255u) == 0u) { if (xb_ld(&(bar)[XB_TMO])) break; if (_sp > XB_SPIN_CAP) { atomicAdd(&(bar)[XB_TMO], 1u); break; } } } } while (0)

struct XcdBarrier {
    unsigned* bar; unsigned x;
    volatile LAS unsigned* st;
};

__device__ __forceinline__ XcdBarrier xcd_barrier_post(unsigned* bar, volatile LAS unsigned* st) {
    XcdBarrier b; b.bar = bar; b.x = xb_xcc_id(); b.st = st;
    if (threadIdx.x == 0) (void)xb_add(&bar[XB_XCNT(b.x)], 1u);
    return b;
}
__device__ __forceinline__ void xcd_barrier_complete(unsigned* bar, unsigned x, unsigned& nloc, unsigned& nx) {
    const unsigned G = gridDim.x * gridDim.y * gridDim.z;
    unsigned sum, cnt, mine, sp = 0u;
    for (;;) {
        sum = 0u; cnt = 0u; mine = 0u;
#pragma unroll
        for (unsigned j = 0; j < 16; ++j) { const unsigned c = xb_ld(&bar[XB_XCNT(j)]); sum += c; cnt += (c > 0u) ? 1u : 0u; mine = (j == x) ? c : mine; }
        if (sum == G) break;
        __builtin_amdgcn_s_sleep(1);
        if ((++sp & 255u) == 0u) { if (xb_ld(&bar[XB_TMO])) break; if (sp > XB_SPIN_CAP) { atomicAdd(&bar[XB_TMO], 1u); break; } }
    }
    nloc = mine > 0u ? mine : 1u; nx = cnt > 0u ? cnt : 1u;
}

__device__ __forceinline__ void xcd_barrier(const XcdBarrier& b) {
    asm volatile("s_waitcnt vmcnt(0)" ::: "memory");
    __syncthreads();
    if (threadIdx.x == 0) {
        unsigned* bar = b.bar;
        __builtin_amdgcn_s_waitcnt(0);
        unsigned nloc = b.st[0], nx = b.st[1];
        if (nloc == 0u) { xcd_barrier_complete(bar, b.x, nloc, nx); b.st[0] = nloc; b.st[1] = nx; }
        const unsigned old = xb_add(&bar[XB_XSUB(b.x)], 1u);
        const unsigned gen = old / nloc;
        if (old + 1u == (gen + 1u) * nloc) {
            __builtin_amdgcn_fence(__ATOMIC_RELEASE, "agent");
            asm volatile("s_waitcnt vmcnt(0)" ::: "memory");
            const unsigned og = xb_add(&bar[XB_TOP], 1u);
            const unsigned tg = og / nx;
            if (og + 1u == (tg + 1u) * nx) xb_add(&bar[XB_TOPGEN], 1u);
            else XB_SPIN(xb_ld(&bar[XB_TOPGEN]) == tg, bar);
            __builtin_amdgcn_fence(__ATOMIC_ACQUIRE, "agent");
            xb_add(&bar[XB_XGEN(b.x)], 1u);
            asm volatile("s_waitcnt vmcnt(0)" ::: "memory");
        } else {
            XB_SPIN(xb_ld(&bar[XB_XGEN(b.x)]) == gen, bar);
            __builtin_amdgcn_fence(__ATOMIC_ACQUIRE, "agent");
            asm volatile("s_waitcnt vmcnt(0)" ::: "memory");
        }
    }
    __syncthreads();
}
struct Args { const void* in[35]; float* out; unsigned char* ws; int ph_lo, ph_hi, use_bar, k_q, k_kv, pad; };
struct Frame {
    LAS unsigned char* lds;
    volatile LAS unsigned* MISC;
    gu32* ctl;
    int tid, lane, wave, G, bx;
    unsigned char* ws; float* out;
};
__device__ __forceinline__ float wave_sum(float v) {
#pragma unroll
    for (int o = 1; o < 64; o <<= 1) v += __shfl_xor(v, o);
    return v;
}
__device__ __forceinline__ float half_sum(float v) {
#pragma unroll
    for (int o = 1; o < 32; o <<= 1) v += __shfl_xor(v, o);
    return v;
}
#define WS_PTR(T, off) ((T*)(F.ws + (off)))

enum { RM_ID = 0, RM_W1 = 1, RM_W3 = 2, RM_EVIN = 3 };
__device__ __forceinline__ int map_row(int mode, int n) {
    if (mode == RM_W1) return 256 * (n >> 7) + (n & 127);
    if (mode == RM_W3) return 256 * (n >> 7) + 128 + (n & 127);
    if (mode == RM_EVIN) return n < 1536 ? n : (n < 1552 ? 2048 + (n - 1536) : 1536 + (n - 1552));
    return n;
}
__device__ __forceinline__ void p0_transpose_item(const float* W, int N, bf16* WT, int ldk, int mode, LAS float* scr, int item, int lane) {
    const int nblk = (N + 31) / 32, kb = item / nblk, nb = item % nblk, k0 = 64 * kb, n0 = 32 * nb;
    const bool okc = (n0 + (lane & 31)) < N;
    float tv[32];
#pragma unroll
    for (int i = 0; i < 32; ++i) { const int kk = 2 * i + (lane >> 5); tv[i] = okc ? __builtin_nontemporal_load(W + (size_t)(k0 + kk) * N + n0 + (lane & 31)) : 0.f; }
#pragma unroll
    for (int i = 0; i < 32; ++i) { const int kk = 2 * i + (lane >> 5); scr[kk * 33 + (lane & 31)] = tv[i]; }
    LDS_WAIT(); asm volatile("" ::: "memory");
    const int c = lane & 7;
#pragma unroll
    for (int j = 0; j < 4; ++j) { const int n = (lane >> 3) + 8 * j; const LAS float* s = scr + (8 * c) * 33 + n;
        v4u o; o.x = pk2(s[0 * 33], s[1 * 33]); o.y = pk2(s[2 * 33], s[3 * 33]); o.z = pk2(s[4 * 33], s[5 * 33]); o.w = pk2(s[6 * 33], s[7 * 33]);
        if (n0 + n < N) *(GAS v4u*)(WT + (size_t)map_row(mode, n0 + n) * ldk + k0 + 8 * c) = o; }
    LDS_WAIT(); asm volatile("" ::: "memory");
}
__device__ __forceinline__ void p0_prologue(Frame& F, const Args& A) {
    LAS float* scr = (LAS float*)(F.lds + F.wave * 16384);
    const int gw = F.bx * NWAVES + F.wave, NGW = F.G * NWAVES;
    const float* ffn_w1 = (const float*)A.in[13]; const float* ffn_w3 = (const float*)A.in[14]; const float* ffn_w2 = (const float*)A.in[15];
    const float* ev_w_in = (const float*)A.in[16]; const float* ev_w_out = (const float*)A.in[22]; const float* od_w_in = (const float*)A.in[23]; const float* od_w_out = (const float*)A.in[33];
    const float* w_uq = (const float*)A.in[25]; const float* w_uk = (const float*)A.in[27]; const float* w_uv = (const float*)A.in[28]; const float* ada_w = (const float*)A.in[10];
    constexpr int I_W1 = 16 * 88, I_W2 = 44 * 32, I_FFN = 2 * I_W1 + I_W2;
    constexpr int I_EVIN = 16 * 65, I_EVOUT = 8 * 32, I_ODIN = 16 * 53, I_ODOUT = 16 * 32, I_UQ = 6 * 24, I_UK = 4 * 16, I_ADA = 16 * 288;
    constexpr int NITEMS = 4 * I_FFN + I_EVIN + I_EVOUT + I_ODIN + I_ODOUT + I_UQ + 2 * I_UK + 2 * I_ADA;
    for (int it = gw; it < NITEMS; it += NGW) {
        int r = it;
        if (r < 4 * I_FFN) { const int i = r / I_FFN; r -= i * I_FFN;
            bf16* w13 = WS_PTR(bf16, WS_W13T + (size_t)i * W13T_STRIDE); bf16* w2 = WS_PTR(bf16, WS_W2T + (size_t)i * W2T_STRIDE);
            if (r < I_W1) { p0_transpose_item(ffn_w1 + (size_t)i * DM * FF, FF, w13, DM, RM_W1, scr, r, F.lane); continue; } r -= I_W1;
            if (r < I_W1) { p0_transpose_item(ffn_w3 + (size_t)i * DM * FF, FF, w13, DM, RM_W3, scr, r, F.lane); continue; } r -= I_W1;
            p0_transpose_item(ffn_w2 + (size_t)i * FF * DM, DM, w2, FF, RM_ID, scr, r, F.lane); continue; }
        r -= 4 * I_FFN;
        if (r < I_EVIN) { p0_transpose_item(ev_w_in, 2064, WS_PTR(bf16, WS_EVIN), DM, RM_EVIN, scr, r, F.lane); continue; } r -= I_EVIN;
        if (r < I_EVOUT) { p0_transpose_item(ev_w_out, DM, WS_PTR(bf16, WS_EVOUT), DM, RM_ID, scr, r, F.lane); continue; } r -= I_EVOUT;
        if (r < I_ODIN) { p0_transpose_item(od_w_in, 1696, WS_PTR(bf16, WS_ODIN), DM, RM_ID, scr, r, F.lane); continue; } r -= I_ODIN;
        if (r < I_ODOUT) { p0_transpose_item(od_w_out, DM, WS_PTR(bf16, WS_ODOUT), DM, RM_ID, scr, r, F.lane); continue; } r -= I_ODOUT;
        if (r < I_UQ) { p0_transpose_item(w_uq, 768, WS_PTR(bf16, WS_WUQ), 384, RM_ID, scr, r, F.lane); continue; } r -= I_UQ;
        if (r < I_UK) { p0_transpose_item(w_uk, 512, WS_PTR(bf16, WS_WKV), 256, RM_ID, scr, r, F.lane); continue; } r -= I_UK;
        if (r < I_UK) { p0_transpose_item(w_uv, 512, WS_PTR(bf16, WS_WKV) + 512 * 256, 256, RM_ID, scr, r, F.lane); continue; } r -= I_UK;
        { const int l = r / I_ADA; r -= l * I_ADA; p0_transpose_item(ada_w + (size_t)l * DM * 9216, 9216, WS_PTR(bf16, WS_ADAT) + (size_t)l * 9216 * DM, DM, RM_ID, scr, r, F.lane); }
    }
    { constexpr int NZ = (240 + 96) * (DM / 8);
      for (int i = F.bx * 512 + F.tid; i < NZ; i += F.G * 512) { const int rr = i / (DM / 8), c8 = i % (DM / 8);
          bf16* dst = rr < 240 ? WS_PTR(bf16, WS_EVIN) + (size_t)(2064 + rr) * DM : WS_PTR(bf16, WS_ODIN) + (size_t)(1696 + rr - 240) * DM;
          *(GAS v4u*)(dst + c8 * 8) = (v4u){0u, 0u, 0u, 0u}; } }
    { const float* pool_w = (const float*)A.in[20]; const float* pool_scale = (const float*)A.in[21]; bf16* evo = WS_PTR(bf16, WS_EVOUT);
      for (int it = gw; it < 512; it += NGW) { const int g = it >> 7, c = it & 127;
          f32x4 acc[4] = {{0.f, 0.f, 0.f, 0.f}, {0.f, 0.f, 0.f, 0.f}, {0.f, 0.f, 0.f, 0.f}, {0.f, 0.f, 0.f, 0.f}};
          for (int d = 0; d < 128; ++d) { const float a = pool_w[(size_t)(g * 128 + c) * 128 + d] * pool_scale[g * 128 + d];
              const float* wr = ev_w_out + (size_t)(512 + g * 128 + d) * DM + 4 * F.lane;
#pragma unroll
              for (int j = 0; j < 4; ++j) acc[j] += a * *(const f32x4*)(wr + 256 * j); }
#pragma unroll
          for (int j = 0; j < 4; ++j)
#pragma unroll
              for (int e = 0; e < 4; ++e) evo[(size_t)(256 * j + 4 * F.lane + e) * DM + 512 + g * 128 + c] = (bf16)f2bf(acc[j][e]); } }
    { const float* cp = (const float*)A.in[8]; const float* cs = (const float*)A.in[9]; bf16* sc = WS_PTR(bf16, WS_SC);
      for (int r = gw; r < 256; r += NGW) { const float* src = r < 2 ? cp + (size_t)r * DM : cs + (size_t)(r - 2) * DM;
#pragma unroll
          for (int j = 0; j < 4; ++j) { f32x4 v = {0.f, 0.f, 0.f, 0.f}; if (r < NBAT) v = *(const f32x4*)(src + 4 * F.lane + 256 * j);
              v2u o; o.x = r < NBAT ? pk2(siluf_(v[0]), siluf_(v[1])) : 0u; o.y = r < NBAT ? pk2(siluf_(v[2]), siluf_(v[3])) : 0u;
              *(GAS v2u*)(sc + (size_t)r * DM + 4 * F.lane + 256 * j) = o; } } }
    { const f32x4* xs = (const f32x4*)A.in[1]; f32x4* xd = (f32x4*)(WS_PTR(float, WS_X) + (size_t)MP * DM);
      for (int i = F.bx * 512 + F.tid; i < MS * DM / 4; i += F.G * 512) xd[i] = xs[i]; }
    { float* rt = WS_PTR(float, WS_RT);
      for (int i = F.bx * 512 + F.tid; i < 8196 * 16; i += F.G * 512) { const int pos = i >> 4, k = i & 15;
          const float freq = exp2f(-(float)k * 0.8304820237218406f);    const float ang = (float)pos * freq; float s, c; sincosf(ang, &s, &c);
          *(f32x2*)(rt + 2 * (size_t)i) = (f32x2){c, s}; } }
}

__device__ __forceinline__ void nm_phase(Frame& F, const float* bp, const float* bs, const float* g, const float* modsh, bf16* H, float* X, const float* slab, int nch, const float* pgate, float pcoef) {
    const int gw = F.bx * NWAVES + F.wave, NGW = F.G * NWAVES;
    f32x4 gv[4];
#pragma unroll
    for (int j = 0; j < 4; ++j) gv[j] = *(const f32x4*)(g + 4 * F.lane + 256 * j);
    for (int row = gw; row < MT; row += NGW) {
        const float* xr = (row < MP ? bp : bs) + (size_t)row * DM + 4 * F.lane;
        f32x4 v[4]; float ss = 0.f;
#pragma unroll
        for (int j = 0; j < 4; ++j) v[j] = *(const f32x4*)(xr + 256 * j);
        if (row >= MP && nch > 0) { f32x4 a[4] = {{0.f, 0.f, 0.f, 0.f}, {0.f, 0.f, 0.f, 0.f}, {0.f, 0.f, 0.f, 0.f}, {0.f, 0.f, 0.f, 0.f}};
            for (int k = 0; k < nch; ++k) { const float* sp = slab + ((size_t)k * MS + (row - MP)) * DM + 4 * F.lane;
#pragma unroll
                for (int j = 0; j < 4; ++j) a[j] += *(const f32x4*)(sp + 256 * j); }
            const float* gp = pgate + (size_t)bidx(row) * MODLD + 4 * F.lane;
#pragma unroll
            for (int j = 0; j < 4; ++j) { v[j] += (*(const f32x4*)(gp + 256 * j) * pcoef) * a[j]; *(f32x4*)(X + (size_t)row * DM + 4 * F.lane + 256 * j) = v[j]; } }
#pragma unroll
        for (int j = 0; j < 4; ++j) ss += (v[j][0] * v[j][0] + v[j][1] * v[j][1]) + (v[j][2] * v[j][2] + v[j][3] * v[j][3]);
        const float rstd = 1.0f / sqrtf(wave_sum(ss) * (1.0f / DM) + 1e-6f);
        const float* mrow = modsh + (size_t)bidx(row) * MODLD + 4 * F.lane;
#pragma unroll
        for (int j = 0; j < 4; ++j) { const f32x4 sh = *(const f32x4*)(mrow + 256 * j), sc = *(const f32x4*)(mrow + DM + 256 * j);
            const f32x4 h = (v[j] * rstd) * gv[j] * (sc + 1.0f) + sh;
            v2u o; o.x = pk2(h[0], h[1]); o.y = pk2(h[2], h[3]);
            *(GAS v2u*)(H + (size_t)row * DM + 4 * F.lane + 256 * j) = o; }
    }
}
__device__ __forceinline__ void final_phase(Frame& F, const float* X, const float* g, float* out, const float* slab, int nch, const float* pgate, float pcoef) {
    const int gw = F.bx * NWAVES + F.wave, NGW = F.G * NWAVES;
    f32x4 gv[4];
#pragma unroll
    for (int j = 0; j < 4; ++j) gv[j] = *(const f32x4*)(g + 4 * F.lane + 256 * j);
    for (int row = gw; row < MT; row += NGW) {
        const float* xr = X + (size_t)row * DM + 4 * F.lane;
        f32x4 v[4]; float ss = 0.f;
#pragma unroll
        for (int j = 0; j < 4; ++j) v[j] = *(const f32x4*)(xr + 256 * j);
        if (row >= MP) { f32x4 a[4] = {{0.f, 0.f, 0.f, 0.f}, {0.f, 0.f, 0.f, 0.f}, {0.f, 0.f, 0.f, 0.f}, {0.f, 0.f, 0.f, 0.f}};
            for (int k = 0; k < nch; ++k) { const float* sp = slab + ((size_t)k * MS + (row - MP)) * DM + 4 * F.lane;
#pragma unroll
                for (int j = 0; j < 4; ++j) a[j] += *(const f32x4*)(sp + 256 * j); }
            const float* gp = pgate + (size_t)bidx(row) * MODLD + 4 * F.lane;
#pragma unroll
            for (int j = 0; j < 4; ++j) v[j] += (*(const f32x4*)(gp + 256 * j) * pcoef) * a[j]; }
#pragma unroll
        for (int j = 0; j < 4; ++j) ss += (v[j][0] * v[j][0] + v[j][1] * v[j][1]) + (v[j][2] * v[j][2] + v[j][3] * v[j][3]);
        const float rstd = 1.0f / sqrtf(wave_sum(ss) * (1.0f / DM) + 1e-6f);
#pragma unroll
        for (int j = 0; j < 4; ++j) *(f32x4*)(out + (size_t)row * DM + 4 * F.lane + 256 * j) = (v[j] * rstd) * gv[j];
    }
}
__device__ __forceinline__ float logsig16(float x) { return (fminf(x, 0.f) - __logf(1.0f + __expf(-fabsf(x)))) * (1.0f / 16.0f); }
__device__ __forceinline__ void gla_cumdecay(Frame& F, const bf16* Z, int row0, int h, const float* gate_w2, const float* gate_b, LAS float* bcs, LAS float* gl, LAS float* seg) {
    const int tid = F.tid;
    { const int t = tid >> 3, j2 = (tid & 7) * 2; const unsigned w = *(const unsigned*)(Z + (size_t)(row0 + t) * ZE + 2048 + j2);
      gl[t * 16 + j2] = bf2f((unsigned short)(w & 0xffffu)); gl[t * 16 + j2 + 1] = bf2f((unsigned short)(w >> 16)); }
    __syncthreads();
    { const int t = tid >> 3, dk8 = (tid & 7) * 8; float x[8];
      { const f32x4 b0 = *(const f32x4*)(gate_b + h * 64 + dk8), b1 = *(const f32x4*)(gate_b + h * 64 + dk8 + 4);
#pragma unroll
        for (int e = 0; e < 4; ++e) { x[e] = b0[e]; x[4 + e] = b1[e]; } }
#pragma unroll
      for (int j = 0; j < 16; ++j) { const float gv = gl[t * 16 + j]; const f32x4 w0 = *(const f32x4*)(gate_w2 + j * 256 + h * 64 + dk8), w1 = *(const f32x4*)(gate_w2 + j * 256 + h * 64 + dk8 + 4);
#pragma unroll
          for (int e = 0; e < 4; ++e) { x[e] += gv * w0[e]; x[4 + e] += gv * w1[e]; } }
#pragma unroll
      for (int e = 0; e < 8; ++e) bcs[t * 64 + dk8 + e] = logsig16(x[e]); }
    __syncthreads();
    { const int dk = tid & 63, sg = tid >> 6; float run = 0.f;
#pragma unroll
      for (int i = 0; i < 8; ++i) { run += bcs[(sg * 8 + i) * 64 + dk]; bcs[(sg * 8 + i) * 64 + dk] = run; }
      seg[sg * 64 + dk] = run; }
    __syncthreads();
    { const int dk = tid & 63, sg = tid >> 6; float pre = 0.f;
      for (int s = 0; s < sg; ++s) pre += seg[s * 64 + dk];
#pragma unroll
      for (int i = 0; i < 8; ++i) bcs[(sg * 8 + i) * 64 + dk] += pre; }
    __syncthreads();
}
__device__ __forceinline__ void gla_g1_unit(Frame& F, const Args& A, int unit) {
    const bf16* Z = WS_PTR(bf16, WS_Z); float* US = WS_PTR(float, WS_US); float* DS = WS_PTR(float, WS_DS);
    int tid = threadIdx.x; asm volatile("" : "+v"(tid)); F.tid = tid; F.lane = tid & 63; F.wave = __builtin_amdgcn_readfirstlane(tid >> 6);
    const int bh = unit >> 7, n = unit & 127, b = bh >> 2, h = bh & 3, row0 = b * TP + n * 64;
    LAS float* bcs = (LAS float*)F.lds; LAS float* kk = bcs + 4096; LAS float* vv = kk + 4096; LAS float* gl = vv + 8192; LAS float* seg = gl + 1024;
    gla_cumdecay(F, Z, row0, h, (const float*)A.in[17], (const float*)A.in[18], bcs, gl, seg);
    { const int s = tid >> 3, dk8 = (tid & 7) * 8; const v4u kw = *(const v4u*)(Z + (size_t)(row0 + s) * ZE + 256 + h * 64 + dk8);
#pragma unroll
      for (int e = 0; e < 4; ++e) { const unsigned w = kw[e]; const int d0 = dk8 + 2 * e;
          kk[s * 64 + d0] = bf2f((unsigned short)(w & 0xffffu)) * __expf(bcs[63 * 64 + d0] - bcs[s * 64 + d0]);
          kk[s * 64 + d0 + 1] = bf2f((unsigned short)(w >> 16)) * __expf(bcs[63 * 64 + d0 + 1] - bcs[s * 64 + d0 + 1]); }
      const int dv16 = (tid & 7) * 16;
#pragma unroll
      for (int q = 0; q < 2; ++q) { const v4u vw = *(const v4u*)(Z + (size_t)(row0 + s) * ZE + 512 + h * 128 + dv16 + 8 * q);
#pragma unroll
          for (int e = 0; e < 4; ++e) { vv[s * 128 + dv16 + 8 * q + 2 * e] = bf2f((unsigned short)(vw[e] & 0xffffu)); vv[s * 128 + dv16 + 8 * q + 2 * e + 1] = bf2f((unsigned short)(vw[e] >> 16)); } }
      if (tid < 64) DS[(size_t)unit * 64 + tid] = __expf(bcs[63 * 64 + tid]); }
    __syncthreads();
    { const int dkq = tid >> 5, dvq = tid & 31; f32x4 acc[4] = {{0.f, 0.f, 0.f, 0.f}, {0.f, 0.f, 0.f, 0.f}, {0.f, 0.f, 0.f, 0.f}, {0.f, 0.f, 0.f, 0.f}};
#pragma unroll 4
      for (int s = 0; s < 64; ++s) { const f32x4 a = *(const LAS f32x4*)(kk + s * 64 + 4 * dkq), bv = *(const LAS f32x4*)(vv + s * 128 + 4 * dvq);
#pragma unroll
          for (int i = 0; i < 4; ++i) acc[i] += a[i] * bv; }
#pragma unroll
      for (int i = 0; i < 4; ++i) *(f32x4*)(US + ((size_t)unit * 64 + 4 * dkq + i) * 128 + 4 * dvq) = acc[i]; }
    __syncthreads();
}
__device__ __forceinline__ void gla_g2_phase(Frame& F) {
    float* US = WS_PTR(float, WS_US); const float* DS = WS_PTR(float, WS_DS); float* outp = F.out + O_GLAP;
    for (int gid = F.bx * 512 + F.tid; gid < 8 * 8192; gid += F.G * 512) {
        const int bh = gid >> 13, e = gid & 8191, dk = e >> 7;
        float* up = US + (size_t)bh * 128 * 8192 + e; const float* dp = DS + (size_t)bh * 128 * 64 + dk; float S = 0.f;
        for (int n0 = 0; n0 < 128; n0 += 8) { float uu[8], dd[8];
#pragma unroll
            for (int i = 0; i < 8; ++i) { uu[i] = up[(size_t)(n0 + i) * 8192]; dd[i] = dp[(n0 + i) * 64]; }
#pragma unroll
            for (int i = 0; i < 8; ++i) { up[(size_t)(n0 + i) * 8192] = S; S = dd[i] * S + uu[i]; } }
        outp[gid] = S;
    }
}
__device__ __forceinline__ void gla_g3_unit(Frame& F, const Args& A, int unit) {
    const bf16* Z = WS_PTR(bf16, WS_Z); const float* US = WS_PTR(float, WS_US); bf16* OP = WS_PTR(bf16, WS_OP);
    int tid = threadIdx.x; asm volatile("" : "+v"(tid)); F.tid = tid; F.lane = tid & 63; F.wave = __builtin_amdgcn_readfirstlane(tid >> 6);
    const int bh = unit >> 7, n = unit & 127, b = bh >> 2, h = bh & 3, row0 = b * TP + n * 64;
    LAS float* bcs = (LAS float*)F.lds; LAS float* attT = bcs;
    LAS float* qiT = bcs + 4096; LAS float* kiT = qiT + 4096; LAS float* vv = kiT + 4096; LAS float* Sst = vv + 8192; LAS float* gl = Sst + 8192; LAS float* seg = gl + 1024;
    gla_cumdecay(F, Z, row0, h, (const float*)A.in[17], (const float*)A.in[18], bcs, gl, seg);
    { const int t = tid >> 3, dk8 = (tid & 7) * 8;
      const v4u qw = *(const v4u*)(Z + (size_t)(row0 + t) * ZE + h * 64 + dk8), kw = *(const v4u*)(Z + (size_t)(row0 + t) * ZE + 256 + h * 64 + dk8);
#pragma unroll
      for (int e = 0; e < 4; ++e) { const int d0 = dk8 + 2 * e; const float b0 = bcs[t * 64 + d0], b1 = bcs[t * 64 + d0 + 1];
          qiT[d0 * 64 + t] = 0.125f * bf2f((unsigned short)(qw[e] & 0xffffu)) * __expf(b0); qiT[(d0 + 1) * 64 + t] = 0.125f * bf2f((unsigned short)(qw[e] >> 16)) * __expf(b1);
          kiT[d0 * 64 + t] = bf2f((unsigned short)(kw[e] & 0xffffu)) * __expf(-b0); kiT[(d0 + 1) * 64 + t] = bf2f((unsigned short)(kw[e] >> 16)) * __expf(-b1); }
      const int dv16 = (tid & 7) * 16;
#pragma unroll
      for (int q = 0; q < 2; ++q) { const v4u vw = *(const v4u*)(Z + (size_t)(row0 + t) * ZE + 512 + h * 128 + dv16 + 8 * q);
#pragma unroll
          for (int e = 0; e < 4; ++e) { vv[t * 128 + dv16 + 8 * q + 2 * e] = bf2f((unsigned short)(vw[e] & 0xffffu)); vv[t * 128 + dv16 + 8 * q + 2 * e + 1] = bf2f((unsigned short)(vw[e] >> 16)); } }
#pragma unroll
      for (int j = 0; j < 4; ++j) *(LAS f32x4*)(Sst + 4 * (tid + 512 * j)) = *(const f32x4*)(US + (size_t)unit * 8192 + 4 * (tid + 512 * j)); }
    __syncthreads();
    { const int t4 = tid >> 5, s2 = tid & 31; f32x4 a0 = {0.f, 0.f, 0.f, 0.f}, a1 = {0.f, 0.f, 0.f, 0.f};
#pragma unroll 4
      for (int dk = 0; dk < 64; ++dk) { const f32x4 qv = *(const LAS f32x4*)(qiT + dk * 64 + 4 * t4); const f32x2 kv = *(const LAS f32x2*)(kiT + dk * 64 + 2 * s2);
          a0 += qv * kv[0]; a1 += qv * kv[1]; }
#pragma unroll
      for (int i = 0; i < 4; ++i) { if (2 * s2 > 4 * t4 + i) a0[i] = 0.f; if (2 * s2 + 1 > 4 * t4 + i) a1[i] = 0.f; }
      *(LAS f32x4*)(attT + (2 * s2) * 64 + 4 * t4) = a0; *(LAS f32x4*)(attT + (2 * s2 + 1) * 64 + 4 * t4) = a1; }
    __syncthreads();
    { const int t4 = tid >> 5, dvq = tid & 31; f32x4 o[4] = {{0.f, 0.f, 0.f, 0.f}, {0.f, 0.f, 0.f, 0.f}, {0.f, 0.f, 0.f, 0.f}, {0.f, 0.f, 0.f, 0.f}};
#pragma unroll 4
      for (int dk = 0; dk < 64; ++dk) { const f32x4 qv = *(const LAS f32x4*)(qiT + dk * 64 + 4 * t4), sv = *(const LAS f32x4*)(Sst + dk * 128 + 4 * dvq);
#pragma unroll
          for (int i = 0; i < 4; ++i) o[i] += qv[i] * sv; }
      const int smax = 4 * t4 + 3;
      for (int s = 0; s <= smax; ++s) { const f32x4 av = *(const LAS f32x4*)(attT + s * 64 + 4 * t4), v4 = *(const LAS f32x4*)(vv + s * 128 + 4 * dvq);
#pragma unroll
          for (int i = 0; i < 4; ++i) o[i] += av[i] * v4; }
      const f32x4 gn = *(const f32x4*)((const float*)A.in[19] + h * 128 + 4 * dvq);
#pragma unroll
      for (int i = 0; i < 4; ++i) { const float ss = half_sum((o[i][0] * o[i][0] + o[i][1] * o[i][1]) + (o[i][2] * o[i][2] + o[i][3] * o[i][3]));
          const float rstd = 1.0f / sqrtf(ss * (1.0f / 128.0f) + 1e-6f); const int row = row0 + 4 * t4 + i;
          const v2u rw = *(const v2u*)(Z + (size_t)row * ZE + 1024 + h * 128 + 4 * dvq);
          const float r0 = bf2f((unsigned short)(rw.x & 0xffffu)), r1 = bf2f((unsigned short)(rw.x >> 16)), r2 = bf2f((unsigned short)(rw.y & 0xffffu)), r3 = bf2f((unsigned short)(rw.y >> 16));
          v2u ow; ow.x = pk2(o[i][0] * rstd * gn[0] * siluf_(r0), o[i][1] * rstd * gn[1] * siluf_(r1)); ow.y = pk2(o[i][2] * rstd * gn[2] * siluf_(r2), o[i][3] * rstd * gn[3] * siluf_(r3));
          *(GAS v2u*)(OP + (size_t)row * DM + h * 128 + 4 * dvq) = ow; } }
    __syncthreads();
}
__device__ __forceinline__ void gla_sample_unit(Frame& F, const Args& A, int unit) {
    const bf16* Z = WS_PTR(bf16, WS_Z); bf16* OP = WS_PTR(bf16, WS_OP);
    const float* gate_w2 = (const float*)A.in[17]; const float* gate_b = (const float*)A.in[18]; const float* S0g = (const float*)A.in[2] + (size_t)unit * 8192; float* Sout = F.out + O_GLAS + (size_t)unit * 8192;
    int tid = threadIdx.x; asm volatile("" : "+v"(tid)); F.tid = tid; F.lane = tid & 63; F.wave = __builtin_amdgcn_readfirstlane(tid >> 6);
    const int b = unit >> 2, h = unit & 3, row0 = MP + 4 * b;
    LAS float* S0 = (LAS float*)F.lds; LAS float* bc = S0 + 8192; LAS float* qi = bc + 256; LAS float* ki = qi + 256; LAS float* kk = ki + 256; LAS float* vv = kk + 256; LAS float* att = vv + 512; LAS float* gl = att + 16; LAS float* red = gl + 64;
#pragma unroll
    for (int j = 0; j < 4; ++j) *(LAS f32x4*)(S0 + 4 * (tid + 512 * j)) = *(const f32x4*)(S0g + 4 * (tid + 512 * j));
    if (tid < 64) gl[tid] = bf2f(Z[(size_t)(row0 + (tid >> 4)) * ZE + 2048 + (tid & 15)]);
    vv[tid] = bf2f(Z[(size_t)(row0 + (tid >> 7)) * ZE + 512 + h * 128 + (tid & 127)]);
    __syncthreads();
    if (tid < 256) { const int t = tid >> 6, dk = tid & 63; float x = gate_b[h * 64 + dk];
#pragma unroll
        for (int j = 0; j < 16; ++j) x += gl[t * 16 + j] * gate_w2[j * 256 + h * 64 + dk];
        bc[t * 64 + dk] = logsig16(x); }
    __syncthreads();
    if (tid < 64) { float run = 0.f;
#pragma unroll
        for (int t = 0; t < 4; ++t) { run += bc[t * 64 + tid]; bc[t * 64 + tid] = run; } }
    __syncthreads();
    if (tid < 256) { const int t = tid >> 6, dk = tid & 63; const float bb = bc[t * 64 + dk], bl = bc[3 * 64 + dk];
        const float qv = bf2f(Z[(size_t)(row0 + t) * ZE + h * 64 + dk]), kv = bf2f(Z[(size_t)(row0 + t) * ZE + 256 + h * 64 + dk]);
        qi[t * 64 + dk] = 0.125f * qv * __expf(bb); ki[t * 64 + dk] = kv * __expf(-bb); kk[t * 64 + dk] = kv * __expf(bl - bb); }
    __syncthreads();
    if (tid < 16) { const int t = tid >> 2, s = tid & 3; float a = 0.f;
        for (int dk = 0; dk < 64; ++dk) a += qi[t * 64 + dk] * ki[s * 64 + dk];
        att[tid] = (s <= t) ? a : 0.f; }
    __syncthreads();
    { const int t = tid >> 7, dv = tid & 127; float o = 0.f;
#pragma unroll 8
      for (int dk = 0; dk < 64; ++dk) o += qi[t * 64 + dk] * S0[dk * 128 + dv];
#pragma unroll
      for (int s = 0; s < 4; ++s) o += att[t * 4 + s] * vv[s * 128 + dv];
      const float ss = wave_sum(o * o); if (F.lane == 0) red[F.wave] = ss;
      __syncthreads();
      const float tot = red[2 * t] + red[2 * t + 1]; const float rstd = 1.0f / sqrtf(tot * (1.0f / 128.0f) + 1e-6f);
      const float gn = ((const float*)A.in[19])[h * 128 + dv]; const float rr = bf2f(Z[(size_t)(row0 + t) * ZE + 1024 + h * 128 + dv]);
      OP[(size_t)(row0 + t) * DM + h * 128 + dv] = (bf16)f2bf(o * rstd * gn * siluf_(rr)); }
#pragma unroll
    for (int j = 0; j < 4; ++j) { const int e = 4 * (tid + 512 * j), dk = e >> 7, dv = e & 127; const float dec = __expf(bc[3 * 64 + dk]);
        f32x4 sn = *(const LAS f32x4*)(S0 + e) * dec;
#pragma unroll
        for (int s = 0; s < 4; ++s) sn += kk[s * 64 + dk] * *(const LAS f32x4*)(vv + s * 128 + dv);
        *(f32x4*)(Sout + e) = sn; }
    __syncthreads();
}
__device__ __forceinline__ void pool_prompt_unit(Frame& F, int unit) {
    const bf16* Z = WS_PTR(bf16, WS_Z); bf16* OP = WS_PTR(bf16, WS_OP); float* hp = F.out + O_POOLP;
    int c = threadIdx.x; asm volatile("" : "+v"(c));
    const int b = unit >> 7, t0 = (unit & 127) * 64, w = 2 << (c >> 7); const size_t rb = (size_t)b * TP;
    float s = 0.f;
    { float pv[16];
#pragma unroll
      for (int j = 0; j < 16; ++j) { const int t = t0 - 1 - j; pv[j] = (j < w && t >= 0) ? bf2f(Z[(rb + t) * ZE + 1536 + c]) : 0.f; }
#pragma unroll
      for (int j = 0; j < 16; ++j) s += pv[j]; }
#pragma unroll 1
    for (int tb = t0; tb < t0 + 64; tb += 16) { float uv[16], ov[16];
#pragma unroll
        for (int j = 0; j < 16; ++j) { const int t = tb + j; uv[j] = bf2f(Z[(rb + t) * ZE + 1536 + c]); ov[j] = (t - w >= 0) ? bf2f(Z[(rb + t - w) * ZE + 1536 + c]) : 0.f; }
#pragma unroll
        for (int j = 0; j < 16; ++j) { const int t = tb + j; s += uv[j]; s -= ov[j];
            const float cnt = (float)((t + 1 < w) ? t + 1 : w);
            OP[(rb + t) * DM + 512 + c] = (bf16)f2bf(s / cnt - uv[j]);
            if (t >= TP - 15) hp[((size_t)b * 15 + (t - (TP - 15))) * 512 + c] = uv[j]; } }
}
__device__ __forceinline__ void pool_sample_unit(Frame& F, const Args& A, int b) {
    const bf16* Z = WS_PTR(bf16, WS_Z); bf16* OP = WS_PTR(bf16, WS_OP); float* hs = F.out + O_POOLS + (size_t)b * 15 * 512; const float* hin = (const float*)A.in[3] + (size_t)b * 15 * 512;
    int c = threadIdx.x; asm volatile("" : "+v"(c));
    const int w = 2 << (c >> 7); float full[19];
#pragma unroll
    for (int i = 0; i < 15; ++i) full[i] = hin[i * 512 + c];
#pragma unroll
    for (int t = 0; t < 4; ++t) full[15 + t] = bf2f(Z[(size_t)(MP + 4 * b + t) * ZE + 1536 + c]);
#pragma unroll
    for (int t = 0; t < 4; ++t) { float s = 0.f;
#pragma unroll
        for (int j = 0; j < 16; ++j) if (j < w) s += full[15 + t - j];
        OP[(size_t)(MP + 4 * b + t) * DM + 512 + c] = (bf16)f2bf(s / (float)w - full[15 + t]); }
#pragma unroll
    for (int i = 0; i < 15; ++i) hs[i * 512 + c] = full[4 + i];
}
__device__ __forceinline__ void even_mid_phase(Frame& F, const Args& A) {
    constexpr int N1 = 1024, N2 = 512, N3 = 256, N4 = 128;
    for (int u = F.bx; u < N1 + N2 + N3 + N4; u += F.G) {
        if (u < N1) gla_g1_unit(F, A, u);
        else if (u < N1 + N2) gla_sample_unit(F, A, u - N1);
        else if (u < N1 + N2 + N3) pool_prompt_unit(F, u - N1 - N2);
        else pool_sample_unit(F, A, u - N1 - N2 - N3);
    }
}
__device__ __forceinline__ void odd_rows(Frame& F, const Args& A) {
    const bf16* Z = WS_PTR(bf16, WS_Z); bf16* CQN = WS_PTR(bf16, WS_CQN); bf16* CKVB = WS_PTR(bf16, WS_CKVB); bf16* KRB = WS_PTR(bf16, WS_KRB); const float* rt = WS_PTR(float, WS_RT);
    const float* q_norm = (const float*)A.in[24]; const float* kv_norm = (const float*)A.in[26];
    const int gw = F.bx * NWAVES + F.wave, NGW = F.G * NWAVES, lane = F.lane;
    for (int row = gw; row < MT; row += NGW) {
        const bf16* zr = Z + (size_t)row * ZO;
        { float v[6]; float ss = 0.f;
#pragma unroll
          for (int j = 0; j < 3; ++j) { const unsigned w = *(const unsigned*)(zr + 2 * lane + 128 * j); v[2 * j] = bf2f((unsigned short)(w & 0xffffu)); v[2 * j + 1] = bf2f((unsigned short)(w >> 16)); ss += v[2 * j] * v[2 * j] + v[2 * j + 1] * v[2 * j + 1]; }
          const float rstd = 1.0f / sqrtf(wave_sum(ss) * (1.0f / 384.0f) + 1e-6f);
#pragma unroll
          for (int j = 0; j < 3; ++j) { const int c = 2 * lane + 128 * j; *(GAS unsigned*)(CQN + (size_t)row * 384 + c) = pk2(v[2 * j] * rstd * q_norm[c], v[2 * j + 1] * rstd * q_norm[c + 1]); } }
        { const v2u w = *(const v2u*)(zr + 384 + 4 * lane); f32x4 v = {bf2f((unsigned short)(w.x & 0xffffu)), bf2f((unsigned short)(w.x >> 16)), bf2f((unsigned short)(w.y & 0xffffu)), bf2f((unsigned short)(w.y >> 16))};
          const float ss = wave_sum((v[0] * v[0] + v[1] * v[1]) + (v[2] * v[2] + v[3] * v[3])); const float rstd = 1.0f / sqrtf(ss * (1.0f / 256.0f) + 1e-6f);
          const f32x4 o = (v * rstd) * *(const f32x4*)(kv_norm + 4 * lane);
          *(f32x4*)(F.out + O_CKV + (size_t)row * 256 + 4 * lane) = o;
          v2u ob; ob.x = pk2(o[0], o[1]); ob.y = pk2(o[2], o[3]); *(GAS v2u*)(CKVB + (size_t)row * 256 + 4 * lane) = ob; }
        if (lane < 16) { const float x1 = bf2f(zr[640 + lane]), x2 = bf2f(zr[640 + 16 + lane]); const f32x2 cs = *(const f32x2*)(rt + (size_t)posof(row) * 32 + 2 * lane);
          const float o1 = x1 * cs[0] - x2 * cs[1], o2 = x2 * cs[0] + x1 * cs[1];
          F.out[O_KR + (size_t)row * 32 + lane] = o1; F.out[O_KR + (size_t)row * 32 + 16 + lane] = o2;
          KRB[(size_t)row * 32 + lane] = (bf16)f2bf(o1); KRB[(size_t)row * 32 + 16 + lane] = (bf16)f2bf(o2); }
    }
}
template <bool SAMPLE> __device__ __forceinline__ void conv_unit(Frame& F, const Args& A, int unit) {
    constexpr int NTOK = SAMPLE ? 4 : 32, NR = NTOK + 30;
    const bf16* Z = WS_PTR(bf16, WS_Z); bf16* OP = WS_PTR(bf16, WS_OP);
    const float* conv_w = (const float*)A.in[29]; const float* conv_b = (const float*)A.in[30]; const float* ng = (const float*)A.in[31]; const float* nb = (const float*)A.in[32];
    const int c = F.tid; LAS float* ut = (LAS float*)F.lds;
    LAS float* stat = ut + 62 * 512;
    const int b = SAMPLE ? unit : (unit >> 8), t0 = SAMPLE ? 0 : (unit & 255) * 32; const size_t rb = SAMPLE ? (size_t)(MP + 4 * b) : (size_t)b * TP;
    constexpr int FB = SAMPLE ? 17 : 16;
#pragma unroll 1
    for (int r0 = 0; r0 < NR; r0 += FB) { bf16 av[FB], gv[FB]; float hv[FB];
#pragma unroll
        for (int q = 0; q < FB; ++q) { const int rr = r0 + q, t = t0 - 30 + rr; av[q] = 0; gv[q] = 0; hv[q] = 0.f;
            if (rr < NR) { if (t >= 0) { const bf16* zr = Z + (rb + t) * ZO; av[q] = zr[672 + c]; gv[q] = zr[1184 + c]; }
                           else if (SAMPLE) hv[q] = ((const float*)A.in[6])[((size_t)b * 30 + rr) * 512 + c]; } }
#pragma unroll
        for (int q = 0; q < FB; ++q) { const int rr = r0 + q, t = t0 - 30 + rr;
            if (rr < NR) ut[rr * 512 + c] = (t >= 0) ? bf2f(av[q]) * sigmoidf_(bf2f(gv[q])) : hv[q]; } }
    float w[31];
#pragma unroll
    for (int j = 0; j < 31; ++j) w[j] = conv_w[j * 512 + c];
    const float bias = conv_b[c];
    if (SAMPLE) { float* cs = F.out + O_CONVS + (size_t)b * 30 * 512;
        for (int i = 0; i < 30; ++i) cs[i * 512 + c] = ut[(4 + i) * 512 + c]; }
    else if (t0 == TP - 32) { float* cp = F.out + O_CONVP + (size_t)b * 30 * 512;
        for (int i = 0; i < 30; ++i) cp[i * 512 + c] = ut[(32 + i) * 512 + c]; }
#pragma unroll 4
    for (int tt = 0; tt < NTOK; ++tt) { float a = bias;
#pragma unroll
        for (int j = 0; j < 31; ++j) a += w[j] * ut[(tt + j) * 512 + c];
        ut[tt * 512 + c] = a; }
    __syncthreads();
    for (int tt = F.wave; tt < NTOK; tt += NWAVES) { float s1 = 0.f, s2 = 0.f;
#pragma unroll
        for (int j = 0; j < 8; ++j) { const float x = ut[tt * 512 + F.lane + 64 * j]; s1 += x; s2 += x * x; }
        s1 = wave_sum(s1); s2 = wave_sum(s2); const float mean = s1 * (1.0f / 512.0f); const float var = fmaxf(s2 * (1.0f / 512.0f) - mean * mean, 0.f);
        if (F.lane == 0) { stat[2 * tt] = mean; stat[2 * tt + 1] = 1.0f / sqrtf(var + 1e-6f); } }
    __syncthreads();
    const float gg = ng[c], bb = nb[c];
#pragma unroll 4
    for (int tt = 0; tt < NTOK; ++tt) { const float y = (ut[tt * 512 + c] - stat[2 * tt]) * stat[2 * tt + 1] * gg + bb;
        OP[(rb + t0 + tt) * DM + 512 + c] = (bf16)f2bf(siluf_(y)); }
    __syncthreads();
}
__device__ __forceinline__ void odd_thin_phase(Frame& F, const Args& A) {
    odd_rows(F, A);
    for (int u = F.bx; u < 512 + 128; u += F.G) { if (u < 512) conv_unit<false>(F, A, u); else conv_unit<true>(F, A, u - 512); }
}
typedef short v4i16_t __attribute__((ext_vector_type(4)));
__device__ __forceinline__ s16x4 vtr(const LAS unsigned char* p) { return __builtin_bit_cast(s16x4, __builtin_amdgcn_ds_read_tr16_b64_v4i16((LAS v4i16_t*)p)); }
#define LBAR() asm volatile("s_waitcnt lgkmcnt(0)\n\ts_barrier" ::: "memory")
__device__ __forceinline__ float xhalf_max(float v) { auto rr = __builtin_amdgcn_permlane32_swap(__float_as_uint(v), __float_as_uint(v), false, false); return fmaxf(__uint_as_float(rr[0]), __uint_as_float(rr[1])); }
__device__ __forceinline__ float xhalf_sum(float v) { auto rr = __builtin_amdgcn_permlane32_swap(__float_as_uint(v), __float_as_uint(v), false, false); return __uint_as_float(rr[0]) + __uint_as_float(rr[1]); }
__device__ __forceinline__ int crow(int r, int hi) { return (r & 3) + 8 * (r >> 2) + 4 * hi; }
__device__ __forceinline__ bf16x8 pack8(const f32x16& p, int s8) {
    v4u w; w.x = pg8::cvt_pk_bf16(p[s8 + 0], p[s8 + 1]); w.y = pg8::cvt_pk_bf16(p[s8 + 2], p[s8 + 3]); w.z = pg8::cvt_pk_bf16(p[s8 + 4], p[s8 + 5]); w.w = pg8::cvt_pk_bf16(p[s8 + 6], p[s8 + 7]);
    return __builtin_bit_cast(bf16x8, w);
}
constexpr int PA_KROW = 208, PA_VROW = 144, PA_VOFF = 64 * PA_KROW, PA_BUF = PA_VOFF + 64 * PA_VROW;
__device__ __forceinline__ void pattn_unit(Frame& F, int b, int h, int qb) {
    const bf16* Q = WS_PTR(bf16, WS_Q); const bf16* KV = WS_PTR(bf16, WS_KV); const bf16* KRB = WS_PTR(bf16, WS_KRB); bf16* OP = WS_PTR(bf16, WS_OP);
    int tid = threadIdx.x; asm volatile("" : "+v"(tid));
    const int lane = tid & 63, wid = __builtin_amdgcn_readfirstlane(tid >> 6), r32 = lane & 31, hi = lane >> 5;
    const size_t rb = (size_t)b * TP; const int q0w = 256 * qb + 32 * wid, NT = 4 * (qb + 1);
    LAS unsigned char* L = F.lds;
    const int skey = tid >> 3, sc = tid & 7, rkey = tid >> 2, rc = tid & 3;
    const bf16* gk = KV + (rb + skey) * 1024 + h * 64 + 8 * sc; const bf16* gv = gk + 512; const bf16* gr = KRB + (rb + rkey) * 32 + 8 * rc;
    const int lk = skey * PA_KROW + (sc << 4), lv = PA_VOFF + skey * PA_VROW + (sc << 4), lr = rkey * PA_KROW + ((8 + rc) << 4);
    v4u sk, sv, sr = {0u, 0u, 0u, 0u};
#define PA_LOAD(kt) do { sk = *(const v4u*)(gk + (size_t)(kt) * 64 * 1024); sv = *(const v4u*)(gv + (size_t)(kt) * 64 * 1024); if (tid < 256) sr = *(const v4u*)(gr + (size_t)(kt) * 64 * 32); } while (0)
#define PA_STORE(bufo) do { *(LAS v4u*)(L + (bufo) + lk) = sk; *(LAS v4u*)(L + (bufo) + lv) = sv; if (tid < 256) *(LAS v4u*)(L + (bufo) + lr) = sr; } while (0)
    PA_LOAD(0);
    bf16x8 qf[6];
    { const bf16* qp = Q + (rb + q0w + r32) * 768 + h * 96 + 8 * hi;
#pragma unroll
      for (int kk = 0; kk < 6; ++kk) qf[kk] = *(const bf16x8*)(qp + 16 * kk); }
    f32x16 o0 = {}, o1 = {}; float mrun = -1e30f, lrun = 0.f;
    PA_STORE(0);
    LBAR();
    const int aoffk = r32 * PA_KROW + (hi << 4);
    const int g = lane >> 4, i16 = lane & 15, hg = g >> 1;
    const int voff = PA_VOFF + (4 * hg + (i16 >> 2)) * PA_VROW + ((16 * (g & 1) + 4 * (i16 & 3)) << 1);
    for (int kt = 0; kt < NT; ++kt) {
        const int bufo = (kt & 1) * PA_BUF;
        if (kt + 1 < NT) PA_LOAD(kt + 1);
        if (64 * kt <= q0w + 31) {
            f32x16 p0 = {}, p1 = {};
            { bf16x8 ka[12];
#pragma unroll
              for (int kk = 0; kk < 6; ++kk) { ka[2 * kk] = *(const LAS bf16x8*)(L + bufo + aoffk + 32 * kk); ka[2 * kk + 1] = *(const LAS bf16x8*)(L + bufo + aoffk + 32 * PA_KROW + 32 * kk); }
#pragma unroll
              for (int kk = 0; kk < 6; ++kk) { p0 = __builtin_amdgcn_mfma_f32_32x32x16_bf16(ka[2 * kk], qf[kk], p0, 0, 0, 0); p1 = __builtin_amdgcn_mfma_f32_32x32x16_bf16(ka[2 * kk + 1], qf[kk], p1, 0, 0, 0); } }
            s16x4 vlo[8], vhi[8];
#pragma unroll
            for (int hf = 0; hf < 2; ++hf)
#pragma unroll
                for (int s = 0; s < 2; ++s)
#pragma unroll
                    for (int dt = 0; dt < 2; ++dt) { const int a0 = bufo + voff + (32 * hf + 16 * s) * PA_VROW + 64 * dt; vlo[(hf * 2 + s) * 2 + dt] = vtr(L + a0); vhi[(hf * 2 + s) * 2 + dt] = vtr(L + a0 + 8 * PA_VROW); }
            if (64 * kt + 63 > q0w) { const int qq = q0w + r32;
#pragma unroll
                for (int r = 0; r < 16; ++r) { const int key = 64 * kt + crow(r, hi); if (key > qq) p0[r] = -INFINITY; if (key + 32 > qq) p1[r] = -INFINITY; } }
            float mt = fmaxf(p0[0], p1[0]);
#pragma unroll
            for (int r = 1; r < 16; ++r) mt = fmaxf(mt, fmaxf(p0[r], p1[r]));
            mt = xhalf_max(mt);
            const float mnew = fmaxf(mrun, mt), alpha = __builtin_amdgcn_exp2f(mrun - mnew); mrun = mnew;
            float rs = 0.f;
#pragma unroll
            for (int r = 0; r < 16; ++r) { p0[r] = __builtin_amdgcn_exp2f(p0[r] - mnew); p1[r] = __builtin_amdgcn_exp2f(p1[r] - mnew); rs += p0[r] + p1[r]; }
            rs = xhalf_sum(rs); lrun = lrun * alpha + rs;
#pragma unroll
            for (int r = 0; r < 16; ++r) { o0[r] *= alpha; o1[r] *= alpha; }
#pragma unroll
            for (int hf = 0; hf < 2; ++hf)
#pragma unroll
                for (int s = 0; s < 2; ++s) { const bf16x8 pb = pack8(hf ? p1 : p0, 8 * s);
#pragma unroll
                    for (int dt = 0; dt < 2; ++dt) { const s16x4 lo = vlo[(hf * 2 + s) * 2 + dt], hh = vhi[(hf * 2 + s) * 2 + dt];
                        const bf16x8 va = {lo[0], lo[1], lo[2], lo[3], hh[0], hh[1], hh[2], hh[3]};
                        if (dt == 0) o0 = __builtin_amdgcn_mfma_f32_32x32x16_bf16(va, pb, o0, 0, 0, 0); else o1 = __builtin_amdgcn_mfma_f32_32x32x16_bf16(va, pb, o1, 0, 0, 0); } }
        }
        if (kt + 1 < NT) PA_STORE(((kt + 1) & 1) * PA_BUF);
        LBAR();
    }
#undef PA_LOAD
#undef PA_STORE
    const float rl = 1.0f / lrun;
    bf16* op = OP + (rb + q0w + r32) * DM + h * 64;
#pragma unroll
    for (int dt = 0; dt < 2; ++dt)
#pragma unroll
        for (int rq = 0; rq < 4; ++rq) { const f32x16& o = dt ? o1 : o0; v2u w; w.x = pk2(o[4 * rq] * rl, o[4 * rq + 1] * rl); w.y = pk2(o[4 * rq + 2] * rl, o[4 * rq + 3] * rl);
            *(GAS v2u*)(op + 32 * dt + 8 * rq + 4 * hi) = w; }
}

constexpr int DT_ROW = 592, DT_TILE = 64 * DT_ROW, DT_QOFF = 2 * DT_TILE, DT_QN = DT_QOFF + 32 * DT_ROW, DT_ML = 133120;
__device__ __forceinline__ void dattn_unit(Frame& F, const Args& A, int unit) {
    const bf16* Q = WS_PTR(bf16, WS_Q); float* PART = WS_PTR(float, WS_PART) + (size_t)unit * PART_F; float* QD = WS_PTR(float, WS_QD);
    const float* cckv = (const float*)A.in[4]; const float* ckr = (const float*)A.in[5]; const int* ptab = (const int*)A.in[7]; const float* w_uk = (const float*)A.in[27];
    int tid = threadIdx.x; asm volatile("" : "+v"(tid));
    const int lane = tid & 63, wid = __builtin_amdgcn_readfirstlane(tid >> 6), r32 = lane & 31, hi = lane >> 5, b = unit >> 3, sp = unit & 7;
    LAS unsigned char* L = F.lds; LAS float* qn = (LAS float*)(L + DT_QN); LAS float* ml = (LAS float*)(L + DT_ML);
    const f32x4* dummy = (const f32x4*)WS_PTR(float, WS_DUMMY);
    LAS int* pidl = (LAS int*)(L + DT_ML + 2048);
    if (tid < 8) pidl[tid] = ptab[b * 64 + sp * 8 + tid];
    __syncthreads();
    f32x4 st0[9], st1[9];
    const int wofs = (tid >> 6) * DT_ROW + (tid & 63) * 8, wofr = (tid >> 3) * DT_ROW + 512 + (tid & 7) * 8;
#define DT_LOAD(tl, st) do { const int t_ = (tl); const bool real_ = t_ < 16; const int pid = pidl[real_ ? (t_ >> 1) : 0]; \
        const f32x4* pc = real_ ? (const f32x4*)(cckv + ((size_t)pid * 128 + (t_ & 1) * 64) * 256) : dummy; const f32x4* pr = real_ ? (const f32x4*)(ckr + ((size_t)pid * 128 + (t_ & 1) * 64) * 32) : dummy; \
        _Pragma("unroll") for (int i = 0; i < 8; ++i) st[i] = __builtin_nontemporal_load(pc + tid + 512 * i); \
        st[8] = __builtin_nontemporal_load(pr + tid); } while (0)
#define DT_STORE(bufo, st) do { _Pragma("unroll") for (int i = 0; i < 8; ++i) { v2u w_; w_.x = pg8::cvt_pk_bf16(st[i][0], st[i][1]); w_.y = pg8::cvt_pk_bf16(st[i][2], st[i][3]); *(LAS v2u*)(L + (bufo) + wofs + i * 8 * DT_ROW) = w_; } \
        { v2u w_; w_.x = pg8::cvt_pk_bf16(st[8][0], st[8][1]); w_.y = pg8::cvt_pk_bf16(st[8][2], st[8][3]); *(LAS v2u*)(L + (bufo) + wofr) = w_; } } while (0)
    DT_LOAD(0, st0); DT_LOAD(1, st1);
    { const int t = tid >> 7, c6 = (tid & 127) * 6;
      const bf16* qp = Q + (size_t)(MP + 4 * b + t) * 768 + c6;
#pragma unroll
      for (int e = 0; e < 6; ++e) { const int c = c6 + e, hh = c / 96, d = c % 96; const bf16 v = qp[e];
          if (d < 64) qn[(t * 8 + hh) * 64 + d] = bf2f(v);
          else { const int q = t * 8 + hh, col = 256 + (d - 64); *(LAS bf16*)(L + DT_QOFF + q * DT_ROW + col * 2) = v;
                 if (sp == 0) QD[((size_t)b * 32 + q) * 288 + col] = bf2f(v); } } }
    __syncthreads();
    { const int hh = tid >> 6, rr = tid & 63;
#pragma unroll 1
      for (int j = 0; j < 4; ++j) { const int r = rr + 64 * j; const f32x4* wp = (const f32x4*)(w_uk + ((size_t)r * 8 + hh) * 64); float a0 = 0.f, a1 = 0.f, a2 = 0.f, a3 = 0.f;
#pragma unroll 4
          for (int d4 = 0; d4 < 16; ++d4) { const f32x4 w = wp[d4];
              const f32x4 x0 = *(const LAS f32x4*)(qn + (0 * 8 + hh) * 64 + 4 * d4), x1 = *(const LAS f32x4*)(qn + (1 * 8 + hh) * 64 + 4 * d4), x2 = *(const LAS f32x4*)(qn + (2 * 8 + hh) * 64 + 4 * d4), x3 = *(const LAS f32x4*)(qn + (3 * 8 + hh) * 64 + 4 * d4);
              a0 += (w[0] * x0[0] + w[1] * x0[1]) + (w[2] * x0[2] + w[3] * x0[3]); a1 += (w[0] * x1[0] + w[1] * x1[1]) + (w[2] * x1[2] + w[3] * x1[3]);
              a2 += (w[0] * x2[0] + w[1] * x2[1]) + (w[2] * x2[2] + w[3] * x2[3]); a3 += (w[0] * x3[0] + w[1] * x3[1]) + (w[2] * x3[2] + w[3] * x3[3]); }
          const float av[4] = {a0, a1, a2, a3};
#pragma unroll
          for (int t = 0; t < 4; ++t) { const int q = t * 8 + hh; *(LAS bf16*)(L + DT_QOFF + q * DT_ROW + r * 2) = (bf16)f2bf(av[t]);
              if (sp == 0) QD[((size_t)b * 32 + q) * 288 + r] = av[t]; } } }
    DT_STORE(0, st0);
    LBAR();
    DT_LOAD(2, st0);
    bf16x8 qf[18];
#pragma unroll
    for (int kk = 0; kk < 18; ++kk) qf[kk] = *(const LAS bf16x8*)(L + DT_QOFF + (lane & 31) * DT_ROW + ((lane >> 5) << 4) + 32 * kk);
    const int kh = wid & 1, dq = wid >> 1, g = lane >> 4, i16 = lane & 15, hg = g >> 1;
    f32x16 o0 = {}, o1 = {}; float mrun = -1e30f, lrun = 0.f;
    const int arow = (32 * kh + r32) * DT_ROW + (hi << 4);
    const int voff = (32 * kh + 4 * hg + (i16 >> 2)) * DT_ROW + ((64 * dq + 16 * (g & 1) + 4 * (i16 & 3)) << 1);
#define DT_ITER(tl, bufo, bufn, stn, DOSTORE, DOLOAD) do { \
        f32x16 p = {}; \
_Pragma("unroll") \
        for (int g6 = 0; g6 < 3; ++g6) { bf16x8 ka[6]; \
_Pragma("unroll") \
            for (int j = 0; j < 6; ++j) ka[j] = *(const LAS bf16x8*)(L + bufo + arow + 32 * (6 * g6 + j)); \
_Pragma("unroll") \
            for (int j = 0; j < 6; ++j) p = __builtin_amdgcn_mfma_f32_32x32x16_bf16(ka[j], qf[6 * g6 + j], p, 0, 0, 0); } \
        s16x4 vlo[4], vhi[4]; \
_Pragma("unroll") \
        for (int s = 0; s < 2; ++s) \
_Pragma("unroll") \
            for (int dt = 0; dt < 2; ++dt) { const int a0 = bufo + voff + 16 * s * DT_ROW + 64 * dt; vlo[2 * s + dt] = vtr(L + a0); vhi[2 * s + dt] = vtr(L + a0 + 8 * DT_ROW); } \
        float mt = p[0]; \
_Pragma("unroll") \
        for (int r = 1; r < 16; ++r) mt = fmaxf(mt, p[r]); \
        mt = xhalf_max(mt); \
        const float mnew = fmaxf(mrun, mt), alpha = __builtin_amdgcn_exp2f(mrun - mnew); mrun = mnew; \
        float rs = 0.f; \
_Pragma("unroll") \
        for (int r = 0; r < 16; ++r) { p[r] = __builtin_amdgcn_exp2f(p[r] - mnew); rs += p[r]; } \
        rs = xhalf_sum(rs); lrun = lrun * alpha + rs; \
_Pragma("unroll") \
        for (int r = 0; r < 16; ++r) { o0[r] *= alpha; o1[r] *= alpha; } \
_Pragma("unroll") \
        for (int s = 0; s < 2; ++s) { const bf16x8 pb = pack8(p, 8 * s); \
_Pragma("unroll") \
            for (int dt = 0; dt < 2; ++dt) { const s16x4 lo = vlo[2 * s + dt], hh = vhi[2 * s + dt]; \
                const bf16x8 va = {lo[0], lo[1], lo[2], lo[3], hh[0], hh[1], hh[2], hh[3]}; \
                if (dt == 0) o0 = __builtin_amdgcn_mfma_f32_32x32x16_bf16(va, pb, o0, 0, 0, 0); else o1 = __builtin_amdgcn_mfma_f32_32x32x16_bf16(va, pb, o1, 0, 0, 0); } } \
        if (DOSTORE) DT_STORE(bufn, stn); \
        LBAR(); \
        if (DOLOAD) DT_LOAD((tl) + 3, stn); } while (0)
    for (int tl = 0; tl < 16; tl += 2) { DT_ITER(tl, 0, DT_TILE, st1, (tl) + 1 < 16, true); DT_ITER(tl + 1, DT_TILE, 0, st0, (tl) + 2 < 16, true); }
#undef DT_ITER
#undef DT_LOAD
#undef DT_STORE
    { LAS float* ow = (LAS float*)L + (size_t)wid * 2048;
#pragma unroll
      for (int dt = 0; dt < 2; ++dt)
#pragma unroll
          for (int r = 0; r < 16; ++r) ow[(32 * dt + crow(r, hi)) * 32 + r32] = dt ? o1[r] : o0[r];
      if (hi == 0) { ml[wid * 64 + r32] = mrun; ml[wid * 64 + 32 + r32] = lrun; } }
    __syncthreads();
    { const int q = tid & 31, dvg = tid >> 5, dqq = dvg >> 2;
      const float m0 = ml[(2 * dqq) * 64 + q], m1 = ml[(2 * dqq + 1) * 64 + q], ms = fmaxf(m0, m1);
      const float w0 = __builtin_amdgcn_exp2f(m0 - ms), w1 = __builtin_amdgcn_exp2f(m1 - ms);
      const float ls = w0 * ml[(2 * dqq) * 64 + 32 + q] + w1 * ml[(2 * dqq + 1) * 64 + 32 + q];
#pragma unroll
      for (int j = 0; j < 16; ++j) { const int dv = dvg * 16 + j, dvl = dv & 63;
          PART[dv * 32 + q] = w0 * ((LAS float*)L)[(size_t)(2 * dqq) * 2048 + dvl * 32 + q] + w1 * ((LAS float*)L)[(size_t)(2 * dqq + 1) * 2048 + dvl * 32 + q]; }
      if (dvg == 0) { PART[8192 + q] = ms; PART[8192 + 32 + q] = ls; } }
    __syncthreads();
}
__device__ __forceinline__ void dcombine_unit(Frame& F, const Args& A, int b) {
    const float* PART = WS_PTR(float, WS_PART) + (size_t)b * NSPLIT * PART_F; const float* QD = WS_PTR(float, WS_QD) + (size_t)b * 32 * 288; bf16* OP = WS_PTR(bf16, WS_OP);
    const float* ckv = F.out + O_CKV + (size_t)(MP + 4 * b) * 256; const float* kr = F.out + O_KR + (size_t)(MP + 4 * b) * 32; const float* w_uv = (const float*)A.in[28];
    int tid = threadIdx.x; asm volatile("" : "+v"(tid));
    LAS float* lat = (LAS float*)F.lds; LAS float* sn = lat + 8192; LAS float* ck = sn + 128; LAS float* qd = ck + 1152;
    for (int i = tid; i < 1024; i += 512) ck[(i >> 8) * 288 + (i & 255)] = ckv[i];
    if (tid < 128) ck[(tid >> 5) * 288 + 256 + (tid & 31)] = kr[tid];
    for (int i = tid; i < 32 * 288; i += 512) qd[(i / 288) * 289 + (i % 288)] = QD[i];
    __syncthreads();
    { const int q = tid >> 4, part = tid & 15; float a[4] = {0.f, 0.f, 0.f, 0.f};
#pragma unroll
      for (int i = 0; i < 18; ++i) { const int r = part * 18 + i; const float x = qd[q * 289 + r];
#pragma unroll
          for (int s = 0; s < 4; ++s) a[s] += x * ck[s * 288 + r]; }
#pragma unroll
      for (int s = 0; s < 4; ++s) { float v = a[s]; v += __shfl_xor(v, 1); v += __shfl_xor(v, 2); v += __shfl_xor(v, 4); v += __shfl_xor(v, 8); a[s] = v; }
      if (part < 4) sn[q * 4 + part] = (part <= (q >> 3)) ? a[part] : -INFINITY; }
    __syncthreads();
    { const int q = tid & 31, dvg = tid >> 5; float mk[NSPLIT], ms = -1e30f;
#pragma unroll
      for (int s = 0; s < NSPLIT; ++s) { mk[s] = PART[(size_t)s * PART_F + 8192 + q]; ms = fmaxf(ms, mk[s]); }
      float pn[4];
#pragma unroll
      for (int s = 0; s < 4; ++s) { pn[s] = sn[q * 4 + s]; ms = fmaxf(ms, pn[s]); }
      float wg[NSPLIT], ls = 0.f;
#pragma unroll
      for (int s = 0; s < NSPLIT; ++s) { wg[s] = __builtin_amdgcn_exp2f(mk[s] - ms); ls += wg[s] * PART[(size_t)s * PART_F + 8192 + 32 + q]; }
#pragma unroll
      for (int s = 0; s < 4; ++s) { pn[s] = __builtin_amdgcn_exp2f(pn[s] - ms); ls += pn[s]; }
      const float rl = 1.0f / ls;
#pragma unroll 1
      for (int j0 = 0; j0 < 16; j0 += 4) { float pv[4][NSPLIT];
#pragma unroll
          for (int j = 0; j < 4; ++j)
#pragma unroll
              for (int s = 0; s < NSPLIT; ++s) pv[j][s] = PART[(size_t)s * PART_F + (dvg * 16 + j0 + j) * 32 + q];
#pragma unroll
          for (int j = 0; j < 4; ++j) { const int dv = dvg * 16 + j0 + j; float acc = 0.f;
#pragma unroll
              for (int s = 0; s < NSPLIT; ++s) acc += wg[s] * pv[j][s];
#pragma unroll
              for (int s = 0; s < 4; ++s) acc += pn[s] * ck[s * 288 + dv];
              lat[q * 256 + dv] = acc * rl; } } }
    __syncthreads();
    { const int hh = tid >> 6, v = tid & 63; float a[4] = {0.f, 0.f, 0.f, 0.f};
#pragma unroll 1
      for (int r0 = 0; r0 < 256; r0 += 32) { float w[32];
#pragma unroll
          for (int i = 0; i < 32; ++i) w[i] = w_uv[((size_t)(r0 + i) * 8 + hh) * 64 + v];
#pragma unroll
          for (int i = 0; i < 32; ++i)
#pragma unroll
              for (int t = 0; t < 4; ++t) a[t] += w[i] * lat[(t * 8 + hh) * 256 + r0 + i]; }
#pragma unroll
      for (int t = 0; t < 4; ++t) OP[(size_t)(MP + 4 * b + t) * DM + hh * 64 + v] = (bf16)f2bf(a[t]); }
    __syncthreads();
}
__device__ __forceinline__ void attn_phase(Frame& F, const Args& A) {
    const bool dfirst = ((F.bx >> 3) & 1) != 0;
#pragma unroll 1
    for (int part = 0; part < 2; ++part) {
#ifndef ATT_NO_D
        if ((part == 0) == dfirst) { for (int rd = 0; rd < NREP(17); ++rd) for (int du = F.bx; du < 128 * NSPLIT; du += F.G) dattn_unit(F, A, du); }
        else
#endif
#ifndef ATT_NO_P
        { for (int rp = 0; rp < NREP(18); ++rp) for (int pr2 = 2 * F.bx; pr2 < 512; pr2 += 2 * F.G) {
#pragma unroll 1
                   for (int e = 0; e < 2; ++e) { const int pr = pr2 >> 1, bh = pr >> 4, s = pr & 15; pattn_unit(F, bh >> 3, bh & 7, e ? s : 31 - s); } } }
#else
        {}
#endif
    }
}
constexpr int N_PHASE_IDS = 43;
#ifndef PHMASK
#define PHMASK 0xFFFFFFFFu
#endif
#define EN(n) (((PHMASK) >> (n)) & 1u)
#define REPSEAM(n) do { if (rep_ + 1 < NREP(n) && args.use_bar) xcd_barrier(bar); } while (0)
#ifndef MK_ONE_LAUNCH
#define MK_ONE_LAUNCH 1
#endif
__global__ void __launch_bounds__(NWAVES * 64, 2) mk_fwd(Args args) {
    extern __shared__ __attribute__((aligned(16))) unsigned char lds[];
    Frame F;
    F.lds = (LAS unsigned char*)lds; F.MISC = (volatile LAS unsigned*)(F.lds + MISC_OFF);
    F.tid = threadIdx.x; F.lane = F.tid & 63; F.wave = __builtin_amdgcn_readfirstlane(F.tid >> 6); F.G = gridDim.x; F.bx = blockIdx.x;
    F.ws = args.ws; F.out = args.out; F.ctl = (gu32*)(args.ws + WS_CTL);
    for (int u = F.tid; u < (LDS_BYTES - LDSCTL_OFF) / 4; u += NWAVES * 64) ((LAS unsigned*)(F.lds + LDSCTL_OFF))[u] = 0u;
    __syncthreads();
    XcdBarrier bar; bar.bar = (unsigned*)(F.ctl + CW_BAR); bar.x = 0; bar.st = nullptr;
    if (args.use_bar) bar = xcd_barrier_post((unsigned*)(F.ctl + CW_BAR), F.MISC + 8);
    const int lo = args.ph_lo, hi = args.ph_hi;
#define RUN(k) (lo <= (k) && (k) < hi)
#define FRESH() do { int t_ = threadIdx.x; asm volatile("" : "+v"(t_)); F.tid = t_; F.lane = t_ & 63; F.wave = __builtin_amdgcn_readfirstlane(t_ >> 6); } while (0)
#define SEAM(k) do { if (args.use_bar && (k) + 1 < hi) xcd_barrier(bar); } while (0)
    LAS unsigned char* ring = F.lds;
    const float* xin_p = (const float*)args.in[0]; const float* xin_s = (const float*)args.in[1] - (size_t)MP * DM;
    float* X = WS_PTR(float, WS_X); bf16* H = WS_PTR(bf16, WS_H); bf16* ACT = WS_PTR(bf16, WS_ACT); bf16* Z = WS_PTR(bf16, WS_Z); bf16* OP = WS_PTR(bf16, WS_OP); float* MOD = WS_PTR(float, WS_MOD);
    const float* norm_g = (const float*)args.in[12];

    if (EN(0) && RUN(0)) { for (int rep_ = 0; rep_ < NREP(0); ++rep_) { FRESH(); p0_prologue(F, args); REPSEAM(0); } SEAM(0); }
    if (EN(1) && RUN(1)) { for (int rep_ = 0; rep_ < NREP(1); ++rep_) { pg8::Gemm g{WS_PTR(bf16, WS_SC), WS_PTR(bf16, WS_ADAT), 256, MODLD, DM, DM, DM}; pg8::StaticOrder S; S.init(256, MODLD, F.G, F.bx);
        pg8::EpiMod E{MOD, (const float*)args.in[11]};
        pg8::gemm_phase<pg8::EpiMod, pg8::StaticOrder, true, true>(ring, g, S, E); REPSEAM(1); } SEAM(1); }
    for (int i = 0; i < 4; ++i) {
        const int pb = 2 + 10 * i, l = i >> 1, f = i & 1;
        const float* src_p = (i == 0) ? xin_p : X; const float* src_s = (i == 0) ? xin_s : X;
        const float* modl = MOD + l * 9216;
        if (EN(2) && RUN(pb + 0)) { for (int rep_ = 0; rep_ < NREP(2); ++rep_) { FRESH(); nm_phase(F, src_p, src_s, norm_g + (l * 3 + (f ? 2 : 0)) * DM, modl + (f ? 6 : 0) * DM, H, X, WS_PTR(float, WS_SLAB), (i == 0 || rep_ > 0) ? 0 : (f ? 4 : 11), (f ? MOD + (l) * 9216 + 5 * DM : MOD + (l - 1) * 9216 + 8 * DM), f ? 1.0f : 0.5f); REPSEAM(2); } SEAM(pb + 0); }
        if (EN(3) && RUN(pb + 1)) { for (int rep_ = 0; rep_ < NREP(3); ++rep_) { pg8::Gemm g{H, WS_PTR(bf16, WS_W13T + (size_t)i * W13T_STRIDE), MT, 2 * FF, DM, DM, DM}; pg8::StaticOrder S; S.init(MT, 2 * FF, F.G, F.bx);
            pg8::EpiSwiglu E{ACT, FF};
            pg8::gemm_phase<pg8::EpiSwiglu, pg8::StaticOrder, true, true>(ring, g, S, E); REPSEAM(3); } SEAM(pb + 1); }
        if (EN(4) && RUN(pb + 2)) { for (int rep_ = 0; rep_ < NREP(4); ++rep_) {
            { pg8::Gemm g{ACT, WS_PTR(bf16, WS_W2T + (size_t)i * W2T_STRIDE), MP, DM, FF, FF, FF}; pg8::StaticOrder S; S.init(MP, DM, F.G, F.bx);
              pg8::EpiRes E{src_p, src_s, rep_ ? WS_PTR(float, WS_DUMMY) : X, modl + (f ? 8 : 2) * DM, 0.5f};
              pg8::gemm_phase<pg8::EpiRes, pg8::StaticOrder, true, true>(ring, g, S, E); }
            __syncthreads();
            { pg8::Gemm g{ACT, WS_PTR(bf16, WS_W2T + (size_t)i * W2T_STRIDE), MT, DM, args.k_kv, FF, FF}; pg8::SplitKOrder S{MP / 256, 2, 4, 11, 256, F.G, F.bx};
              pg8::EpiPartial E{WS_PTR(float, WS_SLAB)};
              pg8::gemm_phase<pg8::EpiPartial, pg8::SplitKOrder, true, true>(ring, g, S, E); }
            REPSEAM(4); } SEAM(pb + 2); }
        if (f == 0) {
            if (EN(5) && RUN(pb + 3)) { for (int rep_ = 0; rep_ < NREP(2); ++rep_) { FRESH(); nm_phase(F, X, X, norm_g + (l * 3 + 1) * DM, modl + 3 * DM, H, X, WS_PTR(float, WS_SLAB), rep_ ? 0 : 11, modl + 2 * DM, 0.5f); REPSEAM(2); } SEAM(pb + 3); }
            if (EN(6) && RUN(pb + 4)) { for (int rep_ = 0; rep_ < NREP(6); ++rep_) { const int NZ = l ? ZO : ZE; pg8::Gemm g{H, WS_PTR(bf16, l ? WS_ODIN : WS_EVIN), MT, NZ, DM, DM, DM}; pg8::StaticOrder S; S.init(MT, NZ, F.G, F.bx);
                pg8::EpiPlain E{Z, NZ};
                pg8::gemm_phase<pg8::EpiPlain, pg8::StaticOrder, true, true>(ring, g, S, E); REPSEAM(6); } SEAM(pb + 4); }
            if (RUN(pb + 5)) { if (l == 0) { if (EN(7)) for (int rep_ = 0; rep_ < NREP(7); ++rep_) { FRESH(); even_mid_phase(F, args); REPSEAM(7); } } else { if (EN(8)) for (int rep_ = 0; rep_ < NREP(8); ++rep_) { FRESH(); odd_thin_phase(F, args); REPSEAM(8); } } SEAM(pb + 5); }
            if (RUN(pb + 6)) { FRESH();
                if (l == 0) { if (EN(9)) gla_g2_phase(F); }
                else { for (int rep_ = 0; rep_ < NREP(10); ++rep_) { if (EN(10)) { pg8::Gemm g{WS_PTR(bf16, WS_CQN), WS_PTR(bf16, WS_WUQ), MT, 768, args.k_q, args.k_q, args.k_q}; pg8::StaticOrder S; S.init(MT, 768, F.G, F.bx);
                         pg8::EpiQ E{WS_PTR(bf16, WS_Q), WS_PTR(float, WS_RT)};
                         pg8::gemm_phase<pg8::EpiQ, pg8::StaticOrder, true, true>(ring, g, S, E); }
                       __syncthreads();
                       if (EN(16)) { const int nkv = opaque_int(1024), mkv = opaque_int(MP); pg8::Gemm g{WS_PTR(bf16, WS_CKVB), WS_PTR(bf16, WS_WKV), mkv, nkv, args.k_kv, args.k_kv, args.k_kv}; pg8::StaticOrder S; S.init(mkv, nkv, F.G, F.bx);
                         pg8::EpiPlain E{WS_PTR(bf16, WS_KV), nkv};
                         pg8::gemm_phase<pg8::EpiPlain, pg8::StaticOrder, true, true>(ring, g, S, E); } REPSEAM(10); } }
                SEAM(pb + 6); }
            if (RUN(pb + 7)) { if (l == 0) { if (EN(11)) for (int rep_ = 0; rep_ < NREP(11); ++rep_) { FRESH(); for (int u = F.bx; u < 1024; u += F.G) gla_g3_unit(F, args, u); REPSEAM(11); } } else { if (EN(12)) for (int rep_ = 0; rep_ < NREP(12); ++rep_) { FRESH(); attn_phase(F, args); REPSEAM(12); } } SEAM(pb + 7); }
            if (RUN(pb + 8)) { FRESH(); if (l == 1) { if (EN(13)) for (int rep_ = 0; rep_ < NREP(13); ++rep_) { for (int b = F.bx; b < 128; b += F.G) dcombine_unit(F, args, b); REPSEAM(13); } SEAM(pb + 8); } }
            if (EN(14) && RUN(pb + 9)) { for (int rep_ = 0; rep_ < NREP(14); ++rep_) {
                { pg8::Gemm g{OP, WS_PTR(bf16, l ? WS_ODOUT : WS_EVOUT), MP, DM, DM, DM, DM}; pg8::StaticOrder S; S.init(MP, DM, F.G, F.bx);
                  pg8::EpiRes E{X, X, rep_ ? WS_PTR(float, WS_DUMMY) : X, modl + 5 * DM, 1.0f};
                  pg8::gemm_phase<pg8::EpiRes, pg8::StaticOrder, true, true>(ring, g, S, E); }
                __syncthreads();
                { pg8::Gemm g{OP, WS_PTR(bf16, l ? WS_ODOUT : WS_EVOUT), MT, DM, args.k_kv, DM, DM}; pg8::SplitKOrder S{MP / 256, 2, 4, 4, 256, F.G, F.bx};
                  pg8::EpiPartial E{WS_PTR(float, WS_SLAB)};
                  pg8::gemm_phase<pg8::EpiPartial, pg8::SplitKOrder, true, true>(ring, g, S, E); }
                REPSEAM(14); } SEAM(pb + 9); }
        }
    }
    if (EN(15) && RUN(42)) { for (int rep_ = 0; rep_ < NREP(15); ++rep_) { FRESH(); final_phase(F, X, (const float*)args.in[34], F.out + O_Y, WS_PTR(float, WS_SLAB), 11, MOD + 9216 + 8 * DM, 0.5f); REPSEAM(15); } }
#undef RUN
#undef SEAM
}

extern "C" void kernel_launch(void* const* d_in, const int* in_sizes, int n_in, void* d_out, int out_size, void* d_ws, size_t ws_size, hipStream_t stream) {
    static int grid = 0;
    if (grid == 0) {
        if (n_in != 35 || (size_t)out_size != O_END || ws_size < WS_END) { fprintf(stderr, "kernel_launch: unexpected shapes: n_in %d out %d ws %zu\n", n_in, out_size, ws_size); grid = -1; return; }
        int dev = 0, cus = 0, per_cu = 0;
        if (hipGetDevice(&dev) != hipSuccess || hipDeviceGetAttribute(&cus, hipDeviceAttributeMultiprocessorCount, dev) != hipSuccess) { grid = -1; return; }
        if (hipFuncSetAttribute((const void*)mk_fwd, hipFuncAttributeMaxDynamicSharedMemorySize, LDS_BYTES) != hipSuccess) { fprintf(stderr, "kernel_launch: hipFuncSetAttribute failed\n"); grid = -1; return; }
        if (hipOccupancyMaxActiveBlocksPerMultiprocessor(&per_cu, (const void*)mk_fwd, NWAVES * 64, LDS_BYTES) != hipSuccess || per_cu < 1) fprintf(stderr, "kernel_launch: occupancy query says %d\n", per_cu);
        (void)hipGetLastError();
        grid = cus;
    }
    if (grid < 0) return;
    if (hipMemsetAsync((char*)d_ws + WS_CTL, 0, CTL_ZERO_BYTES, stream) != hipSuccess) return;
    Args a{};
    for (int i = 0; i < 35; ++i) a.in[i] = d_in[i];
    a.out = (float*)d_out; a.ws = (unsigned char*)d_ws; a.k_q = 384; a.k_kv = 256; a.pad = 0;
#if MK_ONE_LAUNCH
    a.ph_lo = 0; a.ph_hi = N_PHASE_IDS; a.use_bar = 1;
    hipLaunchKernelGGL(mk_fwd, dim3(grid), dim3(NWAVES * 64), LDS_BYTES, stream, a);
#else
    for (int id = 0; id < N_PHASE_IDS; ++id) {
        if (id >= 2 && id < 42) { const int i = (id - 2) / 10, k = (id - 2) % 10; if (k >= 3 && (i & 1)) continue; if (k == 8 && i == 0) continue; }
        a.ph_lo = id; a.ph_hi = id + 1; a.use_bar = 0;
        hipLaunchKernelGGL(mk_fwd, dim3(grid), dim3(NWAVES * 64), LDS_BYTES, stream, a);
    }
#endif
}
```

```cpp
#include <hip/hip_runtime.h>
#include <cstdio>
#include <cstdint>
#define GAS __attribute__((address_space(1)))
#define LAS __attribute__((address_space(3)))
constexpr int DM = 1024, MP = 16384, MS = 512, MT = MP + MS, TP = 8192, NBAT = 130, FF = 2816;
constexpr int MODLD = 18432;
constexpr int ZE = 2304, ZO = 1792;
constexpr float QSCALE = 0.10206207261596577f * 1.4426950408889634f;
__device__ __forceinline__ int bidx(int row) { return row < MP ? (row >> 13) : 2 + ((row - MP) >> 2); }
__device__ __forceinline__ int posof(int row) { return row < MP ? (row & (TP - 1)) : TP + ((row - MP) & 3); }
__device__ __forceinline__ float bf2f(unsigned short b) { return __uint_as_float(((unsigned)b) << 16); }
__device__ __forceinline__ unsigned f2bf(float f) { unsigned u = __builtin_bit_cast(unsigned, f); return (u + 0x7fffu + ((u >> 16) & 1u)) >> 16; }
__device__ __forceinline__ unsigned pk2(float lo, float hi) { return f2bf(lo) | (f2bf(hi) << 16); }
__device__ __forceinline__ float sigmoidf_(float x) { return __builtin_amdgcn_rcpf(1.0f + __expf(-x)); }
__device__ __forceinline__ float siluf_(float x) { return x * __builtin_amdgcn_rcpf(1.0f + __expf(-x)); }
namespace pg8 {
#define PG8_LAS __attribute__((address_space(3)))
typedef unsigned short bf16_t;
typedef short bf16x8 __attribute__((ext_vector_type(8)));
typedef float f32x4 __attribute__((ext_vector_type(4)));
typedef unsigned u32x4 __attribute__((ext_vector_type(4)));
constexpr int BM = 256, BK = 64, HALF = 128, HTB = HALF * BK * 2  , STAGE_BYTES = 8 * HTB, NXCD = 8, WGM = 8;

__host__ __device__ __forceinline__ int lds_byte(int r, int c) { const int st = (r >> 4) * 2 + (c >> 5), rr = r & 15, cc = c & 31, ob = rr * 64 + cc * 2; return st * 1024 + (ob ^ (((ob >> 9) & 1) << 5)); }
__host__ __device__ __forceinline__ void stage_rc(int b, int& R, int& C) { const int st = b / 1024, sb = b % 1024, swz = sb ^ (((sb >> 9) & 1) << 5); R = (st >> 1) * 16 + swz / 64; C = (st & 1) * 32 + (swz % 64) / 2; }
__host__ __device__ __forceinline__ int perm32(int rho) { const int n = rho >> 4, i = rho & 15; return 8 * (i >> 2) + 4 * n + (i & 3); }

struct Unit { int pm, pn, koff; };
struct Gemm { const bf16_t* A; const bf16_t* Bt; int M, N, K, lda, ldb; };

struct StaticOrder {
    int nM, nN, nwg, G, c;
    __host__ __device__ void init(int M, int N, int G_, int c_) { nM = M / BM; nN = N / BM; nwg = nM * nN; G = G_; c = c_; }
    __host__ __device__ bool next(int i, Unit& u) const {
        const long L = (long)i * G + c; if (L >= nwg) return false;
        int wgid = (int)L; { const int q = nwg / NXCD, r = nwg % NXCD, xcd = wgid % NXCD, off = wgid / NXCD; wgid = (xcd < r ? xcd * (q + 1) : r * (q + 1) + (xcd - r) * q) + off; }
        const int nig = WGM * nN, gid = wgid / nig, fm = gid * WGM, gsz = (nM - fm) < WGM ? (nM - fm) : WGM;
        u.pm = fm + ((wgid % nig) % gsz); u.pn = (wgid % nig) / gsz; u.koff = 0; return true;
    }
    __device__ __forceinline__ void a_ready(const Unit&) const {}
    __device__ __forceinline__ void done(const Unit&) const {}
};
struct SplitKOrder {
    int pm0, nP, nN, nch, kc, G, c;
    __device__ bool next(int i, Unit& u) const { const int j = i * G + c; if (j >= nP * nN * nch) return false; const int ch = j % nch, t = j / nch; u.pn = t % nN; u.pm = pm0 + t / nN; u.koff = ch * kc; return true; }
    __device__ __forceinline__ void a_ready(const Unit&) const {}
    __device__ __forceinline__ void done(const Unit&) const {}
};

__device__ __forceinline__ unsigned cvt_pk_bf16(float lo, float hi) { unsigned r; asm volatile("v_cvt_pk_bf16_f32 %0, %1, %2" : "=v"(r) : "v"(lo), "v"(hi)); return r; }

struct EpiPlain {
    static constexpr bool PERM = true, AFTER_DRAIN = false;
    bf16_t* O; int ldc;
    __device__ __forceinline__ void operator()(const f32x4 (&acc)[2][2][4][2], const Unit& u, int wr, int wc, int fr, int fq) const {
        const int row0 = u.pm * BM + wr * 64 + fr, col0 = u.pn * BM + wc * 32 + 8 * fq;
#pragma unroll
        for (int ai = 0; ai < 2; ++ai)
#pragma unroll
            for (int m = 0; m < 4; ++m) { bf16_t* rowp = O + (size_t)(row0 + ai * HALF + m * 16) * ldc + col0;
#pragma unroll
                for (int bj = 0; bj < 2; ++bj) { const f32x4 v0 = acc[ai][bj][m][0], v1 = acc[ai][bj][m][1];
                    u32x4 w; w.x = cvt_pk_bf16(v0[0], v0[1]); w.y = cvt_pk_bf16(v0[2], v0[3]); w.z = cvt_pk_bf16(v1[0], v1[1]); w.w = cvt_pk_bf16(v1[2], v1[3]);
                    *(u32x4*)(rowp + bj * HALF) = w; } }
    }
};
struct EpiSwiglu {
    static constexpr bool PERM = true, AFTER_DRAIN = false;
    bf16_t* O; int ldc;
    __device__ __forceinline__ void operator()(const f32x4 (&acc)[2][2][4][2], const Unit& u, int wr, int wc, int fr, int fq) const {
        const int row0 = u.pm * BM + wr * 64 + fr, col0 = u.pn * HALF + wc * 32 + 8 * fq;
#pragma unroll
        for (int ai = 0; ai < 2; ++ai)
#pragma unroll
            for (int m = 0; m < 4; ++m) { bf16_t* rowp = O + (size_t)(row0 + ai * HALF + m * 16) * ldc + col0;
                float o[8];
#pragma unroll
                for (int n = 0; n < 2; ++n)
#pragma unroll
                    for (int e = 0; e < 4; ++e) { const float g = acc[ai][0][m][n][e], uu = acc[ai][1][m][n][e]; o[n * 4 + e] = siluf_(g) * uu; }
                u32x4 w; w.x = cvt_pk_bf16(o[0], o[1]); w.y = cvt_pk_bf16(o[2], o[3]); w.z = cvt_pk_bf16(o[4], o[5]); w.w = cvt_pk_bf16(o[6], o[7]);
                *(u32x4*)rowp = w; }
    }
};
struct EpiRes {
    static constexpr bool PERM = false, AFTER_DRAIN = false;
    const float* bp; const float* bs; float* out; const float* gate; float coef;
    __device__ __forceinline__ void operator()(const f32x4 (&acc)[2][2][4][2], const Unit& u, int wr, int wc, int fr, int fq) const {
#pragma unroll
        for (int ai = 0; ai < 2; ++ai)
#pragma unroll
            for (int m = 0; m < 4; ++m) { const int row = u.pm * BM + ai * HALF + wr * 64 + m * 16 + fr; const int b = bidx(row);
                const float* base = (row < MP ? bp : bs) + (size_t)row * DM; const float* gr = gate + (size_t)b * MODLD; float* orow = out + (size_t)row * DM;
#pragma unroll
                for (int bj = 0; bj < 2; ++bj)
#pragma unroll
                    for (int n = 0; n < 2; ++n) { const int col = u.pn * BM + bj * HALF + wc * 32 + n * 16 + 4 * fq;
                        const f32x4 xin = *(const f32x4*)(base + col), g = *(const f32x4*)(gr + col);
                        *(f32x4*)(orow + col) = xin + (g * coef) * acc[ai][bj][m][n]; } }
    }
};
struct EpiPartial {
    static constexpr bool PERM = false, AFTER_DRAIN = false;
    float* slab;
    __device__ __forceinline__ void operator()(const f32x4 (&acc)[2][2][4][2], const Unit& u, int wr, int wc, int fr, int fq) const {
        float* sb = slab + (size_t)(u.koff >> 8) * (MS * DM);
#pragma unroll
        for (int ai = 0; ai < 2; ++ai)
#pragma unroll
            for (int m = 0; m < 4; ++m) { const int row = u.pm * BM + ai * HALF + wr * 64 + m * 16 + fr - MP; float* orow = sb + (size_t)row * DM;
#pragma unroll
                for (int bj = 0; bj < 2; ++bj)
#pragma unroll
                    for (int n = 0; n < 2; ++n) { const int col = u.pn * BM + bj * HALF + wc * 32 + n * 16 + 4 * fq; *(f32x4*)(orow + col) = acc[ai][bj][m][n]; } }
    }
};
struct EpiMod {
    static constexpr bool PERM = false, AFTER_DRAIN = false;
    float* out; const float* bias;
    __device__ __forceinline__ void operator()(const f32x4 (&acc)[2][2][4][2], const Unit& u, int wr, int wc, int fr, int fq) const {
#pragma unroll
        for (int ai = 0; ai < 2; ++ai)
#pragma unroll
            for (int m = 0; m < 4; ++m) { const int row = u.pm * BM + ai * HALF + wr * 64 + m * 16 + fr; float* orow = out + (size_t)row * MODLD;
#pragma unroll
                for (int bj = 0; bj < 2; ++bj)
#pragma unroll
                    for (int n = 0; n < 2; ++n) { const int col = u.pn * BM + bj * HALF + wc * 32 + n * 16 + 4 * fq;
                        *(f32x4*)(orow + col) = acc[ai][bj][m][n] + *(const f32x4*)(bias + col); } }
    }
};
struct EpiQ {
    static constexpr bool PERM = false, AFTER_DRAIN = false;
    bf16_t* O; const float* rt;
    __device__ __forceinline__ void operator()(const f32x4 (&acc)[2][2][4][2], const Unit& u, int wr, int wc, int fr, int fq) const {
        typedef unsigned u32x2 __attribute__((ext_vector_type(2)));
#pragma unroll
        for (int ai = 0; ai < 2; ++ai)
#pragma unroll
            for (int m = 0; m < 4; ++m) { const int row = u.pm * BM + ai * HALF + wr * 64 + m * 16 + fr; const int pos = posof(row);
                const float* rtp = rt + (size_t)pos * 32 + 8 * fq;
#pragma unroll
                for (int bj = 0; bj < 2; ++bj) { const int gc0 = u.pn * BM + bj * HALF + wc * 32; const bool isrope = (gc0 % 96) == 64;
                    f32x4 v0 = acc[ai][bj][m][0] * QSCALE, v1 = acc[ai][bj][m][1] * QSCALE;
                    if (isrope) { const f32x4 cs0 = *(const f32x4*)(rtp), cs1 = *(const f32x4*)(rtp + 4);
                        const float c[4] = {cs0[0], cs0[2], cs1[0], cs1[2]}, s[4] = {cs0[1], cs0[3], cs1[1], cs1[3]};
                        f32x4 a, b;
#pragma unroll
                        for (int e = 0; e < 4; ++e) { a[e] = v0[e] * c[e] - v1[e] * s[e]; b[e] = v1[e] * c[e] + v0[e] * s[e]; }
                        v0 = a; v1 = b; }
                    bf16_t* p = O + (size_t)row * 768 + gc0 + 4 * fq;
                    u32x2 w0; w0.x = cvt_pk_bf16(v0[0], v0[1]); w0.y = cvt_pk_bf16(v0[2], v0[3]); *(u32x2*)p = w0;
                    u32x2 w1; w1.x = cvt_pk_bf16(v1[0], v1[1]); w1.y = cvt_pk_bf16(v1[2], v1[3]); *(u32x2*)(p + 16) = w1; }
                asm volatile("" ::: "memory"); }
    }
};

template <class Epi, class Sched, bool ALIGN_EPI = false, bool SP2 = false>
__device__ __forceinline__ void gemm_phase(PG8_LAS unsigned char* lds, const Gemm g, const Sched& S, const Epi& E) {
    int tid = threadIdx.x; asm volatile("" : "+v"(tid));
    const int wid = __builtin_amdgcn_readfirstlane(tid >> 6), lane = tid & 63, wr = wid >> 2, wc = wid & 3, fr = lane & 15, fq = lane >> 4;
    const int K = g.K, nt = K / BK;
    unsigned voffA[2], voffB[2];
#pragma unroll
    for (int i = 0; i < 2; ++i) { int R, C; stage_rc(tid * 16 + i * 8192, R, C); const int Rb = Epi::PERM ? ((R & ~31) + perm32(R & 31)) : R;
        voffA[i] = (unsigned)(R * g.lda + C) * 2u; voffB[i] = (unsigned)(Rb * g.ldb + C) * 2u; }
    const size_t kstep = (size_t)(BK * 2);
    const int lda = g.lda, ldb = g.ldb;
    const size_t hstepA = (size_t)HALF * lda * 2, hstepB = (size_t)HALF * ldb * 2;
    const size_t tstepA = 2 * hstepA, tstepB = 2 * hstepB;
    const unsigned ldsw = (unsigned)wid * 1024u;
    const int aoff = lds_byte(wr * 64 + fr, fq * 8), boff = lds_byte(wc * 32 + fr, fq * 8);
#define PG8_SA(b, h) (((b) * 2 + (h)) * HTB)
#define PG8_SB(b, h) ((4 + (b) * 2 + (h)) * HTB)
#define PG8_STAGE(bufoff, gbase, voff) do { _Pragma("unroll") for (int _i = 0; _i < 2; ++_i) \
        __builtin_amdgcn_global_load_lds((const unsigned*)((const char*)(gbase) + (voff)[_i]), (PG8_LAS unsigned*)(lds + (bufoff) + ldsw + _i * 8192), 16, 0, 0); } while (0)
#define PG8_LDA(dst, b, h) do { _Pragma("unroll") for (int m = 0; m < 4; ++m) _Pragma("unroll") for (int k = 0; k < 2; ++k) dst[m][k] = *(const PG8_LAS bf16x8*)(lds + PG8_SA(b, h) + aoff + m * 2048 + k * 1024); } while (0)
#define PG8_LDB(dst, b, h) do { _Pragma("unroll") for (int n = 0; n < 2; ++n) _Pragma("unroll") for (int k = 0; k < 2; ++k) dst[n][k] = *(const PG8_LAS bf16x8*)(lds + PG8_SB(b, h) + boff + n * 2048 + k * 1024); } while (0)
#define PG8_MMA(ai, bj, At, Bt) do { __builtin_amdgcn_s_setprio(1); _Pragma("unroll") for (int m = 0; m < 4; ++m) _Pragma("unroll") for (int n = 0; n < 2; ++n) _Pragma("unroll") for (int k = 0; k < 2; ++k) \
        acc[ai][bj][m][n] = __builtin_amdgcn_mfma_f32_16x16x32_bf16(Bt[n][k], At[m][k], acc[ai][bj][m][n], 0, 0, 0); __builtin_amdgcn_s_setprio(0); } while (0)
#define PG8_WAIT_V(n) asm volatile("s_waitcnt vmcnt(" #n ")" ::: "memory")
#define PG8_WAIT_L(n) asm volatile("s_waitcnt lgkmcnt(" #n ")" ::: "memory")
#define PG8_BAR __builtin_amdgcn_s_barrier()
#define PG8_SCHED __builtin_amdgcn_sched_barrier(0)
    Unit cur, nxt; int ui = 0;
    if (!S.next(0, cur)) return;
    f32x4 acc[2][2][4][2];
#pragma unroll
    for (int a = 0; a < 2; ++a)
#pragma unroll
        for (int b = 0; b < 2; ++b)
#pragma unroll
            for (int m = 0; m < 4; ++m)
#pragma unroll
                for (int n = 0; n < 2; ++n) acc[a][b][m][n] = (f32x4){0.f, 0.f, 0.f, 0.f};
    bf16x8 At[4][2], B0[2][2], B1[2][2];
    const char* cA = (const char*)g.A + (size_t)cur.pm * tstepA + (size_t)cur.koff * 2; const char* cB = (const char*)g.Bt + (size_t)cur.pn * tstepB + (size_t)cur.koff * 2;
    S.a_ready(cur);
    if constexpr (SP2) {
        PG8_STAGE(PG8_SB(0, 0), cB, voffB); PG8_STAGE(PG8_SB(0, 1), cB + hstepB, voffB); PG8_STAGE(PG8_SA(0, 0), cA, voffA); PG8_STAGE(PG8_SA(0, 1), cA + hstepA, voffA);
        if (wr == 1) PG8_BAR;
        PG8_WAIT_V(2); PG8_BAR;
        PG8_STAGE(PG8_SB(1, 0), cB + kstep, voffB); PG8_STAGE(PG8_SA(1, 0), cA + kstep, voffA); PG8_STAGE(PG8_SB(1, 1), cB + hstepB + kstep, voffB);
        PG8_WAIT_V(6); PG8_BAR;
    } else {
        PG8_STAGE(PG8_SB(0, 0), cB, voffB); PG8_STAGE(PG8_SA(0, 0), cA, voffA); PG8_STAGE(PG8_SB(0, 1), cB + hstepB, voffB); PG8_STAGE(PG8_SA(0, 1), cA + hstepA, voffA);
        if (wr == 1) PG8_BAR;
        PG8_WAIT_V(4); PG8_BAR;
        PG8_STAGE(PG8_SB(1, 0), cB + kstep, voffB); PG8_STAGE(PG8_SA(1, 0), cA + kstep, voffA); PG8_STAGE(PG8_SB(1, 1), cB + hstepB + kstep, voffB);
        PG8_WAIT_V(6); PG8_BAR;
    }
    for (;;) {
        const bool has_next = S.next(ui + 1, nxt);
        const char* nA = has_next ? (const char*)g.A + (size_t)nxt.pm * tstepA + (size_t)nxt.koff * 2 : cA; const char* nB = has_next ? (const char*)g.Bt + (size_t)nxt.pn * tstepB + (size_t)nxt.koff * 2 : cB;
        for (int t = 0; t < nt; t += 2) {
            const bool last = (t == nt - 2);
            const char* a1 = cA + (size_t)(t + 1) * kstep;
            const char* a2 = last ? nA : cA + (size_t)(t + 2) * kstep; const char* b2 = last ? nB : cB + (size_t)(t + 2) * kstep;
            const char* a3 = a2 + kstep; const char* b3 = b2 + kstep;
            if (last && has_next) S.a_ready(nxt);
            if constexpr (SP2) {
            PG8_LDB(B0, 0, 0); PG8_LDB(B1, 0, 1); PG8_SCHED; PG8_LDA(At, 0, 0); PG8_STAGE(PG8_SA(1, 1), a1 + hstepA, voffA);
            PG8_WAIT_V(8); PG8_WAIT_L(0); PG8_BAR; PG8_MMA(0, 0, At, B0); PG8_MMA(0, 1, At, B1); PG8_BAR; PG8_SCHED;
            PG8_LDA(At, 0, 1); PG8_STAGE(PG8_SB(0, 0), b2, voffB); PG8_STAGE(PG8_SB(0, 1), b2 + hstepB, voffB); PG8_STAGE(PG8_SA(0, 0), a2, voffA);
            PG8_WAIT_V(8); PG8_WAIT_L(0); PG8_BAR; PG8_MMA(1, 0, At, B0); PG8_MMA(1, 1, At, B1); PG8_BAR; PG8_SCHED;
            PG8_LDB(B0, 1, 0); PG8_LDB(B1, 1, 1); PG8_SCHED; PG8_LDA(At, 1, 0); PG8_STAGE(PG8_SA(0, 1), a2 + hstepA, voffA);
            PG8_WAIT_V(8); PG8_WAIT_L(0); PG8_BAR; PG8_MMA(0, 0, At, B0); PG8_MMA(0, 1, At, B1); PG8_BAR; PG8_SCHED;
            PG8_LDA(At, 1, 1); PG8_STAGE(PG8_SB(1, 0), b3, voffB); PG8_STAGE(PG8_SB(1, 1), b3 + hstepB, voffB); PG8_STAGE(PG8_SA(1, 0), a3, voffA);
            PG8_WAIT_V(8); PG8_WAIT_L(0); PG8_BAR; PG8_MMA(1, 0, At, B0); PG8_MMA(1, 1, At, B1); PG8_BAR; PG8_SCHED;
            } else {
            PG8_LDB(B0, 0, 0); PG8_SCHED; PG8_LDA(At, 0, 0); PG8_STAGE(PG8_SA(1, 1), a1 + hstepA, voffA);
            PG8_WAIT_L(8); PG8_BAR; PG8_WAIT_L(0); PG8_MMA(0, 0, At, B0); PG8_BAR; PG8_SCHED;
            PG8_LDB(B1, 0, 1); PG8_STAGE(PG8_SB(0, 0), b2, voffB);
            PG8_BAR; PG8_WAIT_L(0); PG8_MMA(0, 1, At, B1); PG8_BAR;
            PG8_LDA(At, 0, 1); PG8_STAGE(PG8_SA(0, 0), a2, voffA);
            PG8_BAR; PG8_WAIT_L(0); PG8_MMA(1, 0, At, B0); PG8_BAR; PG8_SCHED;
            PG8_STAGE(PG8_SB(0, 1), b2 + hstepB, voffB);
            PG8_WAIT_V(6); PG8_BAR; PG8_MMA(1, 1, At, B1); PG8_BAR;
            PG8_LDB(B0, 1, 0); PG8_SCHED; PG8_LDA(At, 1, 0); PG8_STAGE(PG8_SA(0, 1), a2 + hstepA, voffA);
            PG8_WAIT_L(8); PG8_BAR; PG8_WAIT_L(0); PG8_MMA(0, 0, At, B0); PG8_BAR; PG8_SCHED;
            PG8_LDB(B1, 1, 1); PG8_STAGE(PG8_SB(1, 0), b3, voffB);
            PG8_BAR; PG8_WAIT_L(0); PG8_MMA(0, 1, At, B1); PG8_BAR;
            PG8_LDA(At, 1, 1); PG8_STAGE(PG8_SA(1, 0), a3, voffA);
            PG8_BAR; PG8_WAIT_L(0); PG8_MMA(1, 0, At, B0); PG8_BAR; PG8_SCHED;
            PG8_STAGE(PG8_SB(1, 1), b3 + hstepB, voffB);
            PG8_WAIT_V(6); PG8_BAR; PG8_MMA(1, 1, At, B1); PG8_BAR;
            }
        }
        if constexpr (ALIGN_EPI) { if (wr == 0) PG8_BAR; }
        if constexpr (!Epi::AFTER_DRAIN) { E(acc, cur, wr, wc, fr, fq); S.done(cur); }
        if (!has_next) break;
#pragma unroll
        for (int a = 0; a < 2; ++a)
#pragma unroll
            for (int b = 0; b < 2; ++b)
#pragma unroll
                for (int m = 0; m < 4; ++m)
#pragma unroll
                    for (int n = 0; n < 2; ++n) acc[a][b][m][n] = (f32x4){0.f, 0.f, 0.f, 0.f};
        cur = nxt; cA = nA; cB = nB; ++ui;
        if constexpr (ALIGN_EPI) { if (wr == 1) PG8_BAR; }
    }
    PG8_WAIT_V(0);
    if constexpr (!ALIGN_EPI) { if (wr == 0) PG8_BAR; }
    PG8_BAR;
    if constexpr (Epi::AFTER_DRAIN) { E.fused(acc, cur, wr, wc, fr, fq, lds, wid, lane); S.done(cur); }
#undef PG8_SA
#undef PG8_SB
#undef PG8_STAGE
#undef PG8_LDA
#undef PG8_LDB
#undef PG8_MMA
#undef PG8_WAIT_V
#undef PG8_WAIT_L
#undef PG8_BAR
#undef PG8_SCHED
}
}
constexpr size_t MiB = 1u << 20;
constexpr size_t WS_CTL = 0, CTL_ZERO_BYTES = 1 * MiB;
constexpr size_t WS_W13T = 2 * MiB, W13T_STRIDE = 11 * MiB;
constexpr size_t WS_W2T = 46 * MiB, W2T_STRIDE = 5767168;
constexpr size_t WS_EVIN = 68 * MiB, WS_EVOUT = 73 * MiB, WS_ODIN = 75 * MiB, WS_ODOUT = 79 * MiB, WS_WUQ = 81 * MiB, WS_WKV = 82 * MiB;
constexpr size_t WS_ADAT = 83 * MiB, WS_SC = 119 * MiB, WS_RT = 120 * MiB, WS_MOD = 122 * MiB;
constexpr size_t WS_X = 140 * MiB, WS_H = 206 * MiB, WS_ACT = 239 * MiB, WS_Z = 330 * MiB, WS_OP = 405 * MiB;
constexpr size_t WS_US = 438 * MiB, WS_DS = 470 * MiB, WS_CQN = 471 * MiB, WS_CKVB = 484 * MiB, WS_KRB = 493 * MiB, WS_Q = 495 * MiB, WS_KV = 520 * MiB;
constexpr size_t WS_PART = 552 * MiB, WS_QD = 586 * MiB, WS_SLAB = 592 * MiB, WS_DUMMY = 616 * MiB, WS_END = 682 * MiB;
constexpr int NSPLIT = 8, PART_F = 32 * 256 + 64;
constexpr size_t O_Y = 0, O_GLAP = 17301504, O_GLAS = O_GLAP + 65536, O_POOLP = O_GLAS + 4194304, O_POOLS = O_POOLP + 15360, O_CKV = O_POOLS + 983040,
                 O_KR = O_CKV + 4325376, O_CONVP = O_KR + 540672, O_CONVS = O_CONVP + 30720, O_END = O_CONVS + 1966080;
constexpr int CW_TMO = 0, CW_CODE = 1, CW_BAR = 4096;
constexpr int RING_BYTES = 131072, LDSCTL_OFF = RING_BYTES, MISC_OFF = LDSCTL_OFF + 320, LDS_BYTES = 147456;
constexpr int NWAVES = 8;

typedef unsigned short bf16;
typedef unsigned v4u __attribute__((ext_vector_type(4)));
typedef unsigned v2u __attribute__((ext_vector_type(2)));
typedef float f32x4 __attribute__((ext_vector_type(4)));
typedef float f32x2 __attribute__((ext_vector_type(2)));
typedef float f32x16 __attribute__((ext_vector_type(16)));
typedef short bf16x8 __attribute__((ext_vector_type(8)));
typedef short s16x4 __attribute__((ext_vector_type(4)));
typedef GAS unsigned gu32;
#define RLX_AGENT __ATOMIC_RELAXED, __HIP_MEMORY_SCOPE_AGENT
#define LDS_WAIT() asm volatile("s_waitcnt lgkmcnt(0)" ::: "memory")
#define VM_WAIT() asm volatile("s_waitcnt vmcnt(0)" ::: "memory")


#ifndef PROBE_DUP
#define PROBE_DUP 0u
#endif
__device__ __forceinline__ int opaque_int(int v) { asm volatile("" : "+s"(v)); return v; }
#define NREP(n) ((((PROBE_DUP) >> (n)) & 1u) ? opaque_int(2) : 1)

#define XB_TMO      128
#define XB_XCNT(j)  (256  + 64 * (j))
#define XB_XSUB(j)  (1280 + 64 * (j))
#define XB_XGEN(j)  (2304 + 64 * (j))
#define XB_TOP      3328
#define XB_TOPGEN   3392
#define XCD_BAR_WORDS 3456
#define XB_SPIN_CAP (1u << 18)

__device__ __forceinline__ unsigned xb_ld(unsigned* p)              { return __hip_atomic_load(p, __ATOMIC_RELAXED, __HIP_MEMORY_SCOPE_AGENT); }
__device__ __forceinline__ unsigned xb_add(unsigned* p, unsigned v) { return __hip_atomic_fetch_add(p, v, __ATOMIC_RELAXED, __HIP_MEMORY_SCOPE_AGENT); }
__device__ __forceinline__ unsigned xb_xcc_id() { return (unsigned)__builtin_amdgcn_s_getreg((3 << 11) | 20) & 0xFu; }
#define XB_SPIN(cond, bar) do { unsigned _sp = 0; while (cond) { __builtin_amdgcn_s_sleep(1); \
    if ((++_sp & 255u) == 0u) { if (xb_ld(&(bar)[XB_TMO])) break; if (_sp > XB_SPIN_CAP) { atomicAdd(&(bar)[XB_TMO], 1u); break; } } } } while (0)

struct XcdBarrier {
    unsigned* bar; unsigned x;
    volatile LAS unsigned* st;
};

__device__ __forceinline__ XcdBarrier xcd_barrier_post(unsigned* bar, volatile LAS unsigned* st) {
    XcdBarrier b; b.bar = bar; b.x = xb_xcc_id(); b.st = st;
    if (threadIdx.x == 0) (void)xb_add(&bar[XB_XCNT(b.x)], 1u);
    return b;
}
__device__ __forceinline__ void xcd_barrier_complete(unsigned* bar, unsigned x, unsigned& nloc, unsigned& nx) {
    const unsigned G = gridDim.x * gridDim.y * gridDim.z;
    unsigned sum, cnt, mine, sp = 0u;
    for (;;) {
        sum = 0u; cnt = 0u; mine = 0u;
#pragma unroll
        for (unsigned j = 0; j < 16; ++j) { const unsigned c = xb_ld(&bar[XB_XCNT(j)]); sum += c; cnt += (c > 0u) ? 1u : 0u; mine = (j == x) ? c : mine; }
        if (sum == G) break;
        __builtin_amdgcn_s_sleep(1);
        if ((++sp & 255u) == 0u) { if (xb_ld(&bar[XB_TMO])) break; if (sp > XB_SPIN_CAP) { atomicAdd(&bar[XB_TMO], 1u); break; } }
    }
    nloc = mine > 0u ? mine : 1u; nx = cnt > 0u ? cnt : 1u;
}

__device__ __forceinline__ void xcd_barrier(const XcdBarrier& b) {
    asm volatile("s_waitcnt vmcnt(0)" ::: "memory");
    __syncthreads();
    if (threadIdx.x == 0) {
        unsigned* bar = b.bar;
        __builtin_amdgcn_s_waitcnt(0);
        unsigned nloc = b.st[0], nx = b.st[1];
        if (nloc == 0u) { xcd_barrier_complete(bar, b.x, nloc, nx); b.st[0] = nloc; b.st[1] = nx; }
        const unsigned old = xb_add(&bar[XB_XSUB(b.x)], 1u);
        const unsigned gen = old / nloc;
        if (old + 1u == (gen + 1u) * nloc) {
            __builtin_amdgcn_fence(__ATOMIC_RELEASE, "agent");
            asm volatile("s_waitcnt vmcnt(0)" ::: "memory");
            const unsigned og = xb_add(&bar[XB_TOP], 1u);
            const unsigned tg = og / nx;
            if (og + 1u == (tg + 1u) * nx) xb_add(&bar[XB_TOPGEN], 1u);
            else XB_SPIN(xb_ld(&bar[XB_TOPGEN]) == tg, bar);
            __builtin_amdgcn_fence(__ATOMIC_ACQUIRE, "agent");
            xb_add(&bar[XB_XGEN(b.x)], 1u);
            asm volatile("s_waitcnt vmcnt(0)" ::: "memory");
        } else {
            XB_SPIN(xb_ld(&bar[XB_XGEN(b.x)]) == gen, bar);
            __builtin_amdgcn_fence(__ATOMIC_ACQUIRE, "agent");
            asm volatile("s_waitcnt vmcnt(0)" ::: "memory");
        }
    }
    __syncthreads();
}
struct Args { const void* in[35]; float* out; unsigned char* ws; int ph_lo, ph_hi, use_bar, k_q, k_kv, pad; };
struct Frame {
    LAS unsigned char* lds;
    volatile LAS unsigned* MISC;
    gu32* ctl;
    int tid, lane, wave, G, bx;
    unsigned char* ws; float* out;
};
__device__ __forceinline__ float wave_sum(float v) {
#pragma unroll
    for (int o = 1; o < 64; o <<= 1) v += __shfl_xor(v, o);
    return v;
}
__device__ __forceinline__ float half_sum(float v) {
#pragma unroll
    for (int o = 1; o < 32; o <<= 1) v += __shfl_xor(v, o);
    return v;
}
#define WS_PTR(T, off) ((T*)(F.ws + (off)))

enum { RM_ID = 0, RM_W1 = 1, RM_W3 = 2, RM_EVIN = 3 };
__device__ __forceinline__ int map_row(int mode, int n) {
    if (mode == RM_W1) return 256 * (n >> 7) + (n & 127);
    if (mode == RM_W3) return 256 * (n >> 7) + 128 + (n & 127);
    if (mode == RM_EVIN) return n < 1536 ? n : (n < 1552 ? 2048 + (n - 1536) : 1536 + (n - 1552));
    return n;
}
__device__ __forceinline__ void p0_transpose_item(const float* W, int N, bf16* WT, int ldk, int mode, LAS float* scr, int item, int lane) {
    const int nblk = (N + 31) / 32, kb = item / nblk, nb = item % nblk, k0 = 64 * kb, n0 = 32 * nb;
    const bool okc = (n0 + (lane & 31)) < N;
    float tv[32];
#pragma unroll
    for (int i = 0; i < 32; ++i) { const int kk = 2 * i + (lane >> 5); tv[i] = okc ? __builtin_nontemporal_load(W + (size_t)(k0 + kk) * N + n0 + (lane & 31)) : 0.f; }
#pragma unroll
    for (int i = 0; i < 32; ++i) { const int kk = 2 * i + (lane >> 5); scr[kk * 33 + (lane & 31)] = tv[i]; }
    LDS_WAIT(); asm volatile("" ::: "memory");
    const int c = lane & 7;
#pragma unroll
    for (int j = 0; j < 4; ++j) { const int n = (lane >> 3) + 8 * j; const LAS float* s = scr + (8 * c) * 33 + n;
        v4u o; o.x = pk2(s[0 * 33], s[1 * 33]); o.y = pk2(s[2 * 33], s[3 * 33]); o.z = pk2(s[4 * 33], s[5 * 33]); o.w = pk2(s[6 * 33], s[7 * 33]);
        if (n0 + n < N) *(GAS v4u*)(WT + (size_t)map_row(mode, n0 + n) * ldk + k0 + 8 * c) = o; }
    LDS_WAIT(); asm volatile("" ::: "memory");
}
__device__ __forceinline__ void p0_prologue(Frame& F, const Args& A) {
    LAS float* scr = (LAS float*)(F.lds + F.wave * 16384);
    const int gw = F.bx * NWAVES + F.wave, NGW = F.G * NWAVES;
    const float* ffn_w1 = (const float*)A.in[13]; const float* ffn_w3 = (const float*)A.in[14]; const float* ffn_w2 = (const float*)A.in[15];
    const float* ev_w_in = (const float*)A.in[16]; const float* ev_w_out = (const float*)A.in[22]; const float* od_w_in = (const float*)A.in[23]; const float* od_w_out = (const float*)A.in[33];
    const float* w_uq = (const float*)A.in[25]; const float* w_uk = (const float*)A.in[27]; const float* w_uv = (const float*)A.in[28]; const float* ada_w = (const float*)A.in[10];
    constexpr int I_W1 = 16 * 88, I_W2 = 44 * 32, I_FFN = 2 * I_W1 + I_W2;
    constexpr int I_EVIN = 16 * 65, I_EVOUT = 8 * 32, I_ODIN = 16 * 53, I_ODOUT = 16 * 32, I_UQ = 6 * 24, I_UK = 4 * 16, I_ADA = 16 * 288;
    constexpr int NITEMS = 4 * I_FFN + I_EVIN + I_EVOUT + I_ODIN + I_ODOUT + I_UQ + 2 * I_UK + 2 * I_ADA;
    for (int it = gw; it < NITEMS; it += NGW) {
        int r = it;
        if (r < 4 * I_FFN) { const int i = r / I_FFN; r -= i * I_FFN;
            bf16* w13 = WS_PTR(bf16, WS_W13T + (size_t)i * W13T_STRIDE); bf16* w2 = WS_PTR(bf16, WS_W2T + (size_t)i * W2T_STRIDE);
            if (r < I_W1) { p0_transpose_item(ffn_w1 + (size_t)i * DM * FF, FF, w13, DM, RM_W1, scr, r, F.lane); continue; } r -= I_W1;
            if (r < I_W1) { p0_transpose_item(ffn_w3 + (size_t)i * DM * FF, FF, w13, DM, RM_W3, scr, r, F.lane); continue; } r -= I_W1;
            p0_transpose_item(ffn_w2 + (size_t)i * FF * DM, DM, w2, FF, RM_ID, scr, r, F.lane); continue; }
        r -= 4 * I_FFN;
        if (r < I_EVIN) { p0_transpose_item(ev_w_in, 2064, WS_PTR(bf16, WS_EVIN), DM, RM_EVIN, scr, r, F.lane); continue; } r -= I_EVIN;
        if (r < I_EVOUT) { p0_transpose_item(ev_w_out, DM, WS_PTR(bf16, WS_EVOUT), DM, RM_ID, scr, r, F.lane); continue; } r -= I_EVOUT;
        if (r < I_ODIN) { p0_transpose_item(od_w_in, 1696, WS_PTR(bf16, WS_ODIN), DM, RM_ID, scr, r, F.lane); continue; } r -= I_ODIN;
        if (r < I_ODOUT) { p0_transpose_item(od_w_out, DM, WS_PTR(bf16, WS_ODOUT), DM, RM_ID, scr, r, F.lane); continue; } r -= I_ODOUT;
        if (r < I_UQ) { p0_transpose_item(w_uq, 768, WS_PTR(bf16, WS_WUQ), 384, RM_ID, scr, r, F.lane); continue; } r -= I_UQ;
        if (r < I_UK) { p0_transpose_item(w_uk, 512, WS_PTR(bf16, WS_WKV), 256, RM_ID, scr, r, F.lane); continue; } r -= I_UK;
        if (r < I_UK) { p0_transpose_item(w_uv, 512, WS_PTR(bf16, WS_WKV) + 512 * 256, 256, RM_ID, scr, r, F.lane); continue; } r -= I_UK;
        { const int l = r / I_ADA; r -= l * I_ADA; p0_transpose_item(ada_w + (size_t)l * DM * 9216, 9216, WS_PTR(bf16, WS_ADAT) + (size_t)l * 9216 * DM, DM, RM_ID, scr, r, F.lane); }
    }
    { constexpr int NZ = (240 + 96) * (DM / 8);
      for (int i = F.bx * 512 + F.tid; i < NZ; i += F.G * 512) { const int rr = i / (DM / 8), c8 = i % (DM / 8);
          bf16* dst = rr < 240 ? WS_PTR(bf16, WS_EVIN) + (size_t)(2064 + rr) * DM : WS_PTR(bf16, WS_ODIN) + (size_t)(1696 + rr - 240) * DM;
          *(GAS v4u*)(dst + c8 * 8) = (v4u){0u, 0u, 0u, 0u}; } }
    { const float* pool_w = (const float*)A.in[20]; const float* pool_scale = (const float*)A.in[21]; bf16* evo = WS_PTR(bf16, WS_EVOUT);
      for (int it = gw; it < 512; it += NGW) { const int g = it >> 7, c = it & 127;
          f32x4 acc[4] = {{0.f, 0.f, 0.f, 0.f}, {0.f, 0.f, 0.f, 0.f}, {0.f, 0.f, 0.f, 0.f}, {0.f, 0.f, 0.f, 0.f}};
          for (int d = 0; d < 128; ++d) { const float a = pool_w[(size_t)(g * 128 + c) * 128 + d] * pool_scale[g * 128 + d];
              const float* wr = ev_w_out + (size_t)(512 + g * 128 + d) * DM + 4 * F.lane;
#pragma unroll
              for (int j = 0; j < 4; ++j) acc[j] += a * *(const f32x4*)(wr + 256 * j); }
#pragma unroll
          for (int j = 0; j < 4; ++j)
#pragma unroll
              for (int e = 0; e < 4; ++e) evo[(size_t)(256 * j + 4 * F.lane + e) * DM + 512 + g * 128 + c] = (bf16)f2bf(acc[j][e]); } }
    { const float* cp = (const float*)A.in[8]; const float* cs = (const float*)A.in[9]; bf16* sc = WS_PTR(bf16, WS_SC);
      for (int r = gw; r < 256; r += NGW) { const float* src = r < 2 ? cp + (size_t)r * DM : cs + (size_t)(r - 2) * DM;
#pragma unroll
          for (int j = 0; j < 4; ++j) { f32x4 v = {0.f, 0.f, 0.f, 0.f}; if (r < NBAT) v = *(const f32x4*)(src + 4 * F.lane + 256 * j);
              v2u o; o.x = r < NBAT ? pk2(siluf_(v[0]), siluf_(v[1])) : 0u; o.y = r < NBAT ? pk2(siluf_(v[2]), siluf_(v[3])) : 0u;
              *(GAS v2u*)(sc + (size_t)r * DM + 4 * F.lane + 256 * j) = o; } } }
    { const f32x4* xs = (const f32x4*)A.in[1]; f32x4* xd = (f32x4*)(WS_PTR(float, WS_X) + (size_t)MP * DM);
      for (int i = F.bx * 512 + F.tid; i < MS * DM / 4; i += F.G * 512) xd[i] = xs[i]; }
    { float* rt = WS_PTR(float, WS_RT);
      for (int i = F.bx * 512 + F.tid; i < 8196 * 16; i += F.G * 512) { const int pos = i >> 4, k = i & 15;
          const float freq = exp2f(-(float)k * 0.8304820237218406f);    const float ang = (float)pos * freq; float s, c; sincosf(ang, &s, &c);
          *(f32x2*)(rt + 2 * (size_t)i) = (f32x2){c, s}; } }
}

__device__ __forceinline__ void nm_phase(Frame& F, const float* bp, const float* bs, const float* g, const float* modsh, bf16* H, float* X, const float* slab, int nch, const float* pgate, float pcoef) {
    const int gw = F.bx * NWAVES + F.wave, NGW = F.G * NWAVES;
    f32x4 gv[4];
#pragma unroll
    for (int j = 0; j < 4; ++j) gv[j] = *(const f32x4*)(g + 4 * F.lane + 256 * j);
    for (int row = gw; row < MP; row += 2 * NGW) {
        const int row2 = row + NGW; const bool has2 = row2 < MP; const int r2 = has2 ? row2 : row;
        const float* xa = bp + (size_t)row * DM + 4 * F.lane; const float* xb = bp + (size_t)r2 * DM + 4 * F.lane;
        const float* ma = modsh + (size_t)(row >> 13) * MODLD + 4 * F.lane; const float* mb = modsh + (size_t)(r2 >> 13) * MODLD + 4 * F.lane;
        f32x4 va[4], vb[4], sha[4], sca[4], shb[4], scb[4]; float sa = 0.f, sb = 0.f;
#pragma unroll
        for (int j = 0; j < 4; ++j) { va[j] = *(const f32x4*)(xa + 256 * j); vb[j] = *(const f32x4*)(xb + 256 * j); }
#pragma unroll
        for (int j = 0; j < 4; ++j) { sha[j] = *(const f32x4*)(ma + 256 * j); sca[j] = *(const f32x4*)(ma + DM + 256 * j); shb[j] = *(const f32x4*)(mb + 256 * j); scb[j] = *(const f32x4*)(mb + DM + 256 * j); }
#pragma unroll
        for (int j = 0; j < 4; ++j) { sa += (va[j][0] * va[j][0] + va[j][1] * va[j][1]) + (va[j][2] * va[j][2] + va[j][3] * va[j][3]); sb += (vb[j][0] * vb[j][0] + vb[j][1] * vb[j][1]) + (vb[j][2] * vb[j][2] + vb[j][3] * vb[j][3]); }
#pragma unroll
        for (int o = 1; o < 64; o <<= 1) { sa += __shfl_xor(sa, o); sb += __shfl_xor(sb, o); }
        const float ra = 1.0f / sqrtf(sa * (1.0f / DM) + 1e-6f), rb2 = 1.0f / sqrtf(sb * (1.0f / DM) + 1e-6f);
#pragma unroll
        for (int j = 0; j < 4; ++j) { const f32x4 h = (va[j] * ra) * gv[j] * (sca[j] + 1.0f) + sha[j]; v2u o; o.x = pk2(h[0], h[1]); o.y = pk2(h[2], h[3]);
            *(GAS v2u*)(H + (size_t)row * DM + 4 * F.lane + 256 * j) = o; }
        if (has2) {
#pragma unroll
            for (int j = 0; j < 4; ++j) { const f32x4 h = (vb[j] * rb2) * gv[j] * (scb[j] + 1.0f) + shb[j]; v2u o; o.x = pk2(h[0], h[1]); o.y = pk2(h[2], h[3]);
                *(GAS v2u*)(H + (size_t)row2 * DM + 4 * F.lane + 256 * j) = o; } }
    }
    for (int row = MP + gw; row < MT; row += NGW) {
        const float* xr = bs + (size_t)row * DM + 4 * F.lane;
        f32x4 v[4]; float ss = 0.f;
#pragma unroll
        for (int j = 0; j < 4; ++j) v[j] = *(const f32x4*)(xr + 256 * j);
        if (nch > 0) { f32x4 a[4] = {{0.f, 0.f, 0.f, 0.f}, {0.f, 0.f, 0.f, 0.f}, {0.f, 0.f, 0.f, 0.f}, {0.f, 0.f, 0.f, 0.f}};
            for (int k = 0; k < nch; ++k) { const float* sp = slab + ((size_t)k * MS + (row - MP)) * DM + 4 * F.lane;
#pragma unroll
                for (int j = 0; j < 4; ++j) a[j] += *(const f32x4*)(sp + 256 * j); }
            const float* gp = pgate + (size_t)bidx(row) * MODLD + 4 * F.lane;
#pragma unroll
            for (int j = 0; j < 4; ++j) { v[j] += (*(const f32x4*)(gp + 256 * j) * pcoef) * a[j]; *(f32x4*)(X + (size_t)row * DM + 4 * F.lane + 256 * j) = v[j]; } }
#pragma unroll
        for (int j = 0; j < 4; ++j) ss += (v[j][0] * v[j][0] + v[j][1] * v[j][1]) + (v[j][2] * v[j][2] + v[j][3] * v[j][3]);
        const float rstd = 1.0f / sqrtf(wave_sum(ss) * (1.0f / DM) + 1e-6f);
        const float* mrow = modsh + (size_t)bidx(row) * MODLD + 4 * F.lane;
#pragma unroll
        for (int j = 0; j < 4; ++j) { const f32x4 sh = *(const f32x4*)(mrow + 256 * j), sc = *(const f32x4*)(mrow + DM + 256 * j);
            const f32x4 h = (v[j] * rstd) * gv[j] * (sc + 1.0f) + sh;
            v2u o; o.x = pk2(h[0], h[1]); o.y = pk2(h[2], h[3]);
            *(GAS v2u*)(H + (size_t)row * DM + 4 * F.lane + 256 * j) = o; }
    }
}
__device__ __forceinline__ void final_phase(Frame& F, const float* X, const float* g, float* out, const float* slab, int nch, const float* pgate, float pcoef) {
    const int gw = F.bx * NWAVES + F.wave, NGW = F.G * NWAVES;
    f32x4 gv[4];
#pragma unroll
    for (int j = 0; j < 4; ++j) gv[j] = *(const f32x4*)(g + 4 * F.lane + 256 * j);
    for (int row = gw; row < MT; row += NGW) {
        const float* xr = X + (size_t)row * DM + 4 * F.lane;
        f32x4 v[4]; float ss = 0.f;
#pragma unroll
        for (int j = 0; j < 4; ++j) v[j] = *(const f32x4*)(xr + 256 * j);
        if (row >= MP) { f32x4 a[4] = {{0.f, 0.f, 0.f, 0.f}, {0.f, 0.f, 0.f, 0.f}, {0.f, 0.f, 0.f, 0.f}, {0.f, 0.f, 0.f, 0.f}};
            for (int k = 0; k < nch; ++k) { const float* sp = slab + ((size_t)k * MS + (row - MP)) * DM + 4 * F.lane;
#pragma unroll
                for (int j = 0; j < 4; ++j) a[j] += *(const f32x4*)(sp + 256 * j); }
            const float* gp = pgate + (size_t)bidx(row) * MODLD + 4 * F.lane;
#pragma unroll
            for (int j = 0; j < 4; ++j) v[j] += (*(const f32x4*)(gp + 256 * j) * pcoef) * a[j]; }
#pragma unroll
        for (int j = 0; j < 4; ++j) ss += (v[j][0] * v[j][0] + v[j][1] * v[j][1]) + (v[j][2] * v[j][2] + v[j][3] * v[j][3]);
        const float rstd = 1.0f / sqrtf(wave_sum(ss) * (1.0f / DM) + 1e-6f);
#pragma unroll
        for (int j = 0; j < 4; ++j) *(f32x4*)(out + (size_t)row * DM + 4 * F.lane + 256 * j) = (v[j] * rstd) * gv[j];
    }
}
__device__ __forceinline__ float logsig16(float x) { return (fminf(x, 0.f) - __logf(1.0f + __expf(-fabsf(x)))) * (1.0f / 16.0f); }
__device__ __forceinline__ void gla_cumdecay(Frame& F, const bf16* Z, int row0, int h, const float* gate_w2, const float* gate_b, LAS float* bcs, LAS float* gl, LAS float* seg) {
    const int tid = F.tid;
    { const int t = tid >> 3, j2 = (tid & 7) * 2; const unsigned w = *(const unsigned*)(Z + (size_t)(row0 + t) * ZE + 2048 + j2);
      gl[t * 16 + j2] = bf2f((unsigned short)(w & 0xffffu)); gl[t * 16 + j2 + 1] = bf2f((unsigned short)(w >> 16)); }
    __syncthreads();
    { const int t = tid >> 3, dk8 = (tid & 7) * 8; float x[8];
      { const f32x4 b0 = *(const f32x4*)(gate_b + h * 64 + dk8), b1 = *(const f32x4*)(gate_b + h * 64 + dk8 + 4);
#pragma unroll
        for (int e = 0; e < 4; ++e) { x[e] = b0[e]; x[4 + e] = b1[e]; } }
#pragma unroll
      for (int j = 0; j < 16; ++j) { const float gv = gl[t * 16 + j]; const f32x4 w0 = *(const f32x4*)(gate_w2 + j * 256 + h * 64 + dk8), w1 = *(const f32x4*)(gate_w2 + j * 256 + h * 64 + dk8 + 4);
#pragma unroll
          for (int e = 0; e < 4; ++e) { x[e] += gv * w0[e]; x[4 + e] += gv * w1[e]; } }
#pragma unroll
      for (int e = 0; e < 8; ++e) bcs[t * 64 + dk8 + e] = logsig16(x[e]); }
    __syncthreads();
    { const int dk = tid & 63, sg = tid >> 6; float run = 0.f;
#pragma unroll
      for (int i = 0; i < 8; ++i) { run += bcs[(sg * 8 + i) * 64 + dk]; bcs[(sg * 8 + i) * 64 + dk] = run; }
      seg[sg * 64 + dk] = run; }
    __syncthreads();
    { const int dk = tid & 63, sg = tid >> 6; float pre = 0.f;
      for (int s = 0; s < sg; ++s) pre += seg[s * 64 + dk];
#pragma unroll
      for (int i = 0; i < 8; ++i) bcs[(sg * 8 + i) * 64 + dk] += pre; }
    __syncthreads();
}
__device__ __forceinline__ void gla_g1_unit(Frame& F, const Args& A, int unit) {
    const bf16* Z = WS_PTR(bf16, WS_Z); float* US = WS_PTR(float, WS_US); float* DS = WS_PTR(float, WS_DS);
    int tid = threadIdx.x; asm volatile("" : "+v"(tid)); F.tid = tid; F.lane = tid & 63; F.wave = __builtin_amdgcn_readfirstlane(tid >> 6);
    const int bh = unit >> 7, n = unit & 127, b = bh >> 2, h = bh & 3, row0 = b * TP + n * 64;
    LAS float* bcs = (LAS float*)F.lds; LAS float* kk = bcs + 4096; LAS float* vv = kk + 4096; LAS float* gl = vv + 8192; LAS float* seg = gl + 1024;
    gla_cumdecay(F, Z, row0, h, (const float*)A.in[17], (const float*)A.in[18], bcs, gl, seg);
    { const int s = tid >> 3, dk8 = (tid & 7) * 8; const v4u kw = *(const v4u*)(Z + (size_t)(row0 + s) * ZE + 256 + h * 64 + dk8);
#pragma unroll
      for (int e = 0; e < 4; ++e) { const unsigned w = kw[e]; const int d0 = dk8 + 2 * e;
          kk[s * 64 + d0] = bf2f((unsigned short)(w & 0xffffu)) * __expf(bcs[63 * 64 + d0] - bcs[s * 64 + d0]);
          kk[s * 64 + d0 + 1] = bf2f((unsigned short)(w >> 16)) * __expf(bcs[63 * 64 + d0 + 1] - bcs[s * 64 + d0 + 1]); }
      const int dv16 = (tid & 7) * 16;
#pragma unroll
      for (int q = 0; q < 2; ++q) { const v4u vw = *(const v4u*)(Z + (size_t)(row0 + s) * ZE + 512 + h * 128 + dv16 + 8 * q);
#pragma unroll
          for (int e = 0; e < 4; ++e) { vv[s * 128 + dv16 + 8 * q + 2 * e] = bf2f((unsigned short)(vw[e] & 0xffffu)); vv[s * 128 + dv16 + 8 * q + 2 * e + 1] = bf2f((unsigned short)(vw[e] >> 16)); } }
      if (tid < 64) DS[(size_t)unit * 64 + tid] = __expf(bcs[63 * 64 + tid]); }
    __syncthreads();
    { const int dkq = tid >> 5, dvq = tid & 31; f32x4 acc[4] = {{0.f, 0.f, 0.f, 0.f}, {0.f, 0.f, 0.f, 0.f}, {0.f, 0.f, 0.f, 0.f}, {0.f, 0.f, 0.f, 0.f}};
#pragma unroll 4
      for (int s = 0; s < 64; ++s) { const f32x4 a = *(const LAS f32x4*)(kk + s * 64 + 4 * dkq), bv = *(const LAS f32x4*)(vv + s * 128 + 4 * dvq);
#pragma unroll
          for (int i = 0; i < 4; ++i) acc[i] += a[i] * bv; }
#pragma unroll
      for (int i = 0; i < 4; ++i) *(f32x4*)(US + ((size_t)unit * 64 + 4 * dkq + i) * 128 + 4 * dvq) = acc[i]; }
    __syncthreads();
}
__device__ __forceinline__ void gla_g2_phase(Frame& F) {
    float* US = WS_PTR(float, WS_US); const float* DS = WS_PTR(float, WS_DS); float* outp = F.out + O_GLAP;
    for (int gid = F.bx * 512 + F.tid; gid < 8 * 8192; gid += F.G * 512) {
        const int bh = gid >> 13, e = gid & 8191, dk = e >> 7;
        float* up = US + (size_t)bh * 128 * 8192 + e; const float* dp = DS + (size_t)bh * 128 * 64 + dk; float S = 0.f;
        for (int n0 = 0; n0 < 128; n0 += 8) { float uu[8], dd[8];
#pragma unroll
            for (int i = 0; i < 8; ++i) { uu[i] = up[(size_t)(n0 + i) * 8192]; dd[i] = dp[(n0 + i) * 64]; }
#pragma unroll
            for (int i = 0; i < 8; ++i) { up[(size_t)(n0 + i) * 8192] = S; S = dd[i] * S + uu[i]; } }
        outp[gid] = S;
    }
}
__device__ __forceinline__ void gla_g3_unit(Frame& F, const Args& A, int unit) {
    const bf16* Z = WS_PTR(bf16, WS_Z); const float* US = WS_PTR(float, WS_US); bf16* OP = WS_PTR(bf16, WS_OP);
    int tid = threadIdx.x; asm volatile("" : "+v"(tid)); F.tid = tid; F.lane = tid & 63; F.wave = __builtin_amdgcn_readfirstlane(tid >> 6);
    const int bh = unit >> 7, n = unit & 127, b = bh >> 2, h = bh & 3, row0 = b * TP + n * 64;
    LAS float* bcs = (LAS float*)F.lds; LAS float* attT = bcs;
    LAS float* qiT = bcs + 4096; LAS float* kiT = qiT + 4096; LAS float* vv = kiT + 4096; LAS float* Sst = vv + 8192; LAS float* gl = Sst + 8192; LAS float* seg = gl + 1024;
    gla_cumdecay(F, Z, row0, h, (const float*)A.in[17], (const float*)A.in[18], bcs, gl, seg);
    { const int t = tid >> 3, dk8 = (tid & 7) * 8;
      const v4u qw = *(const v4u*)(Z + (size_t)(row0 + t) * ZE + h * 64 + dk8), kw = *(const v4u*)(Z + (size_t)(row0 + t) * ZE + 256 + h * 64 + dk8);
#pragma unroll
      for (int e = 0; e < 4; ++e) { const int d0 = dk8 + 2 * e; const float b0 = bcs[t * 64 + d0], b1 = bcs[t * 64 + d0 + 1];
          qiT[d0 * 64 + t] = 0.125f * bf2f((unsigned short)(qw[e] & 0xffffu)) * __expf(b0); qiT[(d0 + 1) * 64 + t] = 0.125f * bf2f((unsigned short)(qw[e] >> 16)) * __expf(b1);
          kiT[d0 * 64 + t] = bf2f((unsigned short)(kw[e] & 0xffffu)) * __expf(-b0); kiT[(d0 + 1) * 64 + t] = bf2f((unsigned short)(kw[e] >> 16)) * __expf(-b1); }
      const int dv16 = (tid & 7) * 16;
#pragma unroll
      for (int q = 0; q < 2; ++q) { const v4u vw = *(const v4u*)(Z + (size_t)(row0 + t) * ZE + 512 + h * 128 + dv16 + 8 * q);
#pragma unroll
          for (int e = 0; e < 4; ++e) { vv[t * 128 + dv16 + 8 * q + 2 * e] = bf2f((unsigned short)(vw[e] & 0xffffu)); vv[t * 128 + dv16 + 8 * q + 2 * e + 1] = bf2f((unsigned short)(vw[e] >> 16)); } }
#pragma unroll
      for (int j = 0; j < 4; ++j) *(LAS f32x4*)(Sst + 4 * (tid + 512 * j)) = *(const f32x4*)(US + (size_t)unit * 8192 + 4 * (tid + 512 * j)); }
    __syncthreads();
    { const int t4 = tid >> 5, s2 = tid & 31; f32x4 a0 = {0.f, 0.f, 0.f, 0.f}, a1 = {0.f, 0.f, 0.f, 0.f};
#pragma unroll 4
      for (int dk = 0; dk < 64; ++dk) { const f32x4 qv = *(const LAS f32x4*)(qiT + dk * 64 + 4 * t4); const f32x2 kv = *(const LAS f32x2*)(kiT + dk * 64 + 2 * s2);
          a0 += qv * kv[0]; a1 += qv * kv[1]; }
#pragma unroll
      for (int i = 0; i < 4; ++i) { if (2 * s2 > 4 * t4 + i) a0[i] = 0.f; if (2 * s2 + 1 > 4 * t4 + i) a1[i] = 0.f; }
      *(LAS f32x4*)(attT + (2 * s2) * 64 + 4 * t4) = a0; *(LAS f32x4*)(attT + (2 * s2 + 1) * 64 + 4 * t4) = a1; }
    __syncthreads();
    { const int t4 = tid >> 5, dvq = tid & 31; f32x4 o[4] = {{0.f, 0.f, 0.f, 0.f}, {0.f, 0.f, 0.f, 0.f}, {0.f, 0.f, 0.f, 0.f}, {0.f, 0.f, 0.f, 0.f}};
#pragma unroll 4
      for (int dk = 0; dk < 64; ++dk) { const f32x4 qv = *(const LAS f32x4*)(qiT + dk * 64 + 4 * t4), sv = *(const LAS f32x4*)(Sst + dk * 128 + 4 * dvq);
#pragma unroll
          for (int i = 0; i < 4; ++i) o[i] += qv[i] * sv; }
      const int smax = 4 * t4 + 3;
      for (int s = 0; s <= smax; ++s) { const f32x4 av = *(const LAS f32x4*)(attT + s * 64 + 4 * t4), v4 = *(const LAS f32x4*)(vv + s * 128 + 4 * dvq);
#pragma unroll
          for (int i = 0; i < 4; ++i) o[i] += av[i] * v4; }
      const f32x4 gn = *(const f32x4*)((const float*)A.in[19] + h * 128 + 4 * dvq);
#pragma unroll
      for (int i = 0; i < 4; ++i) { const float ss = half_sum((o[i][0] * o[i][0] + o[i][1] * o[i][1]) + (o[i][2] * o[i][2] + o[i][3] * o[i][3]));
          const float rstd = 1.0f / sqrtf(ss * (1.0f / 128.0f) + 1e-6f); const int row = row0 + 4 * t4 + i;
          const v2u rw = *(const v2u*)(Z + (size_t)row * ZE + 1024 + h * 128 + 4 * dvq);
          const float r0 = bf2f((unsigned short)(rw.x & 0xffffu)), r1 = bf2f((unsigned short)(rw.x >> 16)), r2 = bf2f((unsigned short)(rw.y & 0xffffu)), r3 = bf2f((unsigned short)(rw.y >> 16));
          v2u ow; ow.x = pk2(o[i][0] * rstd * gn[0] * siluf_(r0), o[i][1] * rstd * gn[1] * siluf_(r1)); ow.y = pk2(o[i][2] * rstd * gn[2] * siluf_(r2), o[i][3] * rstd * gn[3] * siluf_(r3));
          *(GAS v2u*)(OP + (size_t)row * DM + h * 128 + 4 * dvq) = ow; } }
    __syncthreads();
}
__device__ __forceinline__ void gla_sample_unit(Frame& F, const Args& A, int unit) {
    const bf16* Z = WS_PTR(bf16, WS_Z); bf16* OP = WS_PTR(bf16, WS_OP);
    const float* gate_w2 = (const float*)A.in[17]; const float* gate_b = (const float*)A.in[18]; const float* S0g = (const float*)A.in[2] + (size_t)unit * 8192; float* Sout = F.out + O_GLAS + (size_t)unit * 8192;
    int tid = threadIdx.x; asm volatile("" : "+v"(tid)); F.tid = tid; F.lane = tid & 63; F.wave = __builtin_amdgcn_readfirstlane(tid >> 6);
    const int b = unit >> 2, h = unit & 3, row0 = MP + 4 * b;
    LAS float* S0 = (LAS float*)F.lds; LAS float* bc = S0 + 8192; LAS float* qi = bc + 256; LAS float* ki = qi + 256; LAS float* kk = ki + 256; LAS float* vv = kk + 256; LAS float* att = vv + 512; LAS float* gl = att + 16; LAS float* red = gl + 64;
#pragma unroll
    for (int j = 0; j < 4; ++j) *(LAS f32x4*)(S0 + 4 * (tid + 512 * j)) = *(const f32x4*)(S0g + 4 * (tid + 512 * j));
    if (tid < 64) gl[tid] = bf2f(Z[(size_t)(row0 + (tid >> 4)) * ZE + 2048 + (tid & 15)]);
    vv[tid] = bf2f(Z[(size_t)(row0 + (tid >> 7)) * ZE + 512 + h * 128 + (tid & 127)]);
    __syncthreads();
    if (tid < 256) { const int t = tid >> 6, dk = tid & 63; float x = gate_b[h * 64 + dk];
#pragma unroll
        for (int j = 0; j < 16; ++j) x += gl[t * 16 + j] * gate_w2[j * 256 + h * 64 + dk];
        bc[t * 64 + dk] = logsig16(x); }
    __syncthreads();
    if (tid < 64) { float run = 0.f;
#pragma unroll
        for (int t = 0; t < 4; ++t) { run += bc[t * 64 + tid]; bc[t * 64 + tid] = run; } }
    __syncthreads();
    if (tid < 256) { const int t = tid >> 6, dk = tid & 63; const float bb = bc[t * 64 + dk], bl = bc[3 * 64 + dk];
        const float qv = bf2f(Z[(size_t)(row0 + t) * ZE + h * 64 + dk]), kv = bf2f(Z[(size_t)(row0 + t) * ZE + 256 + h * 64 + dk]);
        qi[t * 64 + dk] = 0.125f * qv * __expf(bb); ki[t * 64 + dk] = kv * __expf(-bb); kk[t * 64 + dk] = kv * __expf(bl - bb); }
    __syncthreads();
    if (tid < 16) { const int t = tid >> 2, s = tid & 3; float a = 0.f;
        for (int dk = 0; dk < 64; ++dk) a += qi[t * 64 + dk] * ki[s * 64 + dk];
        att[tid] = (s <= t) ? a : 0.f; }
    __syncthreads();
    { const int t = tid >> 7, dv = tid & 127; float o = 0.f;
#pragma unroll 8
      for (int dk = 0; dk < 64; ++dk) o += qi[t * 64 + dk] * S0[dk * 128 + dv];
#pragma unroll
      for (int s = 0; s < 4; ++s) o += att[t * 4 + s] * vv[s * 128 + dv];
      const float ss = wave_sum(o * o); if (F.lane == 0) red[F.wave] = ss;
      __syncthreads();
      const float tot = red[2 * t] + red[2 * t + 1]; const float rstd = 1.0f / sqrtf(tot * (1.0f / 128.0f) + 1e-6f);
      const float gn = ((const float*)A.in[19])[h * 128 + dv]; const float rr = bf2f(Z[(size_t)(row0 + t) * ZE + 1024 + h * 128 + dv]);
      OP[(size_t)(row0 + t) * DM + h * 128 + dv] = (bf16)f2bf(o * rstd * gn * siluf_(rr)); }
#pragma unroll
    for (int j = 0; j < 4; ++j) { const int e = 4 * (tid + 512 * j), dk = e >> 7, dv = e & 127; const float dec = __expf(bc[3 * 64 + dk]);
        f32x4 sn = *(const LAS f32x4*)(S0 + e) * dec;
#pragma unroll
        for (int s = 0; s < 4; ++s) sn += kk[s * 64 + dk] * *(const LAS f32x4*)(vv + s * 128 + dv);
        *(f32x4*)(Sout + e) = sn; }
    __syncthreads();
}
__device__ __forceinline__ void pool_prompt_unit(Frame& F, int unit) {
    const bf16* Z = WS_PTR(bf16, WS_Z); bf16* OP = WS_PTR(bf16, WS_OP); float* hp = F.out + O_POOLP;
    int c = threadIdx.x; asm volatile("" : "+v"(c));
    const int b = unit >> 7, t0 = (unit & 127) * 64, w = 2 << (c >> 7); const size_t rb = (size_t)b * TP;
    float s = 0.f;
    { float pv[16];
#pragma unroll
      for (int j = 0; j < 16; ++j) { const int t = t0 - 1 - j; pv[j] = (j < w && t >= 0) ? bf2f(Z[(rb + t) * ZE + 1536 + c]) : 0.f; }
#pragma unroll
      for (int j = 0; j < 16; ++j) s += pv[j]; }
#pragma unroll 1
    for (int tb = t0; tb < t0 + 64; tb += 16) { float uv[16], ov[16];
#pragma unroll
        for (int j = 0; j < 16; ++j) { const int t = tb + j; uv[j] = bf2f(Z[(rb + t) * ZE + 1536 + c]); ov[j] = (t - w >= 0) ? bf2f(Z[(rb + t - w) * ZE + 1536 + c]) : 0.f; }
#pragma unroll
        for (int j = 0; j < 16; ++j) { const int t = tb + j; s += uv[j]; s -= ov[j];
            const float cnt = (float)((t + 1 < w) ? t + 1 : w);
            OP[(rb + t) * DM + 512 + c] = (bf16)f2bf(s / cnt - uv[j]);
            if (t >= TP - 15) hp[((size_t)b * 15 + (t - (TP - 15))) * 512 + c] = uv[j]; } }
}
__device__ __forceinline__ void pool_sample_unit(Frame& F, const Args& A, int b) {
    const bf16* Z = WS_PTR(bf16, WS_Z); bf16* OP = WS_PTR(bf16, WS_OP); float* hs = F.out + O_POOLS + (size_t)b * 15 * 512; const float* hin = (const float*)A.in[3] + (size_t)b * 15 * 512;
    int c = threadIdx.x; asm volatile("" : "+v"(c));
    const int w = 2 << (c >> 7); float full[19];
#pragma unroll
    for (int i = 0; i < 15; ++i) full[i] = hin[i * 512 + c];
#pragma unroll
    for (int t = 0; t < 4; ++t) full[15 + t] = bf2f(Z[(size_t)(MP + 4 * b + t) * ZE + 1536 + c]);
#pragma unroll
    for (int t = 0; t < 4; ++t) { float s = 0.f;
#pragma unroll
        for (int j = 0; j < 16; ++j) if (j < w) s += full[15 + t - j];
        OP[(size_t)(MP + 4 * b + t) * DM + 512 + c] = (bf16)f2bf(s / (float)w - full[15 + t]); }
#pragma unroll
    for (int i = 0; i < 15; ++i) hs[i * 512 + c] = full[4 + i];
}
__device__ __forceinline__ void even_mid_phase(Frame& F, const Args& A) {
    constexpr int N1 = 1024, N2 = 512, N3 = 256, N4 = 128;
    for (int u = F.bx; u < N1 + N2 + N3 + N4; u += F.G) {
        if (u < N1) gla_g1_unit(F, A, u);
        else if (u < N1 + N2) gla_sample_unit(F, A, u - N1);
        else if (u < N1 + N2 + N3) pool_prompt_unit(F, u - N1 - N2);
        else pool_sample_unit(F, A, u - N1 - N2 - N3);
    }
}
__device__ __forceinline__ void odd_rows(Frame& F, const Args& A) {
    const bf16* Z = WS_PTR(bf16, WS_Z); bf16* CQN = WS_PTR(bf16, WS_CQN); bf16* CKVB = WS_PTR(bf16, WS_CKVB); bf16* KRB = WS_PTR(bf16, WS_KRB); const float* rt = WS_PTR(float, WS_RT);
    const float* q_norm = (const float*)A.in[24]; const float* kv_norm = (const float*)A.in[26];
    const int gw = F.bx * NWAVES + F.wave, NGW = F.G * NWAVES, lane = F.lane;
    for (int row = gw; row < MT; row += NGW) {
        const bf16* zr = Z + (size_t)row * ZO;
        { float v[6]; float ss = 0.f;
#pragma unroll
          for (int j = 0; j < 3; ++j) { const unsigned w = *(const unsigned*)(zr + 2 * lane + 128 * j); v[2 * j] = bf2f((unsigned short)(w & 0xffffu)); v[2 * j + 1] = bf2f((unsigned short)(w >> 16)); ss += v[2 * j] * v[2 * j] + v[2 * j + 1] * v[2 * j + 1]; }
          const float rstd = 1.0f / sqrtf(wave_sum(ss) * (1.0f / 384.0f) + 1e-6f);
#pragma unroll
          for (int j = 0; j < 3; ++j) { const int c = 2 * lane + 128 * j; *(GAS unsigned*)(CQN + (size_t)row * 384 + c) = pk2(v[2 * j] * rstd * q_norm[c], v[2 * j + 1] * rstd * q_norm[c + 1]); } }
        { const v2u w = *(const v2u*)(zr + 384 + 4 * lane); f32x4 v = {bf2f((unsigned short)(w.x & 0xffffu)), bf2f((unsigned short)(w.x >> 16)), bf2f((unsigned short)(w.y & 0xffffu)), bf2f((unsigned short)(w.y >> 16))};
          const float ss = wave_sum((v[0] * v[0] + v[1] * v[1]) + (v[2] * v[2] + v[3] * v[3])); const float rstd = 1.0f / sqrtf(ss * (1.0f / 256.0f) + 1e-6f);
          const f32x4 o = (v * rstd) * *(const f32x4*)(kv_norm + 4 * lane);
          *(f32x4*)(F.out + O_CKV + (size_t)row * 256 + 4 * lane) = o;
          v2u ob; ob.x = pk2(o[0], o[1]); ob.y = pk2(o[2], o[3]); *(GAS v2u*)(CKVB + (size_t)row * 256 + 4 * lane) = ob; }
        if (lane < 16) { const float x1 = bf2f(zr[640 + lane]), x2 = bf2f(zr[640 + 16 + lane]); const f32x2 cs = *(const f32x2*)(rt + (size_t)posof(row) * 32 + 2 * lane);
          const float o1 = x1 * cs[0] - x2 * cs[1], o2 = x2 * cs[0] + x1 * cs[1];
          F.out[O_KR + (size_t)row * 32 + lane] = o1; F.out[O_KR + (size_t)row * 32 + 16 + lane] = o2;
          KRB[(size_t)row * 32 + lane] = (bf16)f2bf(o1); KRB[(size_t)row * 32 + 16 + lane] = (bf16)f2bf(o2); }
    }
}
template <bool SAMPLE> __device__ __forceinline__ void conv_unit(Frame& F, const Args& A, int unit) {
    constexpr int NTOK = SAMPLE ? 4 : 32, NR = NTOK + 30;
    const bf16* Z = WS_PTR(bf16, WS_Z); bf16* OP = WS_PTR(bf16, WS_OP);
    const float* conv_w = (const float*)A.in[29]; const float* conv_b = (const float*)A.in[30]; const float* ng = (const float*)A.in[31]; const float* nb = (const float*)A.in[32];
    int c = threadIdx.x; asm volatile("" : "+v"(c)); const int lane = c & 63, wave = __builtin_amdgcn_readfirstlane(c >> 6);
    LAS float* cvl = (LAS float*)F.lds;
    LAS float* stat = cvl + 32 * 512;
    const int b = SAMPLE ? unit : (unit >> 8), t0 = SAMPLE ? 0 : (unit & 255) * 32; const size_t rb = SAMPLE ? (size_t)(MP + 4 * b) : (size_t)b * TP;
    float u[NR];
    { bf16 av[NR], gv[NR];
#pragma unroll
      for (int rr = 0; rr < NR; ++rr) { const int t = t0 - 30 + rr; av[rr] = 0; gv[rr] = 0; u[rr] = 0.f;
          if (t >= 0) { const bf16* zr = Z + (rb + t) * ZO; av[rr] = zr[672 + c]; gv[rr] = zr[1184 + c]; }
          else if (SAMPLE) u[rr] = ((const float*)A.in[6])[((size_t)b * 30 + rr) * 512 + c]; }
#pragma unroll
      for (int rr = 0; rr < NR; ++rr) { const int t = t0 - 30 + rr; if (t >= 0) u[rr] = bf2f(av[rr]) * sigmoidf_(bf2f(gv[rr])); } }
    if (SAMPLE) { float* cs = F.out + O_CONVS + (size_t)b * 30 * 512;
#pragma unroll
        for (int i = 0; i < 30; ++i) cs[i * 512 + c] = u[4 + i]; }
    else if (t0 == TP - 32) { float* cp = F.out + O_CONVP + (size_t)b * 30 * 512;
#pragma unroll
        for (int i = 0; i < 30; ++i) cp[i * 512 + c] = u[32 + i]; }
    float cv[NTOK];
    { const float bias = conv_b[c];
#pragma unroll
      for (int tt = 0; tt < NTOK; ++tt) cv[tt] = bias;
#pragma unroll
      for (int j = 0; j < 31; ++j) { const float w = conv_w[j * 512 + c];
#pragma unroll
          for (int tt = 0; tt < NTOK; ++tt) cv[tt] += w * u[tt + j]; } }
#pragma unroll
    for (int tt = 0; tt < NTOK; ++tt) cvl[tt * 512 + c] = cv[tt];
    __syncthreads();
    for (int tt = wave; tt < NTOK; tt += NWAVES) { float s1 = 0.f, s2 = 0.f;
#pragma unroll
        for (int j = 0; j < 8; ++j) { const float x = cvl[tt * 512 + lane + 64 * j]; s1 += x; s2 += x * x; }
        s1 = wave_sum(s1); s2 = wave_sum(s2); const float mean = s1 * (1.0f / 512.0f); const float var = fmaxf(s2 * (1.0f / 512.0f) - mean * mean, 0.f);
        if (lane == 0) { stat[2 * tt] = mean; stat[2 * tt + 1] = 1.0f / sqrtf(var + 1e-6f); } }
    __syncthreads();
    const float gg = ng[c], bb = nb[c];
#pragma unroll
    for (int tt = 0; tt < NTOK; ++tt) { const float y = (cv[tt] - stat[2 * tt]) * stat[2 * tt + 1] * gg + bb;
        OP[(rb + t0 + tt) * DM + 512 + c] = (bf16)f2bf(siluf_(y)); }
    __syncthreads();
}
__device__ __forceinline__ void odd_thin_phase(Frame& F, const Args& A) {
    odd_rows(F, A);
    for (int u = F.bx; u < 512 + 128; u += F.G) { if (u < 512) conv_unit<false>(F, A, u); else conv_unit<true>(F, A, u - 512); }
}
typedef short v4i16_t __attribute__((ext_vector_type(4)));
__device__ __forceinline__ s16x4 vtr(const LAS unsigned char* p) { return __builtin_bit_cast(s16x4, __builtin_amdgcn_ds_read_tr16_b64_v4i16((LAS v4i16_t*)p)); }
#define LBAR() asm volatile("s_waitcnt lgkmcnt(0)\n\ts_barrier" ::: "memory")
__device__ __forceinline__ float xhalf_max(float v) { auto rr = __builtin_amdgcn_permlane32_swap(__float_as_uint(v), __float_as_uint(v), false, false); return fmaxf(__uint_as_float(rr[0]), __uint_as_float(rr[1])); }
__device__ __forceinline__ float xhalf_sum(float v) { auto rr = __builtin_amdgcn_permlane32_swap(__float_as_uint(v), __float_as_uint(v), false, false); return __uint_as_float(rr[0]) + __uint_as_float(rr[1]); }
__device__ __forceinline__ int crow(int r, int hi) { return (r & 3) + 8 * (r >> 2) + 4 * hi; }
__device__ __forceinline__ bf16x8 pack8(const f32x16& p, int s8) {
    v4u w; w.x = pg8::cvt_pk_bf16(p[s8 + 0], p[s8 + 1]); w.y = pg8::cvt_pk_bf16(p[s8 + 2], p[s8 + 3]); w.z = pg8::cvt_pk_bf16(p[s8 + 4], p[s8 + 5]); w.w = pg8::cvt_pk_bf16(p[s8 + 6], p[s8 + 7]);
    return __builtin_bit_cast(bf16x8, w);
}
constexpr int PA_KROW = 208, PA_VROW = 144, PA_VOFF = 64 * PA_KROW, PA_BUF = PA_VOFF + 64 * PA_VROW;
__device__ __forceinline__ void pattn_unit(Frame& F, int b, int h, int qb) {
    const bf16* Q = WS_PTR(bf16, WS_Q); const bf16* KV = WS_PTR(bf16, WS_KV); const bf16* KRB = WS_PTR(bf16, WS_KRB); bf16* OP = WS_PTR(bf16, WS_OP);
    int tid = threadIdx.x; asm volatile("" : "+v"(tid));
    const int lane = tid & 63, wid = __builtin_amdgcn_readfirstlane(tid >> 6), r32 = lane & 31, hi = lane >> 5;
    const size_t rb = (size_t)b * TP; const int q0w = 256 * qb + 32 * wid, NT = 4 * (qb + 1);
    LAS unsigned char* L = F.lds;
    const int skey = tid >> 3, sc = tid & 7, rkey = tid >> 2, rc = tid & 3;
    const bf16* gk = KV + (rb + skey) * 1024 + h * 64 + 8 * sc; const bf16* gv = gk + 512; const bf16* gr = KRB + (rb + rkey) * 32 + 8 * rc;
    const int lk = skey * PA_KROW + (sc << 4), lv = PA_VOFF + skey * PA_VROW + (sc << 4), lr = rkey * PA_KROW + ((8 + rc) << 4);
    v4u sk, sv, sr = {0u, 0u, 0u, 0u};
#define PA_LOAD(kt) do { sk = *(const v4u*)(gk + (size_t)(kt) * 64 * 1024); sv = *(const v4u*)(gv + (size_t)(kt) * 64 * 1024); if (tid < 256) sr = *(const v4u*)(gr + (size_t)(kt) * 64 * 32); } while (0)
#define PA_STORE(bufo) do { *(LAS v4u*)(L + (bufo) + lk) = sk; *(LAS v4u*)(L + (bufo) + lv) = sv; if (tid < 256) *(LAS v4u*)(L + (bufo) + lr) = sr; } while (0)
    PA_LOAD(0);
    bf16x8 qf[6];
    { const bf16* qp = Q + (rb + q0w + r32) * 768 + h * 96 + 8 * hi;
#pragma unroll
      for (int kk = 0; kk < 6; ++kk) qf[kk] = *(const bf16x8*)(qp + 16 * kk); }
    f32x16 o0 = {}, o1 = {}; float mrun = -1e30f, lrun = 0.f;
    PA_STORE(0);
    LBAR();
    const int aoffk = r32 * PA_KROW + (hi << 4);
    const int g = lane >> 4, i16 = lane & 15, hg = g >> 1;
    const int voff = PA_VOFF + (4 * hg + (i16 >> 2)) * PA_VROW + ((16 * (g & 1) + 4 * (i16 & 3)) << 1);
    for (int kt = 0; kt < NT; ++kt) {
        const int bufo = (kt & 1) * PA_BUF;
        if (kt + 1 < NT) PA_LOAD(kt + 1);
        if (64 * kt <= q0w + 31) {
            f32x16 p0 = {}, p1 = {};
            { bf16x8 ka[12];
#pragma unroll
              for (int kk = 0; kk < 6; ++kk) { ka[2 * kk] = *(const LAS bf16x8*)(L + bufo + aoffk + 32 * kk); ka[2 * kk + 1] = *(const LAS bf16x8*)(L + bufo + aoffk + 32 * PA_KROW + 32 * kk); }
#pragma unroll
              for (int kk = 0; kk < 6; ++kk) { p0 = __builtin_amdgcn_mfma_f32_32x32x16_bf16(ka[2 * kk], qf[kk], p0, 0, 0, 0); p1 = __builtin_amdgcn_mfma_f32_32x32x16_bf16(ka[2 * kk + 1], qf[kk], p1, 0, 0, 0); } }
            s16x4 vlo[8], vhi[8];
#pragma unroll
            for (int hf = 0; hf < 2; ++hf)
#pragma unroll
                for (int s = 0; s < 2; ++s)
#pragma unroll
                    for (int dt = 0; dt < 2; ++dt) { const int a0 = bufo + voff + (32 * hf + 16 * s) * PA_VROW + 64 * dt; vlo[(hf * 2 + s) * 2 + dt] = vtr(L + a0); vhi[(hf * 2 + s) * 2 + dt] = vtr(L + a0 + 8 * PA_VROW); }
            if (64 * kt + 63 > q0w) { const int qq = q0w + r32;
#pragma unroll
                for (int r = 0; r < 16; ++r) { const int key = 64 * kt + crow(r, hi); if (key > qq) p0[r] = -INFINITY; if (key + 32 > qq) p1[r] = -INFINITY; } }
            float mt = fmaxf(p0[0], p1[0]);
#pragma unroll
            for (int r = 1; r < 16; ++r) mt = fmaxf(mt, fmaxf(p0[r], p1[r]));
            mt = xhalf_max(mt);
            const float mnew = fmaxf(mrun, mt), alpha = __builtin_amdgcn_exp2f(mrun - mnew); mrun = mnew;
            float rs = 0.f;
#pragma unroll
            for (int r = 0; r < 16; ++r) { p0[r] = __builtin_amdgcn_exp2f(p0[r] - mnew); p1[r] = __builtin_amdgcn_exp2f(p1[r] - mnew); rs += p0[r] + p1[r]; }
            rs = xhalf_sum(rs); lrun = lrun * alpha + rs;
#pragma unroll
            for (int r = 0; r < 16; ++r) { o0[r] *= alpha; o1[r] *= alpha; }
#pragma unroll
            for (int hf = 0; hf < 2; ++hf)
#pragma unroll
                for (int s = 0; s < 2; ++s) { const bf16x8 pb = pack8(hf ? p1 : p0, 8 * s);
#pragma unroll
                    for (int dt = 0; dt < 2; ++dt) { const s16x4 lo = vlo[(hf * 2 + s) * 2 + dt], hh = vhi[(hf * 2 + s) * 2 + dt];
                        const bf16x8 va = {lo[0], lo[1], lo[2], lo[3], hh[0], hh[1], hh[2], hh[3]};
                        if (dt == 0) o0 = __builtin_amdgcn_mfma_f32_32x32x16_bf16(va, pb, o0, 0, 0, 0); else o1 = __builtin_amdgcn_mfma_f32_32x32x16_bf16(va, pb, o1, 0, 0, 0); } }
        }
        if (kt + 1 < NT) PA_STORE(((kt + 1) & 1) * PA_BUF);
        LBAR();
    }
#undef PA_LOAD
#undef PA_STORE
    const float rl = 1.0f / lrun;
    bf16* op = OP + (rb + q0w + r32) * DM + h * 64;
#pragma unroll
    for (int dt = 0; dt < 2; ++dt)
#pragma unroll
        for (int rq = 0; rq < 4; ++rq) { const f32x16& o = dt ? o1 : o0; v2u w; w.x = pk2(o[4 * rq] * rl, o[4 * rq + 1] * rl); w.y = pk2(o[4 * rq + 2] * rl, o[4 * rq + 3] * rl);
            *(GAS v2u*)(op + 32 * dt + 8 * rq + 4 * hi) = w; }
}

constexpr int DT_ROW = 592, DT_TILE = 64 * DT_ROW, DT_QOFF = 2 * DT_TILE, DT_QN = DT_QOFF + 32 * DT_ROW, DT_ML = 133120;
__device__ __forceinline__ void dattn_unit(Frame& F, const Args& A, int unit) {
    const bf16* Q = WS_PTR(bf16, WS_Q); float* PART = WS_PTR(float, WS_PART) + (size_t)unit * PART_F; float* QD = WS_PTR(float, WS_QD);
    const float* cckv = (const float*)A.in[4]; const float* ckr = (const float*)A.in[5]; const int* ptab = (const int*)A.in[7]; const float* w_uk = (const float*)A.in[27];
    int tid = threadIdx.x; asm volatile("" : "+v"(tid));
    const int lane = tid & 63, wid = __builtin_amdgcn_readfirstlane(tid >> 6), r32 = lane & 31, hi = lane >> 5, b = unit >> 3, sp = unit & 7;
    LAS unsigned char* L = F.lds; LAS float* qn = (LAS float*)(L + DT_QN); LAS float* ml = (LAS float*)(L + DT_ML);
    const f32x4* dummy = (const f32x4*)WS_PTR(float, WS_DUMMY);
    LAS int* pidl = (LAS int*)(L + DT_ML + 2048);
    if (tid < 8) pidl[tid] = ptab[b * 64 + sp * 8 + tid];
    __syncthreads();
    f32x4 st0[9], st1[9];
    const int wofs = (tid >> 6) * DT_ROW + (tid & 63) * 8, wofr = (tid >> 3) * DT_ROW + 512 + (tid & 7) * 8;
#define DT_LOAD(tl, st) do { const int t_ = (tl); const bool real_ = t_ < 16; const int pid = pidl[real_ ? (t_ >> 1) : 0]; \
        const f32x4* pc = real_ ? (const f32x4*)(cckv + ((size_t)pid * 128 + (t_ & 1) * 64) * 256) : dummy; const f32x4* pr = real_ ? (const f32x4*)(ckr + ((size_t)pid * 128 + (t_ & 1) * 64) * 32) : dummy; \
        _Pragma("unroll") for (int i = 0; i < 8; ++i) st[i] = __builtin_nontemporal_load(pc + tid + 512 * i); \
        st[8] = __builtin_nontemporal_load(pr + tid); } while (0)
#define DT_STORE(bufo, st) do { _Pragma("unroll") for (int i = 0; i < 8; ++i) { v2u w_; w_.x = pg8::cvt_pk_bf16(st[i][0], st[i][1]); w_.y = pg8::cvt_pk_bf16(st[i][2], st[i][3]); *(LAS v2u*)(L + (bufo) + wofs + i * 8 * DT_ROW) = w_; } \
        { v2u w_; w_.x = pg8::cvt_pk_bf16(st[8][0], st[8][1]); w_.y = pg8::cvt_pk_bf16(st[8][2], st[8][3]); *(LAS v2u*)(L + (bufo) + wofr) = w_; } } while (0)
    DT_LOAD(0, st0); DT_LOAD(1, st1);
    { const int t = tid >> 7, c6 = (tid & 127) * 6;
      const bf16* qp = Q + (size_t)(MP + 4 * b + t) * 768 + c6;
#pragma unroll
      for (int e = 0; e < 6; ++e) { const int c = c6 + e, hh = c / 96, d = c % 96; const bf16 v = qp[e];
          if (d < 64) qn[(t * 8 + hh) * 64 + d] = bf2f(v);
          else { const int q = t * 8 + hh, col = 256 + (d - 64); *(LAS bf16*)(L + DT_QOFF + q * DT_ROW + col * 2) = v;
                 if (sp == 0) QD[((size_t)b * 32 + q) * 288 + col] = bf2f(v); } } }
    __syncthreads();
    { const int hh = tid >> 6, rr = tid & 63;
#pragma unroll 1
      for (int j = 0; j < 4; ++j) { const int r = rr + 64 * j; const f32x4* wp = (const f32x4*)(w_uk + ((size_t)r * 8 + hh) * 64); float a0 = 0.f, a1 = 0.f, a2 = 0.f, a3 = 0.f;
#pragma unroll 4
          for (int d4 = 0; d4 < 16; ++d4) { const f32x4 w = wp[d4];
              const f32x4 x0 = *(const LAS f32x4*)(qn + (0 * 8 + hh) * 64 + 4 * d4), x1 = *(const LAS f32x4*)(qn + (1 * 8 + hh) * 64 + 4 * d4), x2 = *(const LAS f32x4*)(qn + (2 * 8 + hh) * 64 + 4 * d4), x3 = *(const LAS f32x4*)(qn + (3 * 8 + hh) * 64 + 4 * d4);
              a0 += (w[0] * x0[0] + w[1] * x0[1]) + (w[2] * x0[2] + w[3] * x0[3]); a1 += (w[0] * x1[0] + w[1] * x1[1]) + (w[2] * x1[2] + w[3] * x1[3]);
              a2 += (w[0] * x2[0] + w[1] * x2[1]) + (w[2] * x2[2] + w[3] * x2[3]); a3 += (w[0] * x3[0] + w[1] * x3[1]) + (w[2] * x3[2] + w[3] * x3[3]); }
          const float av[4] = {a0, a1, a2, a3};
#pragma unroll
          for (int t = 0; t < 4; ++t) { const int q = t * 8 + hh; *(LAS bf16*)(L + DT_QOFF + q * DT_ROW + r * 2) = (bf16)f2bf(av[t]);
              if (sp == 0) QD[((size_t)b * 32 + q) * 288 + r] = av[t]; } } }
    DT_STORE(0, st0);
    LBAR();
    DT_LOAD(2, st0);
    bf16x8 qf[18];
#pragma unroll
    for (int kk = 0; kk < 18; ++kk) qf[kk] = *(const LAS bf16x8*)(L + DT_QOFF + (lane & 31) * DT_ROW + ((lane >> 5) << 4) + 32 * kk);
    const int kh = wid & 1, dq = wid >> 1, g = lane >> 4, i16 = lane & 15, hg = g >> 1;
    f32x16 o0 = {}, o1 = {}; float mrun = -1e30f, lrun = 0.f;
    const int arow = (32 * kh + r32) * DT_ROW + (hi << 4);
    const int voff = (32 * kh + 4 * hg + (i16 >> 2)) * DT_ROW + ((64 * dq + 16 * (g & 1) + 4 * (i16 & 3)) << 1);
#define DT_ITER(tl, bufo, bufn, stn, DOSTORE, DOLOAD) do { \
        f32x16 p = {}; \
_Pragma("unroll") \
        for (int g6 = 0; g6 < 3; ++g6) { bf16x8 ka[6]; \
_Pragma("unroll") \
            for (int j = 0; j < 6; ++j) ka[j] = *(const LAS bf16x8*)(L + bufo + arow + 32 * (6 * g6 + j)); \
_Pragma("unroll") \
            for (int j = 0; j < 6; ++j) p = __builtin_amdgcn_mfma_f32_32x32x16_bf16(ka[j], qf[6 * g6 + j], p, 0, 0, 0); } \
        s16x4 vlo[4], vhi[4]; \
_Pragma("unroll") \
        for (int s = 0; s < 2; ++s) \
_Pragma("unroll") \
            for (int dt = 0; dt < 2; ++dt) { const int a0 = bufo + voff + 16 * s * DT_ROW + 64 * dt; vlo[2 * s + dt] = vtr(L + a0); vhi[2 * s + dt] = vtr(L + a0 + 8 * DT_ROW); } \
        float mt = p[0]; \
_Pragma("unroll") \
        for (int r = 1; r < 16; ++r) mt = fmaxf(mt, p[r]); \
        mt = xhalf_max(mt); \
        const float mnew = fmaxf(mrun, mt), alpha = __builtin_amdgcn_exp2f(mrun - mnew); mrun = mnew; \
        float rs = 0.f; \
_Pragma("unroll") \
        for (int r = 0; r < 16; ++r) { p[r] = __builtin_amdgcn_exp2f(p[r] - mnew); rs += p[r]; } \
        rs = xhalf_sum(rs); lrun = lrun * alpha + rs; \
_Pragma("unroll") \
        for (int r = 0; r < 16; ++r) { o0[r] *= alpha; o1[r] *= alpha; } \
_Pragma("unroll") \
        for (int s = 0; s < 2; ++s) { const bf16x8 pb = pack8(p, 8 * s); \
_Pragma("unroll") \
            for (int dt = 0; dt < 2; ++dt) { const s16x4 lo = vlo[2 * s + dt], hh = vhi[2 * s + dt]; \
                const bf16x8 va = {lo[0], lo[1], lo[2], lo[3], hh[0], hh[1], hh[2], hh[3]}; \
                if (dt == 0) o0 = __builtin_amdgcn_mfma_f32_32x32x16_bf16(va, pb, o0, 0, 0, 0); else o1 = __builtin_amdgcn_mfma_f32_32x32x16_bf16(va, pb, o1, 0, 0, 0); } } \
        if (DOSTORE) DT_STORE(bufn, stn); \
        LBAR(); \
        if (DOLOAD) DT_LOAD((tl) + 3, stn); } while (0)
    for (int tl = 0; tl < 16; tl += 2) { DT_ITER(tl, 0, DT_TILE, st1, (tl) + 1 < 16, true); DT_ITER(tl + 1, DT_TILE, 0, st0, (tl) + 2 < 16, true); }
#undef DT_ITER
#undef DT_LOAD
#undef DT_STORE
    { LAS float* ow = (LAS float*)L + (size_t)wid * 2048;
#pragma unroll
      for (int dt = 0; dt < 2; ++dt)
#pragma unroll
          for (int r = 0; r < 16; ++r) ow[(32 * dt + crow(r, hi)) * 32 + r32] = dt ? o1[r] : o0[r];
      if (hi == 0) { ml[wid * 64 + r32] = mrun; ml[wid * 64 + 32 + r32] = lrun; } }
    __syncthreads();
    { const int q = tid & 31, dvg = tid >> 5, dqq = dvg >> 2;
      const float m0 = ml[(2 * dqq) * 64 + q], m1 = ml[(2 * dqq + 1) * 64 + q], ms = fmaxf(m0, m1);
      const float w0 = __builtin_amdgcn_exp2f(m0 - ms), w1 = __builtin_amdgcn_exp2f(m1 - ms);
      const float ls = w0 * ml[(2 * dqq) * 64 + 32 + q] + w1 * ml[(2 * dqq + 1) * 64 + 32 + q];
#pragma unroll
      for (int j = 0; j < 16; ++j) { const int dv = dvg * 16 + j, dvl = dv & 63;
          PART[dv * 32 + q] = w0 * ((LAS float*)L)[(size_t)(2 * dqq) * 2048 + dvl * 32 + q] + w1 * ((LAS float*)L)[(size_t)(2 * dqq + 1) * 2048 + dvl * 32 + q]; }
      if (dvg == 0) { PART[8192 + q] = ms; PART[8192 + 32 + q] = ls; } }
    __syncthreads();
}
__device__ __forceinline__ void dcombine_unit(Frame& F, const Args& A, int b) {
    const float* PART = WS_PTR(float, WS_PART) + (size_t)b * NSPLIT * PART_F; const float* QD = WS_PTR(float, WS_QD) + (size_t)b * 32 * 288; bf16* OP = WS_PTR(bf16, WS_OP);
    const float* ckv = F.out + O_CKV + (size_t)(MP + 4 * b) * 256; const float* kr = F.out + O_KR + (size_t)(MP + 4 * b) * 32; const float* w_uv = (const float*)A.in[28];
    int tid = threadIdx.x; asm volatile("" : "+v"(tid));
    LAS float* lat = (LAS float*)F.lds; LAS float* sn = lat + 8192; LAS float* ck = sn + 128; LAS float* qd = ck + 1152;
    for (int i = tid; i < 1024; i += 512) ck[(i >> 8) * 288 + (i & 255)] = ckv[i];
    if (tid < 128) ck[(tid >> 5) * 288 + 256 + (tid & 31)] = kr[tid];
    for (int i = tid; i < 32 * 288; i += 512) qd[(i / 288) * 289 + (i % 288)] = QD[i];
    __syncthreads();
    { const int q = tid >> 4, part = tid & 15; float a[4] = {0.f, 0.f, 0.f, 0.f};
#pragma unroll
      for (int i = 0; i < 18; ++i) { const int r = part * 18 + i; const float x = qd[q * 289 + r];
#pragma unroll
          for (int s = 0; s < 4; ++s) a[s] += x * ck[s * 288 + r]; }
#pragma unroll
      for (int s = 0; s < 4; ++s) { float v = a[s]; v += __shfl_xor(v, 1); v += __shfl_xor(v, 2); v += __shfl_xor(v, 4); v += __shfl_xor(v, 8); a[s] = v; }
      if (part < 4) sn[q * 4 + part] = (part <= (q >> 3)) ? a[part] : -INFINITY; }
    __syncthreads();
    { const int q = tid & 31, dvg = tid >> 5; float mk[NSPLIT], ms = -1e30f;
#pragma unroll
      for (int s = 0; s < NSPLIT; ++s) { mk[s] = PART[(size_t)s * PART_F + 8192 + q]; ms = fmaxf(ms, mk[s]); }
      float pn[4];
#pragma unroll
      for (int s = 0; s < 4; ++s) { pn[s] = sn[q * 4 + s]; ms = fmaxf(ms, pn[s]); }
      float wg[NSPLIT], ls = 0.f;
#pragma unroll
      for (int s = 0; s < NSPLIT; ++s) { wg[s] = __builtin_amdgcn_exp2f(mk[s] - ms); ls += wg[s] * PART[(size_t)s * PART_F + 8192 + 32 + q]; }
#pragma unroll
      for (int s = 0; s < 4; ++s) { pn[s] = __builtin_amdgcn_exp2f(pn[s] - ms); ls += pn[s]; }
      const float rl = 1.0f / ls;
#pragma unroll 1
      for (int j0 = 0; j0 < 16; j0 += 4) { float pv[4][NSPLIT];
#pragma unroll
          for (int j = 0; j < 4; ++j)
#pragma unroll
              for (int s = 0; s < NSPLIT; ++s) pv[j][s] = PART[(size_t)s * PART_F + (dvg * 16 + j0 + j) * 32 + q];
#pragma unroll
          for (int j = 0; j < 4; ++j) { const int dv = dvg * 16 + j0 + j; float acc = 0.f;
#pragma unroll
              for (int s = 0; s < NSPLIT; ++s) acc += wg[s] * pv[j][s];
#pragma unroll
              for (int s = 0; s < 4; ++s) acc += pn[s] * ck[s * 288 + dv];
              lat[q * 256 + dv] = acc * rl; } } }
    __syncthreads();
    { const int hh = tid >> 6, v = tid & 63; float a[4] = {0.f, 0.f, 0.f, 0.f};
#pragma unroll 1
      for (int r0 = 0; r0 < 256; r0 += 32) { float w[32];
#pragma unroll
          for (int i = 0; i < 32; ++i) w[i] = w_uv[((size_t)(r0 + i) * 8 + hh) * 64 + v];
#pragma unroll
          for (int i = 0; i < 32; ++i)
#pragma unroll
              for (int t = 0; t < 4; ++t) a[t] += w[i] * lat[(t * 8 + hh) * 256 + r0 + i]; }
#pragma unroll
      for (int t = 0; t < 4; ++t) OP[(size_t)(MP + 4 * b + t) * DM + hh * 64 + v] = (bf16)f2bf(a[t]); }
    __syncthreads();
}
__device__ __forceinline__ void attn_phase(Frame& F, const Args& A) {
    const bool dfirst = ((F.bx >> 3) & 1) != 0;
#pragma unroll 1
    for (int part = 0; part < 2; ++part) {
#ifndef ATT_NO_D
        if ((part == 0) == dfirst) { for (int rd = 0; rd < NREP(17); ++rd) for (int du = F.bx; du < 128 * NSPLIT; du += F.G) dattn_unit(F, A, du); }
        else
#endif
#ifndef ATT_NO_P
        { for (int rp = 0; rp < NREP(18); ++rp) for (int pr2 = 2 * F.bx; pr2 < 512; pr2 += 2 * F.G) {
#pragma unroll 1
                   for (int e = 0; e < 2; ++e) { const int pr = pr2 >> 1, bh = pr >> 4, s = pr & 15; pattn_unit(F, bh >> 3, bh & 7, e ? s : 31 - s); } } }
#else
        {}
#endif
    }
}
constexpr int N_PHASE_IDS = 43;
#ifndef PHMASK
#define PHMASK 0xFFFFFFFFu
#endif
#define EN(n) (((PHMASK) >> (n)) & 1u)
#define REPSEAM(n) do { if (rep_ + 1 < NREP(n) && args.use_bar) xcd_barrier(bar); } while (0)
#ifndef MK_ONE_LAUNCH
#define MK_ONE_LAUNCH 1
#endif
__global__ void __launch_bounds__(NWAVES * 64, 2) mk_fwd(Args args) {
    extern __shared__ __attribute__((aligned(16))) unsigned char lds[];
    Frame F;
    F.lds = (LAS unsigned char*)lds; F.MISC = (volatile LAS unsigned*)(F.lds + MISC_OFF);
    F.tid = threadIdx.x; F.lane = F.tid & 63; F.wave = __builtin_amdgcn_readfirstlane(F.tid >> 6); F.G = gridDim.x; F.bx = blockIdx.x;
    F.ws = args.ws; F.out = args.out; F.ctl = (gu32*)(args.ws + WS_CTL);
    for (int u = F.tid; u < (LDS_BYTES - LDSCTL_OFF) / 4; u += NWAVES * 64) ((LAS unsigned*)(F.lds + LDSCTL_OFF))[u] = 0u;
    __syncthreads();
    XcdBarrier bar; bar.bar = (unsigned*)(F.ctl + CW_BAR); bar.x = 0; bar.st = nullptr;
    if (args.use_bar) bar = xcd_barrier_post((unsigned*)(F.ctl + CW_BAR), F.MISC + 8);
    const int lo = args.ph_lo, hi = args.ph_hi;
#define RUN(k) (lo <= (k) && (k) < hi)
#define FRESH() do { int t_ = threadIdx.x; asm volatile("" : "+v"(t_)); F.tid = t_; F.lane = t_ & 63; F.wave = __builtin_amdgcn_readfirstlane(t_ >> 6); } while (0)
#define SEAM(k) do { if (args.use_bar && (k) + 1 < hi) xcd_barrier(bar); } while (0)
    LAS unsigned char* ring = F.lds;
    const float* xin_p = (const float*)args.in[0]; const float* xin_s = (const float*)args.in[1] - (size_t)MP * DM;
    float* X = WS_PTR(float, WS_X); bf16* H = WS_PTR(bf16, WS_H); bf16* ACT = WS_PTR(bf16, WS_ACT); bf16* Z = WS_PTR(bf16, WS_Z); bf16* OP = WS_PTR(bf16, WS_OP); float* MOD = WS_PTR(float, WS_MOD);
    const float* norm_g = (const float*)args.in[12];

    if (EN(0) && RUN(0)) { for (int rep_ = 0; rep_ < NREP(0); ++rep_) { FRESH(); p0_prologue(F, args); REPSEAM(0); } SEAM(0); }
    if (EN(1) && RUN(1)) { for (int rep_ = 0; rep_ < NREP(1); ++rep_) { pg8::Gemm g{WS_PTR(bf16, WS_SC), WS_PTR(bf16, WS_ADAT), 256, MODLD, DM, DM, DM}; pg8::StaticOrder S; S.init(256, MODLD, F.G, F.bx);
        pg8::EpiMod E{MOD, (const float*)args.in[11]};
        pg8::gemm_phase<pg8::EpiMod, pg8::StaticOrder, true, true>(ring, g, S, E); REPSEAM(1); } SEAM(1); }
    for (int i = 0; i < 4; ++i) {
        const int pb = 2 + 10 * i, l = i >> 1, f = i & 1;
        const float* src_p = (i == 0) ? xin_p : X; const float* src_s = (i == 0) ? xin_s : X;
        const float* modl = MOD + l * 9216;
        if (EN(2) && RUN(pb + 0)) { for (int rep_ = 0; rep_ < NREP(2); ++rep_) { FRESH(); nm_phase(F, src_p, src_s, norm_g + (l * 3 + (f ? 2 : 0)) * DM, modl + (f ? 6 : 0) * DM, H, X, WS_PTR(float, WS_SLAB), (i == 0 || rep_ > 0) ? 0 : (f ? 4 : 11), (f ? MOD + (l) * 9216 + 5 * DM : MOD + (l - 1) * 9216 + 8 * DM), f ? 1.0f : 0.5f); REPSEAM(2); } SEAM(pb + 0); }
        if (EN(3) && RUN(pb + 1)) { for (int rep_ = 0; rep_ < NREP(3); ++rep_) { pg8::Gemm g{H, WS_PTR(bf16, WS_W13T + (size_t)i * W13T_STRIDE), MT, 2 * FF, DM, DM, DM}; pg8::StaticOrder S; S.init(MT, 2 * FF, F.G, F.bx);
            pg8::EpiSwiglu E{ACT, FF};
            pg8::gemm_phase<pg8::EpiSwiglu, pg8::StaticOrder, true, true>(ring, g, S, E); REPSEAM(3); } SEAM(pb + 1); }
        if (EN(4) && RUN(pb + 2)) { for (int rep_ = 0; rep_ < NREP(4); ++rep_) {
            { pg8::Gemm g{ACT, WS_PTR(bf16, WS_W2T + (size_t)i * W2T_STRIDE), MP, DM, FF, FF, FF}; pg8::StaticOrder S; S.init(MP, DM, F.G, F.bx);
              pg8::EpiRes E{src_p, src_s, rep_ ? WS_PTR(float, WS_DUMMY) : X, modl + (f ? 8 : 2) * DM, 0.5f};
              pg8::gemm_phase<pg8::EpiRes, pg8::StaticOrder, true, true>(ring, g, S, E); }
            __syncthreads();
            { pg8::Gemm g{ACT, WS_PTR(bf16, WS_W2T + (size_t)i * W2T_STRIDE), MT, DM, args.k_kv, FF, FF}; pg8::SplitKOrder S{MP / 256, 2, 4, 11, 256, F.G, F.bx};
              pg8::EpiPartial E{WS_PTR(float, WS_SLAB)};
              pg8::gemm_phase<pg8::EpiPartial, pg8::SplitKOrder, true, true>(ring, g, S, E); }
            REPSEAM(4); } SEAM(pb + 2); }
        if (f == 0) {
            if (EN(5) && RUN(pb + 3)) { for (int rep_ = 0; rep_ < NREP(2); ++rep_) { FRESH(); nm_phase(F, X, X, norm_g + (l * 3 + 1) * DM, modl + 3 * DM, H, X, WS_PTR(float, WS_SLAB), rep_ ? 0 : 11, modl + 2 * DM, 0.5f); REPSEAM(2); } SEAM(pb + 3); }
            if (EN(6) && RUN(pb + 4)) { for (int rep_ = 0; rep_ < NREP(6); ++rep_) { const int NZ = l ? ZO : ZE; pg8::Gemm g{H, WS_PTR(bf16, l ? WS_ODIN : WS_EVIN), MT, NZ, DM, DM, DM}; pg8::StaticOrder S; S.init(MT, NZ, F.G, F.bx);
                pg8::EpiPlain E{Z, NZ};
                pg8::gemm_phase<pg8::EpiPlain, pg8::StaticOrder, true, true>(ring, g, S, E); REPSEAM(6); } SEAM(pb + 4); }
            if (RUN(pb + 5)) { if (l == 0) { if (EN(7)) for (int rep_ = 0; rep_ < NREP(7); ++rep_) { FRESH(); even_mid_phase(F, args); REPSEAM(7); } } else { if (EN(8)) for (int rep_ = 0; rep_ < NREP(8); ++rep_) { FRESH(); odd_thin_phase(F, args); REPSEAM(8); } } SEAM(pb + 5); }
            if (RUN(pb + 6)) { FRESH();
                if (l == 0) { if (EN(9)) gla_g2_phase(F); }
                else { for (int rep_ = 0; rep_ < NREP(10); ++rep_) { if (EN(10)) { pg8::Gemm g{WS_PTR(bf16, WS_CQN), WS_PTR(bf16, WS_WUQ), MT, 768, args.k_q, args.k_q, args.k_q}; pg8::StaticOrder S; S.init(MT, 768, F.G, F.bx);
                         pg8::EpiQ E{WS_PTR(bf16, WS_Q), WS_PTR(float, WS_RT)};
                         pg8::gemm_phase<pg8::EpiQ, pg8::StaticOrder, true, true>(ring, g, S, E); }
                       __syncthreads();
                       if (EN(16)) { const int nkv = opaque_int(1024), mkv = opaque_int(MP); pg8::Gemm g{WS_PTR(bf16, WS_CKVB), WS_PTR(bf16, WS_WKV), mkv, nkv, args.k_kv, args.k_kv, args.k_kv}; pg8::StaticOrder S; S.init(mkv, nkv, F.G, F.bx);
                         pg8::EpiPlain E{WS_PTR(bf16, WS_KV), nkv};
                         pg8::gemm_phase<pg8::EpiPlain, pg8::StaticOrder, true, true>(ring, g, S, E); } REPSEAM(10); } }
                SEAM(pb + 6); }
            if (RUN(pb + 7)) { if (l == 0) { if (EN(11)) for (int rep_ = 0; rep_ < NREP(11); ++rep_) { FRESH(); for (int u = F.bx; u < 1024; u += F.G) gla_g3_unit(F, args, u); REPSEAM(11); } } else { if (EN(12)) for (int rep_ = 0; rep_ < NREP(12); ++rep_) { FRESH(); attn_phase(F, args); REPSEAM(12); } } SEAM(pb + 7); }
            if (RUN(pb + 8)) { FRESH(); if (l == 1) { if (EN(13)) for (int rep_ = 0; rep_ < NREP(13); ++rep_) { for (int b = F.bx; b < 128; b += F.G) dcombine_unit(F, args, b); REPSEAM(13); } SEAM(pb + 8); } }
            if (EN(14) && RUN(pb + 9)) { for (int rep_ = 0; rep_ < NREP(14); ++rep_) {
                { pg8::Gemm g{OP, WS_PTR(bf16, l ? WS_ODOUT : WS_EVOUT), MP, DM, DM, DM, DM}; pg8::StaticOrder S; S.init(MP, DM, F.G, F.bx);
                  pg8::EpiRes E{X, X, rep_ ? WS_PTR(float, WS_DUMMY) : X, modl + 5 * DM, 1.0f};
                  pg8::gemm_phase<pg8::EpiRes, pg8::StaticOrder, true, true>(ring, g, S, E); }
                __syncthreads();
                { pg8::Gemm g{OP, WS_PTR(bf16, l ? WS_ODOUT : WS_EVOUT), MT, DM, args.k_kv, DM, DM}; pg8::SplitKOrder S{MP / 256, 2, 4, 4, 256, F.G, F.bx};
                  pg8::EpiPartial E{WS_PTR(float, WS_SLAB)};
                  pg8::gemm_phase<pg8::EpiPartial, pg8::SplitKOrder, true, true>(ring, g, S, E); }
                REPSEAM(14); } SEAM(pb + 9); }
        }
    }
    if (EN(15) && RUN(42)) { for (int rep_ = 0; rep_ < NREP(15); ++rep_) { FRESH(); final_phase(F, X, (const float*)args.in[34], F.out + O_Y, WS_PTR(float, WS_SLAB), 11, MOD + 9216 + 8 * DM, 0.5f); REPSEAM(15); } }
#undef RUN
#undef SEAM
}

extern "C" void kernel_launch(void* const* d_in, const int* in_sizes, int n_in, void* d_out, int out_size, void* d_ws, size_t ws_size, hipStream_t stream) {
    static int grid = 0;
    if (grid == 0) {
        if (n_in != 35 || (size_t)out_size != O_END || ws_size < WS_END) { fprintf(stderr, "kernel_launch: unexpected shapes: n_in %d out %d ws %zu\n", n_in, out_size, ws_size); grid = -1; return; }
        int dev = 0, cus = 0, per_cu = 0;
        if (hipGetDevice(&dev) != hipSuccess || hipDeviceGetAttribute(&cus, hipDeviceAttributeMultiprocessorCount, dev) != hipSuccess) { grid = -1; return; }
        if (hipFuncSetAttribute((const void*)mk_fwd, hipFuncAttributeMaxDynamicSharedMemorySize, LDS_BYTES) != hipSuccess) { fprintf(stderr, "kernel_launch: hipFuncSetAttribute failed\n"); grid = -1; return; }
        if (hipOccupancyMaxActiveBlocksPerMultiprocessor(&per_cu, (const void*)mk_fwd, NWAVES * 64, LDS_BYTES) != hipSuccess || per_cu < 1) fprintf(stderr, "kernel_launch: occupancy query says %d\n", per_cu);
        (void)hipGetLastError();
        grid = cus;
    }
    if (grid < 0) return;
    if (hipMemsetAsync((char*)d_ws + WS_CTL, 0, CTL_ZERO_BYTES, stream) != hipSuccess) return;
    Args a{};
    for (int i = 0; i < 35; ++i) a.in[i] = d_in[i];
    a.out = (float*)d_out; a.ws = (unsigned char*)d_ws; a.k_q = 384; a.k_kv = 256; a.pad = 0;
#if MK_ONE_LAUNCH
    a.ph_lo = 0; a.ph_hi = N_PHASE_IDS; a.use_bar = 1;
    hipLaunchKernelGGL(mk_fwd, dim3(grid), dim3(NWAVES * 64), LDS_BYTES, stream, a);
#else
    for (int id = 0; id < N_PHASE_IDS; ++id) {
        if (id >= 2 && id < 42) { const int i = (id - 2) / 10, k = (id - 2) % 10; if (k >= 3 && (i & 1)) continue; if (k == 8 && i == 0) continue; }
        a.ph_lo = id; a.ph_hi = id + 1; a.use_bar = 0;
        hipLaunchKernelGGL(mk_fwd, dim3(grid), dim3(NWAVES * 64), LDS_BYTES, stream, a);
    }
#endif
}
```

```cpp
#include <hip/hip_runtime.h>
#include <cstdio>
#include <cstdint>
#define GAS __attribute__((address_space(1)))
#define LAS __attribute__((address_space(3)))
constexpr int DM = 1024, MP = 16384, MS = 512, MT = MP + MS, TP = 8192, NBAT = 130, FF = 2816;
constexpr int MODLD = 18432;
constexpr int ZE = 2304, ZO = 1792;
constexpr float QSCALE = 0.10206207261596577f * 1.4426950408889634f;
__device__ __forceinline__ int bidx(int row) { return row < MP ? (row >> 13) : 2 + ((row - MP) >> 2); }
__device__ __forceinline__ int posof(int row) { return row < MP ? (row & (TP - 1)) : TP + ((row - MP) & 3); }
__device__ __forceinline__ float bf2f(unsigned short b) { return __uint_as_float(((unsigned)b) << 16); }
__device__ __forceinline__ unsigned f2bf(float f) { unsigned u = __builtin_bit_cast(unsigned, f); return (u + 0x7fffu + ((u >> 16) & 1u)) >> 16; }
__device__ __forceinline__ unsigned pk2(float lo, float hi) { return f2bf(lo) | (f2bf(hi) << 16); }
__device__ __forceinline__ float sigmoidf_(float x) { return __builtin_amdgcn_rcpf(1.0f + __expf(-x)); }
__device__ __forceinline__ float siluf_(float x) { return x * __builtin_amdgcn_rcpf(1.0f + __expf(-x)); }
namespace pg8 {
#define PG8_LAS __attribute__((address_space(3)))
typedef unsigned short bf16_t;
typedef short bf16x8 __attribute__((ext_vector_type(8)));
typedef float f32x4 __attribute__((ext_vector_type(4)));
typedef unsigned u32x4 __attribute__((ext_vector_type(4)));
constexpr int BM = 256, BK = 64, HALF = 128, HTB = HALF * BK * 2  , STAGE_BYTES = 8 * HTB, NXCD = 8, WGM = 8;

__host__ __device__ __forceinline__ int lds_byte(int r, int c) { const int st = (r >> 4) * 2 + (c >> 5), rr = r & 15, cc = c & 31, ob = rr * 64 + cc * 2; return st * 1024 + (ob ^ (((ob >> 9) & 1) << 5)); }
__host__ __device__ __forceinline__ void stage_rc(int b, int& R, int& C) { const int st = b / 1024, sb = b % 1024, swz = sb ^ (((sb >> 9) & 1) << 5); R = (st >> 1) * 16 + swz / 64; C = (st & 1) * 32 + (swz % 64) / 2; }
__host__ __device__ __forceinline__ int perm32(int rho) { const int n = rho >> 4, i = rho & 15; return 8 * (i >> 2) + 4 * n + (i & 3); }

struct Unit { int pm, pn, koff; };
struct Gemm { const bf16_t* A; const bf16_t* Bt; int M, N, K, lda, ldb; };

struct StaticOrder {
    int nM, nN, nwg, G, c;
    __host__ __device__ void init(int M, int N, int G_, int c_) { nM = M / BM; nN = N / BM; nwg = nM * nN; G = G_; c = c_; }
    __host__ __device__ bool next(int i, Unit& u) const {
        const long L = (long)i * G + c; if (L >= nwg) return false;
        int wgid = (int)L; { const int q = nwg / NXCD, r = nwg % NXCD, xcd = wgid % NXCD, off = wgid / NXCD; wgid = (xcd < r ? xcd * (q + 1) : r * (q + 1) + (xcd - r) * q) + off; }
        const int nig = WGM * nN, gid = wgid / nig, fm = gid * WGM, gsz = (nM - fm) < WGM ? (nM - fm) : WGM;
        u.pm = fm + ((wgid % nig) % gsz); u.pn = (wgid % nig) / gsz; u.koff = 0; return true;
    }
    __device__ __forceinline__ void a_ready(const Unit&) const {}
    __device__ __forceinline__ void done(const Unit&) const {}
};
struct SplitKOrder {
    int pm0, nP, nN, nch, kc, G, c;
    __device__ bool next(int i, Unit& u) const { const int j = i * G + c; if (j >= nP * nN * nch) return false; const int ch = j % nch, t = j / nch; u.pn = t % nN; u.pm = pm0 + t / nN; u.koff = ch * kc; return true; }
    __device__ __forceinline__ void a_ready(const Unit&) const {}
    __device__ __forceinline__ void done(const Unit&) const {}
};

__device__ __forceinline__ unsigned cvt_pk_bf16(float lo, float hi) { unsigned r; asm volatile("v_cvt_pk_bf16_f32 %0, %1, %2" : "=v"(r) : "v"(lo), "v"(hi)); return r; }

struct EpiPlain {
    static constexpr bool PERM = true, AFTER_DRAIN = false;
    bf16_t* O; int ldc;
    __device__ __forceinline__ void operator()(const f32x4 (&acc)[2][2][4][2], const Unit& u, int wr, int wc, int fr, int fq) const {
        const int row0 = u.pm * BM + wr * 64 + fr, col0 = u.pn * BM + wc * 32 + 8 * fq;
#pragma unroll
        for (int ai = 0; ai < 2; ++ai)
#pragma unroll
            for (int m = 0; m < 4; ++m) { bf16_t* rowp = O + (size_t)(row0 + ai * HALF + m * 16) * ldc + col0;
#pragma unroll
                for (int bj = 0; bj < 2; ++bj) { const f32x4 v0 = acc[ai][bj][m][0], v1 = acc[ai][bj][m][1];
                    u32x4 w; w.x = cvt_pk_bf16(v0[0], v0[1]); w.y = cvt_pk_bf16(v0[2], v0[3]); w.z = cvt_pk_bf16(v1[0], v1[1]); w.w = cvt_pk_bf16(v1[2], v1[3]);
                    *(u32x4*)(rowp + bj * HALF) = w; } }
    }
};
struct EpiSwiglu {
    static constexpr bool PERM = true, AFTER_DRAIN = false;
    bf16_t* O; int ldc;
    __device__ __forceinline__ void operator()(const f32x4 (&acc)[2][2][4][2], const Unit& u, int wr, int wc, int fr, int fq) const {
        const int row0 = u.pm * BM + wr * 64 + fr, col0 = u.pn * HALF + wc * 32 + 8 * fq;
#pragma unroll
        for (int ai = 0; ai < 2; ++ai)
#pragma unroll
            for (int m = 0; m < 4; ++m) { bf16_t* rowp = O + (size_t)(row0 + ai * HALF + m * 16) * ldc + col0;
                float o[8];
#pragma unroll
                for (int n = 0; n < 2; ++n)
#pragma unroll
                    for (int e = 0; e < 4; ++e) { const float g = acc[ai][0][m][n][e], uu = acc[ai][1][m][n][e]; o[n * 4 + e] = siluf_(g) * uu; }
                u32x4 w; w.x = cvt_pk_bf16(o[0], o[1]); w.y = cvt_pk_bf16(o[2], o[3]); w.z = cvt_pk_bf16(o[4], o[5]); w.w = cvt_pk_bf16(o[6], o[7]);
                *(u32x4*)rowp = w; }
    }
};
struct EpiRes {
    static constexpr bool PERM = false, AFTER_DRAIN = false;
    const float* bp; const float* bs; float* out; const float* gate; float coef;
    __device__ __forceinline__ void operator()(const f32x4 (&acc)[2][2][4][2], const Unit& u, int wr, int wc, int fr, int fq) const {
#pragma unroll
        for (int ai = 0; ai < 2; ++ai)
#pragma unroll
            for (int m = 0; m < 4; ++m) { const int row = u.pm * BM + ai * HALF + wr * 64 + m * 16 + fr; const int b = bidx(row);
                const float* base = (row < MP ? bp : bs) + (size_t)row * DM; const float* gr = gate + (size_t)b * MODLD; float* orow = out + (size_t)row * DM;
#pragma unroll
                for (int bj = 0; bj < 2; ++bj)
#pragma unroll
                    for (int n = 0; n < 2; ++n) { const int col = u.pn * BM + bj * HALF + wc * 32 + n * 16 + 4 * fq;
                        const f32x4 xin = *(const f32x4*)(base + col), g = *(const f32x4*)(gr + col);
                        *(f32x4*)(orow + col) = xin + (g * coef) * acc[ai][bj][m][n]; } }
    }
};
struct EpiPartial {
    static constexpr bool PERM = false, AFTER_DRAIN = false;
    float* slab;
    __device__ __forceinline__ void operator()(const f32x4 (&acc)[2][2][4][2], const Unit& u, int wr, int wc, int fr, int fq) const {
        float* sb = slab + (size_t)(u.koff >> 8) * (MS * DM);
#pragma unroll
        for (int ai = 0; ai < 2; ++ai)
#pragma unroll
            for (int m = 0; m < 4; ++m) { const int row = u.pm * BM + ai * HALF + wr * 64 + m * 16 + fr - MP; float* orow = sb + (size_t)row * DM;
#pragma unroll
                for (int bj = 0; bj < 2; ++bj)
#pragma unroll
                    for (int n = 0; n < 2; ++n) { const int col = u.pn * BM + bj * HALF + wc * 32 + n * 16 + 4 * fq; *(f32x4*)(orow + col) = acc[ai][bj][m][n]; } }
    }
};
struct EpiMod {
    static constexpr bool PERM = false, AFTER_DRAIN = false;
    float* out; const float* bias;
    __device__ __forceinline__ void operator()(const f32x4 (&acc)[2][2][4][2], const Unit& u, int wr, int wc, int fr, int fq) const {
#pragma unroll
        for (int ai = 0; ai < 2; ++ai)
#pragma unroll
            for (int m = 0; m < 4; ++m) { const int row = u.pm * BM + ai * HALF + wr * 64 + m * 16 + fr; float* orow = out + (size_t)row * MODLD;
#pragma unroll
                for (int bj = 0; bj < 2; ++bj)
#pragma unroll
                    for (int n = 0; n < 2; ++n) { const int col = u.pn * BM + bj * HALF + wc * 32 + n * 16 + 4 * fq;
                        *(f32x4*)(orow + col) = acc[ai][bj][m][n] + *(const f32x4*)(bias + col); } }
    }
};
struct EpiQ {
    static constexpr bool PERM = false, AFTER_DRAIN = false;
    bf16_t* O; const float* rt;
    __device__ __forceinline__ void operator()(const f32x4 (&acc)[2][2][4][2], const Unit& u, int wr, int wc, int fr, int fq) const {
        typedef unsigned u32x2 __attribute__((ext_vector_type(2)));
#pragma unroll
        for (int ai = 0; ai < 2; ++ai)
#pragma unroll
            for (int m = 0; m < 4; ++m) { const int row = u.pm * BM + ai * HALF + wr * 64 + m * 16 + fr; const int pos = posof(row);
                const float* rtp = rt + (size_t)pos * 32 + 8 * fq;
#pragma unroll
                for (int bj = 0; bj < 2; ++bj) { const int gc0 = u.pn * BM + bj * HALF + wc * 32; const bool isrope = (gc0 % 96) == 64;
                    f32x4 v0 = acc[ai][bj][m][0] * QSCALE, v1 = acc[ai][bj][m][1] * QSCALE;
                    if (isrope) { const f32x4 cs0 = *(const f32x4*)(rtp), cs1 = *(const f32x4*)(rtp + 4);
                        const float c[4] = {cs0[0], cs0[2], cs1[0], cs1[2]}, s[4] = {cs0[1], cs0[3], cs1[1], cs1[3]};
                        f32x4 a, b;
#pragma unroll
                        for (int e = 0; e < 4; ++e) { a[e] = v0[e] * c[e] - v1[e] * s[e]; b[e] = v1[e] * c[e] + v0[e] * s[e]; }
                        v0 = a; v1 = b; }
                    bf16_t* p = O + (size_t)row * 768 + gc0 + 4 * fq;
                    u32x2 w0; w0.x = cvt_pk_bf16(v0[0], v0[1]); w0.y = cvt_pk_bf16(v0[2], v0[3]); *(u32x2*)p = w0;
                    u32x2 w1; w1.x = cvt_pk_bf16(v1[0], v1[1]); w1.y = cvt_pk_bf16(v1[2], v1[3]); *(u32x2*)(p + 16) = w1; }
                asm volatile("" ::: "memory"); }
    }
};

template <class Epi, class Sched, bool ALIGN_EPI = false, bool SP2 = false>
__device__ __forceinline__ void gemm_phase(PG8_LAS unsigned char* lds, const Gemm g, const Sched& S, const Epi& E) {
    int tid = threadIdx.x; asm volatile("" : "+v"(tid));
    const int wid = __builtin_amdgcn_readfirstlane(tid >> 6), lane = tid & 63, wr = wid >> 2, wc = wid & 3, fr = lane & 15, fq = lane >> 4;
    const int K = g.K, nt = K / BK;
    unsigned voffA[2], voffB[2];
#pragma unroll
    for (int i = 0; i < 2; ++i) { int R, C; stage_rc(tid * 16 + i * 8192, R, C); const int Rb = Epi::PERM ? ((R & ~31) + perm32(R & 31)) : R;
        voffA[i] = (unsigned)(R * g.lda + C) * 2u; voffB[i] = (unsigned)(Rb * g.ldb + C) * 2u; }
    const size_t kstep = (size_t)(BK * 2);
    const int lda = g.lda, ldb = g.ldb;
    const size_t hstepA = (size_t)HALF * lda * 2, hstepB = (size_t)HALF * ldb * 2;
    const size_t tstepA = 2 * hstepA, tstepB = 2 * hstepB;
    const unsigned ldsw = (unsigned)wid * 1024u;
    const int aoff = lds_byte(wr * 64 + fr, fq * 8), boff = lds_byte(wc * 32 + fr, fq * 8);
#define PG8_SA(b, h) (((b) * 2 + (h)) * HTB)
#define PG8_SB(b, h) ((4 + (b) * 2 + (h)) * HTB)
#define PG8_STAGE(bufoff, gbase, voff) do { _Pragma("unroll") for (int _i = 0; _i < 2; ++_i) \
        __builtin_amdgcn_global_load_lds((const unsigned*)((const char*)(gbase) + (voff)[_i]), (PG8_LAS unsigned*)(lds + (bufoff) + ldsw + _i * 8192), 16, 0, 0); } while (0)
#define PG8_LDA(dst, b, h) do { _Pragma("unroll") for (int m = 0; m < 4; ++m) _Pragma("unroll") for (int k = 0; k < 2; ++k) dst[m][k] = *(const PG8_LAS bf16x8*)(lds + PG8_SA(b, h) + aoff + m * 2048 + k * 1024); } while (0)
#define PG8_LDB(dst, b, h) do { _Pragma("unroll") for (int n = 0; n < 2; ++n) _Pragma("unroll") for (int k = 0; k < 2; ++k) dst[n][k] = *(const PG8_LAS bf16x8*)(lds + PG8_SB(b, h) + boff + n * 2048 + k * 1024); } while (0)
#define PG8_MMA(ai, bj, At, Bt) do { __builtin_amdgcn_s_setprio(1); _Pragma("unroll") for (int m = 0; m < 4; ++m) _Pragma("unroll") for (int n = 0; n < 2; ++n) _Pragma("unroll") for (int k = 0; k < 2; ++k) \
        acc[ai][bj][m][n] = __builtin_amdgcn_mfma_f32_16x16x32_bf16(Bt[n][k], At[m][k], acc[ai][bj][m][n], 0, 0, 0); __builtin_amdgcn_s_setprio(0); } while (0)
#define PG8_WAIT_V(n) asm volatile("s_waitcnt vmcnt(" #n ")" ::: "memory")
#define PG8_WAIT_L(n) asm volatile("s_waitcnt lgkmcnt(" #n ")" ::: "memory")
#define PG8_BAR __builtin_amdgcn_s_barrier()
#define PG8_SCHED __builtin_amdgcn_sched_barrier(0)
    Unit cur, nxt; int ui = 0;
    if (!S.next(0, cur)) return;
    f32x4 acc[2][2][4][2];
#pragma unroll
    for (int a = 0; a < 2; ++a)
#pragma unroll
        for (int b = 0; b < 2; ++b)
#pragma unroll
            for (int m = 0; m < 4; ++m)
#pragma unroll
                for (int n = 0; n < 2; ++n) acc[a][b][m][n] = (f32x4){0.f, 0.f, 0.f, 0.f};
    bf16x8 At[4][2], B0[2][2], B1[2][2];
    const char* cA = (const char*)g.A + (size_t)cur.pm * tstepA + (size_t)cur.koff * 2; const char* cB = (const char*)g.Bt + (size_t)cur.pn * tstepB + (size_t)cur.koff * 2;
    S.a_ready(cur);
    if constexpr (SP2) {
        PG8_STAGE(PG8_SB(0, 0), cB, voffB); PG8_STAGE(PG8_SB(0, 1), cB + hstepB, voffB); PG8_STAGE(PG8_SA(0, 0), cA, voffA); PG8_STAGE(PG8_SA(0, 1), cA + hstepA, voffA);
        if (wr == 1) PG8_BAR;
        PG8_WAIT_V(2); PG8_BAR;
        PG8_STAGE(PG8_SB(1, 0), cB + kstep, voffB); PG8_STAGE(PG8_SA(1, 0), cA + kstep, voffA); PG8_STAGE(PG8_SB(1, 1), cB + hstepB + kstep, voffB);
        PG8_WAIT_V(6); PG8_BAR;
    } else {
        PG8_STAGE(PG8_SB(0, 0), cB, voffB); PG8_STAGE(PG8_SA(0, 0), cA, voffA); PG8_STAGE(PG8_SB(0, 1), cB + hstepB, voffB); PG8_STAGE(PG8_SA(0, 1), cA + hstepA, voffA);
        if (wr == 1) PG8_BAR;
        PG8_WAIT_V(4); PG8_BAR;
        PG8_STAGE(PG8_SB(1, 0), cB + kstep, voffB); PG8_STAGE(PG8_SA(1, 0), cA + kstep, voffA); PG8_STAGE(PG8_SB(1, 1), cB + hstepB + kstep, voffB);
        PG8_WAIT_V(6); PG8_BAR;
    }
    for (;;) {
        const bool has_next = S.next(ui + 1, nxt);
        const char* nA = has_next ? (const char*)g.A + (size_t)nxt.pm * tstepA + (size_t)nxt.koff * 2 : cA; const char* nB = has_next ? (const char*)g.Bt + (size_t)nxt.pn * tstepB + (size_t)nxt.koff * 2 : cB;
        for (int t = 0; t < nt; t += 2) {
            const bool last = (t == nt - 2);
            const char* a1 = cA + (size_t)(t + 1) * kstep;
            const char* a2 = last ? nA : cA + (size_t)(t + 2) * kstep; const char* b2 = last ? nB : cB + (size_t)(t + 2) * kstep;
            const char* a3 = a2 + kstep; const char* b3 = b2 + kstep;
            if (last && has_next) S.a_ready(nxt);
            if constexpr (SP2) {
            PG8_LDB(B0, 0, 0); PG8_LDB(B1, 0, 1); PG8_SCHED; PG8_LDA(At, 0, 0); PG8_STAGE(PG8_SA(1, 1), a1 + hstepA, voffA);
            PG8_WAIT_V(8); PG8_WAIT_L(0); PG8_BAR; PG8_MMA(0, 0, At, B0); PG8_MMA(0, 1, At, B1); PG8_BAR; PG8_SCHED;
            PG8_LDA(At, 0, 1); PG8_STAGE(PG8_SB(0, 0), b2, voffB); PG8_STAGE(PG8_SB(0, 1), b2 + hstepB, voffB); PG8_STAGE(PG8_SA(0, 0), a2, voffA);
            PG8_WAIT_V(8); PG8_WAIT_L(0); PG8_BAR; PG8_MMA(1, 0, At, B0); PG8_MMA(1, 1, At, B1); PG8_BAR; PG8_SCHED;
            PG8_LDB(B0, 1, 0); PG8_LDB(B1, 1, 1); PG8_SCHED; PG8_LDA(At, 1, 0); PG8_STAGE(PG8_SA(0, 1), a2 + hstepA, voffA);
            PG8_WAIT_V(8); PG8_WAIT_L(0); PG8_BAR; PG8_MMA(0, 0, At, B0); PG8_MMA(0, 1, At, B1); PG8_BAR; PG8_SCHED;
            PG8_LDA(At, 1, 1); PG8_STAGE(PG8_SB(1, 0), b3, voffB); PG8_STAGE(PG8_SB(1, 1), b3 + hstepB, voffB); PG8_STAGE(PG8_SA(1, 0), a3, voffA);
            PG8_WAIT_V(8); PG8_WAIT_L(0); PG8_BAR; PG8_MMA(1, 0, At, B0); PG8_MMA(1, 1, At, B1); PG8_BAR; PG8_SCHED;
            } else {
            PG8_LDB(B0, 0, 0); PG8_SCHED; PG8_LDA(At, 0, 0); PG8_STAGE(PG8_SA(1, 1), a1 + hstepA, voffA);
            PG8_WAIT_L(8); PG8_BAR; PG8_WAIT_L(0); PG8_MMA(0, 0, At, B0); PG8_BAR; PG8_SCHED;
            PG8_LDB(B1, 0, 1); PG8_STAGE(PG8_SB(0, 0), b2, voffB);
            PG8_BAR; PG8_WAIT_L(0); PG8_MMA(0, 1, At, B1); PG8_BAR;
            PG8_LDA(At, 0, 1); PG8_STAGE(PG8_SA(0, 0), a2, voffA);
            PG8_BAR; PG8_WAIT_L(0); PG8_MMA(1, 0, At, B0); PG8_BAR; PG8_SCHED;
            PG8_STAGE(PG8_SB(0, 1), b2 + hstepB, voffB);
            PG8_WAIT_V(6); PG8_BAR; PG8_MMA(1, 1, At, B1); PG8_BAR;
            PG8_LDB(B0, 1, 0); PG8_SCHED; PG8_LDA(At, 1, 0); PG8_STAGE(PG8_SA(0, 1), a2 + hstepA, voffA);
            PG8_WAIT_L(8); PG8_BAR; PG8_WAIT_L(0); PG8_MMA(0, 0, At, B0); PG8_BAR; PG8_SCHED;
            PG8_LDB(B1, 1, 1); PG8_STAGE(PG8_SB(1, 0), b3, voffB);
            PG8_BAR; PG8_WAIT_L(0); PG8_MMA(0, 1, At, B1); PG8_BAR;
            PG8_LDA(At, 1, 1); PG8_STAGE(PG8_SA(1, 0), a3, voffA);
            PG8_BAR; PG8_WAIT_L(0); PG8_MMA(1, 0, At, B0); PG8_BAR; PG8_SCHED;
            PG8_STAGE(PG8_SB(1, 1), b3 + hstepB, voffB);
            PG8_WAIT_V(6); PG8_BAR; PG8_MMA(1, 1, At, B1); PG8_BAR;
            }
        }
        if constexpr (ALIGN_EPI) { if (wr == 0) PG8_BAR; }
        if constexpr (!Epi::AFTER_DRAIN) { E(acc, cur, wr, wc, fr, fq); S.done(cur); }
        if (!has_next) break;
#pragma unroll
        for (int a = 0; a < 2; ++a)
#pragma unroll
            for (int b = 0; b < 2; ++b)
#pragma unroll
                for (int m = 0; m < 4; ++m)
#pragma unroll
                    for (int n = 0; n < 2; ++n) acc[a][b][m][n] = (f32x4){0.f, 0.f, 0.f, 0.f};
        cur = nxt; cA = nA; cB = nB; ++ui;
        if constexpr (ALIGN_EPI) { if (wr == 1) PG8_BAR; }
    }
    PG8_WAIT_V(0);
    if constexpr (!ALIGN_EPI) { if (wr == 0) PG8_BAR; }
    PG8_BAR;
    if constexpr (Epi::AFTER_DRAIN) { E.fused(acc, cur, wr, wc, fr, fq, lds, wid, lane); S.done(cur); }
#undef PG8_SA
#undef PG8_SB
#undef PG8_STAGE
#undef PG8_LDA
#undef PG8_LDB
#undef PG8_MMA
#undef PG8_WAIT_V
#undef PG8_WAIT_L
#undef PG8_BAR
#undef PG8_SCHED
}
}
constexpr size_t MiB = 1u << 20;
constexpr size_t WS_CTL = 0, CTL_ZERO_BYTES = 1 * MiB;
constexpr size_t WS_W13T = 2 * MiB, W13T_STRIDE = 11 * MiB;
constexpr size_t WS_W2T = 46 * MiB, W2T_STRIDE = 5767168;
constexpr size_t WS_EVIN = 68 * MiB, WS_EVOUT = 73 * MiB, WS_ODIN = 75 * MiB, WS_ODOUT = 79 * MiB, WS_WUQ = 81 * MiB, WS_WKV = 82 * MiB;
constexpr size_t WS_ADAT = 83 * MiB, WS_SC = 119 * MiB, WS_RT = 120 * MiB, WS_MOD = 122 * MiB;
constexpr size_t WS_X = 140 * MiB, WS_H = 206 * MiB, WS_ACT = 239 * MiB, WS_Z = 330 * MiB, WS_OP = 405 * MiB;
constexpr size_t WS_US = 438 * MiB, WS_DS = 470 * MiB, WS_CQN = 471 * MiB, WS_CKVB = 484 * MiB, WS_KRB = 493 * MiB, WS_Q = 495 * MiB, WS_KV = 520 * MiB;
constexpr size_t WS_PART = 552 * MiB, WS_QD = 586 * MiB, WS_SLAB = 592 * MiB, WS_DUMMY = 616 * MiB, WS_BCS = 682 * MiB, WS_END = 698 * MiB;
constexpr int NSPLIT = 4, PART_F = 32 * 256 + 64;
constexpr size_t O_Y = 0, O_GLAP = 17301504, O_GLAS = O_GLAP + 65536, O_POOLP = O_GLAS + 4194304, O_POOLS = O_POOLP + 15360, O_CKV = O_POOLS + 983040,
                 O_KR = O_CKV + 4325376, O_CONVP = O_KR + 540672, O_CONVS = O_CONVP + 30720, O_END = O_CONVS + 1966080;
constexpr int CW_TMO = 0, CW_CODE = 1, CW_BAR = 4096;
constexpr int RING_BYTES = 131072, LDSCTL_OFF = RING_BYTES, MISC_OFF = LDSCTL_OFF + 320, LDS_BYTES = 147456;
constexpr int NWAVES = 8;

typedef unsigned short bf16;
typedef unsigned v4u __attribute__((ext_vector_type(4)));
typedef unsigned v2u __attribute__((ext_vector_type(2)));
typedef float f32x4 __attribute__((ext_vector_type(4)));
typedef float f32x2 __attribute__((ext_vector_type(2)));
typedef float f32x16 __attribute__((ext_vector_type(16)));
typedef short bf16x8 __attribute__((ext_vector_type(8)));
typedef short s16x4 __attribute__((ext_vector_type(4)));
typedef GAS unsigned gu32;
#define RLX_AGENT __ATOMIC_RELAXED, __HIP_MEMORY_SCOPE_AGENT
#define LDS_WAIT() asm volatile("s_waitcnt lgkmcnt(0)" ::: "memory")
#define VM_WAIT() asm volatile("s_waitcnt vmcnt(0)" ::: "memory")


#ifndef PROBE_DUP
#define PROBE_DUP 0u
#endif
__device__ __forceinline__ int opaque_int(int v) { asm volatile("" : "+s"(v)); return v; }
#define NREP(n) ((((PROBE_DUP) >> (n)) & 1u) ? opaque_int(2) : 1)


typedef short v4i16_t __attribute__((ext_vector_type(4)));
__device__ __forceinline__ s16x4 vtr(const LAS unsigned char* p) { return __builtin_bit_cast(s16x4, __builtin_amdgcn_ds_read_tr16_b64_v4i16((LAS v4i16_t*)p)); }
#define LBAR() asm volatile("s_waitcnt lgkmcnt(0)\n\ts_barrier" ::: "memory")
__device__ __forceinline__ float xhalf_max(float v) { auto rr = __builtin_amdgcn_permlane32_swap(__float_as_uint(v), __float_as_uint(v), false, false); return fmaxf(__uint_as_float(rr[0]), __uint_as_float(rr[1])); }
__device__ __forceinline__ float xhalf_sum(float v) { auto rr = __builtin_amdgcn_permlane32_swap(__float_as_uint(v), __float_as_uint(v), false, false); return __uint_as_float(rr[0]) + __uint_as_float(rr[1]); }
__device__ __forceinline__ int crow(int r, int hi) { return (r & 3) + 8 * (r >> 2) + 4 * hi; }
__device__ __forceinline__ bf16x8 pack8(const f32x16& p, int s8) {
    v4u w; w.x = pg8::cvt_pk_bf16(p[s8 + 0], p[s8 + 1]); w.y = pg8::cvt_pk_bf16(p[s8 + 2], p[s8 + 3]); w.z = pg8::cvt_pk_bf16(p[s8 + 4], p[s8 + 5]); w.w = pg8::cvt_pk_bf16(p[s8 + 6], p[s8 + 7]);
    return __builtin_bit_cast(bf16x8, w);
}

#define XB_TMO      128
#define XB_XCNT(j)  (256  + 64 * (j))
#define XB_XSUB(j)  (1280 + 64 * (j))
#define XB_XGEN(j)  (2304 + 64 * (j))
#define XB_TOP      3328
#define XB_TOPGEN   3392
#define XCD_BAR_WORDS 3456
#define XB_SPIN_CAP (1u << 18)

__device__ __forceinline__ unsigned xb_ld(unsigned* p)              { return __hip_atomic_load(p, __ATOMIC_RELAXED, __HIP_MEMORY_SCOPE_AGENT); }
__device__ __forceinline__ unsigned xb_add(unsigned* p, unsigned v) { return __hip_atomic_fetch_add(p, v, __ATOMIC_RELAXED, __HIP_MEMORY_SCOPE_AGENT); }
__device__ __forceinline__ unsigned xb_xcc_id() { return (unsigned)__builtin_amdgcn_s_getreg((3 << 11) | 20) & 0xFu; }
#define XB_SPIN(cond, bar) do { unsigned _sp = 0; while (cond) { __builtin_amdgcn_s_sleep(1); \
    if ((++_sp & 255u) == 0u) { if (xb_ld(&(bar)[XB_TMO])) break; if (_sp > XB_SPIN_CAP) { atomicAdd(&(bar)[XB_TMO], 1u); break; } } } } while (0)

struct XcdBarrier {
    unsigned* bar; unsigned x;
    volatile LAS unsigned* st;
};

__device__ __forceinline__ XcdBarrier xcd_barrier_post(unsigned* bar, volatile LAS unsigned* st) {
    XcdBarrier b; b.bar = bar; b.x = xb_xcc_id(); b.st = st;
    if (threadIdx.x == 0) (void)xb_add(&bar[XB_XCNT(b.x)], 1u);
    return b;
}
__device__ __forceinline__ void xcd_barrier_complete(unsigned* bar, unsigned x, unsigned& nloc, unsigned& nx) {
    const unsigned G = gridDim.x * gridDim.y * gridDim.z;
    unsigned sum, cnt, mine, sp = 0u;
    for (;;) {
        sum = 0u; cnt = 0u; mine = 0u;
#pragma unroll
        for (unsigned j = 0; j < 16; ++j) { const unsigned c = xb_ld(&bar[XB_XCNT(j)]); sum += c; cnt += (c > 0u) ? 1u : 0u; mine = (j == x) ? c : mine; }
        if (sum == G) break;
        __builtin_amdgcn_s_sleep(1);
        if ((++sp & 255u) == 0u) { if (xb_ld(&bar[XB_TMO])) break; if (sp > XB_SPIN_CAP) { atomicAdd(&bar[XB_TMO], 1u); break; } }
    }
    nloc = mine > 0u ? mine : 1u; nx = cnt > 0u ? cnt : 1u;
}

__device__ __forceinline__ void xcd_barrier(const XcdBarrier& b) {
    asm volatile("s_waitcnt vmcnt(0)" ::: "memory");
    __syncthreads();
    if (threadIdx.x == 0) {
        unsigned* bar = b.bar;
        __builtin_amdgcn_s_waitcnt(0);
        unsigned nloc = b.st[0], nx = b.st[1];
        if (nloc == 0u) { xcd_barrier_complete(bar, b.x, nloc, nx); b.st[0] = nloc; b.st[1] = nx; }
        const unsigned old = xb_add(&bar[XB_XSUB(b.x)], 1u);
        const unsigned gen = old / nloc;
        if (old + 1u == (gen + 1u) * nloc) {
            __builtin_amdgcn_fence(__ATOMIC_RELEASE, "agent");
            asm volatile("s_waitcnt vmcnt(0)" ::: "memory");
            const unsigned og = xb_add(&bar[XB_TOP], 1u);
            const unsigned tg = og / nx;
            if (og + 1u == (tg + 1u) * nx) xb_add(&bar[XB_TOPGEN], 1u);
            else XB_SPIN(xb_ld(&bar[XB_TOPGEN]) == tg, bar);
            __builtin_amdgcn_fence(__ATOMIC_ACQUIRE, "agent");
            xb_add(&bar[XB_XGEN(b.x)], 1u);
            asm volatile("s_waitcnt vmcnt(0)" ::: "memory");
        } else {
            XB_SPIN(xb_ld(&bar[XB_XGEN(b.x)]) == gen, bar);
            __builtin_amdgcn_fence(__ATOMIC_ACQUIRE, "agent");
            asm volatile("s_waitcnt vmcnt(0)" ::: "memory");
        }
    }
    __syncthreads();
}
struct Args { const void* in[35]; float* out; unsigned char* ws; int ph_lo, ph_hi, use_bar, k_q, k_kv, pad; };
struct Frame {
    LAS unsigned char* lds;
    volatile LAS unsigned* MISC;
    gu32* ctl;
    int tid, lane, wave, G, bx;
    unsigned char* ws; float* out;
};
__device__ __forceinline__ float wave_sum(float v) {
#pragma unroll
    for (int o = 1; o < 64; o <<= 1) v += __shfl_xor(v, o);
    return v;
}
__device__ __forceinline__ float half_sum(float v) {
#pragma unroll
    for (int o = 1; o < 32; o <<= 1) v += __shfl_xor(v, o);
    return v;
}
#define WS_PTR(T, off) ((T*)(F.ws + (off)))

enum { RM_ID = 0, RM_W1 = 1, RM_W3 = 2, RM_EVIN = 3 };
__device__ __forceinline__ int map_row(int mode, int n) {
    if (mode == RM_W1) return 256 * (n >> 7) + (n & 127);
    if (mode == RM_W3) return 256 * (n >> 7) + 128 + (n & 127);
    if (mode == RM_EVIN) return n < 1536 ? n : (n < 1552 ? 2048 + (n - 1536) : 1536 + (n - 1552));
    return n;
}
__device__ __forceinline__ void p0_transpose_item(const float* W, int N, bf16* WT, int ldk, int mode, LAS float* scr, int item, int lane) {
    const int nblk = (N + 31) / 32, kb = item / nblk, nb = item % nblk, k0 = 64 * kb, n0 = 32 * nb;
    const bool okc = (n0 + (lane & 31)) < N;
    float tv[32];
#pragma unroll
    for (int i = 0; i < 32; ++i) { const int kk = 2 * i + (lane >> 5); tv[i] = okc ? __builtin_nontemporal_load(W + (size_t)(k0 + kk) * N + n0 + (lane & 31)) : 0.f; }
#pragma unroll
    for (int i = 0; i < 32; ++i) { const int kk = 2 * i + (lane >> 5); scr[kk * 33 + (lane & 31)] = tv[i]; }
    LDS_WAIT(); asm volatile("" ::: "memory");
    const int c = lane & 7;
#pragma unroll
    for (int j = 0; j < 4; ++j) { const int n = (lane >> 3) + 8 * j; const LAS float* s = scr + (8 * c) * 33 + n;
        v4u o; o.x = pk2(s[0 * 33], s[1 * 33]); o.y = pk2(s[2 * 33], s[3 * 33]); o.z = pk2(s[4 * 33], s[5 * 33]); o.w = pk2(s[6 * 33], s[7 * 33]);
        if (n0 + n < N) *(GAS v4u*)(WT + (size_t)map_row(mode, n0 + n) * ldk + k0 + 8 * c) = o; }
    LDS_WAIT(); asm volatile("" ::: "memory");
}
__device__ __forceinline__ void p0_prologue(Frame& F, const Args& A) {
    LAS float* scr = (LAS float*)(F.lds + F.wave * 16384);
    const int gw = F.bx * NWAVES + F.wave, NGW = F.G * NWAVES;
    const float* ffn_w1 = (const float*)A.in[13]; const float* ffn_w3 = (const float*)A.in[14]; const float* ffn_w2 = (const float*)A.in[15];
    const float* ev_w_in = (const float*)A.in[16]; const float* ev_w_out = (const float*)A.in[22]; const float* od_w_in = (const float*)A.in[23]; const float* od_w_out = (const float*)A.in[33];
    const float* w_uq = (const float*)A.in[25]; const float* w_uk = (const float*)A.in[27]; const float* w_uv = (const float*)A.in[28]; const float* ada_w = (const float*)A.in[10];
    constexpr int I_W1 = 16 * 88, I_W2 = 44 * 32, I_FFN = 2 * I_W1 + I_W2;
    constexpr int I_EVIN = 16 * 65, I_EVOUT = 8 * 32, I_ODIN = 16 * 53, I_ODOUT = 16 * 32, I_UQ = 6 * 24, I_UK = 4 * 16, I_ADA = 16 * 288;
    constexpr int NITEMS = 4 * I_FFN + I_EVIN + I_EVOUT + I_ODIN + I_ODOUT + I_UQ + 2 * I_UK + 2 * I_ADA;
    for (int it = gw; it < NITEMS; it += NGW) {
        int r = it;
        if (r < 4 * I_FFN) { const int i = r / I_FFN; r -= i * I_FFN;
            bf16* w13 = WS_PTR(bf16, WS_W13T + (size_t)i * W13T_STRIDE); bf16* w2 = WS_PTR(bf16, WS_W2T + (size_t)i * W2T_STRIDE);
            if (r < I_W1) { p0_transpose_item(ffn_w1 + (size_t)i * DM * FF, FF, w13, DM, RM_W1, scr, r, F.lane); continue; } r -= I_W1;
            if (r < I_W1) { p0_transpose_item(ffn_w3 + (size_t)i * DM * FF, FF, w13, DM, RM_W3, scr, r, F.lane); continue; } r -= I_W1;
            p0_transpose_item(ffn_w2 + (size_t)i * FF * DM, DM, w2, FF, RM_ID, scr, r, F.lane); continue; }
        r -= 4 * I_FFN;
        if (r < I_EVIN) { p0_transpose_item(ev_w_in, 2064, WS_PTR(bf16, WS_EVIN), DM, RM_EVIN, scr, r, F.lane); continue; } r -= I_EVIN;
        if (r < I_EVOUT) { p0_transpose_item(ev_w_out, DM, WS_PTR(bf16, WS_EVOUT), DM, RM_ID, scr, r, F.lane); continue; } r -= I_EVOUT;
        if (r < I_ODIN) { p0_transpose_item(od_w_in, 1696, WS_PTR(bf16, WS_ODIN), DM, RM_ID, scr, r, F.lane); continue; } r -= I_ODIN;
        if (r < I_ODOUT) { p0_transpose_item(od_w_out, DM, WS_PTR(bf16, WS_ODOUT), DM, RM_ID, scr, r, F.lane); continue; } r -= I_ODOUT;
        if (r < I_UQ) { p0_transpose_item(w_uq, 768, WS_PTR(bf16, WS_WUQ), 384, RM_ID, scr, r, F.lane); continue; } r -= I_UQ;
        if (r < I_UK) { p0_transpose_item(w_uk, 512, WS_PTR(bf16, WS_WKV), 256, RM_ID, scr, r, F.lane); continue; } r -= I_UK;
        if (r < I_UK) { p0_transpose_item(w_uv, 512, WS_PTR(bf16, WS_WKV) + 512 * 256, 256, RM_ID, scr, r, F.lane); continue; } r -= I_UK;
        { const int l = r / I_ADA; r -= l * I_ADA; p0_transpose_item(ada_w + (size_t)l * DM * 9216, 9216, WS_PTR(bf16, WS_ADAT) + (size_t)l * 9216 * DM, DM, RM_ID, scr, r, F.lane); }
    }
    { constexpr int NZ = (240 + 96) * (DM / 8);
      for (int i = F.bx * 512 + F.tid; i < NZ; i += F.G * 512) { const int rr = i / (DM / 8), c8 = i % (DM / 8);
          bf16* dst = rr < 240 ? WS_PTR(bf16, WS_EVIN) + (size_t)(2064 + rr) * DM : WS_PTR(bf16, WS_ODIN) + (size_t)(1696 + rr - 240) * DM;
          *(GAS v4u*)(dst + c8 * 8) = (v4u){0u, 0u, 0u, 0u}; } }
    { const float* pool_w = (const float*)A.in[20]; const float* pool_scale = (const float*)A.in[21]; bf16* evo = WS_PTR(bf16, WS_EVOUT);
      for (int it = gw; it < 512; it += NGW) { const int g = it >> 7, c = it & 127;
          f32x4 acc[4] = {{0.f, 0.f, 0.f, 0.f}, {0.f, 0.f, 0.f, 0.f}, {0.f, 0.f, 0.f, 0.f}, {0.f, 0.f, 0.f, 0.f}};
          for (int d = 0; d < 128; ++d) { const float a = pool_w[(size_t)(g * 128 + c) * 128 + d] * pool_scale[g * 128 + d];
              const float* wr = ev_w_out + (size_t)(512 + g * 128 + d) * DM + 4 * F.lane;
#pragma unroll
              for (int j = 0; j < 4; ++j) acc[j] += a * *(const f32x4*)(wr + 256 * j); }
#pragma unroll
          for (int j = 0; j < 4; ++j)
#pragma unroll
              for (int e = 0; e < 4; ++e) evo[(size_t)(256 * j + 4 * F.lane + e) * DM + 512 + g * 128 + c] = (bf16)f2bf(acc[j][e]); } }
    { const float* cp = (const float*)A.in[8]; const float* cs = (const float*)A.in[9]; bf16* sc = WS_PTR(bf16, WS_SC);
      for (int r = gw; r < 256; r += NGW) { const float* src = r < 2 ? cp + (size_t)r * DM : cs + (size_t)(r - 2) * DM;
#pragma unroll
          for (int j = 0; j < 4; ++j) { f32x4 v = {0.f, 0.f, 0.f, 0.f}; if (r < NBAT) v = *(const f32x4*)(src + 4 * F.lane + 256 * j);
              v2u o; o.x = r < NBAT ? pk2(siluf_(v[0]), siluf_(v[1])) : 0u; o.y = r < NBAT ? pk2(siluf_(v[2]), siluf_(v[3])) : 0u;
              *(GAS v2u*)(sc + (size_t)r * DM + 4 * F.lane + 256 * j) = o; } } }
    { const f32x4* xs = (const f32x4*)A.in[1]; f32x4* xd = (f32x4*)(WS_PTR(float, WS_X) + (size_t)MP * DM);
      for (int i = F.bx * 512 + F.tid; i < MS * DM / 4; i += F.G * 512) xd[i] = xs[i]; }
    { float* rt = WS_PTR(float, WS_RT);
      for (int i = F.bx * 512 + F.tid; i < 8196 * 16; i += F.G * 512) { const int pos = i >> 4, k = i & 15;
          const float freq = exp2f(-(float)k * 0.8304820237218406f);    const float ang = (float)pos * freq; float s, c; sincosf(ang, &s, &c);
          *(f32x2*)(rt + 2 * (size_t)i) = (f32x2){c, s}; } }
}

__device__ __forceinline__ void nm_phase(Frame& F, const float* bp, const float* bs, const float* g, const float* modsh, bf16* H, float* X, const float* slab, int nch, const float* pgate, float pcoef) {
    const int gw = F.bx * NWAVES + F.wave, NGW = F.G * NWAVES;
    f32x4 gv[4];
#pragma unroll
    for (int j = 0; j < 4; ++j) gv[j] = *(const f32x4*)(g + 4 * F.lane + 256 * j);
    for (int row = gw; row < MP; row += 2 * NGW) {
        const int row2 = row + NGW; const bool has2 = row2 < MP; const int r2 = has2 ? row2 : row;
        const float* xa = bp + (size_t)row * DM + 4 * F.lane; const float* xb = bp + (size_t)r2 * DM + 4 * F.lane;
        const float* ma = modsh + (size_t)(row >> 13) * MODLD + 4 * F.lane; const float* mb = modsh + (size_t)(r2 >> 13) * MODLD + 4 * F.lane;
        f32x4 va[4], vb[4], sha[4], sca[4], shb[4], scb[4]; float sa = 0.f, sb = 0.f;
#pragma unroll
        for (int j = 0; j < 4; ++j) { va[j] = *(const f32x4*)(xa + 256 * j); vb[j] = *(const f32x4*)(xb + 256 * j); }
#pragma unroll
        for (int j = 0; j < 4; ++j) { sha[j] = *(const f32x4*)(ma + 256 * j); sca[j] = *(const f32x4*)(ma + DM + 256 * j); shb[j] = *(const f32x4*)(mb + 256 * j); scb[j] = *(const f32x4*)(mb + DM + 256 * j); }
#pragma unroll
        for (int j = 0; j < 4; ++j) { sa += (va[j][0] * va[j][0] + va[j][1] * va[j][1]) + (va[j][2] * va[j][2] + va[j][3] * va[j][3]); sb += (vb[j][0] * vb[j][0] + vb[j][1] * vb[j][1]) + (vb[j][2] * vb[j][2] + vb[j][3] * vb[j][3]); }
#pragma unroll
        for (int o = 1; o < 64; o <<= 1) { sa += __shfl_xor(sa, o); sb += __shfl_xor(sb, o); }
        const float ra = 1.0f / sqrtf(sa * (1.0f / DM) + 1e-6f), rb2 = 1.0f / sqrtf(sb * (1.0f / DM) + 1e-6f);
#pragma unroll
        for (int j = 0; j < 4; ++j) { const f32x4 h = (va[j] * ra) * gv[j] * (sca[j] + 1.0f) + sha[j]; v2u o; o.x = pk2(h[0], h[1]); o.y = pk2(h[2], h[3]);
            *(GAS v2u*)(H + (size_t)row * DM + 4 * F.lane + 256 * j) = o; }
        if (has2) {
#pragma unroll
            for (int j = 0; j < 4; ++j) { const f32x4 h = (vb[j] * rb2) * gv[j] * (scb[j] + 1.0f) + shb[j]; v2u o; o.x = pk2(h[0], h[1]); o.y = pk2(h[2], h[3]);
                *(GAS v2u*)(H + (size_t)row2 * DM + 4 * F.lane + 256 * j) = o; } }
    }
    for (int row = MP + gw; row < MT; row += NGW) {
        const float* xr = bs + (size_t)row * DM + 4 * F.lane;
        f32x4 v[4]; float ss = 0.f;
#pragma unroll
        for (int j = 0; j < 4; ++j) v[j] = *(const f32x4*)(xr + 256 * j);
        if (nch > 0) { f32x4 a[4] = {{0.f, 0.f, 0.f, 0.f}, {0.f, 0.f, 0.f, 0.f}, {0.f, 0.f, 0.f, 0.f}, {0.f, 0.f, 0.f, 0.f}};
            for (int k = 0; k < nch; ++k) { const float* sp = slab + ((size_t)k * MS + (row - MP)) * DM + 4 * F.lane;
#pragma unroll
                for (int j = 0; j < 4; ++j) a[j] += *(const f32x4*)(sp + 256 * j); }
            const float* gp = pgate + (size_t)bidx(row) * MODLD + 4 * F.lane;
#pragma unroll
            for (int j = 0; j < 4; ++j) { v[j] += (*(const f32x4*)(gp + 256 * j) * pcoef) * a[j]; *(f32x4*)(X + (size_t)row * DM + 4 * F.lane + 256 * j) = v[j]; } }
#pragma unroll
        for (int j = 0; j < 4; ++j) ss += (v[j][0] * v[j][0] + v[j][1] * v[j][1]) + (v[j][2] * v[j][2] + v[j][3] * v[j][3]);
        const float rstd = 1.0f / sqrtf(wave_sum(ss) * (1.0f / DM) + 1e-6f);
        const float* mrow = modsh + (size_t)bidx(row) * MODLD + 4 * F.lane;
#pragma unroll
        for (int j = 0; j < 4; ++j) { const f32x4 sh = *(const f32x4*)(mrow + 256 * j), sc = *(const f32x4*)(mrow + DM + 256 * j);
            const f32x4 h = (v[j] * rstd) * gv[j] * (sc + 1.0f) + sh;
            v2u o; o.x = pk2(h[0], h[1]); o.y = pk2(h[2], h[3]);
            *(GAS v2u*)(H + (size_t)row * DM + 4 * F.lane + 256 * j) = o; }
    }
}
__device__ __forceinline__ void final_phase(Frame& F, const float* X, const float* g, float* out, const float* slab, int nch, const float* pgate, float pcoef) {
    const int gw = F.bx * NWAVES + F.wave, NGW = F.G * NWAVES;
    f32x4 gv[4];
#pragma unroll
    for (int j = 0; j < 4; ++j) gv[j] = *(const f32x4*)(g + 4 * F.lane + 256 * j);
    for (int row = gw; row < MT; row += NGW) {
        const float* xr = X + (size_t)row * DM + 4 * F.lane;
        f32x4 v[4]; float ss = 0.f;
#pragma unroll
        for (int j = 0; j < 4; ++j) v[j] = *(const f32x4*)(xr + 256 * j);
        if (row >= MP) { f32x4 a[4] = {{0.f, 0.f, 0.f, 0.f}, {0.f, 0.f, 0.f, 0.f}, {0.f, 0.f, 0.f, 0.f}, {0.f, 0.f, 0.f, 0.f}};
            for (int k = 0; k < nch; ++k) { const float* sp = slab + ((size_t)k * MS + (row - MP)) * DM + 4 * F.lane;
#pragma unroll
                for (int j = 0; j < 4; ++j) a[j] += *(const f32x4*)(sp + 256 * j); }
            const float* gp = pgate + (size_t)bidx(row) * MODLD + 4 * F.lane;
#pragma unroll
            for (int j = 0; j < 4; ++j) v[j] += (*(const f32x4*)(gp + 256 * j) * pcoef) * a[j]; }
#pragma unroll
        for (int j = 0; j < 4; ++j) ss += (v[j][0] * v[j][0] + v[j][1] * v[j][1]) + (v[j][2] * v[j][2] + v[j][3] * v[j][3]);
        const float rstd = 1.0f / sqrtf(wave_sum(ss) * (1.0f / DM) + 1e-6f);
#pragma unroll
        for (int j = 0; j < 4; ++j) *(f32x4*)(out + (size_t)row * DM + 4 * F.lane + 256 * j) = (v[j] * rstd) * gv[j];
    }
}
__device__ __forceinline__ float logsig16(float x) { return (fminf(x, 0.f) - __logf(1.0f + __expf(-fabsf(x)))) * (1.0f / 16.0f); }
__device__ __forceinline__ void gla_cumdecay(Frame& F, unsigned glw, int h, const float* gate_w2, const float* gate_b, LAS float* bcs, LAS float* gl, LAS float* seg) {
    const int tid = F.tid;
    { const int t = tid >> 3, j2 = (tid & 7) * 2; const unsigned w = glw;
      gl[t * 16 + j2] = bf2f((unsigned short)(w & 0xffffu)); gl[t * 16 + j2 + 1] = bf2f((unsigned short)(w >> 16)); }
    __syncthreads();
    { const int t = tid >> 3, dk8 = (tid & 7) * 8; float x[8];
      { const f32x4 b0 = *(const f32x4*)(gate_b + h * 64 + dk8), b1 = *(const f32x4*)(gate_b + h * 64 + dk8 + 4);
#pragma unroll
        for (int e = 0; e < 4; ++e) { x[e] = b0[e]; x[4 + e] = b1[e]; } }
#pragma unroll
      for (int j = 0; j < 16; ++j) { const float gv = gl[t * 16 + j]; const f32x4 w0 = *(const f32x4*)(gate_w2 + j * 256 + h * 64 + dk8), w1 = *(const f32x4*)(gate_w2 + j * 256 + h * 64 + dk8 + 4);
#pragma unroll
          for (int e = 0; e < 4; ++e) { x[e] += gv * w0[e]; x[4 + e] += gv * w1[e]; } }
#pragma unroll
      for (int e = 0; e < 8; ++e) bcs[t * 64 + dk8 + e] = logsig16(x[e]); }
    __syncthreads();
    { const int dk = tid & 63, sg = tid >> 6; float run = 0.f;
#pragma unroll
      for (int i = 0; i < 8; ++i) { run += bcs[(sg * 8 + i) * 64 + dk]; bcs[(sg * 8 + i) * 64 + dk] = run; }
      seg[sg * 64 + dk] = run; }
    __syncthreads();
    { const int dk = tid & 63, sg = tid >> 6; float pre = 0.f;
      for (int s = 0; s < sg; ++s) pre += seg[s * 64 + dk];
#pragma unroll
      for (int i = 0; i < 8; ++i) bcs[(sg * 8 + i) * 64 + dk] += pre; }
    __syncthreads();
}
constexpr int GK_ROW = 144, GV_ROW = 272;
__device__ __forceinline__ void gla_g1_unit(Frame& F, const Args& A, int unit) {
    const bf16* Z = WS_PTR(bf16, WS_Z); float* US = WS_PTR(float, WS_US); float* DS = WS_PTR(float, WS_DS);
    int tid = threadIdx.x; asm volatile("" : "+v"(tid)); F.tid = tid; F.lane = tid & 63; F.wave = __builtin_amdgcn_readfirstlane(tid >> 6);
    const int bh = unit >> 7, n = unit & 127, b = bh >> 2, h = bh & 3, row0 = b * TP + n * 64;
    LAS float* bcs = (LAS float*)F.lds; LAS float* gl = bcs + 4096; LAS float* seg = gl + 1024;
    LAS unsigned char* KK = F.lds + 24576; LAS unsigned char* VV = KK + 64 * GK_ROW;
    const int s = tid >> 3, dk8 = (tid & 7) * 8, dv16 = (tid & 7) * 16;
    const bf16* zr = Z + (size_t)(row0 + s) * ZE;
    const unsigned glw = *(const unsigned*)(zr + 2048 + (tid & 7) * 2); const v4u kw = *(const v4u*)(zr + 256 + h * 64 + dk8); const v4u vw0 = *(const v4u*)(zr + 512 + h * 128 + dv16), vw1 = *(const v4u*)(zr + 512 + h * 128 + dv16 + 8);
    gla_cumdecay(F, glw, h, (const float*)A.in[17], (const float*)A.in[18], bcs, gl, seg);
    { v4u o; f32x4 bq0, bq1;
#pragma unroll
      for (int e = 0; e < 4; ++e) { const unsigned w = kw[e]; const int d0 = dk8 + 2 * e; const float c0 = bcs[s * 64 + d0], c1 = bcs[s * 64 + d0 + 1];
          if (e < 2) { bq0[2 * e] = c0; bq0[2 * e + 1] = c1; } else { bq1[2 * e - 4] = c0; bq1[2 * e - 3] = c1; }
          o[e] = pk2(bf2f((unsigned short)(w & 0xffffu)) * __expf(bcs[63 * 64 + d0] - c0), bf2f((unsigned short)(w >> 16)) * __expf(bcs[63 * 64 + d0 + 1] - c1)); }
      *(LAS v4u*)(KK + s * GK_ROW + dk8 * 2) = o;
      float* bg = WS_PTR(float, WS_BCS) + (size_t)unit * 4096 + s * 64 + dk8; *(f32x4*)bg = bq0; *(f32x4*)(bg + 4) = bq1;
      *(LAS v4u*)(VV + s * GV_ROW + dv16 * 2) = vw0; *(LAS v4u*)(VV + s * GV_ROW + (dv16 + 8) * 2) = vw1;
      if (tid < 64) DS[(size_t)unit * 64 + tid] = __expf(bcs[63 * 64 + tid]); }
    __syncthreads();
    { const int lane = F.lane, wid = F.wave, r32 = lane & 31, hi = lane >> 5, g = lane >> 4, i16 = lane & 15, hg = g >> 1, dkt = wid & 1, dvt = wid >> 1;
      const int ka = (8 * hg + (i16 >> 2)) * GK_ROW + ((32 * dkt + 16 * (g & 1) + 4 * (i16 & 3)) << 1);
      const int va = (8 * hg + (i16 >> 2)) * GV_ROW + ((32 * dvt + 16 * (g & 1) + 4 * (i16 & 3)) << 1);
      f32x16 acc = {};
#pragma unroll
      for (int kk = 0; kk < 4; ++kk) { const s16x4 a0 = vtr(KK + ka + 16 * kk * GK_ROW), a1 = vtr(KK + ka + (16 * kk + 4) * GK_ROW), b0 = vtr(VV + va + 16 * kk * GV_ROW), b1 = vtr(VV + va + (16 * kk + 4) * GV_ROW);
          const bf16x8 af = {a0[0], a0[1], a0[2], a0[3], a1[0], a1[1], a1[2], a1[3]}, bfr = {b0[0], b0[1], b0[2], b0[3], b1[0], b1[1], b1[2], b1[3]};
          acc = __builtin_amdgcn_mfma_f32_32x32x16_bf16(af, bfr, acc, 0, 0, 0); }
      float* up = US + (size_t)unit * 8192 + 32 * dvt + r32;
#pragma unroll
      for (int r = 0; r < 16; ++r) up[(32 * dkt + crow(r, hi)) * 128] = acc[r]; }
    __syncthreads();
}
__device__ __forceinline__ void gla_g2_phase(Frame& F) {
    float* US = WS_PTR(float, WS_US); const float* DS = WS_PTR(float, WS_DS); float* outp = F.out + O_GLAP;
    for (int gid = F.bx * 512 + F.tid; gid < 8 * 8192; gid += F.G * 512) {
        const int bh = gid >> 13, e = gid & 8191, dk = e >> 7;
        float* up = US + (size_t)bh * 128 * 8192 + e; const float* dp = DS + (size_t)bh * 128 * 64 + dk; float S = 0.f;
        for (int n0 = 0; n0 < 128; n0 += 16) { float uu[16], dd[16];
#pragma unroll
            for (int i = 0; i < 16; ++i) { uu[i] = up[(size_t)(n0 + i) * 8192]; dd[i] = dp[(n0 + i) * 64]; }
#pragma unroll
            for (int i = 0; i < 16; ++i) { up[(size_t)(n0 + i) * 8192] = S; S = dd[i] * S + uu[i]; } }
        outp[gid] = S;
    }
}
__device__ __forceinline__ void gla_g3_unit(Frame& F, const Args& A, int unit) {
    const bf16* Z = WS_PTR(bf16, WS_Z); const float* US = WS_PTR(float, WS_US); bf16* OP = WS_PTR(bf16, WS_OP);
    int tid = threadIdx.x; asm volatile("" : "+v"(tid)); F.tid = tid; F.lane = tid & 63; F.wave = __builtin_amdgcn_readfirstlane(tid >> 6);
    const int bh = unit >> 7, n = unit & 127, b = bh >> 2, h = bh & 3, row0 = b * TP + n * 64;
    LAS float* red = (LAS float*)F.lds + 5632;
    LAS unsigned char* QI = F.lds + 24576; LAS unsigned char* KI = QI + 64 * GK_ROW; LAS unsigned char* SS = KI + 64 * GK_ROW; LAS unsigned char* VV = SS + 64 * GV_ROW;
    { const int t = tid >> 3, dk8 = (tid & 7) * 8, dv16 = (tid & 7) * 16; const bf16* zr = Z + (size_t)(row0 + t) * ZE;
      const float* bg = WS_PTR(float, WS_BCS) + (size_t)unit * 4096 + t * 64 + dk8; const f32x4 bq0 = *(const f32x4*)bg, bq1 = *(const f32x4*)(bg + 4);
      const v4u qw = *(const v4u*)(zr + h * 64 + dk8), kw = *(const v4u*)(zr + 256 + h * 64 + dk8), vw0 = *(const v4u*)(zr + 512 + h * 128 + dv16), vw1 = *(const v4u*)(zr + 512 + h * 128 + dv16 + 8);
      f32x4 sv[4];
#pragma unroll
      for (int j = 0; j < 4; ++j) sv[j] = *(const f32x4*)(US + (size_t)unit * 8192 + 4 * (tid + 512 * j));
      v4u qo, ko;
#pragma unroll
      for (int e = 0; e < 4; ++e) { const float b0 = e < 2 ? bq0[2 * e] : bq1[2 * e - 4], b1 = e < 2 ? bq0[2 * e + 1] : bq1[2 * e - 3];
          qo[e] = pk2(0.125f * bf2f((unsigned short)(qw[e] & 0xffffu)) * __expf(b0), 0.125f * bf2f((unsigned short)(qw[e] >> 16)) * __expf(b1));
          ko[e] = pk2(bf2f((unsigned short)(kw[e] & 0xffffu)) * __expf(-b0), bf2f((unsigned short)(kw[e] >> 16)) * __expf(-b1)); }
      *(LAS v4u*)(QI + t * GK_ROW + dk8 * 2) = qo; *(LAS v4u*)(KI + t * GK_ROW + dk8 * 2) = ko;
      *(LAS v4u*)(VV + t * GV_ROW + dv16 * 2) = vw0; *(LAS v4u*)(VV + t * GV_ROW + (dv16 + 8) * 2) = vw1;
#pragma unroll
      for (int j = 0; j < 4; ++j) { const int e4 = 4 * (tid + 512 * j), dk = e4 >> 7, dv = e4 & 127;
          v2u so; so.x = pk2(sv[j][0], sv[j][1]); so.y = pk2(sv[j][2], sv[j][3]); *(LAS v2u*)(SS + dk * GV_ROW + dv * 2) = so; } }
    __syncthreads();
    const int lane = F.lane, wid = F.wave, r32 = lane & 31, hi = lane >> 5, g = lane >> 4, i16 = lane & 15, hg = g >> 1, dvt = wid & 3, tt = wid >> 2;
    f32x16 o = {};
    { bf16x8 qf[4];
#pragma unroll
      for (int kk = 0; kk < 4; ++kk) qf[kk] = *(const LAS bf16x8*)(QI + (32 * tt + r32) * GK_ROW + (hi << 4) + 32 * kk);
      const int sa = (8 * hg + (i16 >> 2)) * GV_ROW + ((32 * dvt + 16 * (g & 1) + 4 * (i16 & 3)) << 1);
#pragma unroll
      for (int kk = 0; kk < 4; ++kk) { const s16x4 a0 = vtr(SS + sa + 16 * kk * GV_ROW), a1 = vtr(SS + sa + (16 * kk + 4) * GV_ROW);
          const bf16x8 af = {a0[0], a0[1], a0[2], a0[3], a1[0], a1[1], a1[2], a1[3]};
          o = __builtin_amdgcn_mfma_f32_32x32x16_bf16(af, qf[kk], o, 0, 0, 0); }
      const int va = (4 * hg + (i16 >> 2)) * GV_ROW + ((32 * dvt + 16 * (g & 1) + 4 * (i16 & 3)) << 1);
      for (int st = 0; st <= tt; ++st) { f32x16 at = {};
#pragma unroll
          for (int kk = 0; kk < 4; ++kk) { const bf16x8 kf = *(const LAS bf16x8*)(KI + (32 * st + r32) * GK_ROW + (hi << 4) + 32 * kk); at = __builtin_amdgcn_mfma_f32_32x32x16_bf16(kf, qf[kk], at, 0, 0, 0); }
          if (st == tt) {
#pragma unroll
              for (int r = 0; r < 16; ++r) if (crow(r, hi) > r32) at[r] = 0.f; }
#pragma unroll
          for (int s2 = 0; s2 < 2; ++s2) { const bf16x8 pb = pack8(at, 8 * s2);
              const s16x4 lo = vtr(VV + va + (32 * st + 16 * s2) * GV_ROW), hh = vtr(VV + va + (32 * st + 16 * s2 + 8) * GV_ROW);
              const bf16x8 vf = {lo[0], lo[1], lo[2], lo[3], hh[0], hh[1], hh[2], hh[3]};
              o = __builtin_amdgcn_mfma_f32_32x32x16_bf16(vf, pb, o, 0, 0, 0); } } }
    { float ss = 0.f;
#pragma unroll
      for (int r = 0; r < 16; ++r) ss += o[r] * o[r];
      ss = xhalf_sum(ss); if (hi == 0) red[dvt * 64 + 32 * tt + r32] = ss; }
    __syncthreads();
    { const int t = 32 * tt + r32; const float tot = (red[t] + red[64 + t]) + (red[128 + t] + red[192 + t]); const float rstd = 1.0f / sqrtf(tot * (1.0f / 128.0f) + 1e-6f);
      const int row = row0 + t;
#pragma unroll
      for (int rq = 0; rq < 4; ++rq) { const int dv0 = 32 * dvt + 8 * rq + 4 * hi; const f32x4 gn = *(const f32x4*)((const float*)A.in[19] + h * 128 + dv0);
          const v2u rw = *(const v2u*)(Z + (size_t)row * ZE + 1024 + h * 128 + dv0);
          const float r0 = bf2f((unsigned short)(rw.x & 0xffffu)), r1 = bf2f((unsigned short)(rw.x >> 16)), r2 = bf2f((unsigned short)(rw.y & 0xffffu)), r3 = bf2f((unsigned short)(rw.y >> 16));
          v2u ow; ow.x = pk2(o[4 * rq] * rstd * gn[0] * siluf_(r0), o[4 * rq + 1] * rstd * gn[1] * siluf_(r1)); ow.y = pk2(o[4 * rq + 2] * rstd * gn[2] * siluf_(r2), o[4 * rq + 3] * rstd * gn[3] * siluf_(r3));
          *(GAS v2u*)(OP + (size_t)row * DM + h * 128 + dv0) = ow; } }
    __syncthreads();
}
__device__ __forceinline__ void gla_sample_unit(Frame& F, const Args& A, int unit) {
    const bf16* Z = WS_PTR(bf16, WS_Z); bf16* OP = WS_PTR(bf16, WS_OP);
    const float* gate_w2 = (const float*)A.in[17]; const float* gate_b = (const float*)A.in[18]; const float* S0g = (const float*)A.in[2] + (size_t)unit * 8192; float* Sout = F.out + O_GLAS + (size_t)unit * 8192;
    int tid = threadIdx.x; asm volatile("" : "+v"(tid)); F.tid = tid; F.lane = tid & 63; F.wave = __builtin_amdgcn_readfirstlane(tid >> 6);
    const int b = unit >> 2, h = unit & 3, row0 = MP + 4 * b;
    LAS float* S0 = (LAS float*)F.lds; LAS float* bc = S0 + 8192; LAS float* qi = bc + 256; LAS float* ki = qi + 256; LAS float* kk = ki + 256; LAS float* vv = kk + 256; LAS float* att = vv + 512; LAS float* gl = att + 16; LAS float* red = gl + 64;
#pragma unroll
    for (int j = 0; j < 4; ++j) *(LAS f32x4*)(S0 + 4 * (tid + 512 * j)) = *(const f32x4*)(S0g + 4 * (tid + 512 * j));
    if (tid < 64) gl[tid] = bf2f(Z[(size_t)(row0 + (tid >> 4)) * ZE + 2048 + (tid & 15)]);
    vv[tid] = bf2f(Z[(size_t)(row0 + (tid >> 7)) * ZE + 512 + h * 128 + (tid & 127)]);
    __syncthreads();
    if (tid < 256) { const int t = tid >> 6, dk = tid & 63; float x = gate_b[h * 64 + dk];
#pragma unroll
        for (int j = 0; j < 16; ++j) x += gl[t * 16 + j] * gate_w2[j * 256 + h * 64 + dk];
        bc[t * 64 + dk] = logsig16(x); }
    __syncthreads();
    if (tid < 64) { float run = 0.f;
#pragma unroll
        for (int t = 0; t < 4; ++t) { run += bc[t * 64 + tid]; bc[t * 64 + tid] = run; } }
    __syncthreads();
    if (tid < 256) { const int t = tid >> 6, dk = tid & 63; const float bb = bc[t * 64 + dk], bl = bc[3 * 64 + dk];
        const float qv = bf2f(Z[(size_t)(row0 + t) * ZE + h * 64 + dk]), kv = bf2f(Z[(size_t)(row0 + t) * ZE + 256 + h * 64 + dk]);
        qi[t * 64 + dk] = 0.125f * qv * __expf(bb); ki[t * 64 + dk] = kv * __expf(-bb); kk[t * 64 + dk] = kv * __expf(bl - bb); }
    __syncthreads();
    if (tid < 16) { const int t = tid >> 2, s = tid & 3; float a = 0.f;
        for (int dk = 0; dk < 64; ++dk) a += qi[t * 64 + dk] * ki[s * 64 + dk];
        att[tid] = (s <= t) ? a : 0.f; }
    __syncthreads();
    { const int t = tid >> 7, dv = tid & 127; float o = 0.f;
#pragma unroll 8
      for (int dk = 0; dk < 64; ++dk) o += qi[t * 64 + dk] * S0[dk * 128 + dv];
#pragma unroll
      for (int s = 0; s < 4; ++s) o += att[t * 4 + s] * vv[s * 128 + dv];
      const float ss = wave_sum(o * o); if (F.lane == 0) red[F.wave] = ss;
      __syncthreads();
      const float tot = red[2 * t] + red[2 * t + 1]; const float rstd = 1.0f / sqrtf(tot * (1.0f / 128.0f) + 1e-6f);
      const float gn = ((const float*)A.in[19])[h * 128 + dv]; const float rr = bf2f(Z[(size_t)(row0 + t) * ZE + 1024 + h * 128 + dv]);
      OP[(size_t)(row0 + t) * DM + h * 128 + dv] = (bf16)f2bf(o * rstd * gn * siluf_(rr)); }
#pragma unroll
    for (int j = 0; j < 4; ++j) { const int e = 4 * (tid + 512 * j), dk = e >> 7, dv = e & 127; const float dec = __expf(bc[3 * 64 + dk]);
        f32x4 sn = *(const LAS f32x4*)(S0 + e) * dec;
#pragma unroll
        for (int s = 0; s < 4; ++s) sn += kk[s * 64 + dk] * *(const LAS f32x4*)(vv + s * 128 + dv);
        *(f32x4*)(Sout + e) = sn; }
    __syncthreads();
}
__device__ __forceinline__ void pool_prompt_unit(Frame& F, int unit) {
    const bf16* Z = WS_PTR(bf16, WS_Z); bf16* OP = WS_PTR(bf16, WS_OP); float* hp = F.out + O_POOLP;
    int c = threadIdx.x; asm volatile("" : "+v"(c));
    const int b = unit >> 7, t0 = (unit & 127) * 64, w = 2 << (c >> 7); const size_t rb = (size_t)b * TP;
    float s = 0.f;
    { float pv[16];
#pragma unroll
      for (int j = 0; j < 16; ++j) { const int t = t0 - 1 - j; pv[j] = (j < w && t >= 0) ? bf2f(Z[(rb + t) * ZE + 1536 + c]) : 0.f; }
#pragma unroll
      for (int j = 0; j < 16; ++j) s += pv[j]; }
#pragma unroll 1
    for (int tb = t0; tb < t0 + 64; tb += 16) { float uv[16], ov[16];
#pragma unroll
        for (int j = 0; j < 16; ++j) { const int t = tb + j; uv[j] = bf2f(Z[(rb + t) * ZE + 1536 + c]); ov[j] = (t - w >= 0) ? bf2f(Z[(rb + t - w) * ZE + 1536 + c]) : 0.f; }
#pragma unroll
        for (int j = 0; j < 16; ++j) { const int t = tb + j; s += uv[j]; s -= ov[j];
            const float cnt = (float)((t + 1 < w) ? t + 1 : w);
            OP[(rb + t) * DM + 512 + c] = (bf16)f2bf(s / cnt - uv[j]);
            if (t >= TP - 15) hp[((size_t)b * 15 + (t - (TP - 15))) * 512 + c] = uv[j]; } }
}
__device__ __forceinline__ void pool_sample_unit(Frame& F, const Args& A, int b) {
    const bf16* Z = WS_PTR(bf16, WS_Z); bf16* OP = WS_PTR(bf16, WS_OP); float* hs = F.out + O_POOLS + (size_t)b * 15 * 512; const float* hin = (const float*)A.in[3] + (size_t)b * 15 * 512;
    int c = threadIdx.x; asm volatile("" : "+v"(c));
    const int w = 2 << (c >> 7); float full[19];
#pragma unroll
    for (int i = 0; i < 15; ++i) full[i] = hin[i * 512 + c];
#pragma unroll
    for (int t = 0; t < 4; ++t) full[15 + t] = bf2f(Z[(size_t)(MP + 4 * b + t) * ZE + 1536 + c]);
#pragma unroll
    for (int t = 0; t < 4; ++t) { float s = 0.f;
#pragma unroll
        for (int j = 0; j < 16; ++j) if (j < w) s += full[15 + t - j];
        OP[(size_t)(MP + 4 * b + t) * DM + 512 + c] = (bf16)f2bf(s / (float)w - full[15 + t]); }
#pragma unroll
    for (int i = 0; i < 15; ++i) hs[i * 512 + c] = full[4 + i];
}
__device__ __forceinline__ void even_mid_phase(Frame& F, const Args& A) {
    constexpr int N1 = 1024, N2 = 512, N3 = 256, N4 = 128;
    for (int u = F.bx; u < N1 + N2 + N3 + N4; u += F.G) {
        if (u < N1) gla_g1_unit(F, A, u);
        else if (u < N1 + N2) gla_sample_unit(F, A, u - N1);
        else if (u < N1 + N2 + N3) pool_prompt_unit(F, u - N1 - N2);
        else pool_sample_unit(F, A, u - N1 - N2 - N3);
    }
}
__device__ __forceinline__ void odd_rows(Frame& F, const Args& A) {
    const bf16* Z = WS_PTR(bf16, WS_Z); bf16* CQN = WS_PTR(bf16, WS_CQN); bf16* CKVB = WS_PTR(bf16, WS_CKVB); bf16* KRB = WS_PTR(bf16, WS_KRB); const float* rt = WS_PTR(float, WS_RT);
    const float* q_norm = (const float*)A.in[24]; const float* kv_norm = (const float*)A.in[26];
    const int gw = F.bx * NWAVES + F.wave, NGW = F.G * NWAVES, lane = F.lane;
    for (int row = gw; row < MT; row += NGW) {
        const bf16* zr = Z + (size_t)row * ZO;
        { float v[6]; float ss = 0.f;
#pragma unroll
          for (int j = 0; j < 3; ++j) { const unsigned w = *(const unsigned*)(zr + 2 * lane + 128 * j); v[2 * j] = bf2f((unsigned short)(w & 0xffffu)); v[2 * j + 1] = bf2f((unsigned short)(w >> 16)); ss += v[2 * j] * v[2 * j] + v[2 * j + 1] * v[2 * j + 1]; }
          const float rstd = 1.0f / sqrtf(wave_sum(ss) * (1.0f / 384.0f) + 1e-6f);
#pragma unroll
          for (int j = 0; j < 3; ++j) { const int c = 2 * lane + 128 * j; *(GAS unsigned*)(CQN + (size_t)row * 384 + c) = pk2(v[2 * j] * rstd * q_norm[c], v[2 * j + 1] * rstd * q_norm[c + 1]); } }
        { const v2u w = *(const v2u*)(zr + 384 + 4 * lane); f32x4 v = {bf2f((unsigned short)(w.x & 0xffffu)), bf2f((unsigned short)(w.x >> 16)), bf2f((unsigned short)(w.y & 0xffffu)), bf2f((unsigned short)(w.y >> 16))};
          const float ss = wave_sum((v[0] * v[0] + v[1] * v[1]) + (v[2] * v[2] + v[3] * v[3])); const float rstd = 1.0f / sqrtf(ss * (1.0f / 256.0f) + 1e-6f);
          const f32x4 o = (v * rstd) * *(const f32x4*)(kv_norm + 4 * lane);
          *(f32x4*)(F.out + O_CKV + (size_t)row * 256 + 4 * lane) = o;
          v2u ob; ob.x = pk2(o[0], o[1]); ob.y = pk2(o[2], o[3]); *(GAS v2u*)(CKVB + (size_t)row * 256 + 4 * lane) = ob; }
        if (lane < 16) { const float x1 = bf2f(zr[640 + lane]), x2 = bf2f(zr[640 + 16 + lane]); const f32x2 cs = *(const f32x2*)(rt + (size_t)posof(row) * 32 + 2 * lane);
          const float o1 = x1 * cs[0] - x2 * cs[1], o2 = x2 * cs[0] + x1 * cs[1];
          F.out[O_KR + (size_t)row * 32 + lane] = o1; F.out[O_KR + (size_t)row * 32 + 16 + lane] = o2;
          KRB[(size_t)row * 32 + lane] = (bf16)f2bf(o1); KRB[(size_t)row * 32 + 16 + lane] = (bf16)f2bf(o2); }
    }
}
template <bool SAMPLE> __device__ __forceinline__ void conv_unit(Frame& F, const Args& A, int unit) {
    constexpr int NTOK = SAMPLE ? 4 : 32, NR = NTOK + 30;
    const bf16* Z = WS_PTR(bf16, WS_Z); bf16* OP = WS_PTR(bf16, WS_OP);
    const float* conv_w = (const float*)A.in[29]; const float* conv_b = (const float*)A.in[30]; const float* ng = (const float*)A.in[31]; const float* nb = (const float*)A.in[32];
    int c = threadIdx.x; asm volatile("" : "+v"(c)); const int lane = c & 63, wave = __builtin_amdgcn_readfirstlane(c >> 6);
    LAS float* cvl = (LAS float*)F.lds;
    LAS float* stat = cvl + 32 * 512;
    const int b = SAMPLE ? unit : (unit >> 8), t0 = SAMPLE ? 0 : (unit & 255) * 32; const size_t rb = SAMPLE ? (size_t)(MP + 4 * b) : (size_t)b * TP;
    float u[NR];
    { bf16 av[NR], gv[NR];
#pragma unroll
      for (int rr = 0; rr < NR; ++rr) { const int t = t0 - 30 + rr; av[rr] = 0; gv[rr] = 0; u[rr] = 0.f;
          if (t >= 0) { const bf16* zr = Z + (rb + t) * ZO; av[rr] = zr[672 + c]; gv[rr] = zr[1184 + c]; }
          else if (SAMPLE) u[rr] = ((const float*)A.in[6])[((size_t)b * 30 + rr) * 512 + c]; }
#pragma unroll
      for (int rr = 0; rr < NR; ++rr) { const int t = t0 - 30 + rr; if (t >= 0) u[rr] = bf2f(av[rr]) * sigmoidf_(bf2f(gv[rr])); } }
    if (SAMPLE) { float* cs = F.out + O_CONVS + (size_t)b * 30 * 512;
#pragma unroll
        for (int i = 0; i < 30; ++i) cs[i * 512 + c] = u[4 + i]; }
    else if (t0 == TP - 32) { float* cp = F.out + O_CONVP + (size_t)b * 30 * 512;
#pragma unroll
        for (int i = 0; i < 30; ++i) cp[i * 512 + c] = u[32 + i]; }
    float cv[NTOK];
    { const float bias = conv_b[c];
#pragma unroll
      for (int tt = 0; tt < NTOK; ++tt) cv[tt] = bias;
#pragma unroll
      for (int j = 0; j < 31; ++j) { const float w = conv_w[j * 512 + c];
#pragma unroll
          for (int tt = 0; tt < NTOK; ++tt) cv[tt] += w * u[tt + j]; } }
#pragma unroll
    for (int tt = 0; tt < NTOK; ++tt) cvl[tt * 512 + c] = cv[tt];
    __syncthreads();
    for (int tt = wave; tt < NTOK; tt += NWAVES) { float s1 = 0.f, s2 = 0.f;
#pragma unroll
        for (int j = 0; j < 8; ++j) { const float x = cvl[tt * 512 + lane + 64 * j]; s1 += x; s2 += x * x; }
        s1 = wave_sum(s1); s2 = wave_sum(s2); const float mean = s1 * (1.0f / 512.0f); const float var = fmaxf(s2 * (1.0f / 512.0f) - mean * mean, 0.f);
        if (lane == 0) { stat[2 * tt] = mean; stat[2 * tt + 1] = 1.0f / sqrtf(var + 1e-6f); } }
    __syncthreads();
    const float gg = ng[c], bb = nb[c];
#pragma unroll
    for (int tt = 0; tt < NTOK; ++tt) { const float y = (cv[tt] - stat[2 * tt]) * stat[2 * tt + 1] * gg + bb;
        OP[(rb + t0 + tt) * DM + 512 + c] = (bf16)f2bf(siluf_(y)); }
    __syncthreads();
}
__device__ __forceinline__ void odd_thin_phase(Frame& F, const Args& A) {
    odd_rows(F, A);
    for (int u = F.bx; u < 512 + 128; u += F.G) { if (u < 512) conv_unit<false>(F, A, u); else conv_unit<true>(F, A, u - 512); }
}
constexpr int PA_KROW = 208, PA_VROW = 144, PA_VOFF = 64 * PA_KROW, PA_BUF = PA_VOFF + 64 * PA_VROW;
__device__ __forceinline__ void pattn_unit(Frame& F, int b, int h, int qb) {
    const bf16* Q = WS_PTR(bf16, WS_Q); const bf16* KV = WS_PTR(bf16, WS_KV); const bf16* KRB = WS_PTR(bf16, WS_KRB); bf16* OP = WS_PTR(bf16, WS_OP);
    int tid = threadIdx.x; asm volatile("" : "+v"(tid));
    const int lane = tid & 63, wid = __builtin_amdgcn_readfirstlane(tid >> 6), r32 = lane & 31, hi = lane >> 5;
    const size_t rb = (size_t)b * TP; const int q0w = 256 * qb + 32 * wid, NT = 4 * (qb + 1);
    LAS unsigned char* L = F.lds;
    const int skey = tid >> 3, sc = tid & 7, rkey = tid >> 2, rc = tid & 3;
    const bf16* gk = KV + (rb + skey) * 1024 + h * 64 + 8 * sc; const bf16* gv = gk + 512; const bf16* gr = KRB + (rb + rkey) * 32 + 8 * rc;
    const int lk = skey * PA_KROW + (sc << 4), lv = PA_VOFF + skey * PA_VROW + (sc << 4), lr = rkey * PA_KROW + ((8 + rc) << 4);
    v4u sk, sv, sr = {0u, 0u, 0u, 0u};
#define PA_LOAD(kt) do { sk = *(const v4u*)(gk + (size_t)(kt) * 64 * 1024); sv = *(const v4u*)(gv + (size_t)(kt) * 64 * 1024); if (tid < 256) sr = *(const v4u*)(gr + (size_t)(kt) * 64 * 32); } while (0)
#define PA_STORE(bufo) do { *(LAS v4u*)(L + (bufo) + lk) = sk; *(LAS v4u*)(L + (bufo) + lv) = sv; if (tid < 256) *(LAS v4u*)(L + (bufo) + lr) = sr; } while (0)
    PA_LOAD(0);
    bf16x8 qf[6];
    { const bf16* qp = Q + (rb + q0w + r32) * 768 + h * 96 + 8 * hi;
#pragma unroll
      for (int kk = 0; kk < 6; ++kk) qf[kk] = *(const bf16x8*)(qp + 16 * kk); }
    f32x16 o0 = {}, o1 = {}; float mrun = -1e30f, lrun = 0.f;
    PA_STORE(0);
    LBAR();
    const int aoffk = r32 * PA_KROW + (hi << 4);
    const int g = lane >> 4, i16 = lane & 15, hg = g >> 1;
    const int voff = PA_VOFF + (4 * hg + (i16 >> 2)) * PA_VROW + ((16 * (g & 1) + 4 * (i16 & 3)) << 1);
    for (int kt = 0; kt < NT; ++kt) {
        const int bufo = (kt & 1) * PA_BUF;
        if (kt + 1 < NT) PA_LOAD(kt + 1);
        if (64 * kt <= q0w + 31) {
            f32x16 p0 = {}, p1 = {};
            { bf16x8 ka[12];
#pragma unroll
              for (int kk = 0; kk < 6; ++kk) { ka[2 * kk] = *(const LAS bf16x8*)(L + bufo + aoffk + 32 * kk); ka[2 * kk + 1] = *(const LAS bf16x8*)(L + bufo + aoffk + 32 * PA_KROW + 32 * kk); }
#pragma unroll
              for (int kk = 0; kk < 6; ++kk) { p0 = __builtin_amdgcn_mfma_f32_32x32x16_bf16(ka[2 * kk], qf[kk], p0, 0, 0, 0); p1 = __builtin_amdgcn_mfma_f32_32x32x16_bf16(ka[2 * kk + 1], qf[kk], p1, 0, 0, 0); } }
            s16x4 vlo[8], vhi[8];
#pragma unroll
            for (int hf = 0; hf < 2; ++hf)
#pragma unroll
                for (int s = 0; s < 2; ++s)
#pragma unroll
                    for (int dt = 0; dt < 2; ++dt) { const int a0 = bufo + voff + (32 * hf + 16 * s) * PA_VROW + 64 * dt; vlo[(hf * 2 + s) * 2 + dt] = vtr(L + a0); vhi[(hf * 2 + s) * 2 + dt] = vtr(L + a0 + 8 * PA_VROW); }
            if (64 * kt + 63 > q0w) { const int qq = q0w + r32;
#pragma unroll
                for (int r = 0; r < 16; ++r) { const int key = 64 * kt + crow(r, hi); if (key > qq) p0[r] = -INFINITY; if (key + 32 > qq) p1[r] = -INFINITY; } }
            float mt = fmaxf(p0[0], p1[0]);
#pragma unroll
            for (int r = 1; r < 16; ++r) mt = fmaxf(mt, fmaxf(p0[r], p1[r]));
            mt = xhalf_max(mt);
            const float mnew = fmaxf(mrun, mt), alpha = __builtin_amdgcn_exp2f(mrun - mnew); mrun = mnew;
            float rs = 0.f;
#pragma unroll
            for (int r = 0; r < 16; ++r) { p0[r] = __builtin_amdgcn_exp2f(p0[r] - mnew); p1[r] = __builtin_amdgcn_exp2f(p1[r] - mnew); rs += p0[r] + p1[r]; }
            rs = xhalf_sum(rs); lrun = lrun * alpha + rs;
#pragma unroll
            for (int r = 0; r < 16; ++r) { o0[r] *= alpha; o1[r] *= alpha; }
#pragma unroll
            for (int hf = 0; hf < 2; ++hf)
#pragma unroll
                for (int s = 0; s < 2; ++s) { const bf16x8 pb = pack8(hf ? p1 : p0, 8 * s);
#pragma unroll
                    for (int dt = 0; dt < 2; ++dt) { const s16x4 lo = vlo[(hf * 2 + s) * 2 + dt], hh = vhi[(hf * 2 + s) * 2 + dt];
                        const bf16x8 va = {lo[0], lo[1], lo[2], lo[3], hh[0], hh[1], hh[2], hh[3]};
                        if (dt == 0) o0 = __builtin_amdgcn_mfma_f32_32x32x16_bf16(va, pb, o0, 0, 0, 0); else o1 = __builtin_amdgcn_mfma_f32_32x32x16_bf16(va, pb, o1, 0, 0, 0); } }
        }
        if (kt + 1 < NT) PA_STORE(((kt + 1) & 1) * PA_BUF);
        LBAR();
    }
#undef PA_LOAD
#undef PA_STORE
    const float rl = 1.0f / lrun;
    bf16* op = OP + (rb + q0w + r32) * DM + h * 64;
#pragma unroll
    for (int dt = 0; dt < 2; ++dt)
#pragma unroll
        for (int rq = 0; rq < 4; ++rq) { const f32x16& o = dt ? o1 : o0; v2u w; w.x = pk2(o[4 * rq] * rl, o[4 * rq + 1] * rl); w.y = pk2(o[4 * rq + 2] * rl, o[4 * rq + 3] * rl);
            *(GAS v2u*)(op + 32 * dt + 8 * rq + 4 * hi) = w; }
}

constexpr int DT_ROW = 592, DT_TILE = 64 * DT_ROW, DT_QOFF = 2 * DT_TILE, DT_QN = DT_QOFF + 32 * DT_ROW, DT_ML = 133120;
__device__ __forceinline__ void dattn_unit(Frame& F, const Args& A, int unit) {
    const bf16* Q = WS_PTR(bf16, WS_Q); float* PART = WS_PTR(float, WS_PART) + (size_t)unit * PART_F; float* QD = WS_PTR(float, WS_QD);
    const float* cckv = (const float*)A.in[4]; const float* ckr = (const float*)A.in[5]; const int* ptab = (const int*)A.in[7]; const float* w_uk = (const float*)A.in[27];
    int tid = threadIdx.x; asm volatile("" : "+v"(tid));
    const int lane = tid & 63, wid = __builtin_amdgcn_readfirstlane(tid >> 6), r32 = lane & 31, hi = lane >> 5, b = unit / NSPLIT, sp = unit % NSPLIT;
    LAS unsigned char* L = F.lds; LAS float* qn = (LAS float*)(L + DT_QN); LAS float* ml = (LAS float*)(L + DT_ML);
    const f32x4* dummy = (const f32x4*)WS_PTR(float, WS_DUMMY);
    LAS int* pidl = (LAS int*)(L + DT_ML + 2048);
    constexpr int NPG = 64 / NSPLIT, NTL = 2 * NPG;
    if (tid < NPG) pidl[tid] = ptab[b * 64 + sp * NPG + tid];
    __syncthreads();
    f32x4 st0[9], st1[9];
    const int wofs = (tid >> 6) * DT_ROW + (tid & 63) * 8, wofr = (tid >> 3) * DT_ROW + 512 + (tid & 7) * 8;
#define DT_LOAD(tl, st) do { const int t_ = (tl); const bool real_ = t_ < NTL; const int pid = pidl[real_ ? (t_ >> 1) : 0]; \
        const f32x4* pc = real_ ? (const f32x4*)(cckv + ((size_t)pid * 128 + (t_ & 1) * 64) * 256) : dummy; const f32x4* pr = real_ ? (const f32x4*)(ckr + ((size_t)pid * 128 + (t_ & 1) * 64) * 32) : dummy; \
        _Pragma("unroll") for (int i = 0; i < 8; ++i) st[i] = __builtin_nontemporal_load(pc + tid + 512 * i); \
        st[8] = __builtin_nontemporal_load(pr + tid); } while (0)
#define DT_STORE(bufo, st) do { _Pragma("unroll") for (int i = 0; i < 8; ++i) { v2u w_; w_.x = pg8::cvt_pk_bf16(st[i][0], st[i][1]); w_.y = pg8::cvt_pk_bf16(st[i][2], st[i][3]); *(LAS v2u*)(L + (bufo) + wofs + i * 8 * DT_ROW) = w_; } \
        { v2u w_; w_.x = pg8::cvt_pk_bf16(st[8][0], st[8][1]); w_.y = pg8::cvt_pk_bf16(st[8][2], st[8][3]); *(LAS v2u*)(L + (bufo) + wofr) = w_; } } while (0)
    DT_LOAD(0, st0); DT_LOAD(1, st1);
    { const int t = tid >> 7, c6 = (tid & 127) * 6;
      const bf16* qp = Q + (size_t)(MP + 4 * b + t) * 768 + c6;
#pragma unroll
      for (int e = 0; e < 6; ++e) { const int c = c6 + e, hh = c / 96, d = c % 96; const bf16 v = qp[e];
          if (d < 64) qn[(t * 8 + hh) * 64 + d] = bf2f(v);
          else { const int q = t * 8 + hh, col = 256 + (d - 64); *(LAS bf16*)(L + DT_QOFF + q * DT_ROW + col * 2) = v;
                 if (sp == 0) QD[((size_t)b * 32 + q) * 288 + col] = bf2f(v); } } }
    __syncthreads();
    { const int hh = tid >> 6, rr = tid & 63;
#pragma unroll 1
      for (int j = 0; j < 4; ++j) { const int r = rr + 64 * j; const f32x4* wp = (const f32x4*)(w_uk + ((size_t)r * 8 + hh) * 64); float a0 = 0.f, a1 = 0.f, a2 = 0.f, a3 = 0.f;
#pragma unroll 4
          for (int d4 = 0; d4 < 16; ++d4) { const f32x4 w = wp[d4];
              const f32x4 x0 = *(const LAS f32x4*)(qn + (0 * 8 + hh) * 64 + 4 * d4), x1 = *(const LAS f32x4*)(qn + (1 * 8 + hh) * 64 + 4 * d4), x2 = *(const LAS f32x4*)(qn + (2 * 8 + hh) * 64 + 4 * d4), x3 = *(const LAS f32x4*)(qn + (3 * 8 + hh) * 64 + 4 * d4);
              a0 += (w[0] * x0[0] + w[1] * x0[1]) + (w[2] * x0[2] + w[3] * x0[3]); a1 += (w[0] * x1[0] + w[1] * x1[1]) + (w[2] * x1[2] + w[3] * x1[3]);
              a2 += (w[0] * x2[0] + w[1] * x2[1]) + (w[2] * x2[2] + w[3] * x2[3]); a3 += (w[0] * x3[0] + w[1] * x3[1]) + (w[2] * x3[2] + w[3] * x3[3]); }
          const float av[4] = {a0, a1, a2, a3};
#pragma unroll
          for (int t = 0; t < 4; ++t) { const int q = t * 8 + hh; *(LAS bf16*)(L + DT_QOFF + q * DT_ROW + r * 2) = (bf16)f2bf(av[t]);
              if (sp == 0) QD[((size_t)b * 32 + q) * 288 + r] = av[t]; } } }
    DT_STORE(0, st0);
    LBAR();
    DT_LOAD(2, st0);
    bf16x8 qf[18];
#pragma unroll
    for (int kk = 0; kk < 18; ++kk) qf[kk] = *(const LAS bf16x8*)(L + DT_QOFF + (lane & 31) * DT_ROW + ((lane >> 5) << 4) + 32 * kk);
    const int kh = wid & 1, dq = wid >> 1, g = lane >> 4, i16 = lane & 15, hg = g >> 1;
    f32x16 o0 = {}, o1 = {}; float mrun = -1e30f, lrun = 0.f;
    const int arow = (32 * kh + r32) * DT_ROW + (hi << 4);
    const int voff = (32 * kh + 4 * hg + (i16 >> 2)) * DT_ROW + ((64 * dq + 16 * (g & 1) + 4 * (i16 & 3)) << 1);
#define DT_ITER(tl, bufo, bufn, stn, DOSTORE, DOLOAD) do { \
        f32x16 p = {}; \
_Pragma("unroll") \
        for (int g6 = 0; g6 < 3; ++g6) { bf16x8 ka[6]; \
_Pragma("unroll") \
            for (int j = 0; j < 6; ++j) ka[j] = *(const LAS bf16x8*)(L + bufo + arow + 32 * (6 * g6 + j)); \
_Pragma("unroll") \
            for (int j = 0; j < 6; ++j) p = __builtin_amdgcn_mfma_f32_32x32x16_bf16(ka[j], qf[6 * g6 + j], p, 0, 0, 0); } \
        s16x4 vlo[4], vhi[4]; \
_Pragma("unroll") \
        for (int s = 0; s < 2; ++s) \
_Pragma("unroll") \
            for (int dt = 0; dt < 2; ++dt) { const int a0 = bufo + voff + 16 * s * DT_ROW + 64 * dt; vlo[2 * s + dt] = vtr(L + a0); vhi[2 * s + dt] = vtr(L + a0 + 8 * DT_ROW); } \
        float mt = p[0]; \
_Pragma("unroll") \
        for (int r = 1; r < 16; ++r) mt = fmaxf(mt, p[r]); \
        mt = xhalf_max(mt); \
        const float mnew = fmaxf(mrun, mt), alpha = __builtin_amdgcn_exp2f(mrun - mnew); mrun = mnew; \
        float rs = 0.f; \
_Pragma("unroll") \
        for (int r = 0; r < 16; ++r) { p[r] = __builtin_amdgcn_exp2f(p[r] - mnew); rs += p[r]; } \
        rs = xhalf_sum(rs); lrun = lrun * alpha + rs; \
_Pragma("unroll") \
        for (int r = 0; r < 16; ++r) { o0[r] *= alpha; o1[r] *= alpha; } \
_Pragma("unroll") \
        for (int s = 0; s < 2; ++s) { const bf16x8 pb = pack8(p, 8 * s); \
_Pragma("unroll") \
            for (int dt = 0; dt < 2; ++dt) { const s16x4 lo = vlo[2 * s + dt], hh = vhi[2 * s + dt]; \
                const bf16x8 va = {lo[0], lo[1], lo[2], lo[3], hh[0], hh[1], hh[2], hh[3]}; \
                if (dt == 0) o0 = __builtin_amdgcn_mfma_f32_32x32x16_bf16(va, pb, o0, 0, 0, 0); else o1 = __builtin_amdgcn_mfma_f32_32x32x16_bf16(va, pb, o1, 0, 0, 0); } } \
        if (DOSTORE) DT_STORE(bufn, stn); \
        LBAR(); \
        if (DOLOAD) DT_LOAD((tl) + 3, stn); } while (0)
    for (int tl = 0; tl < NTL; tl += 2) { DT_ITER(tl, 0, DT_TILE, st1, (tl) + 1 < NTL, true); DT_ITER(tl + 1, DT_TILE, 0, st0, (tl) + 2 < NTL, true); }
#undef DT_ITER
#undef DT_LOAD
#undef DT_STORE
    { LAS float* ow = (LAS float*)L + (size_t)wid * 2048;
#pragma unroll
      for (int dt = 0; dt < 2; ++dt)
#pragma unroll
          for (int r = 0; r < 16; ++r) ow[(32 * dt + crow(r, hi)) * 32 + r32] = dt ? o1[r] : o0[r];
      if (hi == 0) { ml[wid * 64 + r32] = mrun; ml[wid * 64 + 32 + r32] = lrun; } }
    __syncthreads();
    { const int q = tid & 31, dvg = tid >> 5, dqq = dvg >> 2;
      const float m0 = ml[(2 * dqq) * 64 + q], m1 = ml[(2 * dqq + 1) * 64 + q], ms = fmaxf(m0, m1);
      const float w0 = __builtin_amdgcn_exp2f(m0 - ms), w1 = __builtin_amdgcn_exp2f(m1 - ms);
      const float ls = w0 * ml[(2 * dqq) * 64 + 32 + q] + w1 * ml[(2 * dqq + 1) * 64 + 32 + q];
#pragma unroll
      for (int j = 0; j < 16; ++j) { const int dv = dvg * 16 + j, dvl = dv & 63;
          PART[dv * 32 + q] = w0 * ((LAS float*)L)[(size_t)(2 * dqq) * 2048 + dvl * 32 + q] + w1 * ((LAS float*)L)[(size_t)(2 * dqq + 1) * 2048 + dvl * 32 + q]; }
      if (dvg == 0) { PART[8192 + q] = ms; PART[8192 + 32 + q] = ls; } }
    __syncthreads();
}
__device__ __forceinline__ void dcombine_unit(Frame& F, const Args& A, int b) {
    const float* PART = WS_PTR(float, WS_PART) + (size_t)b * NSPLIT * PART_F; const float* QD = WS_PTR(float, WS_QD) + (size_t)b * 32 * 288; bf16* OP = WS_PTR(bf16, WS_OP);
    const float* ckv = F.out + O_CKV + (size_t)(MP + 4 * b) * 256; const float* kr = F.out + O_KR + (size_t)(MP + 4 * b) * 32; const float* w_uv = (const float*)A.in[28];
    int tid = threadIdx.x; asm volatile("" : "+v"(tid));
    LAS float* lat = (LAS float*)F.lds; LAS float* sn = lat + 8192; LAS float* ck = sn + 128; LAS float* qd = ck + 1152;
    for (int i = tid; i < 1024; i += 512) ck[(i >> 8) * 288 + (i & 255)] = ckv[i];
    if (tid < 128) ck[(tid >> 5) * 288 + 256 + (tid & 31)] = kr[tid];
    for (int i = tid; i < 32 * 288; i += 512) qd[(i / 288) * 289 + (i % 288)] = QD[i];
    __syncthreads();
    { const int q = tid >> 4, part = tid & 15; float a[4] = {0.f, 0.f, 0.f, 0.f};
#pragma unroll
      for (int i = 0; i < 18; ++i) { const int r = part * 18 + i; const float x = qd[q * 289 + r];
#pragma unroll
          for (int s = 0; s < 4; ++s) a[s] += x * ck[s * 288 + r]; }
#pragma unroll
      for (int s = 0; s < 4; ++s) { float v = a[s]; v += __shfl_xor(v, 1); v += __shfl_xor(v, 2); v += __shfl_xor(v, 4); v += __shfl_xor(v, 8); a[s] = v; }
      if (part < 4) sn[q * 4 + part] = (part <= (q >> 3)) ? a[part] : -INFINITY; }
    __syncthreads();
    { const int q = tid & 31, dvg = tid >> 5; float mk[NSPLIT], ms = -1e30f;
#pragma unroll
      for (int s = 0; s < NSPLIT; ++s) { mk[s] = PART[(size_t)s * PART_F + 8192 + q]; ms = fmaxf(ms, mk[s]); }
      float pn[4];
#pragma unroll
      for (int s = 0; s < 4; ++s) { pn[s] = sn[q * 4 + s]; ms = fmaxf(ms, pn[s]); }
      float wg[NSPLIT], ls = 0.f;
#pragma unroll
      for (int s = 0; s < NSPLIT; ++s) { wg[s] = __builtin_amdgcn_exp2f(mk[s] - ms); ls += wg[s] * PART[(size_t)s * PART_F + 8192 + 32 + q]; }
#pragma unroll
      for (int s = 0; s < 4; ++s) { pn[s] = __builtin_amdgcn_exp2f(pn[s] - ms); ls += pn[s]; }
      const float rl = 1.0f / ls;
#pragma unroll 1
      for (int j0 = 0; j0 < 16; j0 += 4) { float pv[4][NSPLIT];
#pragma unroll
          for (int j = 0; j < 4; ++j)
#pragma unroll
              for (int s = 0; s < NSPLIT; ++s) pv[j][s] = PART[(size_t)s * PART_F + (dvg * 16 + j0 + j) * 32 + q];
#pragma unroll
          for (int j = 0; j < 4; ++j) { const int dv = dvg * 16 + j0 + j; float acc = 0.f;
#pragma unroll
              for (int s = 0; s < NSPLIT; ++s) acc += wg[s] * pv[j][s];
#pragma unroll
              for (int s = 0; s < 4; ++s) acc += pn[s] * ck[s * 288 + dv];
              lat[q * 256 + dv] = acc * rl; } } }
    __syncthreads();
    { const int hh = tid >> 6, v = tid & 63; float a[4] = {0.f, 0.f, 0.f, 0.f};
#pragma unroll 1
      for (int r0 = 0; r0 < 256; r0 += 32) { float w[32];
#pragma unroll
          for (int i = 0; i < 32; ++i) w[i] = w_uv[((size_t)(r0 + i) * 8 + hh) * 64 + v];
#pragma unroll
          for (int i = 0; i < 32; ++i)
#pragma unroll
              for (int t = 0; t < 4; ++t) a[t] += w[i] * lat[(t * 8 + hh) * 256 + r0 + i]; }
#pragma unroll
      for (int t = 0; t < 4; ++t) OP[(size_t)(MP + 4 * b + t) * DM + hh * 64 + v] = (bf16)f2bf(a[t]); }
    __syncthreads();
}
__device__ __forceinline__ void attn_phase(Frame& F, const Args& A) {
    const bool dfirst = ((F.bx >> 3) & 1) != 0;
#pragma unroll 1
    for (int part = 0; part < 2; ++part) {
#ifndef ATT_NO_D
        if ((part == 0) == dfirst) { for (int rd = 0; rd < NREP(17); ++rd) for (int du = F.bx; du < 128 * NSPLIT; du += F.G) dattn_unit(F, A, du); }
        else
#endif
#ifndef ATT_NO_P
        { for (int rp = 0; rp < NREP(18); ++rp) for (int pr2 = 2 * F.bx; pr2 < 512; pr2 += 2 * F.G) {
#pragma unroll 1
                   for (int e = 0; e < 2; ++e) { const int pr = pr2 >> 1, bh = pr >> 4, s = pr & 15; pattn_unit(F, bh >> 3, bh & 7, e ? s : 31 - s); } } }
#else
        {}
#endif
    }
}
constexpr int N_PHASE_IDS = 43;
#ifndef PHMASK
#define PHMASK 0xFFFFFFFFu
#endif
#define EN(n) (((PHMASK) >> (n)) & 1u)
#define REPSEAM(n) do { if (rep_ + 1 < NREP(n) && args.use_bar) xcd_barrier(bar); } while (0)
#ifndef MK_ONE_LAUNCH
#define MK_ONE_LAUNCH 1
#endif
__global__ void __launch_bounds__(NWAVES * 64, 2) mk_fwd(Args args) {
    extern __shared__ __attribute__((aligned(16))) unsigned char lds[];
    Frame F;
    F.lds = (LAS unsigned char*)lds; F.MISC = (volatile LAS unsigned*)(F.lds + MISC_OFF);
    F.tid = threadIdx.x; F.lane = F.tid & 63; F.wave = __builtin_amdgcn_readfirstlane(F.tid >> 6); F.G = gridDim.x; F.bx = blockIdx.x;
    F.ws = args.ws; F.out = args.out; F.ctl = (gu32*)(args.ws + WS_CTL);
    for (int u = F.tid; u < (LDS_BYTES - LDSCTL_OFF) / 4; u += NWAVES * 64) ((LAS unsigned*)(F.lds + LDSCTL_OFF))[u] = 0u;
    __syncthreads();
    XcdBarrier bar; bar.bar = (unsigned*)(F.ctl + CW_BAR); bar.x = 0; bar.st = nullptr;
    if (args.use_bar) bar = xcd_barrier_post((unsigned*)(F.ctl + CW_BAR), F.MISC + 8);
    const int lo = args.ph_lo, hi = args.ph_hi;
#define RUN(k) (lo <= (k) && (k) < hi)
#define FRESH() do { int t_ = threadIdx.x; asm volatile("" : "+v"(t_)); F.tid = t_; F.lane = t_ & 63; F.wave = __builtin_amdgcn_readfirstlane(t_ >> 6); \
    { unsigned char* w_ = args.ws; asm volatile("" : "+s"(w_)); F.ws = w_; float* o_ = args.out; asm volatile("" : "+s"(o_)); F.out = o_; } } while (0)
#define SEAM(k) do { if (args.use_bar && (k) + 1 < hi) xcd_barrier(bar); } while (0)
    LAS unsigned char* ring = F.lds;
    const float* xin_p = (const float*)args.in[0]; const float* xin_s = (const float*)args.in[1] - (size_t)MP * DM;
#define X WS_PTR(float, WS_X)
#define H WS_PTR(bf16, WS_H)
#define ACT WS_PTR(bf16, WS_ACT)
#define Z WS_PTR(bf16, WS_Z)
#define OP WS_PTR(bf16, WS_OP)
#define MOD WS_PTR(float, WS_MOD)
    const float* norm_g = (const float*)args.in[12];

    if (EN(0) && RUN(0)) { for (int rep_ = 0; rep_ < NREP(0); ++rep_) { FRESH(); p0_prologue(F, args); REPSEAM(0); } SEAM(0); }
    if (EN(1) && RUN(1)) { for (int rep_ = 0; rep_ < NREP(1); ++rep_) { FRESH(); pg8::Gemm g{WS_PTR(bf16, WS_SC), WS_PTR(bf16, WS_ADAT), 256, MODLD, DM, DM, DM}; pg8::StaticOrder S; S.init(256, MODLD, F.G, F.bx);
        pg8::EpiMod E{MOD, (const float*)args.in[11]};
        pg8::gemm_phase<pg8::EpiMod, pg8::StaticOrder, true, true>(ring, g, S, E); REPSEAM(1); } SEAM(1); }
    for (int i = 0; i < 4; ++i) {
        const int pb = 2 + 10 * i, l = i >> 1, f = i & 1;
        const float* src_p = (i == 0) ? xin_p : X; const float* src_s = (i == 0) ? xin_s : X;
        const float* modl = MOD + l * 9216;
        if (EN(2) && RUN(pb + 0)) { for (int rep_ = 0; rep_ < NREP(2); ++rep_) { FRESH(); nm_phase(F, src_p, src_s, norm_g + (l * 3 + (f ? 2 : 0)) * DM, modl + (f ? 6 : 0) * DM, H, X, WS_PTR(float, WS_SLAB), (i == 0 || rep_ > 0) ? 0 : (f ? 4 : 11), (f ? MOD + (l) * 9216 + 5 * DM : MOD + (l - 1) * 9216 + 8 * DM), f ? 1.0f : 0.5f); REPSEAM(2); } SEAM(pb + 0); }
        if (EN(3) && RUN(pb + 1)) { for (int rep_ = 0; rep_ < NREP(3); ++rep_) { FRESH(); pg8::Gemm g{H, WS_PTR(bf16, WS_W13T + (size_t)i * W13T_STRIDE), MT, 2 * FF, DM, DM, DM}; pg8::StaticOrder S; S.init(MT, 2 * FF, F.G, F.bx);
            pg8::EpiSwiglu E{ACT, FF};
            pg8::gemm_phase<pg8::EpiSwiglu, pg8::StaticOrder, true, true>(ring, g, S, E); REPSEAM(3); } SEAM(pb + 1); }
        if (EN(4) && RUN(pb + 2)) { for (int rep_ = 0; rep_ < NREP(4); ++rep_) { FRESH();
            { pg8::Gemm g{ACT, WS_PTR(bf16, WS_W2T + (size_t)i * W2T_STRIDE), MP, DM, FF, FF, FF}; pg8::StaticOrder S; S.init(MP, DM, F.G, F.bx);
              pg8::EpiRes E{src_p, src_s, rep_ ? WS_PTR(float, WS_DUMMY) : X, modl + (f ? 8 : 2) * DM, 0.5f};
              pg8::gemm_phase<pg8::EpiRes, pg8::StaticOrder, true, true>(ring, g, S, E); }
            __syncthreads();
            { pg8::Gemm g{ACT, WS_PTR(bf16, WS_W2T + (size_t)i * W2T_STRIDE), MT, DM, args.k_kv, FF, FF}; pg8::SplitKOrder S{MP / 256, 2, 4, 11, 256, F.G, F.bx};
              pg8::EpiPartial E{WS_PTR(float, WS_SLAB)};
              pg8::gemm_phase<pg8::EpiPartial, pg8::SplitKOrder, true, true>(ring, g, S, E); }
            REPSEAM(4); } SEAM(pb + 2); }
        if (f == 0) {
            if (EN(5) && RUN(pb + 3)) { for (int rep_ = 0; rep_ < NREP(2); ++rep_) { FRESH(); nm_phase(F, X, X, norm_g + (l * 3 + 1) * DM, modl + 3 * DM, H, X, WS_PTR(float, WS_SLAB), rep_ ? 0 : 11, modl + 2 * DM, 0.5f); REPSEAM(2); } SEAM(pb + 3); }
            if (EN(6) && RUN(pb + 4)) { for (int rep_ = 0; rep_ < NREP(6); ++rep_) { FRESH(); const int NZ = l ? ZO : ZE; pg8::Gemm g{H, WS_PTR(bf16, l ? WS_ODIN : WS_EVIN), MT, NZ, DM, DM, DM}; pg8::StaticOrder S; S.init(MT, NZ, F.G, F.bx);
                pg8::EpiPlain E{Z, NZ};
                pg8::gemm_phase<pg8::EpiPlain, pg8::StaticOrder, true, true>(ring, g, S, E); REPSEAM(6); } SEAM(pb + 4); }
            if (RUN(pb + 5)) { if (l == 0) { if (EN(7)) for (int rep_ = 0; rep_ < NREP(7); ++rep_) { FRESH(); even_mid_phase(F, args); REPSEAM(7); } } else { if (EN(8)) for (int rep_ = 0; rep_ < NREP(8); ++rep_) { FRESH(); odd_thin_phase(F, args); REPSEAM(8); } } SEAM(pb + 5); }
            if (RUN(pb + 6)) { FRESH();
                if (l == 0) { if (EN(9)) gla_g2_phase(F); }
                else { for (int rep_ = 0; rep_ < NREP(10); ++rep_) { FRESH(); if (EN(10)) { pg8::Gemm g{WS_PTR(bf16, WS_CQN), WS_PTR(bf16, WS_WUQ), MT, 768, args.k_q, args.k_q, args.k_q}; pg8::StaticOrder S; S.init(MT, 768, F.G, F.bx);
                         pg8::EpiQ E{WS_PTR(bf16, WS_Q), WS_PTR(float, WS_RT)};
                         pg8::gemm_phase<pg8::EpiQ, pg8::StaticOrder, true, true>(ring, g, S, E); }
                       __syncthreads();
                       if (EN(16)) { const int nkv = opaque_int(1024), mkv = opaque_int(MP); pg8::Gemm g{WS_PTR(bf16, WS_CKVB), WS_PTR(bf16, WS_WKV), mkv, nkv, args.k_kv, args.k_kv, args.k_kv}; pg8::StaticOrder S; S.init(mkv, nkv, F.G, F.bx);
                         pg8::EpiPlain E{WS_PTR(bf16, WS_KV), nkv};
                         pg8::gemm_phase<pg8::EpiPlain, pg8::StaticOrder, true, true>(ring, g, S, E); } REPSEAM(10); } }
                SEAM(pb + 6); }
            if (RUN(pb + 7)) { if (l == 0) { if (EN(11)) for (int rep_ = 0; rep_ < NREP(11); ++rep_) { FRESH(); for (int u = F.bx; u < 1024; u += F.G) gla_g3_unit(F, args, u); REPSEAM(11); } } else { if (EN(12)) for (int rep_ = 0; rep_ < NREP(12); ++rep_) { FRESH(); attn_phase(F, args); REPSEAM(12); } } SEAM(pb + 7); }
            if (RUN(pb + 8)) { FRESH(); if (l == 1) { if (EN(13)) for (int rep_ = 0; rep_ < NREP(13); ++rep_) { for (int b = F.bx; b < 128; b += F.G) dcombine_unit(F, args, b); REPSEAM(13); } SEAM(pb + 8); } }
            if (EN(14) && RUN(pb + 9)) { for (int rep_ = 0; rep_ < NREP(14); ++rep_) { FRESH();
                { pg8::Gemm g{OP, WS_PTR(bf16, l ? WS_ODOUT : WS_EVOUT), MP, DM, DM, DM, DM}; pg8::StaticOrder S; S.init(MP, DM, F.G, F.bx);
                  pg8::EpiRes E{X, X, rep_ ? WS_PTR(float, WS_DUMMY) : X, modl + 5 * DM, 1.0f};
                  pg8::gemm_phase<pg8::EpiRes, pg8::StaticOrder, true, true>(ring, g, S, E); }
                __syncthreads();
                { pg8::Gemm g{OP, WS_PTR(bf16, l ? WS_ODOUT : WS_EVOUT), MT, DM, args.k_kv, DM, DM}; pg8::SplitKOrder S{MP / 256, 2, 4, 4, 256, F.G, F.bx};
                  pg8::EpiPartial E{WS_PTR(float, WS_SLAB)};
                  pg8::gemm_phase<pg8::EpiPartial, pg8::SplitKOrder, true, true>(ring, g, S, E); }
                REPSEAM(14); } SEAM(pb + 9); }
        }
    }
    if (EN(15) && RUN(42)) { for (int rep_ = 0; rep_ < NREP(15); ++rep_) { FRESH(); final_phase(F, X, (const float*)args.in[34], F.out + O_Y, WS_PTR(float, WS_SLAB), 11, MOD + 9216 + 8 * DM, 0.5f); REPSEAM(15); } }
#undef RUN
#undef SEAM
#undef X
#undef H
#undef ACT
#undef Z
#undef OP
#undef MOD
}

extern "C" void kernel_launch(void* const* d_in, const int* in_sizes, int n_in, void* d_out, int out_size, void* d_ws, size_t ws_size, hipStream_t stream) {
    static int grid = 0;
    if (grid == 0) {
        if (n_in != 35 || (size_t)out_size != O_END || ws_size < WS_END) { fprintf(stderr, "kernel_launch: unexpected shapes: n_in %d out %d ws %zu\n", n_in, out_size, ws_size); grid = -1; return; }
        int dev = 0, cus = 0, per_cu = 0;
        if (hipGetDevice(&dev) != hipSuccess || hipDeviceGetAttribute(&cus, hipDeviceAttributeMultiprocessorCount, dev) != hipSuccess) { grid = -1; return; }
        if (hipFuncSetAttribute((const void*)mk_fwd, hipFuncAttributeMaxDynamicSharedMemorySize, LDS_BYTES) != hipSuccess) { fprintf(stderr, "kernel_launch: hipFuncSetAttribute failed\n"); grid = -1; return; }
        if (hipOccupancyMaxActiveBlocksPerMultiprocessor(&per_cu, (const void*)mk_fwd, NWAVES * 64, LDS_BYTES) != hipSuccess || per_cu < 1) fprintf(stderr, "kernel_launch: occupancy query says %d\n", per_cu);
        (void)hipGetLastError();
        grid = cus;
    }
    if (grid < 0) return;
    if (hipMemsetAsync((char*)d_ws + WS_CTL, 0, CTL_ZERO_BYTES, stream) != hipSuccess) return;
    Args a{};
    for (int i = 0; i < 35; ++i) a.in[i] = d_in[i];
    a.out = (float*)d_out; a.ws = (unsigned char*)d_ws; a.k_q = 384; a.k_kv = 256; a.pad = 0;
#if MK_ONE_LAUNCH
    a.ph_lo = 0; a.ph_hi = N_PHASE_IDS; a.use_bar = 1;
    hipLaunchKernelGGL(mk_fwd, dim3(grid), dim3(NWAVES * 64), LDS_BYTES, stream, a);
#else
    for (int id = 0; id < N_PHASE_IDS; ++id) {
        if (id >= 2 && id < 42) { const int i = (id - 2) / 10, k = (id - 2) % 10; if (k >= 3 && (i & 1)) continue; if (k == 8 && i == 0) continue; }
        a.ph_lo = id; a.ph_hi = id + 1; a.use_bar = 0;
        hipLaunchKernelGGL(mk_fwd, dim3(grid), dim3(NWAVES * 64), LDS_BYTES, stream, a);
    }
#endif
}
```

```cpp
#include <hip/hip_runtime.h>
#include <cstdio>
#include <cstdint>
#define GAS __attribute__((address_space(1)))
#define LAS __attribute__((address_space(3)))
constexpr int DM = 1024, MP = 16384, MS = 512, MT = MP + MS, TP = 8192, NBAT = 130, FF = 2816;
constexpr int MODLD = 18432;
constexpr int ZE = 2304, ZO = 1792;
constexpr float QSCALE = 0.10206207261596577f * 1.4426950408889634f;
__device__ __forceinline__ int bidx(int row) { return row < MP ? (row >> 13) : 2 + ((row - MP) >> 2); }
__device__ __forceinline__ int posof(int row) { return row < MP ? (row & (TP - 1)) : TP + ((row - MP) & 3); }
__device__ __forceinline__ float bf2f(unsigned short b) { return __uint_as_float(((unsigned)b) << 16); }
__device__ __forceinline__ unsigned f2bf(float f) { unsigned u = __builtin_bit_cast(unsigned, f); return (u + 0x7fffu + ((u >> 16) & 1u)) >> 16; }
__device__ __forceinline__ unsigned pk2(float lo, float hi) { return f2bf(lo) | (f2bf(hi) << 16); }
__device__ __forceinline__ float sigmoidf_(float x) { return __builtin_amdgcn_rcpf(1.0f + __expf(-x)); }
__device__ __forceinline__ float siluf_(float x) { return x * __builtin_amdgcn_rcpf(1.0f + __expf(-x)); }
namespace pg8 {
#define PG8_LAS __attribute__((address_space(3)))
typedef unsigned short bf16_t;
typedef short bf16x8 __attribute__((ext_vector_type(8)));
typedef float f32x4 __attribute__((ext_vector_type(4)));
typedef unsigned u32x4 __attribute__((ext_vector_type(4)));
constexpr int BM = 256, BK = 64, HALF = 128, HTB = HALF * BK * 2  , STAGE_BYTES = 8 * HTB, NXCD = 8, WGM = 8;

__host__ __device__ __forceinline__ int lds_byte(int r, int c) { const int st = (r >> 4) * 2 + (c >> 5), rr = r & 15, cc = c & 31, ob = rr * 64 + cc * 2; return st * 1024 + (ob ^ (((ob >> 9) & 1) << 5)); }
__host__ __device__ __forceinline__ void stage_rc(int b, int& R, int& C) { const int st = b / 1024, sb = b % 1024, swz = sb ^ (((sb >> 9) & 1) << 5); R = (st >> 1) * 16 + swz / 64; C = (st & 1) * 32 + (swz % 64) / 2; }
__host__ __device__ __forceinline__ int perm32(int rho) { const int n = rho >> 4, i = rho & 15; return 8 * (i >> 2) + 4 * n + (i & 3); }

struct Unit { int pm, pn, koff; };
struct Gemm { const bf16_t* A; const bf16_t* Bt; int M, N, K, lda, ldb; };

struct StaticOrder {
    int nM, nN, nwg, G, c;
    __host__ __device__ void init(int M, int N, int G_, int c_) { nM = M / BM; nN = N / BM; nwg = nM * nN; G = G_; c = c_; }
    __host__ __device__ bool next(int i, Unit& u) const {
        const long L = (long)i * G + c; if (L >= nwg) return false;
        int wgid = (int)L; { const int q = nwg / NXCD, r = nwg % NXCD, xcd = wgid % NXCD, off = wgid / NXCD; wgid = (xcd < r ? xcd * (q + 1) : r * (q + 1) + (xcd - r) * q) + off; }
        const int nig = WGM * nN, gid = wgid / nig, fm = gid * WGM, gsz = (nM - fm) < WGM ? (nM - fm) : WGM;
        u.pm = fm + ((wgid % nig) % gsz); u.pn = (wgid % nig) / gsz; u.koff = 0; return true;
    }
    __device__ __forceinline__ void a_ready(const Unit&) const {}
    __device__ __forceinline__ void done(const Unit&) const {}
};
struct SplitKOrder {
    int pm0, nP, nN, nch, kc, G, c;
    __device__ bool next(int i, Unit& u) const { const int j = i * G + c; if (j >= nP * nN * nch) return false; const int ch = j % nch, t = j / nch; u.pn = t % nN; u.pm = pm0 + t / nN; u.koff = ch * kc; return true; }
    __device__ __forceinline__ void a_ready(const Unit&) const {}
    __device__ __forceinline__ void done(const Unit&) const {}
};

__device__ __forceinline__ unsigned cvt_pk_bf16(float lo, float hi) { unsigned r; asm volatile("v_cvt_pk_bf16_f32 %0, %1, %2" : "=v"(r) : "v"(lo), "v"(hi)); return r; }

struct EpiPlain {
    static constexpr bool PERM = true, AFTER_DRAIN = false;
    bf16_t* O; int ldc;
    __device__ __forceinline__ void operator()(const f32x4 (&acc)[2][2][4][2], const Unit& u, int wr, int wc, int fr, int fq) const {
        const int row0 = u.pm * BM + wr * 64 + fr, col0 = u.pn * BM + wc * 32 + 8 * fq;
#pragma unroll
        for (int ai = 0; ai < 2; ++ai)
#pragma unroll
            for (int m = 0; m < 4; ++m) { bf16_t* rowp = O + (size_t)(row0 + ai * HALF + m * 16) * ldc + col0;
#pragma unroll
                for (int bj = 0; bj < 2; ++bj) { const f32x4 v0 = acc[ai][bj][m][0], v1 = acc[ai][bj][m][1];
                    u32x4 w; w.x = cvt_pk_bf16(v0[0], v0[1]); w.y = cvt_pk_bf16(v0[2], v0[3]); w.z = cvt_pk_bf16(v1[0], v1[1]); w.w = cvt_pk_bf16(v1[2], v1[3]);
                    *(u32x4*)(rowp + bj * HALF) = w; } }
    }
};
struct EpiSwiglu {
    static constexpr bool PERM = true, AFTER_DRAIN = false;
    bf16_t* O; int ldc;
    __device__ __forceinline__ void operator()(const f32x4 (&acc)[2][2][4][2], const Unit& u, int wr, int wc, int fr, int fq) const {
        const int row0 = u.pm * BM + wr * 64 + fr, col0 = u.pn * HALF + wc * 32 + 8 * fq;
#pragma unroll
        for (int ai = 0; ai < 2; ++ai)
#pragma unroll
            for (int m = 0; m < 4; ++m) { bf16_t* rowp = O + (size_t)(row0 + ai * HALF + m * 16) * ldc + col0;
                float o[8];
#pragma unroll
                for (int n = 0; n < 2; ++n)
#pragma unroll
                    for (int e = 0; e < 4; ++e) { const float g = acc[ai][0][m][n][e], uu = acc[ai][1][m][n][e]; o[n * 4 + e] = siluf_(g) * uu; }
                u32x4 w; w.x = cvt_pk_bf16(o[0], o[1]); w.y = cvt_pk_bf16(o[2], o[3]); w.z = cvt_pk_bf16(o[4], o[5]); w.w = cvt_pk_bf16(o[6], o[7]);
                *(u32x4*)rowp = w; }
    }
};
struct EpiRes {
    static constexpr bool PERM = false, AFTER_DRAIN = false;
    const float* bp; const float* bs; float* out; const float* gate; float coef;
    __device__ __forceinline__ void operator()(const f32x4 (&acc)[2][2][4][2], const Unit& u, int wr, int wc, int fr, int fq) const {
#pragma unroll
        for (int ai = 0; ai < 2; ++ai)
#pragma unroll
            for (int m = 0; m < 4; ++m) { const int row = u.pm * BM + ai * HALF + wr * 64 + m * 16 + fr; const int b = bidx(row);
                const float* base = (row < MP ? bp : bs) + (size_t)row * DM; const float* gr = gate + (size_t)b * MODLD; float* orow = out + (size_t)row * DM;
#pragma unroll
                for (int bj = 0; bj < 2; ++bj)
#pragma unroll
                    for (int n = 0; n < 2; ++n) { const int col = u.pn * BM + bj * HALF + wc * 32 + n * 16 + 4 * fq;
                        const f32x4 xin = *(const f32x4*)(base + col), g = *(const f32x4*)(gr + col);
                        *(f32x4*)(orow + col) = xin + (g * coef) * acc[ai][bj][m][n]; } }
    }
};
struct EpiPartial {
    static constexpr bool PERM = false, AFTER_DRAIN = false;
    float* slab;
    __device__ __forceinline__ void operator()(const f32x4 (&acc)[2][2][4][2], const Unit& u, int wr, int wc, int fr, int fq) const {
        float* sb = slab + (size_t)(u.koff >> 8) * (MS * DM);
#pragma unroll
        for (int ai = 0; ai < 2; ++ai)
#pragma unroll
            for (int m = 0; m < 4; ++m) { const int row = u.pm * BM + ai * HALF + wr * 64 + m * 16 + fr - MP; float* orow = sb + (size_t)row * DM;
#pragma unroll
                for (int bj = 0; bj < 2; ++bj)
#pragma unroll
                    for (int n = 0; n < 2; ++n) { const int col = u.pn * BM + bj * HALF + wc * 32 + n * 16 + 4 * fq; *(f32x4*)(orow + col) = acc[ai][bj][m][n]; } }
    }
};
struct EpiMod {
    static constexpr bool PERM = false, AFTER_DRAIN = false;
    float* out; const float* bias;
    __device__ __forceinline__ void operator()(const f32x4 (&acc)[2][2][4][2], const Unit& u, int wr, int wc, int fr, int fq) const {
#pragma unroll
        for (int ai = 0; ai < 2; ++ai)
#pragma unroll
            for (int m = 0; m < 4; ++m) { const int row = u.pm * BM + ai * HALF + wr * 64 + m * 16 + fr; float* orow = out + (size_t)row * MODLD;
#pragma unroll
                for (int bj = 0; bj < 2; ++bj)
#pragma unroll
                    for (int n = 0; n < 2; ++n) { const int col = u.pn * BM + bj * HALF + wc * 32 + n * 16 + 4 * fq;
                        *(f32x4*)(orow + col) = acc[ai][bj][m][n] + *(const f32x4*)(bias + col); } }
    }
};
struct EpiQ {
    static constexpr bool PERM = false, AFTER_DRAIN = false;
    bf16_t* O; const float* rt;
    __device__ __forceinline__ void operator()(const f32x4 (&acc)[2][2][4][2], const Unit& u, int wr, int wc, int fr, int fq) const {
        typedef unsigned u32x2 __attribute__((ext_vector_type(2)));
#pragma unroll
        for (int ai = 0; ai < 2; ++ai)
#pragma unroll
            for (int m = 0; m < 4; ++m) { const int row = u.pm * BM + ai * HALF + wr * 64 + m * 16 + fr; const int pos = posof(row);
                const float* rtp = rt + (size_t)pos * 32 + 8 * fq;
#pragma unroll
                for (int bj = 0; bj < 2; ++bj) { const int gc0 = u.pn * BM + bj * HALF + wc * 32; const bool isrope = (gc0 % 96) == 64;
                    f32x4 v0 = acc[ai][bj][m][0] * QSCALE, v1 = acc[ai][bj][m][1] * QSCALE;
                    if (isrope) { const f32x4 cs0 = *(const f32x4*)(rtp), cs1 = *(const f32x4*)(rtp + 4);
                        const float c[4] = {cs0[0], cs0[2], cs1[0], cs1[2]}, s[4] = {cs0[1], cs0[3], cs1[1], cs1[3]};
                        f32x4 a, b;
#pragma unroll
                        for (int e = 0; e < 4; ++e) { a[e] = v0[e] * c[e] - v1[e] * s[e]; b[e] = v1[e] * c[e] + v0[e] * s[e]; }
                        v0 = a; v1 = b; }
                    bf16_t* p = O + (size_t)row * 768 + gc0 + 4 * fq;
                    u32x2 w0; w0.x = cvt_pk_bf16(v0[0], v0[1]); w0.y = cvt_pk_bf16(v0[2], v0[3]); *(u32x2*)p = w0;
                    u32x2 w1; w1.x = cvt_pk_bf16(v1[0], v1[1]); w1.y = cvt_pk_bf16(v1[2], v1[3]); *(u32x2*)(p + 16) = w1; }
                asm volatile("" ::: "memory"); }
    }
};

template <class Epi, class Sched, bool ALIGN_EPI = false, bool SP2 = false>
__device__ __forceinline__ void gemm_phase(PG8_LAS unsigned char* lds, const Gemm g, const Sched& S, const Epi& E) {
    int tid = threadIdx.x; asm volatile("" : "+v"(tid));
    const int wid = __builtin_amdgcn_readfirstlane(tid >> 6), lane = tid & 63, wr = wid >> 2, wc = wid & 3, fr = lane & 15, fq = lane >> 4;
    const int K = g.K, nt = K / BK;
    unsigned voffA[2], voffB[2];
#pragma unroll
    for (int i = 0; i < 2; ++i) { int R, C; stage_rc(tid * 16 + i * 8192, R, C); const int Rb = Epi::PERM ? ((R & ~31) + perm32(R & 31)) : R;
        voffA[i] = (unsigned)(R * g.lda + C) * 2u; voffB[i] = (unsigned)(Rb * g.ldb + C) * 2u; }
    const size_t kstep = (size_t)(BK * 2);
    const int lda = g.lda, ldb = g.ldb;
    const size_t hstepA = (size_t)HALF * lda * 2, hstepB = (size_t)HALF * ldb * 2;
    const size_t tstepA = 2 * hstepA, tstepB = 2 * hstepB;
    const unsigned ldsw = (unsigned)wid * 1024u;
    const int aoff = lds_byte(wr * 64 + fr, fq * 8), boff = lds_byte(wc * 32 + fr, fq * 8);
#define PG8_SA(b, h) (((b) * 2 + (h)) * HTB)
#define PG8_SB(b, h) ((4 + (b) * 2 + (h)) * HTB)
#define PG8_STAGE(bufoff, gbase, voff) do { _Pragma("unroll") for (int _i = 0; _i < 2; ++_i) \
        __builtin_amdgcn_global_load_lds((const unsigned*)((const char*)(gbase) + (voff)[_i]), (PG8_LAS unsigned*)(lds + (bufoff) + ldsw + _i * 8192), 16, 0, 0); } while (0)
#define PG8_LDA(dst, b, h) do { _Pragma("unroll") for (int m = 0; m < 4; ++m) _Pragma("unroll") for (int k = 0; k < 2; ++k) dst[m][k] = *(const PG8_LAS bf16x8*)(lds + PG8_SA(b, h) + aoff + m * 2048 + k * 1024); } while (0)
#define PG8_LDB(dst, b, h) do { _Pragma("unroll") for (int n = 0; n < 2; ++n) _Pragma("unroll") for (int k = 0; k < 2; ++k) dst[n][k] = *(const PG8_LAS bf16x8*)(lds + PG8_SB(b, h) + boff + n * 2048 + k * 1024); } while (0)
#define PG8_MMA(ai, bj, At, Bt) do { __builtin_amdgcn_s_setprio(1); _Pragma("unroll") for (int m = 0; m < 4; ++m) _Pragma("unroll") for (int n = 0; n < 2; ++n) _Pragma("unroll") for (int k = 0; k < 2; ++k) \
        acc[ai][bj][m][n] = __builtin_amdgcn_mfma_f32_16x16x32_bf16(Bt[n][k], At[m][k], acc[ai][bj][m][n], 0, 0, 0); __builtin_amdgcn_s_setprio(0); } while (0)
#define PG8_WAIT_V(n) asm volatile("s_waitcnt vmcnt(" #n ")" ::: "memory")
#define PG8_WAIT_L(n) asm volatile("s_waitcnt lgkmcnt(" #n ")" ::: "memory")
#define PG8_BAR __builtin_amdgcn_s_barrier()
#define PG8_SCHED __builtin_amdgcn_sched_barrier(0)
    Unit cur, nxt; int ui = 0;
    if (!S.next(0, cur)) return;
    f32x4 acc[2][2][4][2];
#pragma unroll
    for (int a = 0; a < 2; ++a)
#pragma unroll
        for (int b = 0; b < 2; ++b)
#pragma unroll
            for (int m = 0; m < 4; ++m)
#pragma unroll
                for (int n = 0; n < 2; ++n) acc[a][b][m][n] = (f32x4){0.f, 0.f, 0.f, 0.f};
    bf16x8 At[4][2], B0[2][2], B1[2][2];
    const char* cA = (const char*)g.A + (size_t)cur.pm * tstepA + (size_t)cur.koff * 2; const char* cB = (const char*)g.Bt + (size_t)cur.pn * tstepB + (size_t)cur.koff * 2;
    S.a_ready(cur);
    if constexpr (SP2) {
        PG8_STAGE(PG8_SB(0, 0), cB, voffB); PG8_STAGE(PG8_SB(0, 1), cB + hstepB, voffB); PG8_STAGE(PG8_SA(0, 0), cA, voffA); PG8_STAGE(PG8_SA(0, 1), cA + hstepA, voffA);
        if (wr == 1) PG8_BAR;
        PG8_WAIT_V(2); PG8_BAR;
        PG8_STAGE(PG8_SB(1, 0), cB + kstep, voffB); PG8_STAGE(PG8_SA(1, 0), cA + kstep, voffA); PG8_STAGE(PG8_SB(1, 1), cB + hstepB + kstep, voffB);
        PG8_WAIT_V(6); PG8_BAR;
    } else {
        PG8_STAGE(PG8_SB(0, 0), cB, voffB); PG8_STAGE(PG8_SA(0, 0), cA, voffA); PG8_STAGE(PG8_SB(0, 1), cB + hstepB, voffB); PG8_STAGE(PG8_SA(0, 1), cA + hstepA, voffA);
        if (wr == 1) PG8_BAR;
        PG8_WAIT_V(4); PG8_BAR;
        PG8_STAGE(PG8_SB(1, 0), cB + kstep, voffB); PG8_STAGE(PG8_SA(1, 0), cA + kstep, voffA); PG8_STAGE(PG8_SB(1, 1), cB + hstepB + kstep, voffB);
        PG8_WAIT_V(6); PG8_BAR;
    }
    for (;;) {
        const bool has_next = S.next(ui + 1, nxt);
        const char* nA = has_next ? (const char*)g.A + (size_t)nxt.pm * tstepA + (size_t)nxt.koff * 2 : cA; const char* nB = has_next ? (const char*)g.Bt + (size_t)nxt.pn * tstepB + (size_t)nxt.koff * 2 : cB;
        for (int t = 0; t < nt; t += 2) {
            const bool last = (t == nt - 2);
            const char* a1 = cA + (size_t)(t + 1) * kstep;
            const char* a2 = last ? nA : cA + (size_t)(t + 2) * kstep; const char* b2 = last ? nB : cB + (size_t)(t + 2) * kstep;
            const char* a3 = a2 + kstep; const char* b3 = b2 + kstep;
            if (last && has_next) S.a_ready(nxt);
            if constexpr (SP2) {
            PG8_LDB(B0, 0, 0); PG8_LDB(B1, 0, 1); PG8_SCHED; PG8_LDA(At, 0, 0); PG8_STAGE(PG8_SA(1, 1), a1 + hstepA, voffA);
            PG8_WAIT_V(8); PG8_WAIT_L(0); PG8_BAR; PG8_MMA(0, 0, At, B0); PG8_MMA(0, 1, At, B1); PG8_BAR; PG8_SCHED;
            PG8_LDA(At, 0, 1); PG8_STAGE(PG8_SB(0, 0), b2, voffB); PG8_STAGE(PG8_SB(0, 1), b2 + hstepB, voffB); PG8_STAGE(PG8_SA(0, 0), a2, voffA);
            PG8_WAIT_V(8); PG8_WAIT_L(0); PG8_BAR; PG8_MMA(1, 0, At, B0); PG8_MMA(1, 1, At, B1); PG8_BAR; PG8_SCHED;
            PG8_LDB(B0, 1, 0); PG8_LDB(B1, 1, 1); PG8_SCHED; PG8_LDA(At, 1, 0); PG8_STAGE(PG8_SA(0, 1), a2 + hstepA, voffA);
            PG8_WAIT_V(8); PG8_WAIT_L(0); PG8_BAR; PG8_MMA(0, 0, At, B0); PG8_MMA(0, 1, At, B1); PG8_BAR; PG8_SCHED;
            PG8_LDA(At, 1, 1); PG8_STAGE(PG8_SB(1, 0), b3, voffB); PG8_STAGE(PG8_SB(1, 1), b3 + hstepB, voffB); PG8_STAGE(PG8_SA(1, 0), a3, voffA);
            PG8_WAIT_V(8); PG8_WAIT_L(0); PG8_BAR; PG8_MMA(1, 0, At, B0); PG8_MMA(1, 1, At, B1); PG8_BAR; PG8_SCHED;
            } else {
            PG8_LDB(B0, 0, 0); PG8_SCHED; PG8_LDA(At, 0, 0); PG8_STAGE(PG8_SA(1, 1), a1 + hstepA, voffA);
            PG8_WAIT_L(8); PG8_BAR; PG8_WAIT_L(0); PG8_MMA(0, 0, At, B0); PG8_BAR; PG8_SCHED;
            PG8_LDB(B1, 0, 1); PG8_STAGE(PG8_SB(0, 0), b2, voffB);
            PG8_BAR; PG8_WAIT_L(0); PG8_MMA(0, 1, At, B1); PG8_BAR;
            PG8_LDA(At, 0, 1); PG8_STAGE(PG8_SA(0, 0), a2, voffA);
            PG8_BAR; PG8_WAIT_L(0); PG8_MMA(1, 0, At, B0); PG8_BAR; PG8_SCHED;
            PG8_STAGE(PG8_SB(0, 1), b2 + hstepB, voffB);
            PG8_WAIT_V(6); PG8_BAR; PG8_MMA(1, 1, At, B1); PG8_BAR;
            PG8_LDB(B0, 1, 0); PG8_SCHED; PG8_LDA(At, 1, 0); PG8_STAGE(PG8_SA(0, 1), a2 + hstepA, voffA);
            PG8_WAIT_L(8); PG8_BAR; PG8_WAIT_L(0); PG8_MMA(0, 0, At, B0); PG8_BAR; PG8_SCHED;
            PG8_LDB(B1, 1, 1); PG8_STAGE(PG8_SB(1, 0), b3, voffB);
            PG8_BAR; PG8_WAIT_L(0); PG8_MMA(0, 1, At, B1); PG8_BAR;
            PG8_LDA(At, 1, 1); PG8_STAGE(PG8_SA(1, 0), a3, voffA);
            PG8_BAR; PG8_WAIT_L(0); PG8_MMA(1, 0, At, B0); PG8_BAR; PG8_SCHED;
            PG8_STAGE(PG8_SB(1, 1), b3 + hstepB, voffB);
            PG8_WAIT_V(6); PG8_BAR; PG8_MMA(1, 1, At, B1); PG8_BAR;
            }
        }
        if constexpr (ALIGN_EPI) { if (wr == 0) PG8_BAR; }
        if constexpr (!Epi::AFTER_DRAIN) { E(acc, cur, wr, wc, fr, fq); S.done(cur); }
        if (!has_next) break;
#pragma unroll
        for (int a = 0; a < 2; ++a)
#pragma unroll
            for (int b = 0; b < 2; ++b)
#pragma unroll
                for (int m = 0; m < 4; ++m)
#pragma unroll
                    for (int n = 0; n < 2; ++n) acc[a][b][m][n] = (f32x4){0.f, 0.f, 0.f, 0.f};
        cur = nxt; cA = nA; cB = nB; ++ui;
        if constexpr (ALIGN_EPI) { if (wr == 1) PG8_BAR; }
    }
    PG8_WAIT_V(0);
    if constexpr (!ALIGN_EPI) { if (wr == 0) PG8_BAR; }
    PG8_BAR;
    if constexpr (Epi::AFTER_DRAIN) { E.fused(acc, cur, wr, wc, fr, fq, lds, wid, lane); S.done(cur); }
#undef PG8_SA
#undef PG8_SB
#undef PG8_STAGE
#undef PG8_LDA
#undef PG8_LDB
#undef PG8_MMA
#undef PG8_WAIT_V
#undef PG8_WAIT_L
#undef PG8_BAR
#undef PG8_SCHED
}
}
constexpr size_t MiB = 1u << 20;
constexpr size_t WS_CTL = 0, CTL_ZERO_BYTES = 1 * MiB;
constexpr size_t WS_W13T = 2 * MiB, W13T_STRIDE = 11 * MiB;
constexpr size_t WS_W2T = 46 * MiB, W2T_STRIDE = 5767168;
constexpr size_t WS_EVIN = 68 * MiB, WS_EVOUT = 73 * MiB, WS_ODIN = 75 * MiB, WS_ODOUT = 79 * MiB, WS_WUQ = 81 * MiB, WS_WKV = 82 * MiB;
constexpr size_t WS_ADAT = 83 * MiB, WS_SC = 119 * MiB, WS_RT = 120 * MiB, WS_MOD = 122 * MiB;
constexpr size_t WS_X = 140 * MiB, WS_H = 206 * MiB, WS_ACT = 239 * MiB, WS_Z = 330 * MiB, WS_OP = 405 * MiB;
constexpr size_t WS_US = 438 * MiB, WS_DS = 470 * MiB, WS_CQN = 471 * MiB, WS_CKVB = 484 * MiB, WS_KRB = 493 * MiB, WS_Q = 495 * MiB, WS_KV = 520 * MiB;
constexpr size_t WS_PART = 552 * MiB, WS_QD = 586 * MiB, WS_SLAB = 592 * MiB, WS_DUMMY = 616 * MiB, WS_BCS = 682 * MiB, WS_END = 698 * MiB;
constexpr int NSPLIT = 2, PART_F = 32 * 256 + 64;
constexpr size_t O_Y = 0, O_GLAP = 17301504, O_GLAS = O_GLAP + 65536, O_POOLP = O_GLAS + 4194304, O_POOLS = O_POOLP + 15360, O_CKV = O_POOLS + 983040,
                 O_KR = O_CKV + 4325376, O_CONVP = O_KR + 540672, O_CONVS = O_CONVP + 30720, O_END = O_CONVS + 1966080;
constexpr int CW_TMO = 0, CW_CODE = 1, CW_BAR = 4096;
constexpr int RING_BYTES = 131072, LDSCTL_OFF = RING_BYTES, MISC_OFF = LDSCTL_OFF + 320, LDS_BYTES = 147456;
constexpr int NWAVES = 8;

typedef unsigned short bf16;
typedef unsigned v4u __attribute__((ext_vector_type(4)));
typedef unsigned v2u __attribute__((ext_vector_type(2)));
typedef float f32x4 __attribute__((ext_vector_type(4)));
typedef float f32x2 __attribute__((ext_vector_type(2)));
typedef float f32x16 __attribute__((ext_vector_type(16)));
typedef short bf16x8 __attribute__((ext_vector_type(8)));
typedef short s16x4 __attribute__((ext_vector_type(4)));
typedef GAS unsigned gu32;
#define RLX_AGENT __ATOMIC_RELAXED, __HIP_MEMORY_SCOPE_AGENT
#define LDS_WAIT() asm volatile("s_waitcnt lgkmcnt(0)" ::: "memory")
#define VM_WAIT() asm volatile("s_waitcnt vmcnt(0)" ::: "memory")


#ifndef PROBE_DUP
#define PROBE_DUP 0u
#endif
__device__ __forceinline__ int opaque_int(int v) { asm volatile("" : "+s"(v)); return v; }
#define NREP(n) ((((PROBE_DUP) >> (n)) & 1u) ? opaque_int(2) : 1)


typedef short v4i16_t __attribute__((ext_vector_type(4)));
__device__ __forceinline__ s16x4 vtr(const LAS unsigned char* p) { return __builtin_bit_cast(s16x4, __builtin_amdgcn_ds_read_tr16_b64_v4i16((LAS v4i16_t*)p)); }
#define LBAR() asm volatile("s_waitcnt lgkmcnt(0)\n\ts_barrier" ::: "memory")
__device__ __forceinline__ float xhalf_max(float v) { auto rr = __builtin_amdgcn_permlane32_swap(__float_as_uint(v), __float_as_uint(v), false, false); return fmaxf(__uint_as_float(rr[0]), __uint_as_float(rr[1])); }
__device__ __forceinline__ float xhalf_sum(float v) { auto rr = __builtin_amdgcn_permlane32_swap(__float_as_uint(v), __float_as_uint(v), false, false); return __uint_as_float(rr[0]) + __uint_as_float(rr[1]); }
__device__ __forceinline__ int crow(int r, int hi) { return (r & 3) + 8 * (r >> 2) + 4 * hi; }
__device__ __forceinline__ bf16x8 pack8(const f32x16& p, int s8) {
    v4u w; w.x = pg8::cvt_pk_bf16(p[s8 + 0], p[s8 + 1]); w.y = pg8::cvt_pk_bf16(p[s8 + 2], p[s8 + 3]); w.z = pg8::cvt_pk_bf16(p[s8 + 4], p[s8 + 5]); w.w = pg8::cvt_pk_bf16(p[s8 + 6], p[s8 + 7]);
    return __builtin_bit_cast(bf16x8, w);
}

#define XB_TMO      128
#define XB_XCNT(j)  (256  + 64 * (j))
#define XB_XSUB(j)  (1280 + 64 * (j))
#define XB_XGEN(j)  (2304 + 64 * (j))
#define XB_TOP      3328
#define XB_TOPGEN   3392
#define XCD_BAR_WORDS 3456
#define XB_SPIN_CAP (1u << 18)

__device__ __forceinline__ unsigned xb_ld(unsigned* p)              { return __hip_atomic_load(p, __ATOMIC_RELAXED, __HIP_MEMORY_SCOPE_AGENT); }
__device__ __forceinline__ unsigned xb_add(unsigned* p, unsigned v) { return __hip_atomic_fetch_add(p, v, __ATOMIC_RELAXED, __HIP_MEMORY_SCOPE_AGENT); }
__device__ __forceinline__ unsigned xb_xcc_id() { return (unsigned)__builtin_amdgcn_s_getreg((3 << 11) | 20) & 0xFu; }
#define XB_SPIN(cond, bar) do { unsigned _sp = 0; while (cond) { __builtin_amdgcn_s_sleep(1); \
    if ((++_sp & 255u) == 0u) { if (xb_ld(&(bar)[XB_TMO])) break; if (_sp > XB_SPIN_CAP) { atomicAdd(&(bar)[XB_TMO], 1u); break; } } } } while (0)

struct XcdBarrier {
    unsigned* bar; unsigned x;
    volatile LAS unsigned* st;
};

__device__ __forceinline__ XcdBarrier xcd_barrier_post(unsigned* bar, volatile LAS unsigned* st) {
    XcdBarrier b; b.bar = bar; b.x = xb_xcc_id(); b.st = st;
    if (threadIdx.x == 0) (void)xb_add(&bar[XB_XCNT(b.x)], 1u);
    return b;
}
__device__ __forceinline__ void xcd_barrier_complete(unsigned* bar, unsigned x, unsigned& nloc, unsigned& nx) {
    const unsigned G = gridDim.x * gridDim.y * gridDim.z;
    unsigned sum, cnt, mine, sp = 0u;
    for (;;) {
        sum = 0u; cnt = 0u; mine = 0u;
#pragma unroll
        for (unsigned j = 0; j < 16; ++j) { const unsigned c = xb_ld(&bar[XB_XCNT(j)]); sum += c; cnt += (c > 0u) ? 1u : 0u; mine = (j == x) ? c : mine; }
        if (sum == G) break;
        __builtin_amdgcn_s_sleep(1);
        if ((++sp & 255u) == 0u) { if (xb_ld(&bar[XB_TMO])) break; if (sp > XB_SPIN_CAP) { atomicAdd(&bar[XB_TMO], 1u); break; } }
    }
    nloc = mine > 0u ? mine : 1u; nx = cnt > 0u ? cnt : 1u;
}

__device__ __forceinline__ void xcd_barrier(const XcdBarrier& b) {
    asm volatile("s_waitcnt vmcnt(0)" ::: "memory");
    __syncthreads();
    if (threadIdx.x == 0) {
        unsigned* bar = b.bar;
        __builtin_amdgcn_s_waitcnt(0);
        unsigned nloc = b.st[0], nx = b.st[1];
        if (nloc == 0u) { xcd_barrier_complete(bar, b.x, nloc, nx); b.st[0] = nloc; b.st[1] = nx; }
        const unsigned old = xb_add(&bar[XB_XSUB(b.x)], 1u);
        const unsigned gen = old / nloc;
        if (old + 1u == (gen + 1u) * nloc) {
            __builtin_amdgcn_fence(__ATOMIC_RELEASE, "agent");
            asm volatile("s_waitcnt vmcnt(0)" ::: "memory");
            const unsigned og = xb_add(&bar[XB_TOP], 1u);
            const unsigned tg = og / nx;
            if (og + 1u == (tg + 1u) * nx) xb_add(&bar[XB_TOPGEN], 1u);
            else XB_SPIN(xb_ld(&bar[XB_TOPGEN]) == tg, bar);
            __builtin_amdgcn_fence(__ATOMIC_ACQUIRE, "agent");
            xb_add(&bar[XB_XGEN(b.x)], 1u);
            asm volatile("s_waitcnt vmcnt(0)" ::: "memory");
        } else {
            XB_SPIN(xb_ld(&bar[XB_XGEN(b.x)]) == gen, bar);
            __builtin_amdgcn_fence(__ATOMIC_ACQUIRE, "agent");
            asm volatile("s_waitcnt vmcnt(0)" ::: "memory");
        }
    }
    __syncthreads();
}
struct Args { const void* in[35]; float* out; unsigned char* ws; int ph_lo, ph_hi, use_bar, k_q, k_kv, pad; };
struct Frame {
    LAS unsigned char* lds;
    volatile LAS unsigned* MISC;
    gu32* ctl;
    int tid, lane, wave, G, bx;
    unsigned char* ws; float* out;
};
__device__ __forceinline__ float wave_sum(float v) {
#pragma unroll
    for (int o = 1; o < 64; o <<= 1) v += __shfl_xor(v, o);
    return v;
}
__device__ __forceinline__ float half_sum(float v) {
#pragma unroll
    for (int o = 1; o < 32; o <<= 1) v += __shfl_xor(v, o);
    return v;
}
#define WS_PTR(T, off) ((T*)(F.ws + (off)))

enum { RM_ID = 0, RM_W1 = 1, RM_W3 = 2, RM_EVIN = 3 };
__device__ __forceinline__ int map_row(int mode, int n) {
    if (mode == RM_W1) return 256 * (n >> 7) + (n & 127);
    if (mode == RM_W3) return 256 * (n >> 7) + 128 + (n & 127);
    if (mode == RM_EVIN) return n < 1536 ? n : (n < 1552 ? 2048 + (n - 1536) : 1536 + (n - 1552));
    return n;
}
__device__ __forceinline__ void p0_transpose_item(const float* W, int N, bf16* WT, int ldk, int mode, LAS float* scr, int item, int lane) {
    const int nblk = (N + 31) / 32, kb = item / nblk, nb = item % nblk, k0 = 64 * kb, n0 = 32 * nb;
    const bool okc = (n0 + (lane & 31)) < N;
    float tv[32];
#pragma unroll
    for (int i = 0; i < 32; ++i) { const int kk = 2 * i + (lane >> 5); tv[i] = okc ? __builtin_nontemporal_load(W + (size_t)(k0 + kk) * N + n0 + (lane & 31)) : 0.f; }
#pragma unroll
    for (int i = 0; i < 32; ++i) { const int kk = 2 * i + (lane >> 5); scr[kk * 33 + (lane & 31)] = tv[i]; }
    LDS_WAIT(); asm volatile("" ::: "memory");
    const int c = lane & 7;
#pragma unroll
    for (int j = 0; j < 4; ++j) { const int n = (lane >> 3) + 8 * j; const LAS float* s = scr + (8 * c) * 33 + n;
        v4u o; o.x = pk2(s[0 * 33], s[1 * 33]); o.y = pk2(s[2 * 33], s[3 * 33]); o.z = pk2(s[4 * 33], s[5 * 33]); o.w = pk2(s[6 * 33], s[7 * 33]);
        if (n0 + n < N) *(GAS v4u*)(WT + (size_t)map_row(mode, n0 + n) * ldk + k0 + 8 * c) = o; }
    LDS_WAIT(); asm volatile("" ::: "memory");
}
__device__ __forceinline__ void p0_prologue(Frame& F, const Args& A) {
    LAS float* scr = (LAS float*)(F.lds + F.wave * 16384);
    const int gw = F.bx * NWAVES + F.wave, NGW = F.G * NWAVES;
    const float* ffn_w1 = (const float*)A.in[13]; const float* ffn_w3 = (const float*)A.in[14]; const float* ffn_w2 = (const float*)A.in[15];
    const float* ev_w_in = (const float*)A.in[16]; const float* ev_w_out = (const float*)A.in[22]; const float* od_w_in = (const float*)A.in[23]; const float* od_w_out = (const float*)A.in[33];
    const float* w_uq = (const float*)A.in[25]; const float* w_uk = (const float*)A.in[27]; const float* w_uv = (const float*)A.in[28]; const float* ada_w = (const float*)A.in[10];
    constexpr int I_W1 = 16 * 88, I_W2 = 44 * 32, I_FFN = 2 * I_W1 + I_W2;
    constexpr int I_EVIN = 16 * 65, I_EVOUT = 8 * 32, I_ODIN = 16 * 53, I_ODOUT = 16 * 32, I_UQ = 6 * 24, I_UK = 4 * 16, I_ADA = 16 * 288;
    constexpr int NITEMS = 4 * I_FFN + I_EVIN + I_EVOUT + I_ODIN + I_ODOUT + I_UQ + 2 * I_UK + 2 * I_ADA;
    for (int it = gw; it < NITEMS; it += NGW) {
        int r = it;
        if (r < 4 * I_FFN) { const int i = r / I_FFN; r -= i * I_FFN;
            bf16* w13 = WS_PTR(bf16, WS_W13T + (size_t)i * W13T_STRIDE); bf16* w2 = WS_PTR(bf16, WS_W2T + (size_t)i * W2T_STRIDE);
            if (r < I_W1) { p0_transpose_item(ffn_w1 + (size_t)i * DM * FF, FF, w13, DM, RM_W1, scr, r, F.lane); continue; } r -= I_W1;
            if (r < I_W1) { p0_transpose_item(ffn_w3 + (size_t)i * DM * FF, FF, w13, DM, RM_W3, scr, r, F.lane); continue; } r -= I_W1;
            p0_transpose_item(ffn_w2 + (size_t)i * FF * DM, DM, w2, FF, RM_ID, scr, r, F.lane); continue; }
        r -= 4 * I_FFN;
        if (r < I_EVIN) { p0_transpose_item(ev_w_in, 2064, WS_PTR(bf16, WS_EVIN), DM, RM_EVIN, scr, r, F.lane); continue; } r -= I_EVIN;
        if (r < I_EVOUT) { p0_transpose_item(ev_w_out, DM, WS_PTR(bf16, WS_EVOUT), DM, RM_ID, scr, r, F.lane); continue; } r -= I_EVOUT;
        if (r < I_ODIN) { p0_transpose_item(od_w_in, 1696, WS_PTR(bf16, WS_ODIN), DM, RM_ID, scr, r, F.lane); continue; } r -= I_ODIN;
        if (r < I_ODOUT) { p0_transpose_item(od_w_out, DM, WS_PTR(bf16, WS_ODOUT), DM, RM_ID, scr, r, F.lane); continue; } r -= I_ODOUT;
        if (r < I_UQ) { p0_transpose_item(w_uq, 768, WS_PTR(bf16, WS_WUQ), 384, RM_ID, scr, r, F.lane); continue; } r -= I_UQ;
        if (r < I_UK) { p0_transpose_item(w_uk, 512, WS_PTR(bf16, WS_WKV), 256, RM_ID, scr, r, F.lane); continue; } r -= I_UK;
        if (r < I_UK) { p0_transpose_item(w_uv, 512, WS_PTR(bf16, WS_WKV) + 512 * 256, 256, RM_ID, scr, r, F.lane); continue; } r -= I_UK;
        { const int l = r / I_ADA; r -= l * I_ADA; p0_transpose_item(ada_w + (size_t)l * DM * 9216, 9216, WS_PTR(bf16, WS_ADAT) + (size_t)l * 9216 * DM, DM, RM_ID, scr, r, F.lane); }
    }
    { constexpr int NZ = (240 + 96) * (DM / 8);
      for (int i = F.bx * 512 + F.tid; i < NZ; i += F.G * 512) { const int rr = i / (DM / 8), c8 = i % (DM / 8);
          bf16* dst = rr < 240 ? WS_PTR(bf16, WS_EVIN) + (size_t)(2064 + rr) * DM : WS_PTR(bf16, WS_ODIN) + (size_t)(1696 + rr - 240) * DM;
          *(GAS v4u*)(dst + c8 * 8) = (v4u){0u, 0u, 0u, 0u}; } }
    { const float* pool_w = (const float*)A.in[20]; const float* pool_scale = (const float*)A.in[21]; bf16* evo = WS_PTR(bf16, WS_EVOUT);
      for (int it = gw; it < 512; it += NGW) { const int g = it >> 7, c = it & 127;
          f32x4 acc[4] = {{0.f, 0.f, 0.f, 0.f}, {0.f, 0.f, 0.f, 0.f}, {0.f, 0.f, 0.f, 0.f}, {0.f, 0.f, 0.f, 0.f}};
          for (int d = 0; d < 128; ++d) { const float a = pool_w[(size_t)(g * 128 + c) * 128 + d] * pool_scale[g * 128 + d];
              const float* wr = ev_w_out + (size_t)(512 + g * 128 + d) * DM + 4 * F.lane;
#pragma unroll
              for (int j = 0; j < 4; ++j) acc[j] += a * *(const f32x4*)(wr + 256 * j); }
#pragma unroll
          for (int j = 0; j < 4; ++j)
#pragma unroll
              for (int e = 0; e < 4; ++e) evo[(size_t)(256 * j + 4 * F.lane + e) * DM + 512 + g * 128 + c] = (bf16)f2bf(acc[j][e]); } }
    { const float* cp = (const float*)A.in[8]; const float* cs = (const float*)A.in[9]; bf16* sc = WS_PTR(bf16, WS_SC);
      for (int r = gw; r < 256; r += NGW) { const float* src = r < 2 ? cp + (size_t)r * DM : cs + (size_t)(r - 2) * DM;
#pragma unroll
          for (int j = 0; j < 4; ++j) { f32x4 v = {0.f, 0.f, 0.f, 0.f}; if (r < NBAT) v = *(const f32x4*)(src + 4 * F.lane + 256 * j);
              v2u o; o.x = r < NBAT ? pk2(siluf_(v[0]), siluf_(v[1])) : 0u; o.y = r < NBAT ? pk2(siluf_(v[2]), siluf_(v[3])) : 0u;
              *(GAS v2u*)(sc + (size_t)r * DM + 4 * F.lane + 256 * j) = o; } } }
    { const f32x4* xs = (const f32x4*)A.in[1]; f32x4* xd = (f32x4*)(WS_PTR(float, WS_X) + (size_t)MP * DM);
      for (int i = F.bx * 512 + F.tid; i < MS * DM / 4; i += F.G * 512) xd[i] = xs[i]; }
    { float* rt = WS_PTR(float, WS_RT);
      for (int i = F.bx * 512 + F.tid; i < 8196 * 16; i += F.G * 512) { const int pos = i >> 4, k = i & 15;
          const float freq = exp2f(-(float)k * 0.8304820237218406f);    const float ang = (float)pos * freq; float s, c; sincosf(ang, &s, &c);
          *(f32x2*)(rt + 2 * (size_t)i) = (f32x2){c, s}; } }
}

__device__ __forceinline__ void nm_phase(Frame& F, const float* bp, const float* bs, const float* g, const float* modsh, bf16* H, float* X, const float* slab, int nch, const float* pgate, float pcoef) {
    const int gw = F.bx * NWAVES + F.wave, NGW = F.G * NWAVES;
    f32x4 gv[4];
#pragma unroll
    for (int j = 0; j < 4; ++j) gv[j] = *(const f32x4*)(g + 4 * F.lane + 256 * j);
    for (int row = gw; row < MP; row += 2 * NGW) {
        const int row2 = row + NGW; const bool has2 = row2 < MP; const int r2 = has2 ? row2 : row;
        const float* xa = bp + (size_t)row * DM + 4 * F.lane; const float* xb = bp + (size_t)r2 * DM + 4 * F.lane;
        const float* ma = modsh + (size_t)(row >> 13) * MODLD + 4 * F.lane; const float* mb = modsh + (size_t)(r2 >> 13) * MODLD + 4 * F.lane;
        f32x4 va[4], vb[4], sha[4], sca[4], shb[4], scb[4]; float sa = 0.f, sb = 0.f;
#pragma unroll
        for (int j = 0; j < 4; ++j) { va[j] = *(const f32x4*)(xa + 256 * j); vb[j] = *(const f32x4*)(xb + 256 * j); }
#pragma unroll
        for (int j = 0; j < 4; ++j) { sha[j] = *(const f32x4*)(ma + 256 * j); sca[j] = *(const f32x4*)(ma + DM + 256 * j); shb[j] = *(const f32x4*)(mb + 256 * j); scb[j] = *(const f32x4*)(mb + DM + 256 * j); }
#pragma unroll
        for (int j = 0; j < 4; ++j) { sa += (va[j][0] * va[j][0] + va[j][1] * va[j][1]) + (va[j][2] * va[j][2] + va[j][3] * va[j][3]); sb += (vb[j][0] * vb[j][0] + vb[j][1] * vb[j][1]) + (vb[j][2] * vb[j][2] + vb[j][3] * vb[j][3]); }
#pragma unroll
        for (int o = 1; o < 64; o <<= 1) { sa += __shfl_xor(sa, o); sb += __shfl_xor(sb, o); }
        const float ra = 1.0f / sqrtf(sa * (1.0f / DM) + 1e-6f), rb2 = 1.0f / sqrtf(sb * (1.0f / DM) + 1e-6f);
#pragma unroll
        for (int j = 0; j < 4; ++j) { const f32x4 h = (va[j] * ra) * gv[j] * (sca[j] + 1.0f) + sha[j]; v2u o; o.x = pk2(h[0], h[1]); o.y = pk2(h[2], h[3]);
            *(GAS v2u*)(H + (size_t)row * DM + 4 * F.lane + 256 * j) = o; }
        if (has2) {
#pragma unroll
            for (int j = 0; j < 4; ++j) { const f32x4 h = (vb[j] * rb2) * gv[j] * (scb[j] + 1.0f) + shb[j]; v2u o; o.x = pk2(h[0], h[1]); o.y = pk2(h[2], h[3]);
                *(GAS v2u*)(H + (size_t)row2 * DM + 4 * F.lane + 256 * j) = o; } }
    }
    for (int row = MP + gw; row < MT; row += NGW) {
        const float* xr = bs + (size_t)row * DM + 4 * F.lane;
        f32x4 v[4]; float ss = 0.f;
#pragma unroll
        for (int j = 0; j < 4; ++j) v[j] = *(const f32x4*)(xr + 256 * j);
        if (nch > 0) { f32x4 a[4] = {{0.f, 0.f, 0.f, 0.f}, {0.f, 0.f, 0.f, 0.f}, {0.f, 0.f, 0.f, 0.f}, {0.f, 0.f, 0.f, 0.f}};
            for (int k = 0; k < nch; ++k) { const float* sp = slab + ((size_t)k * MS + (row - MP)) * DM + 4 * F.lane;
#pragma unroll
                for (int j = 0; j < 4; ++j) a[j] += *(const f32x4*)(sp + 256 * j); }
            const float* gp = pgate + (size_t)bidx(row) * MODLD + 4 * F.lane;
#pragma unroll
            for (int j = 0; j < 4; ++j) { v[j] += (*(const f32x4*)(gp + 256 * j) * pcoef) * a[j]; *(f32x4*)(X + (size_t)row * DM + 4 * F.lane + 256 * j) = v[j]; } }
#pragma unroll
        for (int j = 0; j < 4; ++j) ss += (v[j][0] * v[j][0] + v[j][1] * v[j][1]) + (v[j][2] * v[j][2] + v[j][3] * v[j][3]);
        const float rstd = 1.0f / sqrtf(wave_sum(ss) * (1.0f / DM) + 1e-6f);
        const float* mrow = modsh + (size_t)bidx(row) * MODLD + 4 * F.lane;
#pragma unroll
        for (int j = 0; j < 4; ++j) { const f32x4 sh = *(const f32x4*)(mrow + 256 * j), sc = *(const f32x4*)(mrow + DM + 256 * j);
            const f32x4 h = (v[j] * rstd) * gv[j] * (sc + 1.0f) + sh;
            v2u o; o.x = pk2(h[0], h[1]); o.y = pk2(h[2], h[3]);
            *(GAS v2u*)(H + (size_t)row * DM + 4 * F.lane + 256 * j) = o; }
    }
}
__device__ __forceinline__ void final_phase(Frame& F, const float* X, const float* g, float* out, const float* slab, int nch, const float* pgate, float pcoef) {
    const int gw = F.bx * NWAVES + F.wave, NGW = F.G * NWAVES;
    f32x4 gv[4];
#pragma unroll
    for (int j = 0; j < 4; ++j) gv[j] = *(const f32x4*)(g + 4 * F.lane + 256 * j);
    for (int row = gw; row < MT; row += NGW) {
        const float* xr = X + (size_t)row * DM + 4 * F.lane;
        f32x4 v[4]; float ss = 0.f;
#pragma unroll
        for (int j = 0; j < 4; ++j) v[j] = *(const f32x4*)(xr + 256 * j);
        if (row >= MP) { f32x4 a[4] = {{0.f, 0.f, 0.f, 0.f}, {0.f, 0.f, 0.f, 0.f}, {0.f, 0.f, 0.f, 0.f}, {0.f, 0.f, 0.f, 0.f}};
            for (int k = 0; k < nch; ++k) { const float* sp = slab + ((size_t)k * MS + (row - MP)) * DM + 4 * F.lane;
#pragma unroll
                for (int j = 0; j < 4; ++j) a[j] += *(const f32x4*)(sp + 256 * j); }
            const float* gp = pgate + (size_t)bidx(row) * MODLD + 4 * F.lane;
#pragma unroll
            for (int j = 0; j < 4; ++j) v[j] += (*(const f32x4*)(gp + 256 * j) * pcoef) * a[j]; }
#pragma unroll
        for (int j = 0; j < 4; ++j) ss += (v[j][0] * v[j][0] + v[j][1] * v[j][1]) + (v[j][2] * v[j][2] + v[j][3] * v[j][3]);
        const float rstd = 1.0f / sqrtf(wave_sum(ss) * (1.0f / DM) + 1e-6f);
#pragma unroll
        for (int j = 0; j < 4; ++j) *(f32x4*)(out + (size_t)row * DM + 4 * F.lane + 256 * j) = (v[j] * rstd) * gv[j];
    }
}
__device__ __forceinline__ float logsig16(float x) { return (fminf(x, 0.f) - __logf(1.0f + __expf(-fabsf(x)))) * (1.0f / 16.0f); }
__device__ __forceinline__ void gla_cumdecay(Frame& F, unsigned glw, int h, const float* gate_w2, const float* gate_b, LAS float* bcs, LAS float* gl, LAS float* seg) {
    const int tid = F.tid;
    { const int t = tid >> 3, j2 = (tid & 7) * 2; const unsigned w = glw;
      gl[t * 16 + j2] = bf2f((unsigned short)(w & 0xffffu)); gl[t * 16 + j2 + 1] = bf2f((unsigned short)(w >> 16)); }
    __syncthreads();
    { const int t = tid >> 3, dk8 = (tid & 7) * 8; float x[8];
      { const f32x4 b0 = *(const f32x4*)(gate_b + h * 64 + dk8), b1 = *(const f32x4*)(gate_b + h * 64 + dk8 + 4);
#pragma unroll
        for (int e = 0; e < 4; ++e) { x[e] = b0[e]; x[4 + e] = b1[e]; } }
#pragma unroll
      for (int j = 0; j < 16; ++j) { const float gv = gl[t * 16 + j]; const f32x4 w0 = *(const f32x4*)(gate_w2 + j * 256 + h * 64 + dk8), w1 = *(const f32x4*)(gate_w2 + j * 256 + h * 64 + dk8 + 4);
#pragma unroll
          for (int e = 0; e < 4; ++e) { x[e] += gv * w0[e]; x[4 + e] += gv * w1[e]; } }
#pragma unroll
      for (int e = 0; e < 8; ++e) bcs[t * 64 + dk8 + e] = logsig16(x[e]); }
    __syncthreads();
    { const int dk = tid & 63, sg = tid >> 6; float run = 0.f;
#pragma unroll
      for (int i = 0; i < 8; ++i) { run += bcs[(sg * 8 + i) * 64 + dk]; bcs[(sg * 8 + i) * 64 + dk] = run; }
      seg[sg * 64 + dk] = run; }
    __syncthreads();
    { const int dk = tid & 63, sg = tid >> 6; float pre = 0.f;
      for (int s = 0; s < sg; ++s) pre += seg[s * 64 + dk];
#pragma unroll
      for (int i = 0; i < 8; ++i) bcs[(sg * 8 + i) * 64 + dk] += pre; }
    __syncthreads();
}
constexpr int GK_ROW = 144, GV_ROW = 272;
__device__ __forceinline__ void gla_g1_unit(Frame& F, const Args& A, int unit) {
    const bf16* Z = WS_PTR(bf16, WS_Z); float* US = WS_PTR(float, WS_US); float* DS = WS_PTR(float, WS_DS);
    int tid = threadIdx.x; asm volatile("" : "+v"(tid)); F.tid = tid; F.lane = tid & 63; F.wave = __builtin_amdgcn_readfirstlane(tid >> 6);
    const int bh = unit >> 7, n = unit & 127, b = bh >> 2, h = bh & 3, row0 = b * TP + n * 64;
    LAS float* bcs = (LAS float*)F.lds; LAS float* gl = bcs + 4096; LAS float* seg = gl + 1024;
    LAS unsigned char* KK = F.lds + 24576; LAS unsigned char* VV = KK + 64 * GK_ROW;
    const int s = tid >> 3, dk8 = (tid & 7) * 8, dv16 = (tid & 7) * 16;
    const bf16* zr = Z + (size_t)(row0 + s) * ZE;
    const unsigned glw = *(const unsigned*)(zr + 2048 + (tid & 7) * 2); const v4u kw = *(const v4u*)(zr + 256 + h * 64 + dk8); const v4u vw0 = *(const v4u*)(zr + 512 + h * 128 + dv16), vw1 = *(const v4u*)(zr + 512 + h * 128 + dv16 + 8);
    gla_cumdecay(F, glw, h, (const float*)A.in[17], (const float*)A.in[18], bcs, gl, seg);
    { v4u o; f32x4 bq0, bq1;
#pragma unroll
      for (int e = 0; e < 4; ++e) { const unsigned w = kw[e]; const int d0 = dk8 + 2 * e; const float c0 = bcs[s * 64 + d0], c1 = bcs[s * 64 + d0 + 1];
          if (e < 2) { bq0[2 * e] = c0; bq0[2 * e + 1] = c1; } else { bq1[2 * e - 4] = c0; bq1[2 * e - 3] = c1; }
          o[e] = pk2(bf2f((unsigned short)(w & 0xffffu)) * __expf(bcs[63 * 64 + d0] - c0), bf2f((unsigned short)(w >> 16)) * __expf(bcs[63 * 64 + d0 + 1] - c1)); }
      *(LAS v4u*)(KK + s * GK_ROW + dk8 * 2) = o;
      float* bg = WS_PTR(float, WS_BCS) + (size_t)unit * 4096 + s * 64 + dk8; *(f32x4*)bg = bq0; *(f32x4*)(bg + 4) = bq1;
      *(LAS v4u*)(VV + s * GV_ROW + dv16 * 2) = vw0; *(LAS v4u*)(VV + s * GV_ROW + (dv16 + 8) * 2) = vw1;
      if (tid < 64) DS[(size_t)unit * 64 + tid] = __expf(bcs[63 * 64 + tid]); }
    __syncthreads();
    { const int lane = F.lane, wid = F.wave, r32 = lane & 31, hi = lane >> 5, g = lane >> 4, i16 = lane & 15, hg = g >> 1, dkt = wid & 1, dvt = wid >> 1;
      const int ka = (8 * hg + (i16 >> 2)) * GK_ROW + ((32 * dkt + 16 * (g & 1) + 4 * (i16 & 3)) << 1);
      const int va = (8 * hg + (i16 >> 2)) * GV_ROW + ((32 * dvt + 16 * (g & 1) + 4 * (i16 & 3)) << 1);
      f32x16 acc = {};
#pragma unroll
      for (int kk = 0; kk < 4; ++kk) { const s16x4 a0 = vtr(KK + ka + 16 * kk * GK_ROW), a1 = vtr(KK + ka + (16 * kk + 4) * GK_ROW), b0 = vtr(VV + va + 16 * kk * GV_ROW), b1 = vtr(VV + va + (16 * kk + 4) * GV_ROW);
          const bf16x8 af = {a0[0], a0[1], a0[2], a0[3], a1[0], a1[1], a1[2], a1[3]}, bfr = {b0[0], b0[1], b0[2], b0[3], b1[0], b1[1], b1[2], b1[3]};
          acc = __builtin_amdgcn_mfma_f32_32x32x16_bf16(af, bfr, acc, 0, 0, 0); }
      float* up = US + (size_t)unit * 8192 + 32 * dvt + r32;
#pragma unroll
      for (int r = 0; r < 16; ++r) up[(32 * dkt + crow(r, hi)) * 128] = acc[r]; }
    __syncthreads();
}
__device__ __forceinline__ void gla_g2_phase(Frame& F) {
    float* US = WS_PTR(float, WS_US); const float* DS = WS_PTR(float, WS_DS); float* outp = F.out + O_GLAP;
    for (int gid = F.bx * 512 + F.tid; gid < 8 * 8192; gid += F.G * 512) {
        const int bh = gid >> 13, e = gid & 8191, dk = e >> 7;
        float* up = US + (size_t)bh * 128 * 8192 + e; const float* dp = DS + (size_t)bh * 128 * 64 + dk; float S = 0.f;
        for (int n0 = 0; n0 < 128; n0 += 16) { float uu[16], dd[16];
#pragma unroll
            for (int i = 0; i < 16; ++i) { uu[i] = up[(size_t)(n0 + i) * 8192]; dd[i] = dp[(n0 + i) * 64]; }
#pragma unroll
            for (int i = 0; i < 16; ++i) { up[(size_t)(n0 + i) * 8192] = S; S = dd[i] * S + uu[i]; } }
        outp[gid] = S;
    }
}
__device__ __forceinline__ void gla_g3_unit(Frame& F, const Args& A, int unit) {
    const bf16* Z = WS_PTR(bf16, WS_Z); const float* US = WS_PTR(float, WS_US); bf16* OP = WS_PTR(bf16, WS_OP);
    int tid = threadIdx.x; asm volatile("" : "+v"(tid)); F.tid = tid; F.lane = tid & 63; F.wave = __builtin_amdgcn_readfirstlane(tid >> 6);
    const int bh = unit >> 7, n = unit & 127, b = bh >> 2, h = bh & 3, row0 = b * TP + n * 64;
    LAS float* red = (LAS float*)F.lds + 5632;
    LAS unsigned char* QI = F.lds + 24576; LAS unsigned char* KI = QI + 64 * GK_ROW; LAS unsigned char* SS = KI + 64 * GK_ROW; LAS unsigned char* VV = SS + 64 * GV_ROW;
    { const int t = tid >> 3, dk8 = (tid & 7) * 8, dv16 = (tid & 7) * 16; const bf16* zr = Z + (size_t)(row0 + t) * ZE;
      const float* bg = WS_PTR(float, WS_BCS) + (size_t)unit * 4096 + t * 64 + dk8; const f32x4 bq0 = *(const f32x4*)bg, bq1 = *(const f32x4*)(bg + 4);
      const v4u qw = *(const v4u*)(zr + h * 64 + dk8), kw = *(const v4u*)(zr + 256 + h * 64 + dk8), vw0 = *(const v4u*)(zr + 512 + h * 128 + dv16), vw1 = *(const v4u*)(zr + 512 + h * 128 + dv16 + 8);
      f32x4 sv[4];
#pragma unroll
      for (int j = 0; j < 4; ++j) sv[j] = *(const f32x4*)(US + (size_t)unit * 8192 + 4 * (tid + 512 * j));
      v4u qo, ko;
#pragma unroll
      for (int e = 0; e < 4; ++e) { const float b0 = e < 2 ? bq0[2 * e] : bq1[2 * e - 4], b1 = e < 2 ? bq0[2 * e + 1] : bq1[2 * e - 3];
          qo[e] = pk2(0.125f * bf2f((unsigned short)(qw[e] & 0xffffu)) * __expf(b0), 0.125f * bf2f((unsigned short)(qw[e] >> 16)) * __expf(b1));
          ko[e] = pk2(bf2f((unsigned short)(kw[e] & 0xffffu)) * __expf(-b0), bf2f((unsigned short)(kw[e] >> 16)) * __expf(-b1)); }
      *(LAS v4u*)(QI + t * GK_ROW + dk8 * 2) = qo; *(LAS v4u*)(KI + t * GK_ROW + dk8 * 2) = ko;
      *(LAS v4u*)(VV + t * GV_ROW + dv16 * 2) = vw0; *(LAS v4u*)(VV + t * GV_ROW + (dv16 + 8) * 2) = vw1;
#pragma unroll
      for (int j = 0; j < 4; ++j) { const int e4 = 4 * (tid + 512 * j), dk = e4 >> 7, dv = e4 & 127;
          v2u so; so.x = pk2(sv[j][0], sv[j][1]); so.y = pk2(sv[j][2], sv[j][3]); *(LAS v2u*)(SS + dk * GV_ROW + dv * 2) = so; } }
    __syncthreads();
    const int lane = F.lane, wid = F.wave, r32 = lane & 31, hi = lane >> 5, g = lane >> 4, i16 = lane & 15, hg = g >> 1, dvt = wid & 3, tt = wid >> 2;
    f32x16 o = {};
    { bf16x8 qf[4];
#pragma unroll
      for (int kk = 0; kk < 4; ++kk) qf[kk] = *(const LAS bf16x8*)(QI + (32 * tt + r32) * GK_ROW + (hi << 4) + 32 * kk);
      const int sa = (8 * hg + (i16 >> 2)) * GV_ROW + ((32 * dvt + 16 * (g & 1) + 4 * (i16 & 3)) << 1);
#pragma unroll
      for (int kk = 0; kk < 4; ++kk) { const s16x4 a0 = vtr(SS + sa + 16 * kk * GV_ROW), a1 = vtr(SS + sa + (16 * kk + 4) * GV_ROW);
          const bf16x8 af = {a0[0], a0[1], a0[2], a0[3], a1[0], a1[1], a1[2], a1[3]};
          o = __builtin_amdgcn_mfma_f32_32x32x16_bf16(af, qf[kk], o, 0, 0, 0); }
      const int va = (4 * hg + (i16 >> 2)) * GV_ROW + ((32 * dvt + 16 * (g & 1) + 4 * (i16 & 3)) << 1);
      for (int st = 0; st <= tt; ++st) { f32x16 at = {};
#pragma unroll
          for (int kk = 0; kk < 4; ++kk) { const bf16x8 kf = *(const LAS bf16x8*)(KI + (32 * st + r32) * GK_ROW + (hi << 4) + 32 * kk); at = __builtin_amdgcn_mfma_f32_32x32x16_bf16(kf, qf[kk], at, 0, 0, 0); }
          if (st == tt) {
#pragma unroll
              for (int r = 0; r < 16; ++r) if (crow(r, hi) > r32) at[r] = 0.f; }
#pragma unroll
          for (int s2 = 0; s2 < 2; ++s2) { const bf16x8 pb = pack8(at, 8 * s2);
              const s16x4 lo = vtr(VV + va + (32 * st + 16 * s2) * GV_ROW), hh = vtr(VV + va + (32 * st + 16 * s2 + 8) * GV_ROW);
              const bf16x8 vf = {lo[0], lo[1], lo[2], lo[3], hh[0], hh[1], hh[2], hh[3]};
              o = __builtin_amdgcn_mfma_f32_32x32x16_bf16(vf, pb, o, 0, 0, 0); } } }
    { float ss = 0.f;
#pragma unroll
      for (int r = 0; r < 16; ++r) ss += o[r] * o[r];
      ss = xhalf_sum(ss); if (hi == 0) red[dvt * 64 + 32 * tt + r32] = ss; }
    __syncthreads();
    { const int t = 32 * tt + r32; const float tot = (red[t] + red[64 + t]) + (red[128 + t] + red[192 + t]); const float rstd = 1.0f / sqrtf(tot * (1.0f / 128.0f) + 1e-6f);
      const int row = row0 + t;
#pragma unroll
      for (int rq = 0; rq < 4; ++rq) { const int dv0 = 32 * dvt + 8 * rq + 4 * hi; const f32x4 gn = *(const f32x4*)((const float*)A.in[19] + h * 128 + dv0);
          const v2u rw = *(const v2u*)(Z + (size_t)row * ZE + 1024 + h * 128 + dv0);
          const float r0 = bf2f((unsigned short)(rw.x & 0xffffu)), r1 = bf2f((unsigned short)(rw.x >> 16)), r2 = bf2f((unsigned short)(rw.y & 0xffffu)), r3 = bf2f((unsigned short)(rw.y >> 16));
          v2u ow; ow.x = pk2(o[4 * rq] * rstd * gn[0] * siluf_(r0), o[4 * rq + 1] * rstd * gn[1] * siluf_(r1)); ow.y = pk2(o[4 * rq + 2] * rstd * gn[2] * siluf_(r2), o[4 * rq + 3] * rstd * gn[3] * siluf_(r3));
          *(GAS v2u*)(OP + (size_t)row * DM + h * 128 + dv0) = ow; } }
    __syncthreads();
}
__device__ __forceinline__ void gla_sample_unit(Frame& F, const Args& A, int unit) {
    const bf16* Z = WS_PTR(bf16, WS_Z); bf16* OP = WS_PTR(bf16, WS_OP);
    const float* gate_w2 = (const float*)A.in[17]; const float* gate_b = (const float*)A.in[18]; const float* S0g = (const float*)A.in[2] + (size_t)unit * 8192; float* Sout = F.out + O_GLAS + (size_t)unit * 8192;
    int tid = threadIdx.x; asm volatile("" : "+v"(tid)); F.tid = tid; F.lane = tid & 63; F.wave = __builtin_amdgcn_readfirstlane(tid >> 6);
    const int b = unit >> 2, h = unit & 3, row0 = MP + 4 * b;
    LAS float* S0 = (LAS float*)F.lds; LAS float* bc = S0 + 8192; LAS float* qi = bc + 256; LAS float* ki = qi + 256; LAS float* kk = ki + 256; LAS float* vv = kk + 256; LAS float* att = vv + 512; LAS float* gl = att + 16; LAS float* red = gl + 64;
#pragma unroll
    for (int j = 0; j < 4; ++j) *(LAS f32x4*)(S0 + 4 * (tid + 512 * j)) = *(const f32x4*)(S0g + 4 * (tid + 512 * j));
    if (tid < 64) gl[tid] = bf2f(Z[(size_t)(row0 + (tid >> 4)) * ZE + 2048 + (tid & 15)]);
    vv[tid] = bf2f(Z[(size_t)(row0 + (tid >> 7)) * ZE + 512 + h * 128 + (tid & 127)]);
    __syncthreads();
    if (tid < 256) { const int t = tid >> 6, dk = tid & 63; float x = gate_b[h * 64 + dk];
#pragma unroll
        for (int j = 0; j < 16; ++j) x += gl[t * 16 + j] * gate_w2[j * 256 + h * 64 + dk];
        bc[t * 64 + dk] = logsig16(x); }
    __syncthreads();
    if (tid < 64) { float run = 0.f;
#pragma unroll
        for (int t = 0; t < 4; ++t) { run += bc[t * 64 + tid]; bc[t * 64 + tid] = run; } }
    __syncthreads();
    if (tid < 256) { const int t = tid >> 6, dk = tid & 63; const float bb = bc[t * 64 + dk], bl = bc[3 * 64 + dk];
        const float qv = bf2f(Z[(size_t)(row0 + t) * ZE + h * 64 + dk]), kv = bf2f(Z[(size_t)(row0 + t) * ZE + 256 + h * 64 + dk]);
        qi[t * 64 + dk] = 0.125f * qv * __expf(bb); ki[t * 64 + dk] = kv * __expf(-bb); kk[t * 64 + dk] = kv * __expf(bl - bb); }
    __syncthreads();
    if (tid < 16) { const int t = tid >> 2, s = tid & 3; float a = 0.f;
        for (int dk = 0; dk < 64; ++dk) a += qi[t * 64 + dk] * ki[s * 64 + dk];
        att[tid] = (s <= t) ? a : 0.f; }
    __syncthreads();
    { const int t = tid >> 7, dv = tid & 127; float o = 0.f;
#pragma unroll 8
      for (int dk = 0; dk < 64; ++dk) o += qi[t * 64 + dk] * S0[dk * 128 + dv];
#pragma unroll
      for (int s = 0; s < 4; ++s) o += att[t * 4 + s] * vv[s * 128 + dv];
      const float ss = wave_sum(o * o); if (F.lane == 0) red[F.wave] = ss;
      __syncthreads();
      const float tot = red[2 * t] + red[2 * t + 1]; const float rstd = 1.0f / sqrtf(tot * (1.0f / 128.0f) + 1e-6f);
      const float gn = ((const float*)A.in[19])[h * 128 + dv]; const float rr = bf2f(Z[(size_t)(row0 + t) * ZE + 1024 + h * 128 + dv]);
      OP[(size_t)(row0 + t) * DM + h * 128 + dv] = (bf16)f2bf(o * rstd * gn * siluf_(rr)); }
#pragma unroll
    for (int j = 0; j < 4; ++j) { const int e = 4 * (tid + 512 * j), dk = e >> 7, dv = e & 127; const float dec = __expf(bc[3 * 64 + dk]);
        f32x4 sn = *(const LAS f32x4*)(S0 + e) * dec;
#pragma unroll
        for (int s = 0; s < 4; ++s) sn += kk[s * 64 + dk] * *(const LAS f32x4*)(vv + s * 128 + dv);
        *(f32x4*)(Sout + e) = sn; }
    __syncthreads();
}
__device__ __forceinline__ void pool_prompt_unit(Frame& F, int unit) {
    const bf16* Z = WS_PTR(bf16, WS_Z); bf16* OP = WS_PTR(bf16, WS_OP); float* hp = F.out + O_POOLP;
    int c = threadIdx.x; asm volatile("" : "+v"(c));
    const int b = unit >> 7, t0 = (unit & 127) * 64, w = 2 << (c >> 7); const size_t rb = (size_t)b * TP;
    float s = 0.f;
    { float pv[16];
#pragma unroll
      for (int j = 0; j < 16; ++j) { const int t = t0 - 1 - j; pv[j] = (j < w && t >= 0) ? bf2f(Z[(rb + t) * ZE + 1536 + c]) : 0.f; }
#pragma unroll
      for (int j = 0; j < 16; ++j) s += pv[j]; }
#pragma unroll 1
    for (int tb = t0; tb < t0 + 64; tb += 16) { float uv[16], ov[16];
#pragma unroll
        for (int j = 0; j < 16; ++j) { const int t = tb + j; uv[j] = bf2f(Z[(rb + t) * ZE + 1536 + c]); ov[j] = (t - w >= 0) ? bf2f(Z[(rb + t - w) * ZE + 1536 + c]) : 0.f; }
#pragma unroll
        for (int j = 0; j < 16; ++j) { const int t = tb + j; s += uv[j]; s -= ov[j];
            const float cnt = (float)((t + 1 < w) ? t + 1 : w);
            OP[(rb + t) * DM + 512 + c] = (bf16)f2bf(s / cnt - uv[j]);
            if (t >= TP - 15) hp[((size_t)b * 15 + (t - (TP - 15))) * 512 + c] = uv[j]; } }
}
__device__ __forceinline__ void pool_sample_unit(Frame& F, const Args& A, int b) {
    const bf16* Z = WS_PTR(bf16, WS_Z); bf16* OP = WS_PTR(bf16, WS_OP); float* hs = F.out + O_POOLS + (size_t)b * 15 * 512; const float* hin = (const float*)A.in[3] + (size_t)b * 15 * 512;
    int c = threadIdx.x; asm volatile("" : "+v"(c));
    const int w = 2 << (c >> 7); float full[19];
#pragma unroll
    for (int i = 0; i < 15; ++i) full[i] = hin[i * 512 + c];
#pragma unroll
    for (int t = 0; t < 4; ++t) full[15 + t] = bf2f(Z[(size_t)(MP + 4 * b + t) * ZE + 1536 + c]);
#pragma unroll
    for (int t = 0; t < 4; ++t) { float s = 0.f;
#pragma unroll
        for (int j = 0; j < 16; ++j) if (j < w) s += full[15 + t - j];
        OP[(size_t)(MP + 4 * b + t) * DM + 512 + c] = (bf16)f2bf(s / (float)w - full[15 + t]); }
#pragma unroll
    for (int i = 0; i < 15; ++i) hs[i * 512 + c] = full[4 + i];
}
__device__ __forceinline__ void even_mid_phase(Frame& F, const Args& A) {
    constexpr int N1 = 1024, N2 = 512, N3 = 256, N4 = 128;
    for (int u = F.bx; u < N1 + N2 + N3 + N4; u += F.G) {
        if (u < N1) gla_g1_unit(F, A, u);
        else if (u < N1 + N2) gla_sample_unit(F, A, u - N1);
        else if (u < N1 + N2 + N3) pool_prompt_unit(F, u - N1 - N2);
        else pool_sample_unit(F, A, u - N1 - N2 - N3);
    }
}
__device__ __forceinline__ void odd_rows(Frame& F, const Args& A) {
    const bf16* Z = WS_PTR(bf16, WS_Z); bf16* CQN = WS_PTR(bf16, WS_CQN); bf16* CKVB = WS_PTR(bf16, WS_CKVB); bf16* KRB = WS_PTR(bf16, WS_KRB); const float* rt = WS_PTR(float, WS_RT);
    const float* q_norm = (const float*)A.in[24]; const float* kv_norm = (const float*)A.in[26];
    const int gw = F.bx * NWAVES + F.wave, NGW = F.G * NWAVES, lane = F.lane;
    for (int row = gw; row < MT; row += NGW) {
        const bf16* zr = Z + (size_t)row * ZO;
        { float v[6]; float ss = 0.f;
#pragma unroll
          for (int j = 0; j < 3; ++j) { const unsigned w = *(const unsigned*)(zr + 2 * lane + 128 * j); v[2 * j] = bf2f((unsigned short)(w & 0xffffu)); v[2 * j + 1] = bf2f((unsigned short)(w >> 16)); ss += v[2 * j] * v[2 * j] + v[2 * j + 1] * v[2 * j + 1]; }
          const float rstd = 1.0f / sqrtf(wave_sum(ss) * (1.0f / 384.0f) + 1e-6f);
#pragma unroll
          for (int j = 0; j < 3; ++j) { const int c = 2 * lane + 128 * j; *(GAS unsigned*)(CQN + (size_t)row * 384 + c) = pk2(v[2 * j] * rstd * q_norm[c], v[2 * j + 1] * rstd * q_norm[c + 1]); } }
        { const v2u w = *(const v2u*)(zr + 384 + 4 * lane); f32x4 v = {bf2f((unsigned short)(w.x & 0xffffu)), bf2f((unsigned short)(w.x >> 16)), bf2f((unsigned short)(w.y & 0xffffu)), bf2f((unsigned short)(w.y >> 16))};
          const float ss = wave_sum((v[0] * v[0] + v[1] * v[1]) + (v[2] * v[2] + v[3] * v[3])); const float rstd = 1.0f / sqrtf(ss * (1.0f / 256.0f) + 1e-6f);
          const f32x4 o = (v * rstd) * *(const f32x4*)(kv_norm + 4 * lane);
          *(f32x4*)(F.out + O_CKV + (size_t)row * 256 + 4 * lane) = o;
          v2u ob; ob.x = pk2(o[0], o[1]); ob.y = pk2(o[2], o[3]); *(GAS v2u*)(CKVB + (size_t)row * 256 + 4 * lane) = ob; }
        if (lane < 16) { const float x1 = bf2f(zr[640 + lane]), x2 = bf2f(zr[640 + 16 + lane]); const f32x2 cs = *(const f32x2*)(rt + (size_t)posof(row) * 32 + 2 * lane);
          const float o1 = x1 * cs[0] - x2 * cs[1], o2 = x2 * cs[0] + x1 * cs[1];
          F.out[O_KR + (size_t)row * 32 + lane] = o1; F.out[O_KR + (size_t)row * 32 + 16 + lane] = o2;
          KRB[(size_t)row * 32 + lane] = (bf16)f2bf(o1); KRB[(size_t)row * 32 + 16 + lane] = (bf16)f2bf(o2); }
    }
}
template <bool SAMPLE> __device__ __forceinline__ void conv_unit(Frame& F, const Args& A, int unit) {
    constexpr int NTOK = SAMPLE ? 4 : 32, NR = NTOK + 30;
    const bf16* Z = WS_PTR(bf16, WS_Z); bf16* OP = WS_PTR(bf16, WS_OP);
    const float* conv_w = (const float*)A.in[29]; const float* conv_b = (const float*)A.in[30]; const float* ng = (const float*)A.in[31]; const float* nb = (const float*)A.in[32];
    int c = threadIdx.x; asm volatile("" : "+v"(c)); const int lane = c & 63, wave = __builtin_amdgcn_readfirstlane(c >> 6);
    LAS float* cvl = (LAS float*)F.lds;
    LAS float* stat = cvl + 32 * 512;
    const int b = SAMPLE ? unit : (unit >> 8), t0 = SAMPLE ? 0 : (unit & 255) * 32; const size_t rb = SAMPLE ? (size_t)(MP + 4 * b) : (size_t)b * TP;
    float u[NR];
    { bf16 av[NR], gv[NR];
#pragma unroll
      for (int rr = 0; rr < NR; ++rr) { const int t = t0 - 30 + rr; av[rr] = 0; gv[rr] = 0; u[rr] = 0.f;
          if (t >= 0) { const bf16* zr = Z + (rb + t) * ZO; av[rr] = zr[672 + c]; gv[rr] = zr[1184 + c]; }
          else if (SAMPLE) u[rr] = ((const float*)A.in[6])[((size_t)b * 30 + rr) * 512 + c]; }
#pragma unroll
      for (int rr = 0; rr < NR; ++rr) { const int t = t0 - 30 + rr; if (t >= 0) u[rr] = bf2f(av[rr]) * sigmoidf_(bf2f(gv[rr])); } }
    if (SAMPLE) { float* cs = F.out + O_CONVS + (size_t)b * 30 * 512;
#pragma unroll
        for (int i = 0; i < 30; ++i) cs[i * 512 + c] = u[4 + i]; }
    else if (t0 == TP - 32) { float* cp = F.out + O_CONVP + (size_t)b * 30 * 512;
#pragma unroll
        for (int i = 0; i < 30; ++i) cp[i * 512 + c] = u[32 + i]; }
    float cv[NTOK];
    { const float bias = conv_b[c];
#pragma unroll
      for (int tt = 0; tt < NTOK; ++tt) cv[tt] = bias;
#pragma unroll
      for (int j = 0; j < 31; ++j) { const float w = conv_w[j * 512 + c];
#pragma unroll
          for (int tt = 0; tt < NTOK; ++tt) cv[tt] += w * u[tt + j]; } }
#pragma unroll
    for (int tt = 0; tt < NTOK; ++tt) cvl[tt * 512 + c] = cv[tt];
    __syncthreads();
    for (int tt = wave; tt < NTOK; tt += NWAVES) { float s1 = 0.f, s2 = 0.f;
#pragma unroll
        for (int j = 0; j < 8; ++j) { const float x = cvl[tt * 512 + lane + 64 * j]; s1 += x; s2 += x * x; }
        s1 = wave_sum(s1); s2 = wave_sum(s2); const float mean = s1 * (1.0f / 512.0f); const float var = fmaxf(s2 * (1.0f / 512.0f) - mean * mean, 0.f);
        if (lane == 0) { stat[2 * tt] = mean; stat[2 * tt + 1] = 1.0f / sqrtf(var + 1e-6f); } }
    __syncthreads();
    const float gg = ng[c], bb = nb[c];
#pragma unroll
    for (int tt = 0; tt < NTOK; ++tt) { const float y = (cv[tt] - stat[2 * tt]) * stat[2 * tt + 1] * gg + bb;
        OP[(rb + t0 + tt) * DM + 512 + c] = (bf16)f2bf(siluf_(y)); }
    __syncthreads();
}
__device__ __forceinline__ void odd_thin_phase(Frame& F, const Args& A) {
    odd_rows(F, A);
    for (int u = F.bx; u < 512 + 128; u += F.G) { if (u < 512) conv_unit<false>(F, A, u); else conv_unit<true>(F, A, u - 512); }
}
constexpr int PA_KROW = 208, PA_VROW = 144, PA_VOFF = 64 * PA_KROW, PA_BUF = PA_VOFF + 64 * PA_VROW;
__device__ __forceinline__ void pattn_unit(Frame& F, int b, int h, int qb) {
    const bf16* Q = WS_PTR(bf16, WS_Q); const bf16* KV = WS_PTR(bf16, WS_KV); const bf16* KRB = WS_PTR(bf16, WS_KRB); bf16* OP = WS_PTR(bf16, WS_OP);
    int tid = threadIdx.x; asm volatile("" : "+v"(tid));
    const int lane = tid & 63, wid = __builtin_amdgcn_readfirstlane(tid >> 6), r32 = lane & 31, hi = lane >> 5;
    const size_t rb = (size_t)b * TP; const int q0w = 256 * qb + 32 * wid, NT = 4 * (qb + 1);
    LAS unsigned char* L = F.lds;
    const int skey = tid >> 3, sc = tid & 7, rkey = (tid & 255) >> 2, rc = tid & 3;
    const bf16* gk = KV + (rb + skey) * 1024 + h * 64 + 8 * sc; const bf16* gv = gk + 512; const bf16* gr = KRB + (rb + rkey) * 32 + 8 * rc;
    const int lk = skey * PA_KROW + (sc << 4), lv = PA_VOFF + skey * PA_VROW + (sc << 4), lr = rkey * PA_KROW + ((8 + rc) << 4);
    v4u skA, svA, srA, skB, svB, srB;
#define PA_LOAD(kt, X) do { const int t_ = (kt) < NT ? (kt) : NT - 1; sk##X = *(const v4u*)(gk + (size_t)t_ * 64 * 1024); sv##X = *(const v4u*)(gv + (size_t)t_ * 64 * 1024); sr##X = *(const v4u*)(gr + (size_t)t_ * 64 * 32); } while (0)
#define PA_STORE(bufo, X) do { *(LAS v4u*)(L + (bufo) + lk) = sk##X; *(LAS v4u*)(L + (bufo) + lv) = sv##X; if (tid < 256) *(LAS v4u*)(L + (bufo) + lr) = sr##X; } while (0)
    PA_LOAD(0, A); PA_LOAD(1, B);
    bf16x8 qf[6];
    { const bf16* qp = Q + (rb + q0w + r32) * 768 + h * 96 + 8 * hi;
#pragma unroll
      for (int kk = 0; kk < 6; ++kk) qf[kk] = *(const bf16x8*)(qp + 16 * kk); }
    f32x16 o0 = {}, o1 = {}, negm = {}; float mref = 0.f, lrun = 0.f;
    PA_STORE(0, A);
    LBAR();
    PA_LOAD(2, A);
    const int aoffk = r32 * PA_KROW + (hi << 4);
    const int g = lane >> 4, i16 = lane & 15, hg = g >> 1;
    const int voff = PA_VOFF + (4 * hg + (i16 >> 2)) * PA_VROW + ((16 * (g & 1) + 4 * (i16 & 3)) << 1);
#define PA_ITER(kt, bufo, bufn, X) do { \
        if (64 * (kt) <= q0w + 31) { \
 \
            f32x16 p0 = negm, p1 = negm; \
            { bf16x8 ka[12]; \
_Pragma("unroll") \
              for (int kk = 0; kk < 6; ++kk) { ka[2 * kk] = *(const LAS bf16x8*)(L + bufo + aoffk + 32 * kk); ka[2 * kk + 1] = *(const LAS bf16x8*)(L + bufo + aoffk + 32 * PA_KROW + 32 * kk); } \
_Pragma("unroll") \
              for (int kk = 0; kk < 6; ++kk) { p0 = __builtin_amdgcn_mfma_f32_32x32x16_bf16(ka[2 * kk], qf[kk], p0, 0, 0, 0); p1 = __builtin_amdgcn_mfma_f32_32x32x16_bf16(ka[2 * kk + 1], qf[kk], p1, 0, 0, 0); } } \
            s16x4 vlo[8], vhi[8]; \
_Pragma("unroll") \
            for (int hf = 0; hf < 2; ++hf) \
_Pragma("unroll") \
                for (int s = 0; s < 2; ++s) \
_Pragma("unroll") \
                    for (int dt = 0; dt < 2; ++dt) { const int a0 = bufo + voff + (32 * hf + 16 * s) * PA_VROW + 64 * dt; vlo[(hf * 2 + s) * 2 + dt] = vtr(L + a0); vhi[(hf * 2 + s) * 2 + dt] = vtr(L + a0 + 8 * PA_VROW); } \
            if (64 * (kt) + 63 > q0w) { const int qq = q0w + r32; \
_Pragma("unroll") \
                for (int r = 0; r < 16; ++r) { const int key = 64 * (kt) + crow(r, hi); if (key > qq) p0[r] = -INFINITY; if (key + 32 > qq) p1[r] = -INFINITY; } } \
            float mt = fmaxf(fmaxf(p0[0], p1[0]), fmaxf(p0[1], p1[1])); \
_Pragma("unroll") \
            for (int r = 2; r < 16; r += 2) mt = fmaxf(fmaxf(mt, fmaxf(p0[r], p1[r])), fmaxf(p0[r + 1], p1[r + 1])); \
            mt = xhalf_max(mt); \
            if ((kt) == 0 || __any(mt > 8.0f)) { \
                const float dl = ((kt) == 0) ? mt : fmaxf(mt, 0.f), alpha = ((kt) == 0) ? 1.0f : __builtin_amdgcn_exp2f(-dl); mref += dl; lrun *= alpha; \
_Pragma("unroll") \
                for (int r = 0; r < 16; ++r) { p0[r] -= dl; p1[r] -= dl; o0[r] *= alpha; o1[r] *= alpha; negm[r] = -mref; } } \
            float rs = 0.f; \
_Pragma("unroll") \
            for (int r = 0; r < 16; ++r) { p0[r] = __builtin_amdgcn_exp2f(p0[r]); p1[r] = __builtin_amdgcn_exp2f(p1[r]); rs += p0[r] + p1[r]; } \
            lrun += xhalf_sum(rs); \
_Pragma("unroll") \
            for (int hf = 0; hf < 2; ++hf) \
_Pragma("unroll") \
                for (int s = 0; s < 2; ++s) { const bf16x8 pb = pack8(hf ? p1 : p0, 8 * s); \
_Pragma("unroll") \
                    for (int dt = 0; dt < 2; ++dt) { const s16x4 lo = vlo[(hf * 2 + s) * 2 + dt], hh = vhi[(hf * 2 + s) * 2 + dt]; \
                        const bf16x8 va = {lo[0], lo[1], lo[2], lo[3], hh[0], hh[1], hh[2], hh[3]}; \
                        if (dt == 0) o0 = __builtin_amdgcn_mfma_f32_32x32x16_bf16(va, pb, o0, 0, 0, 0); else o1 = __builtin_amdgcn_mfma_f32_32x32x16_bf16(va, pb, o1, 0, 0, 0); } } \
        } \
        if ((kt) + 1 < NT) PA_STORE(bufn, X); \
        LBAR(); \
        PA_LOAD((kt) + 3, X); } while (0)
    for (int kt = 0; kt < NT; kt += 2) { PA_ITER(kt, 0, PA_BUF, B); PA_ITER(kt + 1, PA_BUF, 0, A); }
#undef PA_ITER
#undef PA_LOAD
#undef PA_STORE
    const float rl = 1.0f / lrun;
    bf16* op = OP + (rb + q0w + r32) * DM + h * 64;
#pragma unroll
    for (int dt = 0; dt < 2; ++dt)
#pragma unroll
        for (int rq = 0; rq < 4; ++rq) { const f32x16& o = dt ? o1 : o0; v2u w; w.x = pk2(o[4 * rq] * rl, o[4 * rq + 1] * rl); w.y = pk2(o[4 * rq + 2] * rl, o[4 * rq + 3] * rl);
            *(GAS v2u*)(op + 32 * dt + 8 * rq + 4 * hi) = w; }
}

constexpr int DT_ROW = 592, DT_TILE = 64 * DT_ROW, DT_QOFF = 2 * DT_TILE, DT_QN = DT_QOFF + 32 * DT_ROW, DT_ML = 133120;
__device__ __forceinline__ void dattn_unit(Frame& F, const Args& A, int unit) {
    const bf16* Q = WS_PTR(bf16, WS_Q); float* PART = WS_PTR(float, WS_PART) + (size_t)unit * PART_F; float* QD = WS_PTR(float, WS_QD);
    const float* cckv = (const float*)A.in[4]; const float* ckr = (const float*)A.in[5]; const int* ptab = (const int*)A.in[7]; const float* w_uk = (const float*)A.in[27];
    int tid = threadIdx.x; asm volatile("" : "+v"(tid));
    const int lane = tid & 63, wid = __builtin_amdgcn_readfirstlane(tid >> 6), r32 = lane & 31, hi = lane >> 5, b = unit / NSPLIT, sp = unit % NSPLIT;
    LAS unsigned char* L = F.lds; LAS float* qn = (LAS float*)(L + DT_QN); LAS float* ml = (LAS float*)(L + DT_ML);
    const f32x4* dummy = (const f32x4*)WS_PTR(float, WS_DUMMY);
    LAS int* pidl = (LAS int*)(L + DT_ML + 2048);
    constexpr int NPG = 64 / NSPLIT, NTL = 2 * NPG;
    if (tid < NPG) pidl[tid] = ptab[b * 64 + sp * NPG + tid];
    __syncthreads();
    f32x4 st0[9], st1[9];
    const int wofs = (tid >> 6) * DT_ROW + (tid & 63) * 8, wofr = (tid >> 3) * DT_ROW + 512 + (tid & 7) * 8;
#define DT_LOAD(tl, st) do { const int t_ = (tl); const bool real_ = t_ < NTL; const int pid = pidl[real_ ? (t_ >> 1) : 0]; \
        const f32x4* pc = real_ ? (const f32x4*)(cckv + ((size_t)pid * 128 + (t_ & 1) * 64) * 256) : dummy; const f32x4* pr = real_ ? (const f32x4*)(ckr + ((size_t)pid * 128 + (t_ & 1) * 64) * 32) : dummy; \
        _Pragma("unroll") for (int i = 0; i < 8; ++i) st[i] = __builtin_nontemporal_load(pc + tid + 512 * i); \
        st[8] = __builtin_nontemporal_load(pr + tid); } while (0)
#define DT_STORE(bufo, st) do { _Pragma("unroll") for (int i = 0; i < 8; ++i) { v2u w_; w_.x = pg8::cvt_pk_bf16(st[i][0], st[i][1]); w_.y = pg8::cvt_pk_bf16(st[i][2], st[i][3]); *(LAS v2u*)(L + (bufo) + wofs + i * 8 * DT_ROW) = w_; } \
        { v2u w_; w_.x = pg8::cvt_pk_bf16(st[8][0], st[8][1]); w_.y = pg8::cvt_pk_bf16(st[8][2], st[8][3]); *(LAS v2u*)(L + (bufo) + wofr) = w_; } } while (0)
    DT_LOAD(0, st0); DT_LOAD(1, st1);
    { const int t = tid >> 7, c6 = (tid & 127) * 6;
      const bf16* qp = Q + (size_t)(MP + 4 * b + t) * 768 + c6;
#pragma unroll
      for (int e = 0; e < 6; ++e) { const int c = c6 + e, hh = c / 96, d = c % 96; const bf16 v = qp[e];
          if (d < 64) qn[(t * 8 + hh) * 64 + d] = bf2f(v);
          else { const int q = t * 8 + hh, col = 256 + (d - 64); *(LAS bf16*)(L + DT_QOFF + q * DT_ROW + col * 2) = v;
                 if (sp == 0) QD[((size_t)b * 32 + q) * 288 + col] = bf2f(v); } } }
    __syncthreads();
    { const int hh = tid >> 6, rr = tid & 63;
#pragma unroll 1
      for (int j = 0; j < 4; ++j) { const int r = rr + 64 * j; const f32x4* wp = (const f32x4*)(w_uk + ((size_t)r * 8 + hh) * 64); float a0 = 0.f, a1 = 0.f, a2 = 0.f, a3 = 0.f;
#pragma unroll 4
          for (int d4 = 0; d4 < 16; ++d4) { const f32x4 w = wp[d4];
              const f32x4 x0 = *(const LAS f32x4*)(qn + (0 * 8 + hh) * 64 + 4 * d4), x1 = *(const LAS f32x4*)(qn + (1 * 8 + hh) * 64 + 4 * d4), x2 = *(const LAS f32x4*)(qn + (2 * 8 + hh) * 64 + 4 * d4), x3 = *(const LAS f32x4*)(qn + (3 * 8 + hh) * 64 + 4 * d4);
              a0 += (w[0] * x0[0] + w[1] * x0[1]) + (w[2] * x0[2] + w[3] * x0[3]); a1 += (w[0] * x1[0] + w[1] * x1[1]) + (w[2] * x1[2] + w[3] * x1[3]);
              a2 += (w[0] * x2[0] + w[1] * x2[1]) + (w[2] * x2[2] + w[3] * x2[3]); a3 += (w[0] * x3[0] + w[1] * x3[1]) + (w[2] * x3[2] + w[3] * x3[3]); }
          const float av[4] = {a0, a1, a2, a3};
#pragma unroll
          for (int t = 0; t < 4; ++t) { const int q = t * 8 + hh; *(LAS bf16*)(L + DT_QOFF + q * DT_ROW + r * 2) = (bf16)f2bf(av[t]);
              if (sp == 0) QD[((size_t)b * 32 + q) * 288 + r] = av[t]; } } }
    DT_STORE(0, st0);
    LBAR();
    DT_LOAD(2, st0);
    bf16x8 qf[18];
#pragma unroll
    for (int kk = 0; kk < 18; ++kk) qf[kk] = *(const LAS bf16x8*)(L + DT_QOFF + (lane & 31) * DT_ROW + ((lane >> 5) << 4) + 32 * kk);
    const int kh = wid & 1, dq = wid >> 1, g = lane >> 4, i16 = lane & 15, hg = g >> 1;
    f32x16 o0 = {}, o1 = {}; float mrun = -1e30f, lrun = 0.f;
    const int arow = (32 * kh + r32) * DT_ROW + (hi << 4);
    const int voff = (32 * kh + 4 * hg + (i16 >> 2)) * DT_ROW + ((64 * dq + 16 * (g & 1) + 4 * (i16 & 3)) << 1);
#define DT_ITER(tl, bufo, bufn, stn, DOSTORE, DOLOAD) do { \
        f32x16 p = {}; \
_Pragma("unroll") \
        for (int g6 = 0; g6 < 3; ++g6) { bf16x8 ka[6]; \
_Pragma("unroll") \
            for (int j = 0; j < 6; ++j) ka[j] = *(const LAS bf16x8*)(L + bufo + arow + 32 * (6 * g6 + j)); \
_Pragma("unroll") \
            for (int j = 0; j < 6; ++j) p = __builtin_amdgcn_mfma_f32_32x32x16_bf16(ka[j], qf[6 * g6 + j], p, 0, 0, 0); } \
        s16x4 vlo[4], vhi[4]; \
_Pragma("unroll") \
        for (int s = 0; s < 2; ++s) \
_Pragma("unroll") \
            for (int dt = 0; dt < 2; ++dt) { const int a0 = bufo + voff + 16 * s * DT_ROW + 64 * dt; vlo[2 * s + dt] = vtr(L + a0); vhi[2 * s + dt] = vtr(L + a0 + 8 * DT_ROW); } \
        float mt = p[0]; \
_Pragma("unroll") \
        for (int r = 1; r < 16; ++r) mt = fmaxf(mt, p[r]); \
        mt = xhalf_max(mt); \
        const float mnew = fmaxf(mrun, mt), alpha = __builtin_amdgcn_exp2f(mrun - mnew); mrun = mnew; \
        float rs = 0.f; \
_Pragma("unroll") \
        for (int r = 0; r < 16; ++r) { p[r] = __builtin_amdgcn_exp2f(p[r] - mnew); rs += p[r]; } \
        rs = xhalf_sum(rs); lrun = lrun * alpha + rs; \
_Pragma("unroll") \
        for (int r = 0; r < 16; ++r) { o0[r] *= alpha; o1[r] *= alpha; } \
_Pragma("unroll") \
        for (int s = 0; s < 2; ++s) { const bf16x8 pb = pack8(p, 8 * s); \
_Pragma("unroll") \
            for (int dt = 0; dt < 2; ++dt) { const s16x4 lo = vlo[2 * s + dt], hh = vhi[2 * s + dt]; \
                const bf16x8 va = {lo[0], lo[1], lo[2], lo[3], hh[0], hh[1], hh[2], hh[3]}; \
                if (dt == 0) o0 = __builtin_amdgcn_mfma_f32_32x32x16_bf16(va, pb, o0, 0, 0, 0); else o1 = __builtin_amdgcn_mfma_f32_32x32x16_bf16(va, pb, o1, 0, 0, 0); } } \
        if (DOSTORE) DT_STORE(bufn, stn); \
        LBAR(); \
        if (DOLOAD) DT_LOAD((tl) + 3, stn); } while (0)
    for (int tl = 0; tl < NTL; tl += 2) { DT_ITER(tl, 0, DT_TILE, st1, (tl) + 1 < NTL, true); DT_ITER(tl + 1, DT_TILE, 0, st0, (tl) + 2 < NTL, true); }
#undef DT_ITER
#undef DT_LOAD
#undef DT_STORE
    { LAS float* ow = (LAS float*)L + (size_t)wid * 2048;
#pragma unroll
      for (int dt = 0; dt < 2; ++dt)
#pragma unroll
          for (int r = 0; r < 16; ++r) ow[(32 * dt + crow(r, hi)) * 32 + r32] = dt ? o1[r] : o0[r];
      if (hi == 0) { ml[wid * 64 + r32] = mrun; ml[wid * 64 + 32 + r32] = lrun; } }
    __syncthreads();
    { const int q = tid & 31, dvg = tid >> 5, dqq = dvg >> 2;
      const float m0 = ml[(2 * dqq) * 64 + q], m1 = ml[(2 * dqq + 1) * 64 + q], ms = fmaxf(m0, m1);
      const float w0 = __builtin_amdgcn_exp2f(m0 - ms), w1 = __builtin_amdgcn_exp2f(m1 - ms);
      const float ls = w0 * ml[(2 * dqq) * 64 + 32 + q] + w1 * ml[(2 * dqq + 1) * 64 + 32 + q];
#pragma unroll
      for (int j = 0; j < 16; ++j) { const int dv = dvg * 16 + j, dvl = dv & 63;
          PART[dv * 32 + q] = w0 * ((LAS float*)L)[(size_t)(2 * dqq) * 2048 + dvl * 32 + q] + w1 * ((LAS float*)L)[(size_t)(2 * dqq + 1) * 2048 + dvl * 32 + q]; }
      if (dvg == 0) { PART[8192 + q] = ms; PART[8192 + 32 + q] = ls; } }
    __syncthreads();
}
__device__ __forceinline__ void dcombine_unit(Frame& F, const Args& A, int b) {
    const float* PART = WS_PTR(float, WS_PART) + (size_t)b * NSPLIT * PART_F; const float* QD = WS_PTR(float, WS_QD) + (size_t)b * 32 * 288; bf16* OP = WS_PTR(bf16, WS_OP);
    const float* ckv = F.out + O_CKV + (size_t)(MP + 4 * b) * 256; const float* kr = F.out + O_KR + (size_t)(MP + 4 * b) * 32; const float* w_uv = (const float*)A.in[28];
    int tid = threadIdx.x; asm volatile("" : "+v"(tid));
    LAS float* lat = (LAS float*)F.lds; LAS float* sn = lat + 8192; LAS float* ck = sn + 128; LAS float* qd = ck + 1152;
    for (int i = tid; i < 1024; i += 512) ck[(i >> 8) * 288 + (i & 255)] = ckv[i];
    if (tid < 128) ck[(tid >> 5) * 288 + 256 + (tid & 31)] = kr[tid];
    for (int i = tid; i < 32 * 288; i += 512) qd[(i / 288) * 289 + (i % 288)] = QD[i];
    __syncthreads();
    { const int q = tid >> 4, part = tid & 15; float a[4] = {0.f, 0.f, 0.f, 0.f};
#pragma unroll
      for (int i = 0; i < 18; ++i) { const int r = part * 18 + i; const float x = qd[q * 289 + r];
#pragma unroll
          for (int s = 0; s < 4; ++s) a[s] += x * ck[s * 288 + r]; }
#pragma unroll
      for (int s = 0; s < 4; ++s) { float v = a[s]; v += __shfl_xor(v, 1); v += __shfl_xor(v, 2); v += __shfl_xor(v, 4); v += __shfl_xor(v, 8); a[s] = v; }
      if (part < 4) sn[q * 4 + part] = (part <= (q >> 3)) ? a[part] : -INFINITY; }
    __syncthreads();
    { const int q = tid & 31, dvg = tid >> 5; float mk[NSPLIT], ms = -1e30f;
#pragma unroll
      for (int s = 0; s < NSPLIT; ++s) { mk[s] = PART[(size_t)s * PART_F + 8192 + q]; ms = fmaxf(ms, mk[s]); }
      float pn[4];
#pragma unroll
      for (int s = 0; s < 4; ++s) { pn[s] = sn[q * 4 + s]; ms = fmaxf(ms, pn[s]); }
      float wg[NSPLIT], ls = 0.f;
#pragma unroll
      for (int s = 0; s < NSPLIT; ++s) { wg[s] = __builtin_amdgcn_exp2f(mk[s] - ms); ls += wg[s] * PART[(size_t)s * PART_F + 8192 + 32 + q]; }
#pragma unroll
      for (int s = 0; s < 4; ++s) { pn[s] = __builtin_amdgcn_exp2f(pn[s] - ms); ls += pn[s]; }
      const float rl = 1.0f / ls;
#pragma unroll 1
      for (int j0 = 0; j0 < 16; j0 += 4) { float pv[4][NSPLIT];
#pragma unroll
          for (int j = 0; j < 4; ++j)
#pragma unroll
              for (int s = 0; s < NSPLIT; ++s) pv[j][s] = PART[(size_t)s * PART_F + (dvg * 16 + j0 + j) * 32 + q];
#pragma unroll
          for (int j = 0; j < 4; ++j) { const int dv = dvg * 16 + j0 + j; float acc = 0.f;
#pragma unroll
              for (int s = 0; s < NSPLIT; ++s) acc += wg[s] * pv[j][s];
#pragma unroll
              for (int s = 0; s < 4; ++s) acc += pn[s] * ck[s * 288 + dv];
              lat[q * 256 + dv] = acc * rl; } } }
    __syncthreads();
    { const int hh = tid >> 6, v = tid & 63; float a[4] = {0.f, 0.f, 0.f, 0.f};
#pragma unroll 1
      for (int r0 = 0; r0 < 256; r0 += 32) { float w[32];
#pragma unroll
          for (int i = 0; i < 32; ++i) w[i] = w_uv[((size_t)(r0 + i) * 8 + hh) * 64 + v];
#pragma unroll
          for (int i = 0; i < 32; ++i)
#pragma unroll
              for (int t = 0; t < 4; ++t) a[t] += w[i] * lat[(t * 8 + hh) * 256 + r0 + i]; }
#pragma unroll
      for (int t = 0; t < 4; ++t) OP[(size_t)(MP + 4 * b + t) * DM + hh * 64 + v] = (bf16)f2bf(a[t]); }
    __syncthreads();
}
__device__ __forceinline__ void attn_phase(Frame& F, const Args& A) {
    const bool dfirst = ((F.bx >> 3) & 1) != 0;
#pragma unroll 1
    for (int part = 0; part < 2; ++part) {
#ifndef ATT_NO_D
        if ((part == 0) == dfirst) { for (int rd = 0; rd < NREP(17); ++rd) for (int du = F.bx; du < 128 * NSPLIT; du += F.G) dattn_unit(F, A, du); }
        else
#endif
#ifndef ATT_NO_P
        { for (int rp = 0; rp < NREP(18); ++rp) for (int pr2 = 2 * F.bx; pr2 < 512; pr2 += 2 * F.G) {
#pragma unroll 1
                   for (int e = 0; e < 2; ++e) { const int pr = pr2 >> 1, bh = pr >> 4, s = pr & 15; pattn_unit(F, bh >> 3, bh & 7, e ? s : 31 - s); } } }
#else
        {}
#endif
    }
}
constexpr int N_PHASE_IDS = 43;
#ifndef PHMASK
#define PHMASK 0xFFFFFFFFu
#endif
#define EN(n) (((PHMASK) >> (n)) & 1u)
#define REPSEAM(n) do { if (rep_ + 1 < NREP(n) && args.use_bar) xcd_barrier(bar); } while (0)
#ifndef MK_ONE_LAUNCH
#define MK_ONE_LAUNCH 1
#endif
__global__ void __launch_bounds__(NWAVES * 64, 2) mk_fwd(Args args) {
    extern __shared__ __attribute__((aligned(16))) unsigned char lds[];
    Frame F;
    F.lds = (LAS unsigned char*)lds; F.MISC = (volatile LAS unsigned*)(F.lds + MISC_OFF);
    F.tid = threadIdx.x; F.lane = F.tid & 63; F.wave = __builtin_amdgcn_readfirstlane(F.tid >> 6); F.G = gridDim.x; F.bx = blockIdx.x;
    F.ws = args.ws; F.out = args.out; F.ctl = (gu32*)(args.ws + WS_CTL);
    for (int u = F.tid; u < (LDS_BYTES - LDSCTL_OFF) / 4; u += NWAVES * 64) ((LAS unsigned*)(F.lds + LDSCTL_OFF))[u] = 0u;
    __syncthreads();
    XcdBarrier bar; bar.bar = (unsigned*)(F.ctl + CW_BAR); bar.x = 0; bar.st = nullptr;
    if (args.use_bar) bar = xcd_barrier_post((unsigned*)(F.ctl + CW_BAR), F.MISC + 8);
    const int lo = args.ph_lo, hi = args.ph_hi;
#define RUN(k) (lo <= (k) && (k) < hi)
#define FRESH() do { int t_ = threadIdx.x; asm volatile("" : "+v"(t_)); F.tid = t_; F.lane = t_ & 63; F.wave = __builtin_amdgcn_readfirstlane(t_ >> 6); \
    { unsigned char* w_ = args.ws; asm volatile("" : "+s"(w_)); F.ws = w_; float* o_ = args.out; asm volatile("" : "+s"(o_)); F.out = o_; } } while (0)
#define SEAM(k) do { if (args.use_bar && (k) + 1 < hi) xcd_barrier(bar); } while (0)
    LAS unsigned char* ring = F.lds;
    const float* xin_p = (const float*)args.in[0]; const float* xin_s = (const float*)args.in[1] - (size_t)MP * DM;
#define X WS_PTR(float, WS_X)
#define H WS_PTR(bf16, WS_H)
#define ACT WS_PTR(bf16, WS_ACT)
#define Z WS_PTR(bf16, WS_Z)
#define OP WS_PTR(bf16, WS_OP)
#define MOD WS_PTR(float, WS_MOD)
    const float* norm_g = (const float*)args.in[12];

    if (EN(0) && RUN(0)) { for (int rep_ = 0; rep_ < NREP(0); ++rep_) { FRESH(); p0_prologue(F, args); REPSEAM(0); } SEAM(0); }
    if (EN(1) && RUN(1)) { for (int rep_ = 0; rep_ < NREP(1); ++rep_) { FRESH(); pg8::Gemm g{WS_PTR(bf16, WS_SC), WS_PTR(bf16, WS_ADAT), 256, MODLD, DM, DM, DM}; pg8::StaticOrder S; S.init(256, MODLD, F.G, F.bx);
        pg8::EpiMod E{MOD, (const float*)args.in[11]};
        pg8::gemm_phase<pg8::EpiMod, pg8::StaticOrder, true, true>(ring, g, S, E); REPSEAM(1); } SEAM(1); }
    for (int i = 0; i < 4; ++i) {
        const int pb = 2 + 10 * i, l = i >> 1, f = i & 1;
        const float* src_p = (i == 0) ? xin_p : X; const float* src_s = (i == 0) ? xin_s : X;
        const float* modl = MOD + l * 9216;
        if (EN(2) && RUN(pb + 0)) { for (int rep_ = 0; rep_ < NREP(2); ++rep_) { FRESH(); nm_phase(F, src_p, src_s, norm_g + (l * 3 + (f ? 2 : 0)) * DM, modl + (f ? 6 : 0) * DM, H, X, WS_PTR(float, WS_SLAB), (i == 0 || rep_ > 0) ? 0 : (f ? 4 : 11), (f ? MOD + (l) * 9216 + 5 * DM : MOD + (l - 1) * 9216 + 8 * DM), f ? 1.0f : 0.5f); REPSEAM(2); } SEAM(pb + 0); }
        if (EN(3) && RUN(pb + 1)) { for (int rep_ = 0; rep_ < NREP(3); ++rep_) { FRESH(); pg8::Gemm g{H, WS_PTR(bf16, WS_W13T + (size_t)i * W13T_STRIDE), MT, 2 * FF, DM, DM, DM}; pg8::StaticOrder S; S.init(MT, 2 * FF, F.G, F.bx);
            pg8::EpiSwiglu E{ACT, FF};
            pg8::gemm_phase<pg8::EpiSwiglu, pg8::StaticOrder, true, true>(ring, g, S, E); REPSEAM(3); } SEAM(pb + 1); }
        if (EN(4) && RUN(pb + 2)) { for (int rep_ = 0; rep_ < NREP(4); ++rep_) { FRESH();
            { pg8::Gemm g{ACT, WS_PTR(bf16, WS_W2T + (size_t)i * W2T_STRIDE), MP, DM, FF, FF, FF}; pg8::StaticOrder S; S.init(MP, DM, F.G, F.bx);
              pg8::EpiRes E{src_p, src_s, rep_ ? WS_PTR(float, WS_DUMMY) : X, modl + (f ? 8 : 2) * DM, 0.5f};
              pg8::gemm_phase<pg8::EpiRes, pg8::StaticOrder, true, true>(ring, g, S, E); }
            __syncthreads();
            { pg8::Gemm g{ACT, WS_PTR(bf16, WS_W2T + (size_t)i * W2T_STRIDE), MT, DM, args.k_kv, FF, FF}; pg8::SplitKOrder S{MP / 256, 2, 4, 11, 256, F.G, F.bx};
              pg8::EpiPartial E{WS_PTR(float, WS_SLAB)};
              pg8::gemm_phase<pg8::EpiPartial, pg8::SplitKOrder, true, true>(ring, g, S, E); }
            REPSEAM(4); } SEAM(pb + 2); }
        if (f == 0) {
            if (EN(5) && RUN(pb + 3)) { for (int rep_ = 0; rep_ < NREP(2); ++rep_) { FRESH(); nm_phase(F, X, X, norm_g + (l * 3 + 1) * DM, modl + 3 * DM, H, X, WS_PTR(float, WS_SLAB), rep_ ? 0 : 11, modl + 2 * DM, 0.5f); REPSEAM(2); } SEAM(pb + 3); }
            if (EN(6) && RUN(pb + 4)) { for (int rep_ = 0; rep_ < NREP(6); ++rep_) { FRESH(); const int NZ = l ? ZO : ZE; pg8::Gemm g{H, WS_PTR(bf16, l ? WS_ODIN : WS_EVIN), MT, NZ, DM, DM, DM}; pg8::StaticOrder S; S.init(MT, NZ, F.G, F.bx);
                pg8::EpiPlain E{Z, NZ};
                pg8::gemm_phase<pg8::EpiPlain, pg8::StaticOrder, true, true>(ring, g, S, E); REPSEAM(6); } SEAM(pb + 4); }
            if (RUN(pb + 5)) { if (l == 0) { if (EN(7)) for (int rep_ = 0; rep_ < NREP(7); ++rep_) { FRESH(); even_mid_phase(F, args); REPSEAM(7); } } else { if (EN(8)) for (int rep_ = 0; rep_ < NREP(8); ++rep_) { FRESH(); odd_thin_phase(F, args); REPSEAM(8); } } SEAM(pb + 5); }
            if (RUN(pb + 6)) { FRESH();
                if (l == 0) { if (EN(9)) gla_g2_phase(F); }
                else { for (int rep_ = 0; rep_ < NREP(10); ++rep_) { FRESH(); if (EN(10)) { pg8::Gemm g{WS_PTR(bf16, WS_CQN), WS_PTR(bf16, WS_WUQ), MT, 768, args.k_q, args.k_q, args.k_q}; pg8::StaticOrder S; S.init(MT, 768, F.G, F.bx);
                         pg8::EpiQ E{WS_PTR(bf16, WS_Q), WS_PTR(float, WS_RT)};
                         pg8::gemm_phase<pg8::EpiQ, pg8::StaticOrder, true, true>(ring, g, S, E); }
                       __syncthreads();
                       if (EN(16)) { const int nkv = opaque_int(1024), mkv = opaque_int(MP); pg8::Gemm g{WS_PTR(bf16, WS_CKVB), WS_PTR(bf16, WS_WKV), mkv, nkv, args.k_kv, args.k_kv, args.k_kv}; pg8::StaticOrder S; S.init(mkv, nkv, F.G, F.bx);
                         pg8::EpiPlain E{WS_PTR(bf16, WS_KV), nkv};
                         pg8::gemm_phase<pg8::EpiPlain, pg8::StaticOrder, true, true>(ring, g, S, E); } REPSEAM(10); } }
                SEAM(pb + 6); }
            if (RUN(pb + 7)) { if (l == 0) { if (EN(11)) for (int rep_ = 0; rep_ < NREP(11); ++rep_) { FRESH(); for (int u = F.bx; u < 1024; u += F.G) gla_g3_unit(F, args, u); REPSEAM(11); } } else { if (EN(12)) for (int rep_ = 0; rep_ < NREP(12); ++rep_) { FRESH(); attn_phase(F, args); REPSEAM(12); } } SEAM(pb + 7); }
            if (RUN(pb + 8)) { FRESH(); if (l == 1) { if (EN(13)) for (int rep_ = 0; rep_ < NREP(13); ++rep_) { for (int b = F.bx; b < 128; b += F.G) dcombine_unit(F, args, b); REPSEAM(13); } SEAM(pb + 8); } }
            if (EN(14) && RUN(pb + 9)) { for (int rep_ = 0; rep_ < NREP(14); ++rep_) { FRESH();
                { pg8::Gemm g{OP, WS_PTR(bf16, l ? WS_ODOUT : WS_EVOUT), MP, DM, DM, DM, DM}; pg8::StaticOrder S; S.init(MP, DM, F.G, F.bx);
                  pg8::EpiRes E{X, X, rep_ ? WS_PTR(float, WS_DUMMY) : X, modl + 5 * DM, 1.0f};
                  pg8::gemm_phase<pg8::EpiRes, pg8::StaticOrder, true, true>(ring, g, S, E); }
                __syncthreads();
                { pg8::Gemm g{OP, WS_PTR(bf16, l ? WS_ODOUT : WS_EVOUT), MT, DM, args.k_kv, DM, DM}; pg8::SplitKOrder S{MP / 256, 2, 4, 4, 256, F.G, F.bx};
                  pg8::EpiPartial E{WS_PTR(float, WS_SLAB)};
                  pg8::gemm_phase<pg8::EpiPartial, pg8::SplitKOrder, true, true>(ring, g, S, E); }
                REPSEAM(14); } SEAM(pb + 9); }
        }
    }
    if (EN(15) && RUN(42)) { for (int rep_ = 0; rep_ < NREP(15); ++rep_) { FRESH(); final_phase(F, X, (const float*)args.in[34], F.out + O_Y, WS_PTR(float, WS_SLAB), 11, MOD + 9216 + 8 * DM, 0.5f); REPSEAM(15); } }
#undef RUN
#undef SEAM
#undef X
#undef H
#undef ACT
#undef Z
#undef OP
#undef MOD
}

extern "C" void kernel_launch(void* const* d_in, const int* in_sizes, int n_in, void* d_out, int out_size, void* d_ws, size_t ws_size, hipStream_t stream) {
    static int grid = 0;
    if (grid == 0) {
        if (n_in != 35 || (size_t)out_size != O_END || ws_size < WS_END) { fprintf(stderr, "kernel_launch: unexpected shapes: n_in %d out %d ws %zu\n", n_in, out_size, ws_size); grid = -1; return; }
        int dev = 0, cus = 0, per_cu = 0;
        if (hipGetDevice(&dev) != hipSuccess || hipDeviceGetAttribute(&cus, hipDeviceAttributeMultiprocessorCount, dev) != hipSuccess) { grid = -1; return; }
        if (hipFuncSetAttribute((const void*)mk_fwd, hipFuncAttributeMaxDynamicSharedMemorySize, LDS_BYTES) != hipSuccess) { fprintf(stderr, "kernel_launch: hipFuncSetAttribute failed\n"); grid = -1; return; }
        if (hipOccupancyMaxActiveBlocksPerMultiprocessor(&per_cu, (const void*)mk_fwd, NWAVES * 64, LDS_BYTES) != hipSuccess || per_cu < 1) fprintf(stderr, "kernel_launch: occupancy query says %d\n", per_cu);
        (void)hipGetLastError();
        grid = cus;
    }
    if (grid < 0) return;
    if (hipMemsetAsync((char*)d_ws + WS_CTL, 0, CTL_ZERO_BYTES, stream) != hipSuccess) return;
    Args a{};
    for (int i = 0; i < 35; ++i) a.in[i] = d_in[i];
    a.out = (float*)d_out; a.ws = (unsigned char*)d_ws; a.k_q = 384; a.k_kv = 256; a.pad = 0;
#if MK_ONE_LAUNCH
    a.ph_lo = 0; a.ph_hi = N_PHASE_IDS; a.use_bar = 1;
    hipLaunchKernelGGL(mk_fwd, dim3(grid), dim3(NWAVES * 64), LDS_BYTES, stream, a);
#else
    for (int id = 0; id < N_PHASE_IDS; ++id) {
        if (id >= 2 && id < 42) { const int i = (id - 2) / 10, k = (id - 2) % 10; if (k >= 3 && (i & 1)) continue; if (k == 8 && i == 0) continue; }
        a.ph_lo = id; a.ph_hi = id + 1; a.use_bar = 0;
        hipLaunchKernelGGL(mk_fwd, dim3(grid), dim3(NWAVES * 64), LDS_BYTES, stream, a);
    }
#endif
}
```
